# Optimizing an MI355X kernel written in HIP

```python
import jax, jax.numpy as jnp
from jax import lax
import numpy as np

D_MODEL = 1024
BATCH = 32
SEQ = 256
DEPTH = 4
DEC_BATCH = 8
DEC_SEQ = 2048
PAST_LEN = 256

GRID_W = 64
N_EVEN = (DEPTH + 1) // 2
N_ODD = DEPTH // 2
ROPE_BASE = 10000.0
EPS = 1e-6
Q_BLOCK = 128
NEG_INF = -1e30

MLA_HEADS = 8
MLA_NOPE = 64
MLA_ROPE = 32
MLA_V = 64
MLA_Q_RANK = 384
MLA_KV_RANK = 256
MLA_WIDTH = MLA_HEADS * MLA_V
MLA_SCALE = (MLA_NOPE + MLA_ROPE) ** -0.5
POOL_WINDOWS = (2, 4, 8, 16)
POOL_GROUPS = 4
POOL_GROUP_W = D_MODEL // 8
POOL_WIDTH = POOL_GROUPS * POOL_GROUP_W
A_IN = MLA_Q_RANK + MLA_KV_RANK + MLA_ROPE + MLA_WIDTH + 2 * POOL_WIDTH
A_MIX = MLA_WIDTH + POOL_WIDTH
SWA_HEADS = 16
SWA_KV_HEADS = 4
SWA_HEAD_DIM = 64
SWA_WINDOW = 128
SWA_WIDTH = SWA_HEADS * SWA_HEAD_DIM
SWA_KV_W = SWA_KV_HEADS * SWA_HEAD_DIM
SWA_SCALE = SWA_HEAD_DIM ** -0.5
C_IN = 2 * SWA_WIDTH + 2 * SWA_KV_W

kernel_name = "hybrid_diffusion_mla_pool_swa_step"


def rmsnorm(x, g):
    xf = x.astype(jnp.float32)
    y = xf * lax.rsqrt(jnp.mean(xf * xf, axis=-1, keepdims=True) + EPS)
    return (y * g.astype(jnp.float32)).astype(x.dtype)


def ada_mod(cvec, w, b):
    m = jax.nn.silu(cvec) @ w + b
    shift, scale, gate = jnp.split(m, 3, axis=-1)
    return shift[:, None], scale[:, None], gate[:, None]


def modulate(x, mod, g):
    shift, scale, _ = mod
    return rmsnorm(x, g) * (1 + scale) + shift


def grid_positions(T):
    rows = T // GRID_W
    row = jnp.repeat(jnp.arange(rows, dtype=jnp.float32), GRID_W)
    col = jnp.tile(jnp.arange(GRID_W, dtype=jnp.float32), rows)
    return row, col


def _rope_1d(x, pos):
    n = x.shape[-1]
    inv = ROPE_BASE ** (-jnp.arange(0, n, 2, dtype=jnp.float32) / n)
    ang = pos[:, None] * inv[None]
    cos = jnp.cos(ang)[None, :, None, :]
    sin = jnp.sin(ang)[None, :, None, :]
    x1, x2 = x[..., : n // 2], x[..., n // 2:]
    return jnp.concatenate([x1 * cos - x2 * sin, x1 * sin + x2 * cos], axis=-1)


def rope_2d(x):
    T, R = x.shape[1], x.shape[-1]
    row, col = grid_positions(T)
    xf = x.astype(jnp.float32)
    out = jnp.concatenate([_rope_1d(xf[..., : R // 2], row), _rope_1d(xf[..., R // 2:], col)], axis=-1)
    return out.astype(x.dtype)


def dense_attention(q, k, v, scale, sink=None):
    B, T, H, d = q.shape
    KH = k.shape[2]
    G = H // KH
    dv = v.shape[-1]
    nb = T // Q_BLOCK
    qb = q.reshape(B, nb, Q_BLOCK, KH, G, d).transpose(1, 0, 2, 3, 4, 5)

    def block(qi):
        s = jnp.einsum('bqkgd,bskd->bkgqs', qi, k).astype(jnp.float32) * scale
        if sink is not None:
            sk = jnp.broadcast_to(sink.astype(jnp.float32).reshape(1, KH, G, 1, 1), s.shape[:-1] + (1,))
            p = jax.nn.softmax(jnp.concatenate([s, sk], axis=-1), axis=-1)[..., :-1]
        else:
            p = jax.nn.softmax(s, axis=-1)
        return jnp.einsum('bkgqs,bskd->bqkgd', p.astype(v.dtype), v)

    o = lax.map(block, qb)
    return o.transpose(1, 0, 2, 3, 4, 5).reshape(B, T, H, dv)


def banded_attention(q, k, v, ck, cv, sink, scale):
    B, T, H, d = q.shape
    KH = k.shape[2]
    G = H // KH
    W = SWA_WINDOW
    nb = T // W
    P = ck.shape[1]
    qb = q.reshape(B, nb, W, KH, G, d)

    def neighbours(t):
        tp = jnp.pad(t, ((0, 0), (W, W), (0, 0), (0, 0))).reshape(B, nb + 2, W, KH, t.shape[-1])
        return jnp.concatenate([tp[:, :-2], tp[:, 1:-1], tp[:, 2:]], axis=2)

    kw, vw = neighbours(k), neighbours(v)
    s_loc = jnp.einsum('bnqkgd,bnskd->bnkgqs', qb, kw).astype(jnp.float32) * scale
    qpos = jnp.arange(nb)[:, None] * W + jnp.arange(W)[None]
    kpos = (jnp.arange(nb)[:, None] - 1) * W + jnp.arange(3 * W)[None]
    rel = kpos[:, None, :] - qpos[:, :, None]
    valid = (jnp.abs(rel) <= SWA_WINDOW) & (kpos[:, None, :] >= 0) & (kpos[:, None, :] < T)
    s_loc = jnp.where(valid[None, :, None, None], s_loc, NEG_INF)
    s_ctx = jnp.einsum('bnqkgd,bpkd->bnkgqp', qb, ck).astype(jnp.float32) * scale
    sk = jnp.broadcast_to(sink.astype(jnp.float32).reshape(1, 1, KH, G, 1, 1), s_loc.shape[:-1] + (1,))
    p = jax.nn.softmax(jnp.concatenate([s_loc, s_ctx, sk], axis=-1), axis=-1)
    L = 3 * W
    p_loc = p[..., :L].astype(v.dtype)
    p_ctx = p[..., L:L + P].astype(v.dtype)
    o = jnp.einsum('bnkgqs,bnskd->bnqkgd', p_loc, vw) + jnp.einsum('bnkgqp,bpkd->bnqkgd', p_ctx, cv)
    return o.reshape(B, T, H, v.shape[-1])


def multiscale_pool(v, w_pool, s_pool):
    B, T, _ = v.shape
    vf = v.astype(jnp.float32).reshape(B, T, POOL_GROUPS, POOL_GROUP_W)
    S = jnp.concatenate([jnp.zeros((B, 1, POOL_GROUPS, POOL_GROUP_W), jnp.float32), lax.cumsum(vf, axis=1)], axis=1)
    t = jnp.arange(T)
    outs = []
    for g, w in enumerate(POOL_WINDOWS):
        lo = jnp.clip(t - w // 2, 0, T)
        hi = jnp.clip(t + w // 2, 0, T)
        cnt = (hi - lo).astype(jnp.float32)[None, :, None]
        outs.append((S[:, hi, g] - S[:, lo, g]) / cnt)
    pooled = jnp.stack(outs, axis=2) - vf
    y = jnp.einsum('btgc,gce->btge', pooled, w_pool.astype(jnp.float32)).reshape(B, T, POOL_WIDTH)
    return (y * s_pool.astype(jnp.float32)).astype(v.dtype)


def mla_pool_mixer(h, w_in, g_qn, g_kvn, w_uq, w_ukv, w_pool, s_pool, w_out, ctx_ckv=None, ctx_krope=None):
    B, T, _ = h.shape
    i1 = MLA_Q_RANK
    i2 = i1 + MLA_KV_RANK
    i3 = i2 + MLA_ROPE
    i4 = i3 + MLA_WIDTH
    i5 = i4 + POOL_WIDTH
    cq, ckv, krope, gate_a, v_pool, gate_b = jnp.split(h @ w_in, [i1, i2, i3, i4, i5], axis=-1)
    ckv = rmsnorm(ckv, g_kvn)
    q = (rmsnorm(cq, g_qn) @ w_uq).reshape(B, T, MLA_HEADS, MLA_NOPE + MLA_ROPE)
    if ctx_ckv is not None:
        q = jnp.concatenate([q[..., :MLA_NOPE], rope_2d(q[..., MLA_NOPE:])], axis=-1)
        kr_lat = rope_2d(krope[:, :, None, :])
        keys_ckv = jnp.concatenate([ckv, ctx_ckv], axis=1)
        keys_kr = jnp.concatenate([kr_lat, ctx_krope[:, :, None, :]], axis=1)
    else:
        keys_ckv, keys_kr = ckv, krope[:, :, None, :]
    S = keys_ckv.shape[1]
    kv = (keys_ckv @ w_ukv).reshape(B, S, MLA_HEADS, MLA_NOPE + MLA_V)
    k = jnp.concatenate([kv[..., :MLA_NOPE], jnp.broadcast_to(keys_kr, (B, S, MLA_HEADS, MLA_ROPE))], axis=-1)
    v = kv[..., MLA_NOPE:]
    o = dense_attention(q, k, v, MLA_SCALE)
    a = o.reshape(B, T, MLA_WIDTH) * jax.nn.silu(gate_a)
    b = multiscale_pool(v_pool, w_pool, s_pool) * jax.nn.silu(gate_b)
    out = jnp.concatenate([a, b], axis=-1) @ w_out
    return out, ckv, krope


def swa_mixer(h, w_in, sink, w_out, ctx_k=None, ctx_v=None):
    B, T, _ = h.shape
    q, k, v, g = jnp.split(h @ w_in, [SWA_WIDTH, SWA_WIDTH + SWA_KV_W, SWA_WIDTH + 2 * SWA_KV_W], axis=-1)
    q = q.reshape(B, T, SWA_HEADS, SWA_HEAD_DIM)
    k = k.reshape(B, T, SWA_KV_HEADS, SWA_HEAD_DIM)
    v = v.reshape(B, T, SWA_KV_HEADS, SWA_HEAD_DIM)
    if ctx_k is None:
        o = dense_attention(q, k, v, SWA_SCALE, sink)
    else:
        o = banded_attention(rope_2d(q), rope_2d(k), v, ctx_k, ctx_v, sink, SWA_SCALE)
    out = (o.reshape(B, T, SWA_WIDTH) * jax.nn.silu(g)) @ w_out
    return out, k, v


def setup_inputs(seed: int = 0) -> dict:
    key = jax.random.key(seed)
    ks = jax.random.split(key, 23)
    f = jnp.float32
    D = D_MODEL

    def nrm(k, shape, scale=1.0):
        return jax.random.normal(k, shape, f) * scale

    return {
        "x_prompt": nrm(ks[0], (BATCH, SEQ, D)),
        "x_sample": nrm(ks[1], (DEC_BATCH, DEC_SEQ, D)),
        "cache_ckv": nrm(ks[2], (DEC_BATCH, N_EVEN, PAST_LEN, MLA_KV_RANK)),
        "cache_krope": nrm(ks[3], (DEC_BATCH, N_EVEN, PAST_LEN, MLA_ROPE)),
        "cache_k": nrm(ks[4], (DEC_BATCH, N_ODD, PAST_LEN, SWA_KV_HEADS, SWA_HEAD_DIM)),
        "cache_v": nrm(ks[5], (DEC_BATCH, N_ODD, PAST_LEN, SWA_KV_HEADS, SWA_HEAD_DIM)),
        "c": nrm(ks[6], (DEC_BATCH, D)),
        "c_ctx": nrm(ks[7], (D,)),
        "ada_w": nrm(ks[8], (DEPTH, D, 3 * D), D ** -0.5),
        "ada_b": nrm(ks[9], (DEPTH, 3 * D), 0.02),
        "norm_pre": 1.0 + nrm(ks[10], (DEPTH, D), 0.1),
        "norm_post": 1.0 + nrm(ks[11], (DEPTH, D), 0.1),
        "mla_w_in": nrm(ks[12], (N_EVEN, D, A_IN), D ** -0.5),
        "mla_g_qn": 1.0 + nrm(ks[13], (N_EVEN, MLA_Q_RANK), 0.1),
        "mla_g_kvn": 1.0 + nrm(ks[14], (N_EVEN, MLA_KV_RANK), 0.1),
        "mla_w_uq": nrm(ks[15], (N_EVEN, MLA_Q_RANK, MLA_HEADS * (MLA_NOPE + MLA_ROPE)), MLA_Q_RANK ** -0.5),
        "mla_w_ukv": nrm(ks[16], (N_EVEN, MLA_KV_RANK, MLA_HEADS * (MLA_NOPE + MLA_V)), MLA_KV_RANK ** -0.5),
        "pool_w": nrm(ks[17], (N_EVEN, POOL_GROUPS, POOL_GROUP_W, POOL_GROUP_W), POOL_GROUP_W ** -0.5),
        "pool_scale": 1.0 + nrm(ks[18], (N_EVEN, POOL_WIDTH), 0.1),
        "mixa_w_out": nrm(ks[19], (N_EVEN, A_MIX, D), A_MIX ** -0.5),
        "swa_w_in": nrm(ks[20], (N_ODD, D, C_IN), D ** -0.5),
        "swa_sink": nrm(ks[21], (N_ODD, SWA_HEADS)),
        "swa_w_out": nrm(ks[22], (N_ODD, SWA_WIDTH, D), SWA_WIDTH ** -0.5),
    }


def reference(x_prompt, x_sample, cache_ckv, cache_krope, cache_k, cache_v, c, c_ctx,
              ada_w, ada_b, norm_pre, norm_post,
              mla_w_in, mla_g_qn, mla_g_kvn, mla_w_uq, mla_w_ukv, pool_w, pool_scale, mixa_w_out,
              swa_w_in, swa_sink, swa_w_out):
    xp, xs = x_prompt, x_sample
    st_ckv, st_krope, st_k, st_v = [], [], [], []
    for l in range(DEPTH):
        mp = ada_mod(c_ctx[None], ada_w[l], ada_b[l])
        ms = ada_mod(c, ada_w[l], ada_b[l])
        hp = modulate(xp, mp, norm_pre[l])
        hs = modulate(xs, ms, norm_pre[l])
        if l % 2 == 0:
            i = l // 2
            wts = (mla_w_in[i], mla_g_qn[i], mla_g_kvn[i], mla_w_uq[i], mla_w_ukv[i], pool_w[i], pool_scale[i], mixa_w_out[i])
            op, ckv, krope = mla_pool_mixer(hp, *wts)
            os_, _, _ = mla_pool_mixer(hs, *wts, ctx_ckv=cache_ckv[:, i], ctx_krope=cache_krope[:, i])
            st_ckv.append(ckv)
            st_krope.append(krope)
        else:
            i = l // 2
            op, kc, vc = swa_mixer(hp, swa_w_in[i], swa_sink[i], swa_w_out[i])
            os_, _, _ = swa_mixer(hs, swa_w_in[i], swa_sink[i], swa_w_out[i], ctx_k=cache_k[:, i], ctx_v=cache_v[:, i])
            st_k.append(kc)
            st_v.append(vc)
        xp = xp + mp[2] * rmsnorm(op, norm_post[l])
        xs = xs + ms[2] * rmsnorm(os_, norm_post[l])
    state_ckv = jnp.stack(st_ckv, axis=1)
    state_krope = jnp.stack(st_krope, axis=1)
    state_k = jnp.stack(st_k, axis=1)
    state_v = jnp.stack(st_v, axis=1)
    return (xp, xs, state_ckv, state_krope, state_k, state_v)
```

```cpp
#include <hip/hip_runtime.h>
#include <cstdio>
#include <cstdint>

#ifndef MK_PER_PHASE
#define MK_PER_PHASE 0
#endif

#define GAS __attribute__((address_space(1)))
#define LAS __attribute__((address_space(3)))
typedef unsigned short bf16;
typedef short bf16x8 __attribute__((ext_vector_type(8)));
typedef short s16x4 __attribute__((ext_vector_type(4)));
typedef float f32x4 __attribute__((ext_vector_type(4)));
typedef float f32x2 __attribute__((ext_vector_type(2)));
typedef float f32x16 __attribute__((ext_vector_type(16)));
typedef unsigned u32x4 __attribute__((ext_vector_type(4)));
typedef unsigned u32x2 __attribute__((ext_vector_type(2)));
typedef __bf16 bf16x2_t __attribute__((ext_vector_type(2)));

constexpr int D = 1024, RP = 8192, RS = 16384, R = RP + RS;
constexpr int RK = RP + 8 * 2304;
constexpr int NL = 4;
constexpr float EPS = 1e-6f, LOG2E = 1.4426950408889634f;
constexpr float MLA_SC = 0.10206207261596577f * LOG2E;
constexpr float SWA_SC = 0.125f * LOG2E;
constexpr int OFF_CKV = 25165824, OFF_KR = 29360128, OFF_K = 29884416, OFF_V = 34078720, OUT_TOTAL = 38273024;

constexpr size_t MiB = 1u << 20;
constexpr size_t WS_CTL = 0, CTL_ZERO_BYTES = 64 * 1024;
constexpr size_t WS_MOD = 1 * MiB;
constexpr size_t WS_ROPE8 = 1 * MiB + 512 * 1024;
constexpr size_t WS_ROPE16 = WS_ROPE8 + 4096;
constexpr size_t SZ_WIN_MLA = 2304ull * 1024 * 2, SZ_WUQ = 768ull * 384 * 2, SZ_WUKV = 1024ull * 256 * 2, SZ_WPOOL = 512ull * 512 * 2,
                 SZ_WOUT = 1024ull * 1024 * 2, SZ_WIN_SWA = 2560ull * 1024 * 2;
constexpr size_t WS_W = 2 * MiB;
constexpr size_t SZ_W_MLA = SZ_WIN_MLA + SZ_WUQ + SZ_WUKV + SZ_WPOOL + SZ_WOUT, SZ_W_SWA = SZ_WIN_SWA + SZ_WOUT;
constexpr size_t WS_W_MLA0 = WS_W, WS_W_MLA1 = WS_W + SZ_W_MLA, WS_W_SWA0 = WS_W + 2 * SZ_W_MLA, WS_W_SWA1 = WS_W_SWA0 + SZ_W_SWA;
static_assert(WS_W_SWA1 + SZ_W_SWA <= 34 * MiB, "weights");
constexpr size_t WS_H = 34 * MiB;
constexpr size_t WS_GAB = 82 * MiB;
constexpr size_t WS_CQ = 130 * MiB;
constexpr size_t WS_CKV = 148 * MiB;
constexpr size_t WS_KRB = 161 * MiB;
constexpr size_t WS_KRF = 163 * MiB;
constexpr size_t WS_KN = 166 * MiB;
constexpr size_t WS_V = 192 * MiB;
constexpr size_t WS_PO = 218 * MiB;
constexpr size_t WS_SK = 178 * MiB;
constexpr size_t WS_SV = 191 * MiB;
constexpr size_t WS_END = 242 * MiB;

__device__ __forceinline__ unsigned f2bf(float f) { unsigned u = __builtin_bit_cast(unsigned, f); return (u + 0x7fffu + ((u >> 16) & 1u)) >> 16; }
__device__ __forceinline__ unsigned pk2(float lo, float hi) { f32x2 v = {lo, hi}; bf16x2_t b = __builtin_convertvector(v, bf16x2_t); return __builtin_bit_cast(unsigned, b); }
__device__ __forceinline__ float bflo(unsigned w) { return __uint_as_float(w << 16); }
__device__ __forceinline__ float bfhi(unsigned w) { return __uint_as_float(w & 0xffff0000u); }
__device__ __forceinline__ float silu_fast(float x) { return x * __builtin_amdgcn_rcpf(1.f + __builtin_amdgcn_exp2f(-x * LOG2E)); }
__device__ __forceinline__ float wave_sum(float v) {
#pragma unroll
    for (int o = 1; o < 64; o <<= 1) v += __shfl_xor(v, o);
    return v;
}
#define LDS_WAIT() asm volatile("s_waitcnt lgkmcnt(0)" ::: "memory")
__device__ __forceinline__ int opaque_tid() { int t = threadIdx.x; asm volatile("" : "+v"(t)); return t; }

namespace pg8 {
typedef unsigned short bf16_t;
constexpr int BM = 256, BK = 64, HALF = 128, HTB = HALF * BK * 2, STAGE_BYTES = 8 * HTB, NXCD = 8, WGM = 8;
__host__ __device__ __forceinline__ int lds_byte(int r, int c) { const int st = (r >> 4) * 2 + (c >> 5), rr = r & 15, cc = c & 31, ob = rr * 64 + cc * 2; return st * 1024 + (ob ^ (((ob >> 9) & 1) << 5)); }
__host__ __device__ __forceinline__ void stage_rc(int b, int& Rr, int& C) { const int st = b / 1024, sb = b % 1024, swz = sb ^ (((sb >> 9) & 1) << 5); Rr = (st >> 1) * 16 + swz / 64; C = (st & 1) * 32 + (swz % 64) / 2; }
__host__ __device__ __forceinline__ int perm32(int rho) { const int n = rho >> 4, i = rho & 15; return 8 * (i >> 2) + 4 * n + (i & 3); }
struct Unit { int pm, pn; };
struct Gemm { const bf16_t* A; const bf16_t* Bt; int M, N, K, lda; };
struct StaticOrder {
    int nM, nN, nwg, G, c;
    __device__ void init(int M, int N, int G_, int c_) { nM = M / BM; nN = N / BM; nwg = nM * nN; G = G_; c = c_; }
    __device__ bool next(int i, Unit& u) const {
        const long L = (long)i * G + c; if (L >= nwg) return false;
        int wgid = (int)L; { const int q = nwg / NXCD, r = nwg % NXCD, xcd = wgid % NXCD, off = wgid / NXCD; wgid = (xcd < r ? xcd * (q + 1) : r * (q + 1) + (xcd - r) * q) + off; }
        const int nig = WGM * nN, gid = wgid / nig, fm = gid * WGM, gsz = (nM - fm) < WGM ? (nM - fm) : WGM;
        u.pm = fm + ((wgid % nig) % gsz); u.pn = (wgid % nig) / gsz; return true;
    }
};
template <class Epi, bool ALIGN_EPI>
__device__ __forceinline__ void gemm_phase(LAS unsigned char* lds, const Gemm g, const StaticOrder& S, const Epi& E) {
    const int tid = opaque_tid(), wid = __builtin_amdgcn_readfirstlane(tid >> 6), lane = tid & 63, wr = wid >> 2, wc = wid & 3, fr = lane & 15, fq = lane >> 4;
    const int K = g.K, nt = K / BK, lda = g.lda;
    unsigned voffA[2], voffB[2];
#pragma unroll
    for (int i = 0; i < 2; ++i) { int Rr, C; stage_rc(tid * 16 + i * 8192, Rr, C); const int Rb = Epi::PERM ? ((Rr & ~31) + perm32(Rr & 31)) : Rr;
        voffA[i] = (unsigned)(Rr * lda + C) * 2u; voffB[i] = (unsigned)(Rb * K + C) * 2u; }
    const size_t kstep = (size_t)(BK * 2);
    const size_t hA = (size_t)HALF * lda * 2, hB = (size_t)HALF * K * 2, tA = 2 * hA, tB = 2 * hB;
    const unsigned ldsw = (unsigned)wid * 1024u;
    const int aoff = lds_byte(wr * 64 + fr, fq * 8), boff = lds_byte(wc * 32 + fr, fq * 8);
#define PG8_SA(b, h) (((b) * 2 + (h)) * HTB)
#define PG8_SB(b, h) ((4 + (b) * 2 + (h)) * HTB)
#define PG8_STAGE(bufoff, gbase, voff) do { _Pragma("unroll") for (int _i = 0; _i < 2; ++_i) \
        __builtin_amdgcn_global_load_lds((const unsigned*)((const char*)(gbase) + (voff)[_i]), (LAS unsigned*)(lds + (bufoff) + ldsw + _i * 8192), 16, 0, 0); } while (0)
#define PG8_LDA(dst, b, h) do { _Pragma("unroll") for (int m = 0; m < 4; ++m) _Pragma("unroll") for (int k = 0; k < 2; ++k) dst[m][k] = *(const LAS bf16x8*)(lds + PG8_SA(b, h) + aoff + m * 2048 + k * 1024); } while (0)
#define PG8_LDB(dst, b, h) do { _Pragma("unroll") for (int n = 0; n < 2; ++n) _Pragma("unroll") for (int k = 0; k < 2; ++k) dst[n][k] = *(const LAS bf16x8*)(lds + PG8_SB(b, h) + boff + n * 2048 + k * 1024); } while (0)
#define PG8_MMA(ai, bj, At, Bt) do { __builtin_amdgcn_s_setprio(1); _Pragma("unroll") for (int m = 0; m < 4; ++m) _Pragma("unroll") for (int n = 0; n < 2; ++n) _Pragma("unroll") for (int k = 0; k < 2; ++k) \
        acc[ai][bj][m][n] = __builtin_amdgcn_mfma_f32_16x16x32_bf16(Bt[n][k], At[m][k], acc[ai][bj][m][n], 0, 0, 0); __builtin_amdgcn_s_setprio(0); } while (0)
#define PG8_WAIT_V(n) asm volatile("s_waitcnt vmcnt(" #n ")" ::: "memory")
#define PG8_WAIT_L(n) asm volatile("s_waitcnt lgkmcnt(" #n ")" ::: "memory")
#define PG8_BAR __builtin_amdgcn_s_barrier()
#define PG8_SCHED __builtin_amdgcn_sched_barrier(0)
    Unit cur, nxt; int ui = 0;
    if (!S.next(0, cur)) return;
    f32x4 acc[2][2][4][2];
#pragma unroll
    for (int a = 0; a < 2; ++a)
#pragma unroll
        for (int b = 0; b < 2; ++b)
#pragma unroll
            for (int m = 0; m < 4; ++m)
#pragma unroll
                for (int n = 0; n < 2; ++n) acc[a][b][m][n] = (f32x4){0.f, 0.f, 0.f, 0.f};
    const char* cA = (const char*)g.A + (size_t)cur.pm * tA; const char* cB = (const char*)g.Bt + (size_t)cur.pn * tB;
    PG8_STAGE(PG8_SB(0, 0), cB, voffB); PG8_STAGE(PG8_SB(0, 1), cB + hB, voffB); PG8_STAGE(PG8_SA(0, 0), cA, voffA); PG8_STAGE(PG8_SA(0, 1), cA + hA, voffA);
    if (wr == 1) PG8_BAR;
    PG8_WAIT_V(2); PG8_BAR;
    PG8_STAGE(PG8_SB(1, 0), cB + kstep, voffB); PG8_STAGE(PG8_SA(1, 0), cA + kstep, voffA); PG8_STAGE(PG8_SB(1, 1), cB + hB + kstep, voffB);
    PG8_WAIT_V(6); PG8_BAR;
    for (;;) {
        const bool has_next = S.next(ui + 1, nxt);
        const char* nA = has_next ? (const char*)g.A + (size_t)nxt.pm * tA : cA; const char* nB = has_next ? (const char*)g.Bt + (size_t)nxt.pn * tB : cB;
#pragma nounroll
        for (int t = 0; t < nt; t += 2) {
            const bool last = (t == nt - 2);
            bf16x8 At[4][2], B0[2][2], B1[2][2];
            const char* a1 = cA + (size_t)(t + 1) * kstep;
            const char* a2 = last ? nA : cA + (size_t)(t + 2) * kstep; const char* b2 = last ? nB : cB + (size_t)(t + 2) * kstep;
            const char* a3 = a2 + kstep; const char* b3 = b2 + kstep;
            PG8_LDB(B0, 0, 0); PG8_LDB(B1, 0, 1); PG8_SCHED; PG8_LDA(At, 0, 0); PG8_STAGE(PG8_SA(1, 1), a1 + hA, voffA);
            PG8_WAIT_V(8); PG8_WAIT_L(0); PG8_BAR; PG8_MMA(0, 0, At, B0); PG8_MMA(0, 1, At, B1); PG8_BAR; PG8_SCHED;
            PG8_LDA(At, 0, 1); PG8_STAGE(PG8_SB(0, 0), b2, voffB); PG8_STAGE(PG8_SB(0, 1), b2 + hB, voffB); PG8_STAGE(PG8_SA(0, 0), a2, voffA);
            PG8_WAIT_V(8); PG8_WAIT_L(0); PG8_BAR; PG8_MMA(1, 0, At, B0); PG8_MMA(1, 1, At, B1); PG8_BAR; PG8_SCHED;
            PG8_LDB(B0, 1, 0); PG8_LDB(B1, 1, 1); PG8_SCHED; PG8_LDA(At, 1, 0); PG8_STAGE(PG8_SA(0, 1), a2 + hA, voffA);
            PG8_WAIT_V(8); PG8_WAIT_L(0); PG8_BAR; PG8_MMA(0, 0, At, B0); PG8_MMA(0, 1, At, B1); PG8_BAR; PG8_SCHED;
            PG8_LDA(At, 1, 1); PG8_STAGE(PG8_SB(1, 0), b3, voffB); PG8_STAGE(PG8_SB(1, 1), b3 + hB, voffB); PG8_STAGE(PG8_SA(1, 0), a3, voffA);
            PG8_WAIT_V(8); PG8_WAIT_L(0); PG8_BAR; PG8_MMA(1, 0, At, B0); PG8_MMA(1, 1, At, B1); PG8_BAR; PG8_SCHED;
        }
        if constexpr (ALIGN_EPI) { if (wr == 0) PG8_BAR; }
        E(acc, cur, wr, wc, fr, fq);
        if (!has_next) break;
#pragma unroll
        for (int a = 0; a < 2; ++a)
#pragma unroll
            for (int b = 0; b < 2; ++b)
#pragma unroll
                for (int m = 0; m < 4; ++m)
#pragma unroll
                    for (int n = 0; n < 2; ++n) acc[a][b][m][n] = (f32x4){0.f, 0.f, 0.f, 0.f};
        cur = nxt; cA = nA; cB = nB; ++ui;
        if constexpr (ALIGN_EPI) { if (wr == 1) PG8_BAR; }
    }
    PG8_WAIT_V(0);
    if constexpr (!ALIGN_EPI) { if (wr == 0) PG8_BAR; }
    PG8_BAR;
#undef PG8_SA
#undef PG8_SB
#undef PG8_STAGE
#undef PG8_LDA
#undef PG8_LDB
#undef PG8_MMA
#undef PG8_WAIT_V
#undef PG8_WAIT_L
#undef PG8_BAR
#undef PG8_SCHED
}

__device__ __forceinline__ int rk_base(int pm) { return pm < 32 ? pm * 256 : RP + ((pm - 32) >> 3) * 2304 + ((pm - 32) & 7) * 256; }

struct EpiBf16 {
    static constexpr bool PERM = true;
    bf16* O; int ldc; int split_cols; size_t split_stride;
    __device__ __forceinline__ void operator()(const f32x4 (&acc)[2][2][4][2], const Unit& u, int wr, int wc, int fr, int fq) const {
        const int row0 = u.pm * BM + wr * 64 + fr; int colt = u.pn * BM; bf16* base = O;
        if (split_cols) { const int t = colt / split_cols; base += (size_t)t * split_stride; colt -= t * split_cols; }
        const int col0 = colt + wc * 32 + 8 * fq;
#pragma unroll
        for (int ai = 0; ai < 2; ++ai)
#pragma unroll
            for (int m = 0; m < 4; ++m) { bf16* rowp = base + (size_t)(row0 + ai * HALF + m * 16) * ldc + col0;
#pragma unroll
                for (int bj = 0; bj < 2; ++bj) { const f32x4 v0 = acc[ai][bj][m][0], v1 = acc[ai][bj][m][1];
                    u32x4 w; w.x = pk2(v0[0], v0[1]); w.y = pk2(v0[2], v0[3]); w.z = pk2(v1[0], v1[1]); w.w = pk2(v1[2], v1[3]);
                    *(u32x4*)(rowp + bj * HALF) = w; } }
    }
};
struct EpiPool {
    static constexpr bool PERM = true;
    bf16* GB;
    __device__ __forceinline__ void operator()(const f32x4 (&acc)[2][2][4][2], const Unit& u, int wr, int wc, int fr, int fq) const {
        const int row0 = u.pm * BM + wr * 64 + fr; const int col0 = u.pn * BM + wc * 32 + 8 * fq;
#pragma unroll
        for (int ai = 0; ai < 2; ++ai)
#pragma unroll
            for (int m = 0; m < 4; ++m) { bf16* rowp = GB + (size_t)(row0 + ai * HALF + m * 16) * 1024 + col0;
#pragma unroll
                for (int bj = 0; bj < 2; ++bj) { const f32x4 v0 = acc[ai][bj][m][0], v1 = acc[ai][bj][m][1];
                    const u32x4 gg = *(const u32x4*)(rowp + bj * HALF);
                    u32x4 w;
                    w.x = pk2(v0[0] * silu_fast(bflo(gg.x)), v0[1] * silu_fast(bfhi(gg.x))); w.y = pk2(v0[2] * silu_fast(bflo(gg.y)), v0[3] * silu_fast(bfhi(gg.y)));
                    w.z = pk2(v1[0] * silu_fast(bflo(gg.z)), v1[1] * silu_fast(bfhi(gg.z))); w.w = pk2(v1[2] * silu_fast(bflo(gg.w)), v1[3] * silu_fast(bfhi(gg.w)));
                    *(u32x4*)(rowp + bj * HALF) = w; } }
    }
};
struct EpiMlaIn {
    static constexpr bool PERM = true;
    bf16 *CQ, *CKV, *GAB, *VP; float* KRF;
    __device__ __forceinline__ void operator()(const f32x4 (&acc)[2][2][4][2], const Unit& u, int wr, int wc, int fr, int fq) const {
        const int rt = wr * 64 + fr, grow0 = u.pm * BM, rk0 = rk_base(u.pm), cc = wc * 32 + 8 * fq;
#pragma unroll
        for (int bj = 0; bj < 2; ++bj) {
            const int U = 2 * u.pn + bj;
            if (U == 5) {
                if (wc == 0) {
#pragma unroll
                    for (int ai = 0; ai < 2; ++ai)
#pragma unroll
                        for (int m = 0; m < 4; ++m) { float* p = KRF + (size_t)(grow0 + rt + ai * HALF + m * 16) * 32 + 8 * fq;
                            *(f32x4*)p = acc[ai][bj][m][0]; *(f32x4*)(p + 4) = acc[ai][bj][m][1]; }
                }
                continue;
            }
            bf16* p; int ld, rb = grow0;
            if (U < 3) { p = CQ + 128 * U; ld = 384; }
            else if (U < 5) { p = CKV + 128 * (U - 3); ld = 256; rb = rk0; }
            else if (U < 10) { p = GAB + 128 * (U - 6); ld = 1024; }
            else if (U < 14) { p = VP + 128 * (U - 10); ld = 512; }
            else { p = GAB + 512 + 128 * (U - 14); ld = 1024; }
            p += (size_t)(rb + rt) * ld + cc;
#pragma unroll
            for (int ai = 0; ai < 2; ++ai)
#pragma unroll
                for (int m = 0; m < 4; ++m) { const f32x4 v0 = acc[ai][bj][m][0], v1 = acc[ai][bj][m][1];
                    u32x4 w; w.x = pk2(v0[0], v0[1]); w.y = pk2(v0[2], v0[3]); w.z = pk2(v1[0], v1[1]); w.w = pk2(v1[2], v1[3]);
                    *(u32x4*)(p + (size_t)(ai * HALF + m * 16) * ld) = w; }
        }
    }
};
struct EpiQ {
    static constexpr bool PERM = false;
    bf16* Q; const float* rope8;
    __device__ __forceinline__ void operator()(const f32x4 (&acc)[2][2][4][2], const Unit& u, int wr, int wc, int fr, int fq) const {
        const int rt = wr * 64 + fr, grow0 = u.pm * BM; const bool sample = u.pm >= 32; const int t0 = ((u.pm - 32) & 7) * 256;
#pragma unroll
        for (int bj = 0; bj < 2; ++bj) {
            const int g32 = 8 * u.pn + 4 * bj + wc; const bool rot = sample && (g32 % 3 == 2);
#pragma unroll
            for (int ai = 0; ai < 2; ++ai)
#pragma unroll
                for (int m = 0; m < 4; ++m) { const int r = rt + ai * HALF + m * 16; f32x4 x1 = acc[ai][bj][m][0], x2 = acc[ai][bj][m][1];
                    if (rot) { const int t = t0 + r, pos = (fq < 2) ? (t >> 6) : (t & 63); const float* tb = rope8 + (pos * 8 + 4 * (fq & 1)) * 2;
                        const f32x4 c0 = *(const f32x4*)tb, c1 = *(const f32x4*)(tb + 4);
                        const f32x4 cs = {c0[0], c0[2], c1[0], c1[2]}, sn = {c0[1], c0[3], c1[1], c1[3]};
                        const f32x4 o1 = x1 * cs - x2 * sn, o2 = x1 * sn + x2 * cs; x1 = o1; x2 = o2; }
                    bf16* p = Q + (size_t)(grow0 + r) * 768 + 32 * g32 + 4 * fq;
                    u32x2 w1, w2; w1.x = pk2(x1[0], x1[1]); w1.y = pk2(x1[2], x1[3]); w2.x = pk2(x2[0], x2[1]); w2.y = pk2(x2[2], x2[3]);
                    *(u32x2*)p = w1; *(u32x2*)(p + 16) = w2; }
        }
    }
};
struct EpiSwaIn {
    static constexpr bool PERM = false;
    bf16 *Q, *K, *V, *G; float *stK, *stV; const float* rope16;
    __device__ __forceinline__ void operator()(const f32x4 (&acc)[2][2][4][2], const Unit& u, int wr, int wc, int fr, int fq) const {
        const int rt = wr * 64 + fr, grow0 = u.pm * BM, rk0 = rk_base(u.pm); const bool sample = u.pm >= 32; const int t0 = ((u.pm - 32) & 7) * 256;
        const int pn = u.pn;
#pragma unroll
        for (int bj = 0; bj < 2; ++bj) {
            const int cb = 128 * bj + 32 * wc + 4 * fq;
            const bool rot = sample && pn < 5;
#pragma unroll
            for (int ai = 0; ai < 2; ++ai)
#pragma unroll
                for (int m = 0; m < 4; ++m) { const int r = rt + ai * HALF + m * 16; f32x4 x1 = acc[ai][bj][m][0], x2 = acc[ai][bj][m][1];
                    if (rot) { const int t = t0 + r, pos = (wc & 1) ? (t & 63) : (t >> 6); const float* tb = rope16 + (pos * 16 + 4 * fq) * 2;
                        const f32x4 c0 = *(const f32x4*)tb, c1 = *(const f32x4*)(tb + 4);
                        const f32x4 cs = {c0[0], c0[2], c1[0], c1[2]}, sn = {c0[1], c0[3], c1[1], c1[3]};
                        const f32x4 o1 = x1 * cs - x2 * sn, o2 = x1 * sn + x2 * cs; x1 = o1; x2 = o2; }
                    bf16* p;
                    if (pn < 4) p = Q + (size_t)(grow0 + r) * 1024 + 256 * pn + cb;
                    else if (pn == 4) p = K + (size_t)(rk0 + r) * 256 + cb;
                    else if (pn == 5) p = V + (size_t)(rk0 + r) * 256 + cb;
                    else p = G + (size_t)(grow0 + r) * 1024 + 256 * (pn - 6) + cb;
                    if (!sample && (pn == 4 || pn == 5)) { float* s = (pn == 4 ? stK : stV) + (size_t)(u.pm * 2 * 256 + r) * 256 + cb; *(f32x4*)s = x1; *(f32x4*)(s + 16) = x2; }
                    u32x2 w1, w2; w1.x = pk2(x1[0], x1[1]); w1.y = pk2(x1[2], x1[3]); w2.x = pk2(x2[0], x2[1]); w2.y = pk2(x2[2], x2[3]);
                    *(u32x2*)p = w1; *(u32x2*)(p + 16) = w2; }
        }
    }
};
}

namespace att {
__device__ __forceinline__ int crow(int r, int hi) { return (r & 3) + 8 * (r >> 2) + 4 * hi; }
typedef short v4i16_t __attribute__((ext_vector_type(4)));
__device__ __forceinline__ s16x4 vtr(const LAS char* p) { return __builtin_bit_cast(s16x4, __builtin_amdgcn_ds_read_tr16_b64_v4i16((LAS v4i16_t*)p)); }
struct Desc {
    const bf16* qptr; int ldq;
    const bf16* k0; int ldk0;
    const bf16* k1;
    const bf16* v; int ldv;
    int n_a, row_a, n_b, row_b, key_b;
    int qpos; float sink2; int has_sink;
    bf16* optr; int ldo;
};
template <int MODE>
__device__ __forceinline__ void attn_unit(LAS char* lds, const Desc& u) {
    constexpr int DQK = MODE == 0 ? 96 : 64, NCH = DQK / 8, ND0 = DQK / 16, KB = NCH * 1024, SLOT = KB + 8192;
    const int tid = opaque_tid(), lane = tid & 63, r32 = lane & 31, hi = lane >> 5; const int wid = __builtin_amdgcn_readfirstlane(tid >> 6);
    const bf16* ksrc = u.k0 + (size_t)lane * u.ldk0 + wid * 8;
    const bf16* k1src = (MODE == 0) ? u.k1 + (size_t)lane * 32 + (wid & 3) * 8 : nullptr;
    const bf16* vsrc = u.v + (size_t)(16 * (wid & 3) + (lane >> 2)) * u.ldv + (wid >> 2) * 32 + (lane & 3) * 8;
    const int kdst = wid * 1024 + lane * 16, k1dst = (8 + (wid & 3)) * 1024 + lane * 16, vdst = KB + wid * 1024 + lane * 16;
    const int NT = u.n_a + u.n_b;
    bf16x8 qr[ND0];
#pragma unroll
    for (int d0 = 0; d0 < ND0; ++d0) qr[d0] = *(const bf16x8*)(u.qptr + (size_t)r32 * u.ldq + d0 * 16 + hi * 8);
    float mrun = -1e30f, lrun = 0.f; f32x16 o[2]; o[0] = (f32x16){}; o[1] = (f32x16){};
    u32x4 kreg, k1reg, vreg;
#define TILE_ROW(t) ((t) < u.n_a ? u.row_a + 64 * (t) : u.row_b + 64 * ((t) - u.n_a))
#define ST_LOAD(t) do { const size_t _r = (size_t)TILE_ROW(t); kreg = *(const u32x4*)(ksrc + _r * u.ldk0); if (MODE == 0) k1reg = *(const u32x4*)(k1src + _r * 32); vreg = *(const u32x4*)(vsrc + _r * u.ldv); } while (0)
#define ST_WRITE(slot) do { LAS char* _b = lds + (slot) * SLOT; *(LAS u32x4*)(_b + kdst) = kreg; if (MODE == 0) *(LAS u32x4*)(_b + k1dst) = k1reg; *(LAS u32x4*)(_b + vdst) = vreg; } while (0)
    ST_LOAD(0); ST_WRITE(0);
    __syncthreads();
    for (int t = 0; t < NT; ++t) {
        const LAS char* kb = lds + (t & 1) * SLOT; const LAS char* vb = kb + KB;
        { const int tn = (t + 1 < NT) ? t + 1 : t; ST_LOAD(tn); }
        f32x16 s0 = (f32x16){}, s1 = (f32x16){};
        const LAS char* kp = kb + hi * 1024 + r32 * 16;
#pragma unroll
        for (int d0 = 0; d0 < ND0; ++d0) {
            const bf16x8 b0 = *(const LAS bf16x8*)(kp + d0 * 2048), b1 = *(const LAS bf16x8*)(kp + d0 * 2048 + 512);
            s0 = __builtin_amdgcn_mfma_f32_32x32x16_bf16(b0, qr[d0], s0, 0, 0, 0);
            s1 = __builtin_amdgcn_mfma_f32_32x32x16_bf16(b1, qr[d0], s1, 0, 0, 0);
        }
        if (MODE == 1 && t >= u.n_a) {
            const int k0p = u.key_b + 64 * (t - u.n_a) - u.qpos;
#pragma unroll
            for (int r = 0; r < 16; ++r) { const int d = k0p + crow(r, hi); if (d > 128 || d < -128) s0[r] = -1e30f; if (d + 32 > 128 || d + 32 < -128) s1[r] = -1e30f; }
        }
        float mx = fmaxf(s0[0], s1[0]);
#pragma unroll
        for (int r = 1; r < 16; ++r) mx = fmaxf(mx, fmaxf(s0[r], s1[r]));
        mx = fmaxf(mx, __shfl_xor(mx, 32));
        const float mnew = fmaxf(mrun, mx), alpha = __builtin_amdgcn_exp2f(mrun - mnew); mrun = mnew;
        float sum = 0.f;
#pragma unroll
        for (int r = 0; r < 16; ++r) { s0[r] = __builtin_amdgcn_exp2f(s0[r] - mnew); s1[r] = __builtin_amdgcn_exp2f(s1[r] - mnew); sum += s0[r] + s1[r]; }
        lrun = lrun * alpha + sum;
        if (__any(alpha != 1.f)) {
#pragma unroll
            for (int r = 0; r < 16; ++r) { o[0][r] *= alpha; o[1][r] *= alpha; }
        }
        u32x4 pw[4];
#pragma unroll
        for (int i = 0; i < 4; ++i) { pw[0][i] = pk2(s0[2 * i], s0[2 * i + 1]); pw[1][i] = pk2(s0[8 + 2 * i], s0[9 + 2 * i]); pw[2][i] = pk2(s1[2 * i], s1[2 * i + 1]); pw[3][i] = pk2(s1[8 + 2 * i], s1[9 + 2 * i]); }
        const LAS char* vp = vb + ((lane >> 4) & 1) * 32 + (lane & 3) * 8 + (4 * hi + ((lane & 15) >> 2)) * 64;
#pragma unroll
        for (int d0 = 0; d0 < 2; ++d0)
#pragma unroll
            for (int ks = 0; ks < 4; ++ks) {
                const s16x4 lo = vtr(vp + d0 * 4096 + ks * 1024), hh = vtr(vp + d0 * 4096 + ks * 1024 + 512);
                const bf16x8 vf = {lo[0], lo[1], lo[2], lo[3], hh[0], hh[1], hh[2], hh[3]};
                o[d0] = __builtin_amdgcn_mfma_f32_32x32x16_bf16(vf, __builtin_bit_cast(bf16x8, pw[ks]), o[d0], 0, 0, 0);
            }
        ST_WRITE((t + 1) & 1);
        __syncthreads();
    }
#undef TILE_ROW
#undef ST_LOAD
#undef ST_WRITE
    float lt = lrun + __shfl_xor(lrun, 32);
    if (u.has_sink) lt += __builtin_amdgcn_exp2f(u.sink2 - mrun);
    const float inv = 1.0f / lt;
    bf16* op = u.optr + (size_t)r32 * u.ldo + 4 * hi;
#pragma unroll
    for (int d0 = 0; d0 < 2; ++d0)
#pragma unroll
        for (int g = 0; g < 4; ++g) {
            bf16* p = op + 32 * d0 + 8 * g; const u32x2 gg = *(const u32x2*)p;
            const float a0 = o[d0][4 * g] * inv * silu_fast(bflo(gg.x)), a1 = o[d0][4 * g + 1] * inv * silu_fast(bfhi(gg.x));
            const float a2 = o[d0][4 * g + 2] * inv * silu_fast(bflo(gg.y)), a3 = o[d0][4 * g + 3] * inv * silu_fast(bfhi(gg.y));
            u32x2 w; w.x = pk2(a0, a1); w.y = pk2(a2, a3); *(u32x2*)p = w;
        }
}
}

#define XB_TMO      128
#define XB_XCNT(j)  (256  + 64 * (j))
#define XB_XSUB(j)  (1280 + 64 * (j))
#define XB_XGEN(j)  (2304 + 64 * (j))
#define XB_TOP      3328
#define XB_TOPGEN   3392
#define XCD_BAR_WORDS 3456
#define XB_SPIN_CAP (1u << 20)
__device__ __forceinline__ unsigned xb_ld(unsigned* p)              { return __hip_atomic_load(p, __ATOMIC_RELAXED, __HIP_MEMORY_SCOPE_AGENT); }
__device__ __forceinline__ unsigned xb_add(unsigned* p, unsigned v) { return __hip_atomic_fetch_add(p, v, __ATOMIC_RELAXED, __HIP_MEMORY_SCOPE_AGENT); }
__device__ __forceinline__ unsigned xb_xcc_id() { return (unsigned)__builtin_amdgcn_s_getreg((3 << 11) | 20) & 0xFu; }
#define XB_SPIN(cond, bar) do { unsigned _sp = 0; while (cond) { __builtin_amdgcn_s_sleep(1); \
    if ((++_sp & 255u) == 0u) { if (xb_ld(&(bar)[XB_TMO])) break; if (_sp > XB_SPIN_CAP) { atomicAdd(&(bar)[XB_TMO], 1u); break; } } } } while (0)
struct XcdBarrier { unsigned* bar; unsigned x; volatile LAS unsigned* st; };
__device__ __forceinline__ XcdBarrier xcd_barrier_post(unsigned* bar, volatile LAS unsigned* st) {
    XcdBarrier b; b.bar = bar; b.x = xb_xcc_id(); b.st = st;
    if (threadIdx.x == 0) (void)xb_add(&bar[XB_XCNT(b.x)], 1u);
    return b;
}
__device__ __forceinline__ void xcd_barrier_complete(unsigned* bar, unsigned x, unsigned& nloc, unsigned& nx) {
    const unsigned G = gridDim.x * gridDim.y * gridDim.z;
    unsigned sum, cnt, mine, sp = 0u;
    for (;;) {
        sum = 0u; cnt = 0u; mine = 0u;
#pragma unroll
        for (unsigned j = 0; j < 16; ++j) { const unsigned c = xb_ld(&bar[XB_XCNT(j)]); sum += c; cnt += (c > 0u) ? 1u : 0u; mine = (j == x) ? c : mine; }
        if (sum == G) break;
        __builtin_amdgcn_s_sleep(1);
        if ((++sp & 255u) == 0u) { if (xb_ld(&bar[XB_TMO])) break; if (sp > XB_SPIN_CAP) { atomicAdd(&bar[XB_TMO], 1u); break; } }
    }
    nloc = mine > 0u ? mine : 1u; nx = cnt > 0u ? cnt : 1u;
}
__device__ __forceinline__ void xcd_barrier(const XcdBarrier& b) {
    asm volatile("s_waitcnt vmcnt(0)" ::: "memory");
    __syncthreads();
    if (threadIdx.x == 0) {
        unsigned* bar = b.bar;
        __builtin_amdgcn_s_waitcnt(0);
        unsigned nloc = b.st[0], nx = b.st[1];
        if (nloc == 0u) { xcd_barrier_complete(bar, b.x, nloc, nx); b.st[0] = nloc; b.st[1] = nx; }
        const unsigned old = xb_add(&bar[XB_XSUB(b.x)], 1u);
        const unsigned gen = old / nloc;
        if (old + 1u == (gen + 1u) * nloc) {
            __builtin_amdgcn_fence(__ATOMIC_RELEASE, "agent");
            asm volatile("s_waitcnt vmcnt(0)" ::: "memory");
            const unsigned og = xb_add(&bar[XB_TOP], 1u);
            const unsigned tg = og / nx;
            if (og + 1u == (tg + 1u) * nx) xb_add(&bar[XB_TOPGEN], 1u);
            else XB_SPIN(xb_ld(&bar[XB_TOPGEN]) == tg, bar);
            __builtin_amdgcn_fence(__ATOMIC_ACQUIRE, "agent");
            xb_add(&bar[XB_XGEN(b.x)], 1u);
            asm volatile("s_waitcnt vmcnt(0)" ::: "memory");
        } else {
            XB_SPIN(xb_ld(&bar[XB_XGEN(b.x)]) == gen, bar);
            __builtin_amdgcn_fence(__ATOMIC_ACQUIRE, "agent");
            asm volatile("s_waitcnt vmcnt(0)" ::: "memory");
        }
    }
    __syncthreads();
}

struct Args { const float* in[23]; float* out; unsigned char* ws; int ph_lo, ph_hi; };
constexpr int NWAVES = 8;
constexpr int RING_BYTES = 131072, MISC_OFF = RING_BYTES + 320, LDS_BYTES = 147456;

struct TMap { int kind, row_off, col_off, ldw; const float* nscale; float scale; };
__device__ __forceinline__ void tmap(const TMap& tm, int n, int& drow, float& sc) {
    drow = n + tm.row_off; sc = tm.scale;
    switch (tm.kind) {
        case 1: if (n >= 672) drow += 96; break;
        case 2: { const int e = n % 96; if (e >= 64) { const int d = e - 64; const int p = (d & 7) | ((d & 8) << 1) | ((d & 16) >> 1); drow = n - e + 64 + p; } } break;
        case 3: { const int h = n >> 7, e = n & 127; drow = (e < 64) ? h * 64 + e : 512 + h * 64 + (e - 64); } break;
        case 4: sc = tm.nscale[n]; break;
        case 5: if (n >= 1024) sc = 1.f; break;
        default: break;
    }
}
__device__ __forceinline__ void transpose_item(const float* W, int K, int N, bf16* WT, const TMap& tm, LAS float* scr, int item, int lane) {
    const int nblk = N / 32, kb = item / nblk, nb = item % nblk, k0 = 64 * kb, n0 = 32 * nb;
#pragma unroll 8
    for (int i = 0; i < 32; ++i) { const int kk = 2 * i + (lane >> 5); scr[kk * 33 + (lane & 31)] = W[(size_t)(k0 + kk) * N + n0 + (lane & 31)]; }
    LDS_WAIT(); asm volatile("" ::: "memory");
    const int c = lane & 7;
#pragma unroll
    for (int j = 0; j < 4; ++j) { const int n = (lane >> 3) + 8 * j; const LAS float* s = scr + (8 * c) * 33 + n;
        int drow; float sc; tmap(tm, n0 + n, drow, sc);
        u32x4 o; o.x = pk2(s[0 * 33] * sc, s[1 * 33] * sc); o.y = pk2(s[2 * 33] * sc, s[3 * 33] * sc); o.z = pk2(s[4 * 33] * sc, s[5 * 33] * sc); o.w = pk2(s[6 * 33] * sc, s[7 * 33] * sc);
        *(u32x4*)(WT + (size_t)drow * tm.ldw + tm.col_off + k0 + 8 * c) = o; }
    LDS_WAIT(); asm volatile("" ::: "memory");
}

typedef __attribute__((address_space(4))) const char* kptr_t;
__device__ __forceinline__ const void* arg_ptr(int k) { kptr_t ka = (kptr_t)__builtin_amdgcn_kernarg_segment_ptr(); asm volatile("" : "+s"(ka)); return *(const void* __attribute__((address_space(4)))*)(ka + 8 * k); }
#define ARG_IN(k) ((const float*)arg_ptr(k))
__device__ __forceinline__ int mod_index(int row) { return row < RP ? 8 : ((row - RP) >> 11); }

__global__ void __launch_bounds__(NWAVES * 64, 2) fwd_kernel(Args args) {
    extern __shared__ __attribute__((aligned(16))) unsigned char lds_raw[];
    LAS unsigned char* lds = (LAS unsigned char*)lds_raw;
    volatile LAS unsigned* MISC = (volatile LAS unsigned*)(lds + MISC_OFF);
    const int G = gridDim.x; const int bx = blockIdx.x; const int vcu = (G % 8 == 0) ? (bx % 8) * (G / 8) + bx / 8 : bx;
    const int NGW = G * NWAVES;
    { const int tid0 = threadIdx.x; for (int u = tid0; u < (LDS_BYTES - RING_BYTES) / 4; u += NWAVES * 64) ((LAS unsigned*)(lds + RING_BYTES))[u] = 0u; }
    __syncthreads();
    XcdBarrier bar; bar.bar = (unsigned*)((unsigned char*)arg_ptr(24) + WS_CTL) + 1024; bar.x = 0; bar.st = nullptr;
    if (!MK_PER_PHASE) bar = xcd_barrier_post(bar.bar, MISC + 8);
    const int lo = args.ph_lo, hi = args.ph_hi;
    int pid = 0;
#ifndef PHASE_MASK
#define PHASE_MASK 0xFFFFFFFFu
#endif
#define IN_PH() (lo <= pid && pid < hi)
#ifndef G2M
#define G2M 7
#endif
#define PK(k) ((PHASE_MASK >> (k)) & 1u)
#define END_PH() do { if (!MK_PER_PHASE && lo <= pid && pid + 1 < hi) xcd_barrier(bar); ++pid; } while (0)
#define PH_BEGIN() unsigned char* const ws = (unsigned char*)arg_ptr(24); float* const out = (float*)arg_ptr(23); \
    const int tid = opaque_tid(), lane = tid & 63, wave = __builtin_amdgcn_readfirstlane(tid >> 6), gw = vcu * NWAVES + wave; (void)out; (void)lane; (void)gw; (void)ws
#define MOD ((float*)(ws + WS_MOD))
#define ROPE8 ((float*)(ws + WS_ROPE8))
#define ROPE16 ((float*)(ws + WS_ROPE16))
#define MODP ((float*)(ws + WS_PO))
#define Hb ((bf16*)(ws + WS_H))
#define GAB ((bf16*)(ws + WS_GAB))
#define CQ ((bf16*)(ws + WS_CQ))
#define CKV ((bf16*)(ws + WS_CKV))
#define KRB ((bf16*)(ws + WS_KRB))
#define KRF ((float*)(ws + WS_KRF))
#define KN ((bf16*)(ws + WS_KN))
#define VP ((bf16*)(ws + WS_KN))
#define VV ((bf16*)(ws + WS_V))
#define PO ((bf16*)(ws + WS_PO))
#define SQ ((bf16*)(ws + WS_CQ))
#define SK ((bf16*)(ws + WS_SK))
#define SV ((bf16*)(ws + WS_SV))

    if (IN_PH() && PK(0)) { PH_BEGIN();
        const float* cvec = ARG_IN(6); const float* cctx = ARG_IN(7); const float* ada_w = ARG_IN(8);
        for (int it = gw; it < 768; it += NGW) {
            const int l = it / 192, rem = it % 192, kc = rem / 12, cc = rem % 12, k0 = kc * 64;
            float sv[9];
#pragma unroll
            for (int j = 0; j < 9; ++j) { const float c = (j < 8) ? cvec[j * 1024 + k0 + lane] : cctx[k0 + lane]; sv[j] = c / (1.f + expf(-c)); }
            f32x4 acc[9];
#pragma unroll
            for (int j = 0; j < 9; ++j) acc[j] = (f32x4){0.f, 0.f, 0.f, 0.f};
            const float* wp = ada_w + ((size_t)l * 1024 + k0) * 3072 + cc * 256 + 4 * lane;
#pragma unroll
            for (int kk = 0; kk < 64; ++kk) {
                const f32x4 w = *(const f32x4*)(wp + (size_t)kk * 3072);
#pragma unroll
                for (int j = 0; j < 9; ++j) { const float s = __shfl(sv[j], kk); acc[j] += w * s; }
            }
#pragma unroll
            for (int j = 0; j < 9; ++j) *(f32x4*)(MODP + ((size_t)((kc * 4 + l) * 9 + j)) * 3072 + cc * 256 + 4 * lane) = acc[j];
        }
    }
    END_PH();

    if (IN_PH() && PK(1)) { PH_BEGIN();
        const float* ada_b = ARG_IN(9);
        for (int e = bx * 512 + tid; e < 4 * 9 * 3072; e += G * 512) {
            const int l = e / (9 * 3072), n = e % 3072; float s = ada_b[l * 3072 + n];
#pragma unroll
            for (int kc = 0; kc < 16; ++kc) s += MODP[(size_t)kc * (4 * 9 * 3072) + e];
            MOD[e] = s;
        }
        for (int e = bx * 512 + tid; e < 64 * 8 + 64 * 16; e += G * 512) {
            if (e < 512) { const int pos = e >> 3, i = e & 7; const float inv = powf(10000.f, -(float)i / 8.f), a = (float)pos * inv; ROPE8[2 * e] = cosf(a); ROPE8[2 * e + 1] = sinf(a); }
            else { const int f = e - 512, pos = f >> 4, i = f & 15; const float inv = powf(10000.f, -(float)i / 16.f), a = (float)pos * inv; ROPE16[2 * f] = cosf(a); ROPE16[2 * f + 1] = sinf(a); }
        }
        LAS float* scr = (LAS float*)(lds + wave * 16384);
        constexpr int I1 = 1104, I2 = 144, I3 = 128, I4 = 32, I5 = 512, I6 = 1280, I7 = 512, IMLA = I1 + I2 + I3 + I4 + I5, ISWA = I6 + I7, ITOT = 2 * (IMLA + ISWA);
        for (int it = gw; it < ITOT; it += NGW) {
            int r = it; const int i = (r >= IMLA + ISWA) ? 1 : 0; r -= i * (IMLA + ISWA);
            unsigned char* wm = ws + (i ? WS_W_MLA1 : WS_W_MLA0); unsigned char* wsw = ws + (i ? WS_W_SWA1 : WS_W_SWA0);
            if (r < I1) { TMap tm{1, 0, 0, 1024, nullptr, 1.f}; transpose_item(ARG_IN(12) + (size_t)i * 1024 * 2208, 1024, 2208, (bf16*)wm, tm, scr, r, lane); continue; } r -= I1;
            if (r < I2) { TMap tm{2, 0, 0, 384, nullptr, MLA_SC}; transpose_item(ARG_IN(15) + (size_t)i * 384 * 768, 384, 768, (bf16*)(wm + SZ_WIN_MLA), tm, scr, r, lane); continue; } r -= I2;
            if (r < I3) { TMap tm{3, 0, 0, 256, nullptr, 1.f}; transpose_item(ARG_IN(16) + (size_t)i * 256 * 1024, 256, 1024, (bf16*)(wm + SZ_WIN_MLA + SZ_WUQ), tm, scr, r, lane); continue; } r -= I3;
            if (r < I4) { const int g = r >> 3; TMap tm{4, g * 128, g * 128, 512, ARG_IN(18) + i * 512 + g * 128, 1.f};
                transpose_item(ARG_IN(17) + ((size_t)i * 4 + g) * 128 * 128, 128, 128, (bf16*)(wm + SZ_WIN_MLA + SZ_WUQ + SZ_WUKV), tm, scr, r & 7, lane); continue; } r -= I4;
            if (r < I5) { TMap tm{0, 0, 0, 1024, nullptr, 1.f}; transpose_item(ARG_IN(19) + (size_t)i * 1024 * 1024, 1024, 1024, (bf16*)(wm + SZ_WIN_MLA + SZ_WUQ + SZ_WUKV + SZ_WPOOL), tm, scr, r, lane); continue; } r -= I5;
            if (r < I6) { TMap tm{5, 0, 0, 1024, nullptr, SWA_SC}; transpose_item(ARG_IN(20) + (size_t)i * 1024 * 2560, 1024, 2560, (bf16*)wsw, tm, scr, r, lane); continue; } r -= I6;
            { TMap tm{0, 0, 0, 1024, nullptr, 1.f}; transpose_item(ARG_IN(22) + (size_t)i * 1024 * 1024, 1024, 1024, (bf16*)(wsw + SZ_WIN_SWA), tm, scr, r, lane); }
        }
        const u32x4 z = {0u, 0u, 0u, 0u};
        for (int e = bx * 512 + tid; e < 2 * 96 * 128; e += G * 512) { const int i = e / (96 * 128), f = e % (96 * 128);
            *(u32x4*)(ws + (i ? WS_W_MLA1 : WS_W_MLA0) + (size_t)672 * 2048 + (size_t)f * 16) = z; }
        for (int e = bx * 512 + tid; e < 2 * 512 * 64; e += G * 512) { const int i = e / (512 * 64), f = e % (512 * 64), n = f >> 6, kc = f & 63;
            if ((n >> 7) != (kc >> 4)) *(u32x4*)(ws + (i ? WS_W_MLA1 : WS_W_MLA0) + SZ_WIN_MLA + SZ_WUQ + SZ_WUKV + (size_t)n * 1024 + (size_t)kc * 16) = z; }
    }
    END_PH();

    if (IN_PH() && PK(2)) { PH_BEGIN();
        const float* npre = ARG_IN(10); const float* xin0 = ARG_IN(0); const float* xin1 = ARG_IN(1);
        for (int chunk = gw; chunk < R / 12; chunk += NGW) {
            int curm = -1; f32x4 cB[4], cC[4];
#pragma unroll
            for (int j = 0; j < 4; ++j) { cB[j] = (f32x4){0.f, 0.f, 0.f, 0.f}; cC[j] = cB[j]; }
            for (int rr = 0; rr < 12; ++rr) {
                const int row = chunk * 12 + rr, midx = mod_index(row);
                if (midx != curm) { curm = midx; const float* md = MOD + (size_t)(0 * 9 + midx) * 3072;
#pragma unroll
                    for (int j = 0; j < 4; ++j) { const int c = 4 * lane + 256 * j; const f32x4 g = *(const f32x4*)(npre + c), sc = *(const f32x4*)(md + 1024 + c); cB[j] = g * (sc + 1.f); cC[j] = *(const f32x4*)(md + c); } }
                const float* xr = row < RP ? xin0 + (size_t)row * D : xin1 + (size_t)(row - RP) * D;
                f32x4 v[4]; float ss = 0.f;
#pragma unroll
                for (int j = 0; j < 4; ++j) { v[j] = *(const f32x4*)(xr + 4 * lane + 256 * j); ss += v[j][0] * v[j][0] + v[j][1] * v[j][1] + v[j][2] * v[j][2] + v[j][3] * v[j][3]; }
                const float rstd = 1.f / sqrtf(wave_sum(ss) * (1.f / D) + EPS);
#pragma unroll
                for (int j = 0; j < 4; ++j) { const f32x4 h = v[j] * rstd * cB[j] + cC[j]; u32x2 w; w.x = pk2(h[0], h[1]); w.y = pk2(h[2], h[3]); *(u32x2*)(Hb + (size_t)row * D + 4 * lane + 256 * j) = w; }
            }
        }
    }
    END_PH();

    for (int l = 0; l < NL; ++l) {
        const int i = l >> 1;
        if ((l & 1) == 0) {
#define WM_BASE (ws + (i ? WS_W_MLA1 : WS_W_MLA0))
#define M_WinT ((const bf16*)WM_BASE)
#define M_WuqT ((const bf16*)(WM_BASE + SZ_WIN_MLA))
#define M_WukvT ((const bf16*)(WM_BASE + SZ_WIN_MLA + SZ_WUQ))
#define M_WpT ((const bf16*)(WM_BASE + SZ_WIN_MLA + SZ_WUQ + SZ_WUKV))
#define M_WoT ((const bf16*)(WM_BASE + SZ_WIN_MLA + SZ_WUQ + SZ_WUKV + SZ_WPOOL))
            if (IN_PH() && PK(3)) { PH_BEGIN();
                pg8::Gemm g{Hb, M_WinT, R, 2304, 1024, 1024}; pg8::StaticOrder S; S.init(R, 2304, G, bx);
                pg8::EpiMlaIn E{CQ, CKV, GAB, VP, KRF};
                pg8::gemm_phase<pg8::EpiMlaIn, true>(lds, g, S, E);
            }
            END_PH();
            if (IN_PH() && PK(4)) { PH_BEGIN();
                const float* gq = ARG_IN(13) + i * 384; const float* gkv = ARG_IN(14) + i * 256;
                const float* cckv = ARG_IN(2); const float* ckr = ARG_IN(3);
                for (int row = gw; row < R + 2048; row += NGW) {
                    if (row < R) {
                        const bool prompt = row < RP; const int b = prompt ? row >> 8 : (row - RP) >> 11, t = prompt ? row & 255 : (row - RP) & 2047, T = prompt ? 256 : 2048;
                        const int rk = prompt ? row : RP + b * 2304 + t;
                        { float v[8]; float ss = 0.f; u32x4 w = {0u, 0u, 0u, 0u}; if (lane < 48) w = *(const u32x4*)(CQ + (size_t)row * 384 + 8 * lane);
                          v[0] = bflo(w.x); v[1] = bfhi(w.x); v[2] = bflo(w.y); v[3] = bfhi(w.y); v[4] = bflo(w.z); v[5] = bfhi(w.z); v[6] = bflo(w.w); v[7] = bfhi(w.w);
#pragma unroll
                          for (int e = 0; e < 8; ++e) ss += v[e] * v[e];
                          const float rstd = 1.f / sqrtf(wave_sum(ss) * (1.f / 384.f) + EPS);
                          if (lane < 48) { const f32x4 g0 = *(const f32x4*)(gq + 8 * lane), g1 = *(const f32x4*)(gq + 8 * lane + 4);
                              u32x4 o; o.x = pk2(v[0] * rstd * g0[0], v[1] * rstd * g0[1]); o.y = pk2(v[2] * rstd * g0[2], v[3] * rstd * g0[3]); o.z = pk2(v[4] * rstd * g1[0], v[5] * rstd * g1[1]); o.w = pk2(v[6] * rstd * g1[2], v[7] * rstd * g1[3]);
                              *(u32x4*)(CQ + (size_t)row * 384 + 8 * lane) = o; } }
                        { float v[8]; float ss = 0.f; u32x4 w = {0u, 0u, 0u, 0u}; if (lane < 32) w = *(const u32x4*)(CKV + (size_t)rk * 256 + 8 * lane);
                          v[0] = bflo(w.x); v[1] = bfhi(w.x); v[2] = bflo(w.y); v[3] = bfhi(w.y); v[4] = bflo(w.z); v[5] = bfhi(w.z); v[6] = bflo(w.w); v[7] = bfhi(w.w);
#pragma unroll
                          for (int e = 0; e < 8; ++e) ss += v[e] * v[e];
                          const float rstd = 1.f / sqrtf(wave_sum(ss) * (1.f / 256.f) + EPS);
                          if (lane < 32) { const f32x4 g0 = *(const f32x4*)(gkv + 8 * lane), g1 = *(const f32x4*)(gkv + 8 * lane + 4);
                              const f32x4 y0 = {v[0] * rstd * g0[0], v[1] * rstd * g0[1], v[2] * rstd * g0[2], v[3] * rstd * g0[3]}, y1 = {v[4] * rstd * g1[0], v[5] * rstd * g1[1], v[6] * rstd * g1[2], v[7] * rstd * g1[3]};
                              u32x4 o; o.x = pk2(y0[0], y0[1]); o.y = pk2(y0[2], y0[3]); o.z = pk2(y1[0], y1[1]); o.w = pk2(y1[2], y1[3]);
                              *(u32x4*)(CKV + (size_t)rk * 256 + 8 * lane) = o;
                              if (prompt) { float* s = out + OFF_CKV + ((size_t)(b * 2 + i) * 256 + t) * 256 + 8 * lane; *(f32x4*)s = y0; *(f32x4*)(s + 4) = y1; } } }
                        { if (lane < 32) { const float kv = KRF[(size_t)row * 32 + lane]; if (prompt) out[OFF_KR + ((size_t)(b * 2 + i) * 256 + t) * 32 + lane] = kv; }
                          if (lane < 16) { const int part = lane >> 3, fi = lane & 7; float x1 = KRF[(size_t)row * 32 + part * 16 + fi], x2 = KRF[(size_t)row * 32 + part * 16 + fi + 8];
                              if (!prompt) { const int pos = part ? (t & 63) : (t >> 6); const float cs = ROPE8[(pos * 8 + fi) * 2], sn = ROPE8[(pos * 8 + fi) * 2 + 1]; const float o1 = x1 * cs - x2 * sn, o2 = x1 * sn + x2 * cs; x1 = o1; x2 = o2; }
                              KRB[(size_t)rk * 32 + lane] = (bf16)f2bf(x1); KRB[(size_t)rk * 32 + 16 + lane] = (bf16)f2bf(x2); } }
                        { const int half = 1 << (lane >> 4); const bf16* vb = VP + (size_t)(row - t) * 512 + 8 * lane; float s[8];
#pragma unroll
                          for (int e = 0; e < 8; ++e) s[e] = 0.f;
#pragma unroll
                          for (int dt = -8; dt < 8; ++dt) { const int tt = t + dt; if (dt >= -half && dt < half && tt >= 0 && tt < T) { const u32x4 w = *(const u32x4*)(vb + (size_t)tt * 512);
                                  s[0] += bflo(w.x); s[1] += bfhi(w.x); s[2] += bflo(w.y); s[3] += bfhi(w.y); s[4] += bflo(w.z); s[5] += bfhi(w.z); s[6] += bflo(w.w); s[7] += bfhi(w.w); } }
                          const int plo = (t - half) > 0 ? (t - half) : 0, phi = (t + half) < T ? (t + half) : T; const float ic = 1.f / (float)(phi - plo);
                          const u32x4 w = *(const u32x4*)(vb + (size_t)t * 512);
                          u32x4 o; o.x = pk2(s[0] * ic - bflo(w.x), s[1] * ic - bfhi(w.x)); o.y = pk2(s[2] * ic - bflo(w.y), s[3] * ic - bfhi(w.y)); o.z = pk2(s[4] * ic - bflo(w.z), s[5] * ic - bfhi(w.z)); o.w = pk2(s[6] * ic - bflo(w.w), s[7] * ic - bfhi(w.w));
                          *(u32x4*)(PO + (size_t)row * 512 + 8 * lane) = o; }
                    } else {
                        const int ci = row - R, b = ci >> 8, p = ci & 255, rk = RP + b * 2304 + 2048 + p;
                        if (lane < 32) { const float* s = cckv + ((size_t)(b * 2 + i) * 256 + p) * 256 + 8 * lane; const f32x4 y0 = *(const f32x4*)s, y1 = *(const f32x4*)(s + 4);
                            u32x4 o; o.x = pk2(y0[0], y0[1]); o.y = pk2(y0[2], y0[3]); o.z = pk2(y1[0], y1[1]); o.w = pk2(y1[2], y1[3]); *(u32x4*)(CKV + (size_t)rk * 256 + 8 * lane) = o; }
                        if (lane < 16) { const int part = lane >> 3, fi = lane & 7; const float* s = ckr + ((size_t)(b * 2 + i) * 256 + p) * 32 + part * 16 + fi;
                            KRB[(size_t)rk * 32 + lane] = (bf16)f2bf(s[0]); KRB[(size_t)rk * 32 + 16 + lane] = (bf16)f2bf(s[8]); }
                    }
                }
            }
            END_PH();
            if (IN_PH() && PK(5)) { PH_BEGIN();
                if (G2M & 1) { pg8::Gemm g{CQ, M_WuqT, R, 768, 384, 384}; pg8::StaticOrder S; S.init(R, 768, G, bx); pg8::EpiQ E{Hb, ROPE8}; pg8::gemm_phase<pg8::EpiQ, true>(lds, g, S, E); }
                if (G2M & 2) { pg8::Gemm g{CKV, M_WukvT, RK, 1024, 256, 256}; pg8::StaticOrder S; S.init(RK, 1024, G, bx); pg8::EpiBf16 E{KN, 512, 512, (size_t)(WS_V - WS_KN) / 2}; pg8::gemm_phase<pg8::EpiBf16, true>(lds, g, S, E); }
                if (G2M & 4) { pg8::Gemm g{PO, M_WpT, R, 512, 512, 512}; pg8::StaticOrder S; S.init(R, 512, G, bx); pg8::EpiPool E{GAB + 512}; pg8::gemm_phase<pg8::EpiPool, true>(lds, g, S, E); }
            }
            END_PH();
            if (IN_PH() && PK(6)) { PH_BEGIN();
                for (int un = vcu; un < 768; un += G) {
                    att::Desc d; d.ldq = 768; d.ldk0 = 512; d.ldv = 512; d.ldo = 1024; d.n_b = 0; d.row_b = 0; d.key_b = 0; d.qpos = 0; d.sink2 = 0.f; d.has_sink = 0; d.k1 = KRB;
                    int h, qrow, krow;
                    if (un < 512) { const int b = un >> 6, qb = un & 7; h = (un >> 3) & 7; qrow = RP + b * 2048 + qb * 256 + wave * 32; krow = RP + b * 2304; d.n_a = 36; }
                    else { const int v = un - 512, b = v >> 3; h = v & 7; qrow = b * 256 + wave * 32; krow = b * 256; d.n_a = 4; }
                    d.row_a = krow; d.qptr = Hb + (size_t)qrow * 768 + h * 96; d.k0 = KN + h * 64; d.v = VV + h * 64; d.optr = GAB + (size_t)qrow * 1024 + h * 64;
                    att::attn_unit<0>((LAS char*)lds, d);
                }
            }
            END_PH();
            if (IN_PH() && PK(7)) { PH_BEGIN();
                pg8::Gemm g{GAB, M_WoT, R, 1024, 1024, 1024}; pg8::StaticOrder S; S.init(R, 1024, G, bx); pg8::EpiBf16 E{Hb, 1024, 0, 0}; pg8::gemm_phase<pg8::EpiBf16, true>(lds, g, S, E);
            }
            END_PH();
        } else {
#define WS_BASE (ws + (i ? WS_W_SWA1 : WS_W_SWA0))
#define S_WinT ((const bf16*)WS_BASE)
#define S_WoT ((const bf16*)(WS_BASE + SZ_WIN_SWA))
            if (IN_PH() && PK(8)) { PH_BEGIN();
                const float* ck = ARG_IN(4); const float* cv = ARG_IN(5);
                for (int e = bx * 512 + tid; e < 2 * 2048 * 32; e += G * 512) {
                    const int which = e / (2048 * 32), f = e % (2048 * 32), rowi = f >> 5, ch = f & 31, b = rowi >> 8, p = rowi & 255;
                    const float* s = (which ? cv : ck) + ((size_t)(b * 2 + i) * 256 + p) * 256 + 8 * ch; const f32x4 y0 = *(const f32x4*)s, y1 = *(const f32x4*)(s + 4);
                    u32x4 o; o.x = pk2(y0[0], y0[1]); o.y = pk2(y0[2], y0[3]); o.z = pk2(y1[0], y1[1]); o.w = pk2(y1[2], y1[3]);
                    *(u32x4*)((which ? SV : SK) + (size_t)(RP + b * 2304 + 2048 + p) * 256 + 8 * ch) = o;
                }
                pg8::Gemm g{Hb, S_WinT, R, 2560, 1024, 1024}; pg8::StaticOrder S; S.init(R, 2560, G, bx);
                pg8::EpiSwaIn E{SQ, SK, SV, GAB, out + OFF_K + (size_t)i * 65536, out + OFF_V + (size_t)i * 65536, ROPE16};
                pg8::gemm_phase<pg8::EpiSwaIn, true>(lds, g, S, E);
            }
            END_PH();
            if (IN_PH() && PK(9)) { PH_BEGIN();
                const float* sink = ARG_IN(21) + i * 16;
                for (int un = vcu; un < 1536; un += G) {
                    att::Desc d; d.ldq = 1024; d.ldk0 = 256; d.ldv = 256; d.ldo = 1024; d.k1 = nullptr; d.has_sink = 1; d.n_a = 4;
                    int kvh, qrow, q0;
                    if (un < 1024) { const int b = un >> 7, blk = un & 31; kvh = (un >> 5) & 3; q0 = blk * 64; const int kb = RP + b * 2304;
                        qrow = RP + b * 2048 + q0 + (wave & 1) * 32; d.row_a = kb + 2048;
                        const int kfirst = q0 - 128 > 0 ? q0 - 128 : 0, klast = q0 + 128 < 2048 - 64 ? q0 + 128 : 2048 - 64;
                        d.key_b = kfirst; d.row_b = kb + kfirst; d.n_b = (klast - kfirst) / 64 + 1; }
                    else { const int v = un - 1024, b = v >> 4, blk = v & 3; kvh = (v >> 2) & 3; q0 = blk * 64; qrow = b * 256 + q0 + (wave & 1) * 32; d.row_a = b * 256; d.n_b = 0; d.row_b = 0; d.key_b = 0; }
                    const int head = kvh * 4 + (wave >> 1);
                    d.qpos = q0 + (wave & 1) * 32 + (lane & 31); d.sink2 = sink[head] * LOG2E;
                    d.qptr = SQ + (size_t)qrow * 1024 + head * 64; d.k0 = SK + kvh * 64; d.v = SV + kvh * 64; d.optr = GAB + (size_t)qrow * 1024 + head * 64;
                    att::attn_unit<1>((LAS char*)lds, d);
                }
            }
            END_PH();
            if (IN_PH() && PK(10)) { PH_BEGIN();
                pg8::Gemm g{GAB, S_WoT, R, 1024, 1024, 1024}; pg8::StaticOrder S; S.init(R, 1024, G, bx); pg8::EpiBf16 E{Hb, 1024, 0, 0}; pg8::gemm_phase<pg8::EpiBf16, true>(lds, g, S, E);
            }
            END_PH();
        }
        if (IN_PH() && PK(11)) { PH_BEGIN();
            const float* xin0 = ARG_IN(0); const float* xin1 = ARG_IN(1); const float* npost = ARG_IN(11) + l * 1024; const float* npre = ARG_IN(10) + (l + 1 < NL ? l + 1 : l) * 1024; const bool has_next = l + 1 < NL;
            for (int chunk = gw; chunk < R / 12; chunk += NGW) {
                int curm = -1; f32x4 cA[4], cB[4], cC[4];
#pragma unroll
                for (int j = 0; j < 4; ++j) { cA[j] = (f32x4){0.f, 0.f, 0.f, 0.f}; cB[j] = cA[j]; cC[j] = cA[j]; }
                for (int rr = 0; rr < 12; ++rr) {
                    const int row = chunk * 12 + rr, midx = mod_index(row);
                    if (midx != curm) { curm = midx; const float* md = MOD + (size_t)(l * 9 + midx) * 3072; const float* mdn = MOD + (size_t)((has_next ? l + 1 : l) * 9 + midx) * 3072;
#pragma unroll
                        for (int j = 0; j < 4; ++j) { const int c = 4 * lane + 256 * j; cA[j] = *(const f32x4*)(md + 2048 + c) * *(const f32x4*)(npost + c);
                            cB[j] = *(const f32x4*)(npre + c) * (*(const f32x4*)(mdn + 1024 + c) + 1.f); cC[j] = *(const f32x4*)(mdn + c); } }
                    const float* xr = (l == 0) ? (row < RP ? xin0 + (size_t)row * D : xin1 + (size_t)(row - RP) * D) : out + (size_t)row * D;
                    f32x4 xv[4], ov[4]; float ss = 0.f;
#pragma unroll
                    for (int j = 0; j < 4; ++j) { xv[j] = *(const f32x4*)(xr + 4 * lane + 256 * j); const u32x2 w = *(const u32x2*)(Hb + (size_t)row * D + 4 * lane + 256 * j);
                        ov[j] = (f32x4){bflo(w.x), bfhi(w.x), bflo(w.y), bfhi(w.y)}; ss += ov[j][0] * ov[j][0] + ov[j][1] * ov[j][1] + ov[j][2] * ov[j][2] + ov[j][3] * ov[j][3]; }
                    const float rstd = 1.f / sqrtf(wave_sum(ss) * (1.f / D) + EPS); float s2 = 0.f;
#pragma unroll
                    for (int j = 0; j < 4; ++j) { xv[j] = xv[j] + ov[j] * rstd * cA[j]; *(f32x4*)(out + (size_t)row * D + 4 * lane + 256 * j) = xv[j]; s2 += xv[j][0] * xv[j][0] + xv[j][1] * xv[j][1] + xv[j][2] * xv[j][2] + xv[j][3] * xv[j][3]; }
                    if (has_next) { const float r2 = 1.f / sqrtf(wave_sum(s2) * (1.f / D) + EPS);
#pragma unroll
                        for (int j = 0; j < 4; ++j) { const f32x4 h = xv[j] * r2 * cB[j] + cC[j]; u32x2 w; w.x = pk2(h[0], h[1]); w.y = pk2(h[2], h[3]); *(u32x2*)(Hb + (size_t)row * D + 4 * lane + 256 * j) = w; } }
                }
            }
        }
        END_PH();
    }
#undef IN_PH
#undef END_PH
}

constexpr int N_PHASES = 3 + 6 + 4 + 6 + 4;

extern "C" void kernel_launch(void* const* d_in, const int* in_sizes, int n_in, void* d_out, int out_size, void* d_ws, size_t ws_size, hipStream_t stream) {
    static int grid = 0;
    if (grid == 0) {
        if (n_in != 23 || out_size != OUT_TOTAL || ws_size < WS_END) { fprintf(stderr, "kernel_launch: unexpected shapes (n_in %d out %d ws %zu)\n", n_in, out_size, ws_size); grid = -1; return; }
        int dev = 0, cus = 0;
        if (hipGetDevice(&dev) != hipSuccess || hipDeviceGetAttribute(&cus, hipDeviceAttributeMultiprocessorCount, dev) != hipSuccess) { grid = -1; return; }
        if (hipFuncSetAttribute((const void*)fwd_kernel, hipFuncAttributeMaxDynamicSharedMemorySize, LDS_BYTES) != hipSuccess) { fprintf(stderr, "kernel_launch: hipFuncSetAttribute failed\n"); grid = -1; return; }
        int per_cu = 0;
        if (hipOccupancyMaxActiveBlocksPerMultiprocessor(&per_cu, (const void*)fwd_kernel, NWAVES * 64, LDS_BYTES) != hipSuccess || per_cu < 1) { fprintf(stderr, "kernel_launch: occupancy query says %d\n", per_cu); }
        (void)hipGetLastError();
        grid = cus;
    }
    if (grid < 0) return;
    (void)hipMemsetAsync((char*)d_ws + WS_CTL, 0, CTL_ZERO_BYTES, stream);
    Args a{};
    for (int i = 0; i < 23; ++i) a.in[i] = (const float*)d_in[i];
    a.out = (float*)d_out; a.ws = (unsigned char*)d_ws;
#if MK_PER_PHASE
    for (int p = 0; p < N_PHASES; ++p) { a.ph_lo = p; a.ph_hi = p + 1; hipLaunchKernelGGL(fwd_kernel, dim3(grid), dim3(NWAVES * 64), LDS_BYTES, stream, a); }
#else
    a.ph_lo = 0; a.ph_hi = N_PHASES;
    hipLaunchKernelGGL(fwd_kernel, dim3(grid), dim3(NWAVES * 64), LDS_BYTES, stream, a);
#endif
}
```

```cpp
#include <hip/hip_runtime.h>
#include <cstdio>
#include <cstdint>

#define PROBE_DUP 0x0u
#define PROBE_BAR2 0
#ifndef MK_PER_PHASE
#define MK_PER_PHASE 0
#endif

#define GAS __attribute__((address_space(1)))
#define LAS __attribute__((address_space(3)))
typedef unsigned short bf16;
typedef short bf16x8 __attribute__((ext_vector_type(8)));
typedef short s16x4 __attribute__((ext_vector_type(4)));
typedef float f32x4 __attribute__((ext_vector_type(4)));
typedef float f32x2 __attribute__((ext_vector_type(2)));
typedef float f32x16 __attribute__((ext_vector_type(16)));
typedef unsigned u32x4 __attribute__((ext_vector_type(4)));
typedef unsigned u32x2 __attribute__((ext_vector_type(2)));
typedef __bf16 bf16x2_t __attribute__((ext_vector_type(2)));

constexpr int D = 1024, RP = 8192, RS = 16384, R = RP + RS;
constexpr int RK = RP + 8 * 2304;
constexpr int NL = 4;
constexpr float EPS = 1e-6f, LOG2E = 1.4426950408889634f;
constexpr float MLA_SC = 0.10206207261596577f * LOG2E;
constexpr float SWA_SC = 0.125f * LOG2E;
constexpr int OFF_CKV = 25165824, OFF_KR = 29360128, OFF_K = 29884416, OFF_V = 34078720, OUT_TOTAL = 38273024;

constexpr size_t MiB = 1u << 20;
constexpr size_t WS_CTL = 0, CTL_ZERO_BYTES = 64 * 1024;
constexpr size_t WS_MOD = 1 * MiB;
constexpr size_t WS_ROPE8 = 1 * MiB + 512 * 1024;
constexpr size_t WS_ROPE16 = WS_ROPE8 + 4096;
constexpr size_t SZ_WIN_MLA = 2304ull * 1024 * 2, SZ_WUQ = 768ull * 384 * 2, SZ_WUKV = 1024ull * 256 * 2, SZ_WPOOL = 512ull * 512 * 2,
                 SZ_WOUT = 1024ull * 1024 * 2, SZ_WIN_SWA = 2560ull * 1024 * 2;
constexpr size_t WS_W = 2 * MiB;
constexpr size_t SZ_W_MLA = SZ_WIN_MLA + SZ_WUQ + SZ_WUKV + SZ_WPOOL + SZ_WOUT, SZ_W_SWA = SZ_WIN_SWA + SZ_WOUT;
constexpr size_t WS_W_MLA0 = WS_W, WS_W_MLA1 = WS_W + SZ_W_MLA, WS_W_SWA0 = WS_W + 2 * SZ_W_MLA, WS_W_SWA1 = WS_W_SWA0 + SZ_W_SWA;
static_assert(WS_W_SWA1 + SZ_W_SWA <= 34 * MiB, "weights");
constexpr size_t WS_H = 34 * MiB;
constexpr size_t WS_GAB = 82 * MiB;
constexpr size_t WS_CQ = 130 * MiB;
constexpr size_t WS_CKV = 148 * MiB;
constexpr size_t WS_KRB = 161 * MiB;
constexpr size_t WS_KRF = 163 * MiB;
constexpr size_t WS_KN = 166 * MiB;
constexpr size_t WS_V = 192 * MiB;
constexpr size_t WS_PO = 218 * MiB;
constexpr size_t WS_SK = 178 * MiB;
constexpr size_t WS_SV = 191 * MiB;
constexpr size_t WS_MODP = 242 * MiB;
constexpr size_t WS_END = 244 * MiB;

__device__ __forceinline__ unsigned f2bf(float f) { unsigned u = __builtin_bit_cast(unsigned, f); return (u + 0x7fffu + ((u >> 16) & 1u)) >> 16; }
__device__ __forceinline__ unsigned pk2(float lo, float hi) { f32x2 v = {lo, hi}; bf16x2_t b = __builtin_convertvector(v, bf16x2_t); return __builtin_bit_cast(unsigned, b); }
__device__ __forceinline__ float bflo(unsigned w) { return __uint_as_float(w << 16); }
__device__ __forceinline__ float bfhi(unsigned w) { return __uint_as_float(w & 0xffff0000u); }
__device__ __forceinline__ float silu_fast(float x) { return x * __builtin_amdgcn_rcpf(1.f + __builtin_amdgcn_exp2f(-x * LOG2E)); }
#define DPP_ADD(v, ctrl) ((v) + __int_as_float(__builtin_amdgcn_update_dpp(0, __float_as_int(v), (ctrl), 0xf, 0xf, true)))
__device__ __forceinline__ float wave_sum(float v) {
    v = DPP_ADD(v, 0xB1); v = DPP_ADD(v, 0x4E); v = DPP_ADD(v, 0x124); v = DPP_ADD(v, 0x128);
    { auto rr = __builtin_amdgcn_permlane16_swap(__float_as_uint(v), __float_as_uint(v), false, false); v = __uint_as_float(rr[0]) + __uint_as_float(rr[1]); }
    { auto rr = __builtin_amdgcn_permlane32_swap(__float_as_uint(v), __float_as_uint(v), false, false); v = __uint_as_float(rr[0]) + __uint_as_float(rr[1]); }
    return v;
}
#define LDS_WAIT() asm volatile("s_waitcnt lgkmcnt(0)" ::: "memory")
__device__ __forceinline__ int opaque_tid() { int t = threadIdx.x; asm volatile("" : "+v"(t)); return t; }

namespace pg8 {
typedef unsigned short bf16_t;
constexpr int BM = 256, BK = 64, HALF = 128, HTB = HALF * BK * 2, STAGE_BYTES = 8 * HTB, NXCD = 8, WGM = 8;
__host__ __device__ __forceinline__ int lds_byte(int r, int c) { const int st = (r >> 4) * 2 + (c >> 5), rr = r & 15, cc = c & 31, ob = rr * 64 + cc * 2; return st * 1024 + (ob ^ (((ob >> 9) & 1) << 5)); }
__host__ __device__ __forceinline__ void stage_rc(int b, int& Rr, int& C) { const int st = b / 1024, sb = b % 1024, swz = sb ^ (((sb >> 9) & 1) << 5); Rr = (st >> 1) * 16 + swz / 64; C = (st & 1) * 32 + (swz % 64) / 2; }
__host__ __device__ __forceinline__ int perm32(int rho) { const int n = rho >> 4, i = rho & 15; return 8 * (i >> 2) + 4 * n + (i & 3); }
struct Unit { int pm, pn; };
struct Gemm { const bf16_t* A; const bf16_t* Bt; int M, N, K, lda; };
struct StaticOrder {
    int nM, nN, nwg, G, c;
    __device__ void init(int M, int N, int G_, int c_) { nM = M / BM; nN = N / BM; nwg = nM * nN; G = G_; c = c_; }
    __device__ bool next(int i, Unit& u) const {
        const long L = (long)i * G + c; if (L >= nwg) return false;
        int wgid = (int)L; { const int q = nwg / NXCD, r = nwg % NXCD, xcd = wgid % NXCD, off = wgid / NXCD; wgid = (xcd < r ? xcd * (q + 1) : r * (q + 1) + (xcd - r) * q) + off; }
        const int nig = WGM * nN, gid = wgid / nig, fm = gid * WGM, gsz = (nM - fm) < WGM ? (nM - fm) : WGM;
        u.pm = fm + ((wgid % nig) % gsz); u.pn = (wgid % nig) / gsz; return true;
    }
};
template <class Epi, bool ALIGN_EPI>
__device__ __forceinline__ void gemm_phase(LAS unsigned char* lds, const Gemm g, const StaticOrder& S, const Epi& E) {
    const int tid = opaque_tid(), wid = __builtin_amdgcn_readfirstlane(tid >> 6), lane = tid & 63, wr = wid >> 2, wc = wid & 3, fr = lane & 15, fq = lane >> 4;
    const int K = g.K, nt = K / BK, lda = g.lda;
    unsigned voffA[2], voffB[2];
#pragma unroll
    for (int i = 0; i < 2; ++i) { int Rr, C; stage_rc(tid * 16 + i * 8192, Rr, C); const int Rb = Epi::PERM ? ((Rr & ~31) + perm32(Rr & 31)) : Rr;
        voffA[i] = (unsigned)(Rr * lda + C) * 2u; voffB[i] = (unsigned)(Rb * K + C) * 2u; }
    const size_t kstep = (size_t)(BK * 2);
    const size_t hA = (size_t)HALF * lda * 2, hB = (size_t)HALF * K * 2, tA = 2 * hA, tB = 2 * hB;
    const unsigned ldsw = (unsigned)wid * 1024u;
    const int aoff = lds_byte(wr * 64 + fr, fq * 8), boff = lds_byte(wc * 32 + fr, fq * 8);
#define PG8_SA(b, h) (((b) * 2 + (h)) * HTB)
#define PG8_SB(b, h) ((4 + (b) * 2 + (h)) * HTB)
#define PG8_STAGE(bufoff, gbase, voff) do { _Pragma("unroll") for (int _i = 0; _i < 2; ++_i) \
        __builtin_amdgcn_global_load_lds((const unsigned*)((const char*)(gbase) + (voff)[_i]), (LAS unsigned*)(lds + (bufoff) + ldsw + _i * 8192), 16, 0, 0); } while (0)
#define PG8_LDA(dst, b, h) do { _Pragma("unroll") for (int m = 0; m < 4; ++m) _Pragma("unroll") for (int k = 0; k < 2; ++k) dst[m][k] = *(const LAS bf16x8*)(lds + PG8_SA(b, h) + aoff + m * 2048 + k * 1024); } while (0)
#define PG8_LDB(dst, b, h) do { _Pragma("unroll") for (int n = 0; n < 2; ++n) _Pragma("unroll") for (int k = 0; k < 2; ++k) dst[n][k] = *(const LAS bf16x8*)(lds + PG8_SB(b, h) + boff + n * 2048 + k * 1024); } while (0)
#define PG8_MMA(ai, bj, At, Bt) do { __builtin_amdgcn_s_setprio(1); _Pragma("unroll") for (int m = 0; m < 4; ++m) _Pragma("unroll") for (int n = 0; n < 2; ++n) _Pragma("unroll") for (int k = 0; k < 2; ++k) \
        acc[ai][bj][m][n] = __builtin_amdgcn_mfma_f32_16x16x32_bf16(Bt[n][k], At[m][k], acc[ai][bj][m][n], 0, 0, 0); __builtin_amdgcn_s_setprio(0); } while (0)
#define PG8_WAIT_V(n) asm volatile("s_waitcnt vmcnt(" #n ")" ::: "memory")
#define PG8_WAIT_L(n) asm volatile("s_waitcnt lgkmcnt(" #n ")" ::: "memory")
#define PG8_BAR __builtin_amdgcn_s_barrier()
#define PG8_SCHED __builtin_amdgcn_sched_barrier(0)
    Unit cur, nxt; int ui = 0;
    if (!S.next(0, cur)) return;
    f32x4 acc[2][2][4][2];
#pragma unroll
    for (int a = 0; a < 2; ++a)
#pragma unroll
        for (int b = 0; b < 2; ++b)
#pragma unroll
            for (int m = 0; m < 4; ++m)
#pragma unroll
                for (int n = 0; n < 2; ++n) acc[a][b][m][n] = (f32x4){0.f, 0.f, 0.f, 0.f};
    const char* cA = (const char*)g.A + (size_t)cur.pm * tA; const char* cB = (const char*)g.Bt + (size_t)cur.pn * tB;
    PG8_STAGE(PG8_SB(0, 0), cB, voffB); PG8_STAGE(PG8_SB(0, 1), cB + hB, voffB); PG8_STAGE(PG8_SA(0, 0), cA, voffA); PG8_STAGE(PG8_SA(0, 1), cA + hA, voffA);
    if (wr == 1) PG8_BAR;
    PG8_WAIT_V(2); PG8_BAR;
    PG8_STAGE(PG8_SB(1, 0), cB + kstep, voffB); PG8_STAGE(PG8_SA(1, 0), cA + kstep, voffA); PG8_STAGE(PG8_SB(1, 1), cB + hB + kstep, voffB);
    PG8_WAIT_V(6); PG8_BAR;
    for (;;) {
        const bool has_next = S.next(ui + 1, nxt);
        const char* nA = has_next ? (const char*)g.A + (size_t)nxt.pm * tA : cA; const char* nB = has_next ? (const char*)g.Bt + (size_t)nxt.pn * tB : cB;
#pragma nounroll
        for (int t = 0; t < nt; t += 2) {
            const bool last = (t == nt - 2);
            bf16x8 At[4][2], B0[2][2], B1[2][2];
            const char* a1 = cA + (size_t)(t + 1) * kstep;
            const char* a2 = last ? nA : cA + (size_t)(t + 2) * kstep; const char* b2 = last ? nB : cB + (size_t)(t + 2) * kstep;
            const char* a3 = a2 + kstep; const char* b3 = b2 + kstep;
            PG8_LDB(B0, 0, 0); PG8_LDB(B1, 0, 1); PG8_SCHED; PG8_LDA(At, 0, 0); PG8_STAGE(PG8_SA(1, 1), a1 + hA, voffA);
            PG8_WAIT_V(8); PG8_WAIT_L(0); PG8_BAR; PG8_MMA(0, 0, At, B0); PG8_MMA(0, 1, At, B1); PG8_BAR; PG8_SCHED;
            PG8_LDA(At, 0, 1); PG8_STAGE(PG8_SB(0, 0), b2, voffB); PG8_STAGE(PG8_SB(0, 1), b2 + hB, voffB); PG8_STAGE(PG8_SA(0, 0), a2, voffA);
            PG8_WAIT_V(8); PG8_WAIT_L(0); PG8_BAR; PG8_MMA(1, 0, At, B0); PG8_MMA(1, 1, At, B1); PG8_BAR; PG8_SCHED;
            PG8_LDB(B0, 1, 0); PG8_LDB(B1, 1, 1); PG8_SCHED; PG8_LDA(At, 1, 0); PG8_STAGE(PG8_SA(0, 1), a2 + hA, voffA);
            PG8_WAIT_V(8); PG8_WAIT_L(0); PG8_BAR; PG8_MMA(0, 0, At, B0); PG8_MMA(0, 1, At, B1); PG8_BAR; PG8_SCHED;
            PG8_LDA(At, 1, 1); PG8_STAGE(PG8_SB(1, 0), b3, voffB); PG8_STAGE(PG8_SB(1, 1), b3 + hB, voffB); PG8_STAGE(PG8_SA(1, 0), a3, voffA);
            PG8_WAIT_V(8); PG8_WAIT_L(0); PG8_BAR; PG8_MMA(1, 0, At, B0); PG8_MMA(1, 1, At, B1); PG8_BAR; PG8_SCHED;
        }
        if constexpr (ALIGN_EPI) { if (wr == 0) PG8_BAR; }
        E(acc, cur, wr, wc, fr, fq);
        if (!has_next) break;
#pragma unroll
        for (int a = 0; a < 2; ++a)
#pragma unroll
            for (int b = 0; b < 2; ++b)
#pragma unroll
                for (int m = 0; m < 4; ++m)
#pragma unroll
                    for (int n = 0; n < 2; ++n) acc[a][b][m][n] = (f32x4){0.f, 0.f, 0.f, 0.f};
        cur = nxt; cA = nA; cB = nB; ++ui;
        if constexpr (ALIGN_EPI) { if (wr == 1) PG8_BAR; }
    }
    PG8_WAIT_V(0);
    if constexpr (!ALIGN_EPI) { if (wr == 0) PG8_BAR; }
    PG8_BAR;
#undef PG8_SA
#undef PG8_SB
#undef PG8_STAGE
#undef PG8_LDA
#undef PG8_LDB
#undef PG8_MMA
#undef PG8_WAIT_V
#undef PG8_WAIT_L
#undef PG8_BAR
#undef PG8_SCHED
}

__device__ __forceinline__ int rk_base(int pm) { return pm < 32 ? pm * 256 : RP + ((pm - 32) >> 3) * 2304 + ((pm - 32) & 7) * 256; }

struct EpiBf16 {
    static constexpr bool PERM = true;
    bf16* O; int ldc; int split_cols; size_t split_stride; int nostore;
    __device__ __forceinline__ void operator()(const f32x4 (&acc)[2][2][4][2], const Unit& u, int wr, int wc, int fr, int fq) const {
        const int row0 = u.pm * BM + wr * 64 + fr; int colt = u.pn * BM; bf16* base = O;
        if (split_cols) { const int t = colt / split_cols; base += (size_t)t * split_stride; colt -= t * split_cols; }
        const int col0 = colt + wc * 32 + 8 * fq;
#pragma unroll
        for (int ai = 0; ai < 2; ++ai)
#pragma unroll
            for (int m = 0; m < 4; ++m) { bf16* rowp = base + (size_t)(row0 + ai * HALF + m * 16) * ldc + col0;
#pragma unroll
                for (int bj = 0; bj < 2; ++bj) { const f32x4 v0 = acc[ai][bj][m][0], v1 = acc[ai][bj][m][1];
                    u32x4 w; w.x = pk2(v0[0], v0[1]); w.y = pk2(v0[2], v0[3]); w.z = pk2(v1[0], v1[1]); w.w = pk2(v1[2], v1[3]);
                    if (nostore) asm volatile("" :: "v"(w)); else *(u32x4*)(rowp + bj * HALF) = w; } }
    }
};
struct EpiPool {
    static constexpr bool PERM = true;
    bf16* GB;
    __device__ __forceinline__ void operator()(const f32x4 (&acc)[2][2][4][2], const Unit& u, int wr, int wc, int fr, int fq) const {
        const int row0 = u.pm * BM + wr * 64 + fr; const int col0 = u.pn * BM + wc * 32 + 8 * fq;
#pragma unroll
        for (int ai = 0; ai < 2; ++ai)
#pragma unroll
            for (int m = 0; m < 4; ++m) { bf16* rowp = GB + (size_t)(row0 + ai * HALF + m * 16) * 1024 + col0;
#pragma unroll
                for (int bj = 0; bj < 2; ++bj) { const f32x4 v0 = acc[ai][bj][m][0], v1 = acc[ai][bj][m][1];
                    const u32x4 gg = *(const u32x4*)(rowp + bj * HALF);
                    u32x4 w;
                    w.x = pk2(v0[0] * silu_fast(bflo(gg.x)), v0[1] * silu_fast(bfhi(gg.x))); w.y = pk2(v0[2] * silu_fast(bflo(gg.y)), v0[3] * silu_fast(bfhi(gg.y)));
                    w.z = pk2(v1[0] * silu_fast(bflo(gg.z)), v1[1] * silu_fast(bfhi(gg.z))); w.w = pk2(v1[2] * silu_fast(bflo(gg.w)), v1[3] * silu_fast(bfhi(gg.w)));
                    *(u32x4*)(rowp + bj * HALF) = w; } }
    }
};
struct EpiMlaIn {
    static constexpr bool PERM = true;
    bf16 *CQ, *CKV, *GAB, *VP; float* KRF;
    __device__ __forceinline__ void operator()(const f32x4 (&acc)[2][2][4][2], const Unit& u, int wr, int wc, int fr, int fq) const {
        const int rt = wr * 64 + fr, grow0 = u.pm * BM, rk0 = rk_base(u.pm), cc = wc * 32 + 8 * fq;
#pragma unroll
        for (int bj = 0; bj < 2; ++bj) {
            const int U = 2 * u.pn + bj;
            if (U == 5) {
                if (wc == 0) {
#pragma unroll
                    for (int ai = 0; ai < 2; ++ai)
#pragma unroll
                        for (int m = 0; m < 4; ++m) { float* p = KRF + (size_t)(grow0 + rt + ai * HALF + m * 16) * 32 + 8 * fq;
                            *(f32x4*)p = acc[ai][bj][m][0]; *(f32x4*)(p + 4) = acc[ai][bj][m][1]; }
                }
                continue;
            }
            bf16* p; int ld, rb = grow0;
            if (U < 3) { p = CQ + 128 * U; ld = 384; }
            else if (U < 5) { p = CKV + 128 * (U - 3); ld = 256; rb = rk0; }
            else if (U < 10) { p = GAB + 128 * (U - 6); ld = 1024; }
            else if (U < 14) { p = VP + 128 * (U - 10); ld = 512; }
            else { p = GAB + 512 + 128 * (U - 14); ld = 1024; }
            p += (size_t)(rb + rt) * ld + cc;
#pragma unroll
            for (int ai = 0; ai < 2; ++ai)
#pragma unroll
                for (int m = 0; m < 4; ++m) { const f32x4 v0 = acc[ai][bj][m][0], v1 = acc[ai][bj][m][1];
                    u32x4 w; w.x = pk2(v0[0], v0[1]); w.y = pk2(v0[2], v0[3]); w.z = pk2(v1[0], v1[1]); w.w = pk2(v1[2], v1[3]);
                    *(u32x4*)(p + (size_t)(ai * HALF + m * 16) * ld) = w; }
        }
    }
};
struct EpiQ {
    static constexpr bool PERM = false;
    bf16* Q; const float* rope8;
    __device__ __forceinline__ void operator()(const f32x4 (&acc)[2][2][4][2], const Unit& u, int wr, int wc, int fr, int fq) const {
        const int rt = wr * 64 + fr, grow0 = u.pm * BM; const bool sample = u.pm >= 32; const int t0 = ((u.pm - 32) & 7) * 256;
#pragma unroll
        for (int bj = 0; bj < 2; ++bj) {
            const int g32 = 8 * u.pn + 4 * bj + wc; const bool rot = sample && (g32 % 3 == 2);
#pragma unroll
            for (int ai = 0; ai < 2; ++ai)
#pragma unroll
                for (int m = 0; m < 4; ++m) { const int r = rt + ai * HALF + m * 16; f32x4 x1 = acc[ai][bj][m][0], x2 = acc[ai][bj][m][1];
                    if (rot) { const int t = t0 + r, pos = (fq < 2) ? (t >> 6) : (t & 63); const float* tb = rope8 + (pos * 8 + 4 * (fq & 1)) * 2;
                        const f32x4 c0 = *(const f32x4*)tb, c1 = *(const f32x4*)(tb + 4);
                        const f32x4 cs = {c0[0], c0[2], c1[0], c1[2]}, sn = {c0[1], c0[3], c1[1], c1[3]};
                        const f32x4 o1 = x1 * cs - x2 * sn, o2 = x1 * sn + x2 * cs; x1 = o1; x2 = o2; }
                    bf16* p = Q + (size_t)(grow0 + r) * 768 + 32 * g32 + 4 * fq;
                    u32x2 w1, w2; w1.x = pk2(x1[0], x1[1]); w1.y = pk2(x1[2], x1[3]); w2.x = pk2(x2[0], x2[1]); w2.y = pk2(x2[2], x2[3]);
                    *(u32x2*)p = w1; *(u32x2*)(p + 16) = w2; asm volatile("" ::: "memory"); }
        }
    }
};
struct EpiSwaIn {
    static constexpr bool PERM = false;
    bf16 *Q, *K, *V, *G; float *stK, *stV; const float* rope16;
    __device__ __forceinline__ void operator()(const f32x4 (&acc)[2][2][4][2], const Unit& u, int wr, int wc, int fr, int fq) const {
        const int rt = wr * 64 + fr, grow0 = u.pm * BM, rk0 = rk_base(u.pm); const bool sample = u.pm >= 32; const int t0 = ((u.pm - 32) & 7) * 256;
        const int pn = u.pn;
#pragma unroll
        for (int bj = 0; bj < 2; ++bj) {
            const int cb = 128 * bj + 32 * wc + 4 * fq;
            const bool rot = sample && pn < 5;
#pragma unroll
            for (int ai = 0; ai < 2; ++ai)
#pragma unroll
                for (int m = 0; m < 4; ++m) { const int r = rt + ai * HALF + m * 16; f32x4 x1 = acc[ai][bj][m][0], x2 = acc[ai][bj][m][1];
                    if (rot) { const int t = t0 + r, pos = (wc & 1) ? (t & 63) : (t >> 6); const float* tb = rope16 + (pos * 16 + 4 * fq) * 2;
                        const f32x4 c0 = *(const f32x4*)tb, c1 = *(const f32x4*)(tb + 4);
                        const f32x4 cs = {c0[0], c0[2], c1[0], c1[2]}, sn = {c0[1], c0[3], c1[1], c1[3]};
                        const f32x4 o1 = x1 * cs - x2 * sn, o2 = x1 * sn + x2 * cs; x1 = o1; x2 = o2; }
                    bf16* p;
                    if (pn < 4) p = Q + (size_t)(grow0 + r) * 1024 + 256 * pn + cb;
                    else if (pn == 4) p = K + (size_t)(rk0 + r) * 256 + cb;
                    else if (pn == 5) p = V + (size_t)(rk0 + r) * 256 + cb;
                    else p = G + (size_t)(grow0 + r) * 1024 + 256 * (pn - 6) + cb;
                    if (!sample && (pn == 4 || pn == 5)) { float* s = (pn == 4 ? stK : stV) + (size_t)(u.pm * 2 * 256 + r) * 256 + cb; *(f32x4*)s = x1; *(f32x4*)(s + 16) = x2; }
                    u32x2 w1, w2; w1.x = pk2(x1[0], x1[1]); w1.y = pk2(x1[2], x1[3]); w2.x = pk2(x2[0], x2[1]); w2.y = pk2(x2[2], x2[3]);
                    *(u32x2*)p = w1; *(u32x2*)(p + 16) = w2; asm volatile("" ::: "memory"); }
        }
    }
};
}

namespace att {
__device__ __forceinline__ int crow(int r, int hi) { return (r & 3) + 8 * (r >> 2) + 4 * hi; }
typedef short v4i16_t __attribute__((ext_vector_type(4)));
__device__ __forceinline__ s16x4 vtr(const LAS char* p) { return __builtin_bit_cast(s16x4, __builtin_amdgcn_ds_read_tr16_b64_v4i16((LAS v4i16_t*)p)); }
__device__ __forceinline__ float xhalf_max(float x) { auto rr = __builtin_amdgcn_permlane32_swap(__float_as_uint(x), __float_as_uint(x), false, false); return __builtin_fmaxf(__uint_as_float(rr[0]), __uint_as_float(rr[1])); }
__device__ __forceinline__ float xhalf_sum(float x) { auto rr = __builtin_amdgcn_permlane32_swap(__float_as_uint(x), __float_as_uint(x), false, false); return __uint_as_float(rr[0]) + __uint_as_float(rr[1]); }
#define SBAR() __builtin_amdgcn_sched_barrier(0)
#define PIN(x) asm volatile("" : "+v"(x))
__device__ __forceinline__ float max3f(float a, float b, float c) { float r; asm("v_max3_f32 %0, %1, %2, %3" : "=v"(r) : "v"(a), "v"(b), "v"(c)); return r; }
__device__ __forceinline__ float max2f(float a, float b) { float r; asm("v_max_f32_e32 %0, %1, %2" : "=v"(r) : "v"(a), "v"(b)); return r; }
struct Desc {
    const bf16* qptr; int ldq;
    const bf16* k0; int ldk0;
    const bf16* k1;
    const bf16* v; int ldv;
    int n_a, row_a, n_b, row_b, key_b;
    int qpos; float sink2; int has_sink;
    bf16* optr; int ldo;
    const bf16* gptr; int ldg;
};
constexpr float THR = 8.f;
template <int MODE>
__device__ __forceinline__ void attn_unit(LAS char* lds, const Desc& u) {
    constexpr int DQK = MODE == 0 ? 96 : 64, NCH = DQK / 8, ND0 = DQK / 16, KB = NCH * 1024, VOFF = 3 * KB, NG = 2 * ND0, NHELD = 8, NLATE = NG - NHELD;
    const int tid = opaque_tid(), lane = tid & 63, r32 = lane & 31, hi = lane >> 5; const int wid = __builtin_amdgcn_readfirstlane(tid >> 6);
    const bf16* ksrc = u.k0 + (size_t)lane * u.ldk0 + wid * 8;
    const bf16* k1src = (MODE == 0) ? u.k1 + (size_t)lane * 32 + (wid & 3) * 8 : nullptr;
    const bf16* vsrc = u.v + (size_t)(16 * (wid & 3) + (lane >> 2)) * u.ldv + (wid >> 2) * 32 + (lane & 3) * 8;
    const int kdst = wid * 1024, k1dst = (8 + (wid & 3)) * 1024, vdst = VOFF + wid * 1024;
    const int vlane = ((lane >> 4) & 1) * 32 + (lane & 3) * 8 + (4 * hi + ((lane & 15) >> 2)) * 64;
    const int kfo = hi * 1024 + r32 * 16;
    const int NT = u.n_a + u.n_b;
    const int qb0 = __builtin_amdgcn_readfirstlane(u.qpos);
#define TILE_ROW(t) ((t) < u.n_a ? u.row_a + 64 * (t) : u.row_b + 64 * ((t) - u.n_a))
#define GLDS16(g, l) __builtin_amdgcn_global_load_lds((const unsigned*)(g), (LAS unsigned*)(l), 16, 0, 0)
#define DMAK(t, soff) do { const size_t _r = (size_t)TILE_ROW(t); GLDS16(ksrc + _r * u.ldk0, lds + (soff) + kdst); if (MODE == 0 && wid < 4) GLDS16(k1src + _r * 32, lds + (soff) + k1dst); } while (0)
#define DMAV(t, vs) do { const size_t _r = (size_t)TILE_ROW(t); GLDS16(vsrc + _r * u.ldv, lds + (vs) * 8192 + vdst); } while (0)
    DMAK(0, 0); if (1 < NT) DMAK(1, KB); DMAV(0, 0);
    bf16x8 qr[ND0];
#pragma unroll
    for (int d0 = 0; d0 < ND0; ++d0) qr[d0] = *(const bf16x8*)(u.qptr + (size_t)r32 * u.ldq + d0 * 16 + hi * 8);
    float mref = 0.f, lsum = 0.f, fsc = 1.f; bool resc = false;
    f32x16 o0 = (f32x16){}, o1 = (f32x16){}, negm = (f32x16){};
    f32x16 cA0 = (f32x16){}, cA1 = (f32x16){}, cB0 = (f32x16){}, cB1 = (f32x16){};
    u32x4 pw[4];
#pragma unroll
    for (int i = 0; i < 4; ++i) pw[i] = (u32x4){0u, 0u, 0u, 0u};
    bf16x8 kf[NHELD];
    int sl_cur = 0, sl_nxt = KB, sl_fre = 2 * KB;
#define ROT() do { const int o_ = sl_cur; sl_cur = sl_nxt; sl_nxt = sl_fre; sl_fre = o_; } while (0)
#define KFADDR(i, soff) (lds + (soff) + kfo + ((i) >> 1) * 2048 + ((i) & 1) * 512)
#define PE(P0, P1, e) ((e) < 16 ? P0[(e) & 15] : P1[(e) & 15])
#define FILL_A(P0, P1, g) do { \
        _Pragma("unroll") for (int e_ = (32 * (g)) / NG; e_ < (32 * ((g) + 1)) / NG; ++e_) sacc += PE(P0, P1, e_); \
        PIN(sacc); \
        _Pragma("unroll") for (int k_ = (16 * (g)) / NG; k_ < (16 * ((g) + 1)) / NG; ++k_) { pw[k_ >> 2][k_ & 3] = pk2(PE(P0, P1, 2 * k_), PE(P0, P1, 2 * k_ + 1)); PIN(pw[k_ >> 2]); } } while (0)
#define QK_PHASE(C0, C1, P0, P1, HAVE_P) do { \
        bf16x8 kl_[NLATE > 0 ? NLATE : 1]; \
        _Pragma("unroll") for (int i_ = 0; i_ < NLATE; ++i_) kl_[i_] = *(const LAS bf16x8*)KFADDR(NHELD + i_, sl_cur); \
        _Pragma("unroll") for (int g_ = 0; g_ < NG; ++g_) { const int d0_ = g_ >> 1; \
            const bf16x8 kk_ = g_ < NHELD ? kf[g_ < NHELD ? g_ : 0] : kl_[g_ >= NHELD ? g_ - NHELD : 0]; \
            if ((g_ & 1) == 0) C0 = __builtin_amdgcn_mfma_f32_32x32x16_bf16(kk_, qr[d0_], d0_ == 0 ? negm : C0, 0, 0, 0); \
            else C1 = __builtin_amdgcn_mfma_f32_32x32x16_bf16(kk_, qr[d0_], d0_ == 0 ? negm : C1, 0, 0, 0); \
            if (HAVE_P) FILL_A(P0, P1, g_); \
            SBAR(); } } while (0)
#define MASKT(C0, C1, t_) do { if (MODE == 1 && (t_) >= u.n_a) { const int key0_ = u.key_b + 64 * ((t_) - u.n_a); \
        if (key0_ - (qb0 + 31) < -128 || key0_ + 63 - qb0 > 128) { const int k0p_ = key0_ - u.qpos; \
            _Pragma("unroll") for (int r = 0; r < 16; ++r) { const int d_ = k0p_ + crow(r, hi); if (d_ > 128 || d_ < -128) C0[r] = -1e30f; if (d_ + 32 > 128 || d_ + 32 < -128) C1[r] = -1e30f; } } } } while (0)
#define DECIDE(C0, C1) do { \
        float a_ = max2f(C0[0], C1[0]), b_ = max2f(C0[1], C1[1]); \
        _Pragma("unroll") for (int r = 2; r < 16; r += 2) { a_ = max3f(a_, C0[r], C1[r]); b_ = max3f(b_, C0[r + 1], C1[r + 1]); } \
        a_ = xhalf_max(max2f(a_, b_)); resc = false; \
        if (__any(a_ > THR)) { const float dl_ = fmaxf(a_, 0.f); mref += dl_; \
            _Pragma("unroll") for (int r = 0; r < 16; ++r) { C0[r] -= dl_; C1[r] -= dl_; } \
            _Pragma("unroll") for (int r = 0; r < 16; ++r) negm[r] = -mref; \
            fsc = __builtin_amdgcn_exp2f(-dl_); lsum *= fsc; resc = true; } } while (0)
#define EXP4(C0, C1, j) do { _Pragma("unroll") for (int e_ = 4 * (j); e_ < 4 * (j) + 4; ++e_) { if (e_ < 16) C0[e_ & 15] = __builtin_amdgcn_exp2f(C0[e_ & 15]); else C1[e_ & 15] = __builtin_amdgcn_exp2f(C1[e_ & 15]); } \
        if (4 * (j) < 16) PIN(C0); else PIN(C1); } while (0)
#define VOFFS(j) ((((j) & 1) * 4096) + (((j) >> 1) * 1024))
#define PV_PHASE(C0, C1, HAVE_C, HAVE_K, tp_) do { \
        const LAS char* vp_ = lds + VOFF + ((tp_) & 1) * 8192 + vlane; \
        s16x4 vl_[8], vh_[8]; \
        vl_[0] = vtr(vp_ + VOFFS(0)); vh_[0] = vtr(vp_ + VOFFS(0) + 512); vl_[1] = vtr(vp_ + VOFFS(1)); vh_[1] = vtr(vp_ + VOFFS(1) + 512); \
        _Pragma("unroll") for (int j = 0; j < 8; ++j) { const int ks = j >> 1, dd = j & 1; \
            if (j + 2 < 8) { vl_[j + 2] = vtr(vp_ + VOFFS(j + 2)); vh_[j + 2] = vtr(vp_ + VOFFS(j + 2) + 512); } \
            if (HAVE_K) kf[j] = *(const LAS bf16x8*)KFADDR(j, sl_nxt); \
            const bf16x8 vf_ = {vl_[j][0], vl_[j][1], vl_[j][2], vl_[j][3], vh_[j][0], vh_[j][1], vh_[j][2], vh_[j][3]}; \
            if (dd == 0) o0 = __builtin_amdgcn_mfma_f32_32x32x16_bf16(vf_, __builtin_bit_cast(bf16x8, pw[ks]), o0, 0, 0, 0); \
            else o1 = __builtin_amdgcn_mfma_f32_32x32x16_bf16(vf_, __builtin_bit_cast(bf16x8, pw[ks]), o1, 0, 0, 0); \
            if (HAVE_C) EXP4(C0, C1, j); \
            SBAR(); } } while (0)
#define STEP(C0, C1, P0, P1, t_) do { \
        if ((t_) + 2 < NT) DMAK((t_) + 2, sl_fre); \
        DMAV(t_, (t_) & 1); \
        float sacc = 0.f; \
        QK_PHASE(C0, C1, P0, P1, true); \
        lsum += sacc; \
        MASKT(C0, C1, t_); \
        DECIDE(C0, C1); \
        SBAR(); \
        PV_PHASE(C0, C1, true, true, (t_) - 1); \
        __syncthreads(); \
        ROT(); \
        if (resc) { o0 *= fsc; o1 *= fsc; } } while (0)
    __syncthreads();
#pragma unroll
    for (int i = 0; i < NHELD; ++i) kf[i] = *(const LAS bf16x8*)KFADDR(i, 0);
    {
        if (2 < NT) DMAK(2, sl_fre);
        float sacc = 0.f; (void)sacc;
        QK_PHASE(cA0, cA1, cA0, cA1, false);
        MASKT(cA0, cA1, 0);
        DECIDE(cA0, cA1);
#pragma unroll
        for (int j = 0; j < 8; ++j) { kf[j] = *(const LAS bf16x8*)KFADDR(j, sl_nxt); EXP4(cA0, cA1, j); SBAR(); }
        __syncthreads();
        ROT();
    }
    int t = 1;
    for (; t + 1 < NT; t += 2) { STEP(cB0, cB1, cA0, cA1, t); STEP(cA0, cA1, cB0, cB1, t + 1); }
    if (t < NT) {
        STEP(cB0, cB1, cA0, cA1, t);
        float sacc = 0.f;
#pragma unroll
        for (int g = 0; g < NG; ++g) FILL_A(cB0, cB1, g);
        lsum += sacc;
        PV_PHASE(cB0, cB1, false, false, NT - 1);
    } else {
        float sacc = 0.f;
#pragma unroll
        for (int g = 0; g < NG; ++g) FILL_A(cA0, cA1, g);
        lsum += sacc;
        PV_PHASE(cA0, cA1, false, false, NT - 1);
    }
#undef TILE_ROW
#undef GLDS16
#undef DMAK
#undef DMAV
#undef ROT
#undef KFADDR
#undef PE
#undef FILL_A
#undef QK_PHASE
#undef MASKT
#undef DECIDE
#undef EXP4
#undef VOFFS
#undef PV_PHASE
#undef STEP
    float lt = xhalf_sum(lsum);
    if (u.has_sink) lt += __builtin_amdgcn_exp2f(u.sink2 - mref);
    const float inv = 1.0f / lt;
    bf16* op = u.optr + (size_t)r32 * u.ldo + 4 * hi; const bf16* gp = u.gptr + (size_t)r32 * u.ldg + 4 * hi;
#pragma unroll
    for (int d0 = 0; d0 < 2; ++d0)
#pragma unroll
        for (int g = 0; g < 4; ++g) {
            bf16* p = op + 32 * d0 + 8 * g; const u32x2 gg = *(const u32x2*)(gp + 32 * d0 + 8 * g);
            const f32x16& o = d0 ? o1 : o0;
            const float a0 = o[4 * g] * inv * silu_fast(bflo(gg.x)), a1 = o[4 * g + 1] * inv * silu_fast(bfhi(gg.x));
            const float a2 = o[4 * g + 2] * inv * silu_fast(bflo(gg.y)), a3 = o[4 * g + 3] * inv * silu_fast(bfhi(gg.y));
            u32x2 w; w.x = pk2(a0, a1); w.y = pk2(a2, a3); *(u32x2*)p = w;
        }
    __syncthreads();
}
#undef SBAR
}

#define XB_TMO      128
#define XB_XCNT(j)  (256  + 64 * (j))
#define XB_XSUB(j)  (1280 + 64 * (j))
#define XB_XGEN(j)  (2304 + 64 * (j))
#define XB_TOP      3328
#define XB_TOPGEN   3392
#define XCD_BAR_WORDS 3456
#define XB_SPIN_CAP (1u << 20)
__device__ __forceinline__ unsigned xb_ld(unsigned* p)              { return __hip_atomic_load(p, __ATOMIC_RELAXED, __HIP_MEMORY_SCOPE_AGENT); }
__device__ __forceinline__ unsigned xb_add(unsigned* p, unsigned v) { return __hip_atomic_fetch_add(p, v, __ATOMIC_RELAXED, __HIP_MEMORY_SCOPE_AGENT); }
__device__ __forceinline__ unsigned xb_xcc_id() { return (unsigned)__builtin_amdgcn_s_getreg((3 << 11) | 20) & 0xFu; }
#define XB_SPIN(cond, bar) do { unsigned _sp = 0; while (cond) { __builtin_amdgcn_s_sleep(1); \
    if ((++_sp & 255u) == 0u) { if (xb_ld(&(bar)[XB_TMO])) break; if (_sp > XB_SPIN_CAP) { atomicAdd(&(bar)[XB_TMO], 1u); break; } } } } while (0)
struct XcdBarrier { unsigned* bar; unsigned x; volatile LAS unsigned* st; };
__device__ __forceinline__ XcdBarrier xcd_barrier_post(unsigned* bar, volatile LAS unsigned* st) {
    XcdBarrier b; b.bar = bar; b.x = xb_xcc_id(); b.st = st;
    if (threadIdx.x == 0) (void)xb_add(&bar[XB_XCNT(b.x)], 1u);
    return b;
}
__device__ __forceinline__ void xcd_barrier_complete(unsigned* bar, unsigned x, unsigned& nloc, unsigned& nx) {
    const unsigned G = gridDim.x * gridDim.y * gridDim.z;
    unsigned sum, cnt, mine, sp = 0u;
    for (;;) {
        sum = 0u; cnt = 0u; mine = 0u;
#pragma unroll
        for (unsigned j = 0; j < 16; ++j) { const unsigned c = xb_ld(&bar[XB_XCNT(j)]); sum += c; cnt += (c > 0u) ? 1u : 0u; mine = (j == x) ? c : mine; }
        if (sum == G) break;
        __builtin_amdgcn_s_sleep(1);
        if ((++sp & 255u) == 0u) { if (xb_ld(&bar[XB_TMO])) break; if (sp > XB_SPIN_CAP) { atomicAdd(&bar[XB_TMO], 1u); break; } }
    }
    nloc = mine > 0u ? mine : 1u; nx = cnt > 0u ? cnt : 1u;
}
__device__ __forceinline__ void xcd_barrier(const XcdBarrier& b0) {
    asm volatile("s_waitcnt vmcnt(0)" ::: "memory");
    __syncthreads();
    if (threadIdx.x == 0) {
        XcdBarrier b = b0; b.x = xb_xcc_id();
        unsigned* bar = b.bar; asm volatile("" : "+s"(bar));
        __builtin_amdgcn_s_waitcnt(0);
        unsigned nloc = b.st[0], nx = b.st[1];
        if (nloc == 0u) { xcd_barrier_complete(bar, b.x, nloc, nx); b.st[0] = nloc; b.st[1] = nx; }
        const unsigned old = xb_add(&bar[XB_XSUB(b.x)], 1u);
        const unsigned gen = old / nloc;
        if (old + 1u == (gen + 1u) * nloc) {
            __builtin_amdgcn_fence(__ATOMIC_RELEASE, "agent");
            asm volatile("s_waitcnt vmcnt(0)" ::: "memory");
            const unsigned og = xb_add(&bar[XB_TOP], 1u);
            const unsigned tg = og / nx;
            if (og + 1u == (tg + 1u) * nx) xb_add(&bar[XB_TOPGEN], 1u);
            else XB_SPIN(xb_ld(&bar[XB_TOPGEN]) == tg, bar);
            __builtin_amdgcn_fence(__ATOMIC_ACQUIRE, "agent");
            xb_add(&bar[XB_XGEN(b.x)], 1u);
            asm volatile("s_waitcnt vmcnt(0)" ::: "memory");
        } else {
            XB_SPIN(xb_ld(&bar[XB_XGEN(b.x)]) == gen, bar);
            __builtin_amdgcn_fence(__ATOMIC_ACQUIRE, "agent");
            asm volatile("s_waitcnt vmcnt(0)" ::: "memory");
        }
    }
    __syncthreads();
}

struct Args { const float* in[23]; float* out; unsigned char* ws; int ph_lo, ph_hi; };
constexpr int NWAVES = 8;
constexpr int N_PHASES = 2 + 6 + 4 + 6 + 4;
constexpr int RING_BYTES = 131072, MISC_OFF = RING_BYTES + 320, LDS_BYTES = 147456;

struct TMap { int kind, row_off, col_off, ldw; const float* nscale; float scale; };
__device__ __forceinline__ void tmap(const TMap& tm, int n, int& drow, float& sc) {
    drow = n + tm.row_off; sc = tm.scale;
    switch (tm.kind) {
        case 1: if (n >= 672) drow += 96; break;
        case 2: { const int e = n % 96; if (e >= 64) { const int d = e - 64; const int p = (d & 7) | ((d & 8) << 1) | ((d & 16) >> 1); drow = n - e + 64 + p; } } break;
        case 3: { const int h = n >> 7, e = n & 127; drow = (e < 64) ? h * 64 + e : 512 + h * 64 + (e - 64); } break;
        case 4: sc = tm.nscale[n]; break;
        case 5: if (n >= 1024) sc = 1.f; break;
        default: break;
    }
}
__device__ __forceinline__ void transpose_item(const float* W, int K, int N, bf16* WT, const TMap& tm, LAS float* scr, int item, int lane) {
    const int nblk = N / 32, kb = item / nblk, nb = item % nblk, k0 = 64 * kb, n0 = 32 * nb;
#pragma unroll 8
    for (int i = 0; i < 32; ++i) { const int kk = 2 * i + (lane >> 5); scr[kk * 33 + (lane & 31)] = W[(size_t)(k0 + kk) * N + n0 + (lane & 31)]; }
    LDS_WAIT(); asm volatile("" ::: "memory");
    const int c = lane & 7;
#pragma unroll
    for (int j = 0; j < 4; ++j) { const int n = (lane >> 3) + 8 * j; const LAS float* s = scr + (8 * c) * 33 + n;
        int drow; float sc; tmap(tm, n0 + n, drow, sc);
        u32x4 o; o.x = pk2(s[0 * 33] * sc, s[1 * 33] * sc); o.y = pk2(s[2 * 33] * sc, s[3 * 33] * sc); o.z = pk2(s[4 * 33] * sc, s[5 * 33] * sc); o.w = pk2(s[6 * 33] * sc, s[7 * 33] * sc);
        *(u32x4*)(WT + (size_t)drow * tm.ldw + tm.col_off + k0 + 8 * c) = o; }
    LDS_WAIT(); asm volatile("" ::: "memory");
}

typedef __attribute__((address_space(4))) const char* kptr_t;
__device__ __forceinline__ const void* arg_ptr(int k) { kptr_t ka = (kptr_t)__builtin_amdgcn_kernarg_segment_ptr(); asm volatile("" : "+s"(ka)); return *(const void* __attribute__((address_space(4)))*)(ka + 8 * k); }
#define ARG_IN(k) ((const float*)arg_ptr(k))
__device__ __forceinline__ f32x4 mod_load(const float* MODPp, const float* ada_b, int l, int midx, int off) {
    f32x4 s = *(const f32x4*)(ada_b + l * 3072 + off);
#pragma unroll
    for (int kq = 0; kq < 4; ++kq) s += *(const f32x4*)(MODPp + ((size_t)((kq * 4 + l) * 9 + midx)) * 3072 + off);
    return s;
}
__device__ __forceinline__ int mod_index(int row) { return row < RP ? 8 : ((row - RP) >> 11); }

__global__ void __launch_bounds__(NWAVES * 64, 2) fwd_kernel(Args args) {
    extern __shared__ __attribute__((aligned(16))) unsigned char lds_raw[];
    LAS unsigned char* lds = (LAS unsigned char*)lds_raw;
    volatile LAS unsigned* MISC = (volatile LAS unsigned*)(lds + MISC_OFF);
    const int G = gridDim.x; const int bx = blockIdx.x; const int vcu = (G % 8 == 0) ? (bx % 8) * (G / 8) + bx / 8 : bx;
    const int NGW = G * NWAVES;
    { const int tid0 = threadIdx.x; for (int u = tid0; u < (LDS_BYTES - RING_BYTES) / 4; u += NWAVES * 64) ((LAS unsigned*)(lds + RING_BYTES))[u] = 0u; }
    __syncthreads();
    XcdBarrier bar; bar.bar = (unsigned*)((unsigned char*)arg_ptr(24) + WS_CTL) + 1024; bar.x = 0; bar.st = nullptr;
    if (!MK_PER_PHASE) bar = xcd_barrier_post(bar.bar, MISC + 8);
    const int lo = MK_PER_PHASE ? args.ph_lo : 0, hi = MK_PER_PHASE ? args.ph_hi : N_PHASES;
    int pid = 0;
#ifndef PHASE_MASK
#define PHASE_MASK 0xFFFFFFFFu
#endif
#define IN_PH() (lo <= pid && pid < hi)
#ifndef G2M
#define G2M 7
#endif
#define PK(k) ((PHASE_MASK >> (k)) & 1u)
#ifndef PROBE_DUP
#define PROBE_DUP 0u
#endif
#define REPS(k) ((((PROBE_DUP) >> (k)) & 1u) ? 2 : 1)
#ifndef PROBE_BAR2
#define PROBE_BAR2 0
#endif
#define END_PH() do { if (!MK_PER_PHASE && lo <= pid && pid + 1 < hi) { xcd_barrier(bar); if (PROBE_BAR2) xcd_barrier(bar); } ++pid; } while (0)
#define PH_BEGIN() unsigned char* const ws = (unsigned char*)arg_ptr(24); float* const out = (float*)arg_ptr(23); \
    const int tid = opaque_tid(), lane = tid & 63, wave = __builtin_amdgcn_readfirstlane(tid >> 6), gw = vcu * NWAVES + wave; (void)out; (void)lane; (void)gw; (void)ws
#define MOD ((float*)(ws + WS_MOD))
#define ROPE8 ((float*)(ws + WS_ROPE8))
#define ROPE16 ((float*)(ws + WS_ROPE16))
#define MODP ((float*)(ws + WS_MODP))
#define Hb ((bf16*)(ws + WS_H))
#define GAB ((bf16*)(ws + WS_GAB))
#define CQ ((bf16*)(ws + WS_CQ))
#define CKV ((bf16*)(ws + WS_CKV))
#define KRB ((bf16*)(ws + WS_KRB))
#define KRF ((float*)(ws + WS_KRF))
#define KN ((bf16*)(ws + WS_KN))
#define VP ((bf16*)(ws + WS_KN))
#define VV ((bf16*)(ws + WS_V))
#define PO ((bf16*)(ws + WS_PO))
#define SQ ((bf16*)(ws + WS_CQ))
#define SK ((bf16*)(ws + WS_SK))
#define SV ((bf16*)(ws + WS_SV))

    if (IN_PH() && PK(1)) for (int rep = 0; rep < REPS(1); ++rep) { PH_BEGIN(); (void)rep;
        {
            const float* cvec = ARG_IN(6); const float* cctx = ARG_IN(7); const float* ada_w = ARG_IN(8);
            LAS float* red = (LAS float*)lds;
            for (int it = bx; it < 192; it += G) {
                const int l = it / 48, rem = it % 48, cc = rem >> 2, kq = rem & 3, k0 = kq * 256 + wave * 32;
                float sv[9];
#pragma unroll
                for (int j = 0; j < 9; ++j) { const float c = (j < 8) ? cvec[j * 1024 + k0 + (lane & 31)] : cctx[k0 + (lane & 31)]; sv[j] = c / (1.f + expf(-c)); }
                f32x4 acc[9];
#pragma unroll
                for (int j = 0; j < 9; ++j) acc[j] = (f32x4){0.f, 0.f, 0.f, 0.f};
                const float* wp = ada_w + ((size_t)l * 1024 + k0) * 3072 + cc * 256 + 4 * lane;
#pragma unroll
                for (int kk = 0; kk < 32; ++kk) {
                    const f32x4 w = *(const f32x4*)(wp + (size_t)kk * 3072);
#pragma unroll
                    for (int j = 0; j < 9; ++j) { const float sc = __int_as_float(__builtin_amdgcn_readlane(__float_as_int(sv[j]), kk)); acc[j] += w * sc; }
                }
#pragma unroll
                for (int j = 0; j < 9; ++j) *(LAS f32x4*)(red + (wave * 9 + j) * 256 + 4 * lane) = acc[j];
                __syncthreads();
                for (int idx = tid; idx < 9 * 256; idx += NWAVES * 64) { const int j = idx >> 8, col = idx & 255; float sm = 0.f;
#pragma unroll
                    for (int w = 0; w < 8; ++w) sm += red[(w * 9 + j) * 256 + col];
                    MODP[((size_t)((kq * 4 + l) * 9 + j)) * 3072 + cc * 256 + col] = sm; }
                __syncthreads();
            }
        }
        for (int e = bx * 512 + tid; e < 64 * 8 + 64 * 16; e += G * 512) {
            if (e < 512) { const int pos = e >> 3, i = e & 7; const float inv = powf(10000.f, -(float)i / 8.f), a = (float)pos * inv; ROPE8[2 * e] = cosf(a); ROPE8[2 * e + 1] = sinf(a); }
            else { const int f = e - 512, pos = f >> 4, i = f & 15; const float inv = powf(10000.f, -(float)i / 16.f), a = (float)pos * inv; ROPE16[2 * f] = cosf(a); ROPE16[2 * f + 1] = sinf(a); }
        }
        LAS float* scr = (LAS float*)(lds + wave * 16384);
        constexpr int I1 = 1104, I2 = 144, I3 = 128, I4 = 32, I5 = 512, I6 = 1280, I7 = 512, IMLA = I1 + I2 + I3 + I4 + I5, ISWA = I6 + I7, ITOT = 2 * (IMLA + ISWA);
        for (int it = gw; it < ITOT; it += NGW) {
            int r = it; const int i = (r >= IMLA + ISWA) ? 1 : 0; r -= i * (IMLA + ISWA);
            unsigned char* wm = ws + (i ? WS_W_MLA1 : WS_W_MLA0); unsigned char* wsw = ws + (i ? WS_W_SWA1 : WS_W_SWA0);
            if (r < I1) { TMap tm{1, 0, 0, 1024, nullptr, 1.f}; transpose_item(ARG_IN(12) + (size_t)i * 1024 * 2208, 1024, 2208, (bf16*)wm, tm, scr, r, lane); continue; } r -= I1;
            if (r < I2) { TMap tm{2, 0, 0, 384, nullptr, MLA_SC}; transpose_item(ARG_IN(15) + (size_t)i * 384 * 768, 384, 768, (bf16*)(wm + SZ_WIN_MLA), tm, scr, r, lane); continue; } r -= I2;
            if (r < I3) { TMap tm{3, 0, 0, 256, nullptr, 1.f}; transpose_item(ARG_IN(16) + (size_t)i * 256 * 1024, 256, 1024, (bf16*)(wm + SZ_WIN_MLA + SZ_WUQ), tm, scr, r, lane); continue; } r -= I3;
            if (r < I4) { const int g = r >> 3; TMap tm{4, g * 128, g * 128, 512, ARG_IN(18) + i * 512 + g * 128, 1.f};
                transpose_item(ARG_IN(17) + ((size_t)i * 4 + g) * 128 * 128, 128, 128, (bf16*)(wm + SZ_WIN_MLA + SZ_WUQ + SZ_WUKV), tm, scr, r & 7, lane); continue; } r -= I4;
            if (r < I5) { TMap tm{0, 0, 0, 1024, nullptr, 1.f}; transpose_item(ARG_IN(19) + (size_t)i * 1024 * 1024, 1024, 1024, (bf16*)(wm + SZ_WIN_MLA + SZ_WUQ + SZ_WUKV + SZ_WPOOL), tm, scr, r, lane); continue; } r -= I5;
            if (r < I6) { TMap tm{5, 0, 0, 1024, nullptr, SWA_SC}; transpose_item(ARG_IN(20) + (size_t)i * 1024 * 2560, 1024, 2560, (bf16*)wsw, tm, scr, r, lane); continue; } r -= I6;
            { TMap tm{0, 0, 0, 1024, nullptr, 1.f}; transpose_item(ARG_IN(22) + (size_t)i * 1024 * 1024, 1024, 1024, (bf16*)(wsw + SZ_WIN_SWA), tm, scr, r, lane); }
        }
        const u32x4 z = {0u, 0u, 0u, 0u};
        for (int e = bx * 512 + tid; e < 2 * 96 * 128; e += G * 512) { const int i = e / (96 * 128), f = e % (96 * 128);
            *(u32x4*)(ws + (i ? WS_W_MLA1 : WS_W_MLA0) + (size_t)672 * 2048 + (size_t)f * 16) = z; }
        for (int e = bx * 512 + tid; e < 2 * 512 * 64; e += G * 512) { const int i = e / (512 * 64), f = e % (512 * 64), n = f >> 6, kc = f & 63;
            if ((n >> 7) != (kc >> 4)) *(u32x4*)(ws + (i ? WS_W_MLA1 : WS_W_MLA0) + SZ_WIN_MLA + SZ_WUQ + SZ_WUKV + (size_t)n * 1024 + (size_t)kc * 16) = z; }
    }
    END_PH();

    if (IN_PH() && PK(2)) for (int rep = 0; rep < REPS(2); ++rep) { PH_BEGIN(); (void)rep;
        const float* npre = ARG_IN(10); const float* xin0 = ARG_IN(0); const float* xin1 = ARG_IN(1); const float* adab = ARG_IN(9);
        {
            const float* npost0 = ARG_IN(11);
            for (int it = bx; it < 36; it += G) { const int l = it / 9, j = it % 9;
                for (int c = tid * 4; c < 1024; c += NWAVES * 64 * 4) { float* cf = MOD + (size_t)(l * 9 + j) * 3072;
                    *(f32x4*)(cf + c) = mod_load(MODP, adab, l, j, 2048 + c) * *(const f32x4*)(npost0 + l * 1024 + c);
                    *(f32x4*)(cf + 1024 + c) = *(const f32x4*)(npre + l * 1024 + c) * (mod_load(MODP, adab, l, j, 1024 + c) + 1.f);
                    *(f32x4*)(cf + 2048 + c) = mod_load(MODP, adab, l, j, c); } }
        }
        for (int chunk = gw; chunk < R / 12; chunk += NGW) {
            int curm = -1; f32x4 cB[4], cC[4];
#pragma unroll
            for (int j = 0; j < 4; ++j) { cB[j] = (f32x4){0.f, 0.f, 0.f, 0.f}; cC[j] = cB[j]; }
            for (int rr = 0; rr < 12; ++rr) {
                const int row = chunk * 12 + rr, midx = mod_index(row);
                if (midx != curm) { curm = midx;
#pragma unroll
                    for (int j = 0; j < 4; ++j) { const int c = 4 * lane + 256 * j; const f32x4 g = *(const f32x4*)(npre + c), sc = mod_load(MODP, adab, 0, midx, 1024 + c); cB[j] = g * (sc + 1.f); cC[j] = mod_load(MODP, adab, 0, midx, c); } }
                const float* xr = row < RP ? xin0 + (size_t)row * D : xin1 + (size_t)(row - RP) * D;
                f32x4 v[4]; float ss = 0.f;
#pragma unroll
                for (int j = 0; j < 4; ++j) { v[j] = *(const f32x4*)(xr + 4 * lane + 256 * j); ss += v[j][0] * v[j][0] + v[j][1] * v[j][1] + v[j][2] * v[j][2] + v[j][3] * v[j][3]; }
                const float rstd = 1.f / sqrtf(wave_sum(ss) * (1.f / D) + EPS);
#pragma unroll
                for (int j = 0; j < 4; ++j) { const f32x4 h = v[j] * rstd * cB[j] + cC[j]; u32x2 w; w.x = pk2(h[0], h[1]); w.y = pk2(h[2], h[3]); *(u32x2*)(Hb + (size_t)row * D + 4 * lane + 256 * j) = w; }
            }
        }
    }
    END_PH();

    for (int l = 0; l < NL; ++l) {
        const int i = l >> 1;
        if ((l & 1) == 0) {
#define WM_BASE (ws + (i ? WS_W_MLA1 : WS_W_MLA0))
#define M_WinT ((const bf16*)WM_BASE)
#define M_WuqT ((const bf16*)(WM_BASE + SZ_WIN_MLA))
#define M_WukvT ((const bf16*)(WM_BASE + SZ_WIN_MLA + SZ_WUQ))
#define M_WpT ((const bf16*)(WM_BASE + SZ_WIN_MLA + SZ_WUQ + SZ_WUKV))
#define M_WoT ((const bf16*)(WM_BASE + SZ_WIN_MLA + SZ_WUQ + SZ_WUKV + SZ_WPOOL))
            if (IN_PH() && PK(3)) for (int rep = 0; rep < REPS(3); ++rep) { PH_BEGIN(); (void)rep;
                pg8::Gemm g{Hb, M_WinT, R, 2304, 1024, 1024}; pg8::StaticOrder S; S.init(R, 2304, G, bx);
                pg8::EpiMlaIn E{CQ, CKV, GAB, VP, KRF};
                pg8::gemm_phase<pg8::EpiMlaIn, true>(lds, g, S, E);
            }
            END_PH();
            if (IN_PH() && PK(4)) for (int rep = 0; rep < REPS(4); ++rep) { PH_BEGIN(); (void)rep;
                const float* gq = ARG_IN(13) + i * 384; const float* gkv = ARG_IN(14) + i * 256;
                const float* cckv = ARG_IN(2); const float* ckr = ARG_IN(3);
                for (int row = gw; row < R + 2048; row += NGW) {
                    if (row < R) {
                        const bool prompt = row < RP; const int b = prompt ? row >> 8 : (row - RP) >> 11, t = prompt ? row & 255 : (row - RP) & 2047, T = prompt ? 256 : 2048;
                        const int rk = prompt ? row : RP + b * 2304 + t;
                        { float v[8]; float ss = 0.f; u32x4 w = {0u, 0u, 0u, 0u}; if (lane < 48) w = *(const u32x4*)(CQ + (size_t)row * 384 + 8 * lane);
                          v[0] = bflo(w.x); v[1] = bfhi(w.x); v[2] = bflo(w.y); v[3] = bfhi(w.y); v[4] = bflo(w.z); v[5] = bfhi(w.z); v[6] = bflo(w.w); v[7] = bfhi(w.w);
#pragma unroll
                          for (int e = 0; e < 8; ++e) ss += v[e] * v[e];
                          const float rstd = 1.f / sqrtf(wave_sum(ss) * (1.f / 384.f) + EPS);
                          if (lane < 48) { const f32x4 g0 = *(const f32x4*)(gq + 8 * lane), g1 = *(const f32x4*)(gq + 8 * lane + 4);
                              u32x4 o; o.x = pk2(v[0] * rstd * g0[0], v[1] * rstd * g0[1]); o.y = pk2(v[2] * rstd * g0[2], v[3] * rstd * g0[3]); o.z = pk2(v[4] * rstd * g1[0], v[5] * rstd * g1[1]); o.w = pk2(v[6] * rstd * g1[2], v[7] * rstd * g1[3]);
                              *(u32x4*)(CQ + (size_t)row * 384 + 8 * lane) = o; } }
                        { float v[8]; float ss = 0.f; u32x4 w = {0u, 0u, 0u, 0u}; if (lane < 32) w = *(const u32x4*)(CKV + (size_t)rk * 256 + 8 * lane);
                          v[0] = bflo(w.x); v[1] = bfhi(w.x); v[2] = bflo(w.y); v[3] = bfhi(w.y); v[4] = bflo(w.z); v[5] = bfhi(w.z); v[6] = bflo(w.w); v[7] = bfhi(w.w);
#pragma unroll
                          for (int e = 0; e < 8; ++e) ss += v[e] * v[e];
                          const float rstd = 1.f / sqrtf(wave_sum(ss) * (1.f / 256.f) + EPS);
                          if (lane < 32) { const f32x4 g0 = *(const f32x4*)(gkv + 8 * lane), g1 = *(const f32x4*)(gkv + 8 * lane + 4);
                              const f32x4 y0 = {v[0] * rstd * g0[0], v[1] * rstd * g0[1], v[2] * rstd * g0[2], v[3] * rstd * g0[3]}, y1 = {v[4] * rstd * g1[0], v[5] * rstd * g1[1], v[6] * rstd * g1[2], v[7] * rstd * g1[3]};
                              u32x4 o; o.x = pk2(y0[0], y0[1]); o.y = pk2(y0[2], y0[3]); o.z = pk2(y1[0], y1[1]); o.w = pk2(y1[2], y1[3]);
                              *(u32x4*)(CKV + (size_t)rk * 256 + 8 * lane) = o;
                              if (prompt) { float* s = out + OFF_CKV + ((size_t)(b * 2 + i) * 256 + t) * 256 + 8 * lane; *(f32x4*)s = y0; *(f32x4*)(s + 4) = y1; } } }
                        { if (lane < 32) { const float kv = KRF[(size_t)row * 32 + lane]; if (prompt) out[OFF_KR + ((size_t)(b * 2 + i) * 256 + t) * 32 + lane] = kv; }
                          if (lane < 16) { const int part = lane >> 3, fi = lane & 7; float x1 = KRF[(size_t)row * 32 + part * 16 + fi], x2 = KRF[(size_t)row * 32 + part * 16 + fi + 8];
                              if (!prompt) { const int pos = part ? (t & 63) : (t >> 6); const float cs = ROPE8[(pos * 8 + fi) * 2], sn = ROPE8[(pos * 8 + fi) * 2 + 1]; const float o1 = x1 * cs - x2 * sn, o2 = x1 * sn + x2 * cs; x1 = o1; x2 = o2; }
                              KRB[(size_t)rk * 32 + lane] = (bf16)f2bf(x1); KRB[(size_t)rk * 32 + 16 + lane] = (bf16)f2bf(x2); } }
                        { const int half = 1 << (lane >> 4); const bf16* vb = VP + (size_t)(row - t) * 512 + 8 * lane; float s[8];
#pragma unroll
                          for (int e = 0; e < 8; ++e) s[e] = 0.f;
#pragma unroll
                          for (int dt = -8; dt < 8; ++dt) { const int tt = t + dt; if (dt >= -half && dt < half && tt >= 0 && tt < T) { const u32x4 w = *(const u32x4*)(vb + (size_t)tt * 512);
                                  s[0] += bflo(w.x); s[1] += bfhi(w.x); s[2] += bflo(w.y); s[3] += bfhi(w.y); s[4] += bflo(w.z); s[5] += bfhi(w.z); s[6] += bflo(w.w); s[7] += bfhi(w.w); } }
                          const int plo = (t - half) > 0 ? (t - half) : 0, phi = (t + half) < T ? (t + half) : T; const float ic = 1.f / (float)(phi - plo);
                          const u32x4 w = *(const u32x4*)(vb + (size_t)t * 512);
                          u32x4 o; o.x = pk2(s[0] * ic - bflo(w.x), s[1] * ic - bfhi(w.x)); o.y = pk2(s[2] * ic - bflo(w.y), s[3] * ic - bfhi(w.y)); o.z = pk2(s[4] * ic - bflo(w.z), s[5] * ic - bfhi(w.z)); o.w = pk2(s[6] * ic - bflo(w.w), s[7] * ic - bfhi(w.w));
                          *(u32x4*)(PO + (size_t)row * 512 + 8 * lane) = o; }
                    } else {
                        const int ci = row - R, b = ci >> 8, p = ci & 255, rk = RP + b * 2304 + 2048 + p;
                        if (lane < 32) { const float* s = cckv + ((size_t)(b * 2 + i) * 256 + p) * 256 + 8 * lane; const f32x4 y0 = *(const f32x4*)s, y1 = *(const f32x4*)(s + 4);
                            u32x4 o; o.x = pk2(y0[0], y0[1]); o.y = pk2(y0[2], y0[3]); o.z = pk2(y1[0], y1[1]); o.w = pk2(y1[2], y1[3]); *(u32x4*)(CKV + (size_t)rk * 256 + 8 * lane) = o; }
                        if (lane < 16) { const int part = lane >> 3, fi = lane & 7; const float* s = ckr + ((size_t)(b * 2 + i) * 256 + p) * 32 + part * 16 + fi;
                            KRB[(size_t)rk * 32 + lane] = (bf16)f2bf(s[0]); KRB[(size_t)rk * 32 + 16 + lane] = (bf16)f2bf(s[8]); }
                    }
                }
            }
            END_PH();
            if (IN_PH() && PK(5)) for (int rep = 0; rep < REPS(5); ++rep) { PH_BEGIN(); (void)rep;
                if (G2M & 1) { pg8::Gemm g{CQ, M_WuqT, R, 768, 384, 384}; pg8::StaticOrder S; S.init(R, 768, G, bx); pg8::EpiQ E{Hb, ROPE8}; pg8::gemm_phase<pg8::EpiQ, true>(lds, g, S, E); }
                if (G2M & 2) { pg8::Gemm g{CKV, M_WukvT, RK, 1024, 256, 256}; pg8::StaticOrder S; S.init(RK, 1024, G, bx); pg8::EpiBf16 E{KN, 512, 512, (size_t)(WS_V - WS_KN) / 2, 0}; pg8::gemm_phase<pg8::EpiBf16, true>(lds, g, S, E); }
                if ((G2M & 4) && (REPS(5) == 1 || rep == 1)) { pg8::Gemm g{PO, M_WpT, R, 512, 512, 512}; pg8::StaticOrder S; S.init(R, 512, G, bx); pg8::EpiPool E{GAB + 512}; pg8::gemm_phase<pg8::EpiPool, true>(lds, g, S, E); }
            }
            END_PH();
            if (IN_PH() && PK(6)) for (int rep = 0; rep < REPS(6); ++rep) { PH_BEGIN(); (void)rep;
                for (int un = vcu; un < 768; un += G) {
                    att::Desc d; d.ldq = 768; d.ldk0 = 512; d.ldv = 512; d.ldo = 1024; d.n_b = 0; d.row_b = 0; d.key_b = 0; d.qpos = 0; d.sink2 = 0.f; d.has_sink = 0; d.k1 = KRB;
                    int h, qrow, krow;
                    if (un < 512) { const int b = un >> 6, qb = un & 7; h = (un >> 3) & 7; qrow = RP + b * 2048 + qb * 256 + wave * 32; krow = RP + b * 2304; d.n_a = 36; }
                    else { const int v = un - 512, b = v >> 3; h = v & 7; qrow = b * 256 + wave * 32; krow = b * 256; d.n_a = 4; }
                    d.row_a = krow; d.qptr = Hb + (size_t)qrow * 768 + h * 96; d.k0 = KN + h * 64; d.v = VV + h * 64; d.optr = GAB + (size_t)qrow * 1024 + h * 64; d.gptr = d.optr; d.ldg = 1024;
                    if (REPS(6) == 2 && rep == 0) { d.optr = PO + (size_t)qrow * 512 + h * 64; d.ldo = 512; }
                    att::attn_unit<0>((LAS char*)lds, d);
                }
            }
            END_PH();
            if (IN_PH() && PK(7)) for (int rep = 0; rep < REPS(7); ++rep) { PH_BEGIN(); (void)rep;
                pg8::Gemm g{GAB, M_WoT, R, 1024, 1024, 1024}; pg8::StaticOrder S; S.init(R, 1024, G, bx); pg8::EpiBf16 E{Hb, 1024, 0, 0, (REPS(7) == 2 && rep == 0) ? 1 : 0}; pg8::gemm_phase<pg8::EpiBf16, true>(lds, g, S, E);
            }
            END_PH();
        } else {
#define WS_BASE (ws + (i ? WS_W_SWA1 : WS_W_SWA0))
#define S_WinT ((const bf16*)WS_BASE)
#define S_WoT ((const bf16*)(WS_BASE + SZ_WIN_SWA))
            if (IN_PH() && PK(8)) for (int rep = 0; rep < REPS(8); ++rep) { PH_BEGIN(); (void)rep;
                const float* ck = ARG_IN(4); const float* cv = ARG_IN(5);
                for (int e = bx * 512 + tid; e < 2 * 2048 * 32; e += G * 512) {
                    const int which = e / (2048 * 32), f = e % (2048 * 32), rowi = f >> 5, ch = f & 31, b = rowi >> 8, p = rowi & 255;
                    const float* s = (which ? cv : ck) + ((size_t)(b * 2 + i) * 256 + p) * 256 + 8 * ch; const f32x4 y0 = *(const f32x4*)s, y1 = *(const f32x4*)(s + 4);
                    u32x4 o; o.x = pk2(y0[0], y0[1]); o.y = pk2(y0[2], y0[3]); o.z = pk2(y1[0], y1[1]); o.w = pk2(y1[2], y1[3]);
                    *(u32x4*)((which ? SV : SK) + (size_t)(RP + b * 2304 + 2048 + p) * 256 + 8 * ch) = o;
                }
                pg8::Gemm g{Hb, S_WinT, R, 2560, 1024, 1024}; pg8::StaticOrder S; S.init(R, 2560, G, bx);
                pg8::EpiSwaIn E{SQ, SK, SV, GAB, out + OFF_K + (size_t)i * 65536, out + OFF_V + (size_t)i * 65536, ROPE16};
                pg8::gemm_phase<pg8::EpiSwaIn, true>(lds, g, S, E);
            }
            END_PH();
            if (IN_PH() && PK(9)) for (int rep = 0; rep < REPS(9); ++rep) { PH_BEGIN(); (void)rep;
                const float* sink = ARG_IN(21) + i * 16;
                for (int un = vcu; un < 1536; un += G) {
                    att::Desc d; d.ldq = 1024; d.ldk0 = 256; d.ldv = 256; d.ldo = 1024; d.k1 = nullptr; d.has_sink = 1; d.n_a = 4;
                    int kvh, qrow, q0;
                    if (un < 1024) { const int b = un >> 7, blk = un & 31; kvh = (un >> 5) & 3; q0 = blk * 64; const int kb = RP + b * 2304;
                        qrow = RP + b * 2048 + q0 + (wave & 1) * 32; d.row_a = kb + 2048;
                        const int kfirst = q0 - 128 > 0 ? q0 - 128 : 0, klast = q0 + 128 < 2048 - 64 ? q0 + 128 : 2048 - 64;
                        d.key_b = kfirst; d.row_b = kb + kfirst; d.n_b = (klast - kfirst) / 64 + 1; }
                    else { const int v = un - 1024, b = v >> 4, blk = v & 3; kvh = (v >> 2) & 3; q0 = blk * 64; qrow = b * 256 + q0 + (wave & 1) * 32; d.row_a = b * 256; d.n_b = 0; d.row_b = 0; d.key_b = 0; }
                    const int head = kvh * 4 + (wave >> 1);
                    d.qpos = q0 + (wave & 1) * 32 + (lane & 31); d.sink2 = sink[head] * LOG2E;
                    d.qptr = SQ + (size_t)qrow * 1024 + head * 64; d.k0 = SK + kvh * 64; d.v = SV + kvh * 64; d.optr = GAB + (size_t)qrow * 1024 + head * 64; d.gptr = d.optr; d.ldg = 1024;
                    if (REPS(9) == 2 && rep == 0) d.optr = (bf16*)(ws + 204 * MiB) + (size_t)qrow * 1024 + head * 64;
                    att::attn_unit<1>((LAS char*)lds, d);
                }
            }
            END_PH();
            if (IN_PH() && PK(10)) for (int rep = 0; rep < REPS(10); ++rep) { PH_BEGIN(); (void)rep;
                pg8::Gemm g{GAB, S_WoT, R, 1024, 1024, 1024}; pg8::StaticOrder S; S.init(R, 1024, G, bx); pg8::EpiBf16 E{Hb, 1024, 0, 0, (REPS(7) == 2 && rep == 0) ? 1 : 0}; pg8::gemm_phase<pg8::EpiBf16, true>(lds, g, S, E);
            }
            END_PH();
        }
        if (IN_PH() && PK(11)) for (int rep = 0; rep < REPS(11); ++rep) { PH_BEGIN(); (void)rep;
            const float* xin0 = ARG_IN(0); const float* xin1 = ARG_IN(1); const bool has_next = l + 1 < NL;
            for (int chunk = gw; chunk < R / 12; chunk += NGW) {
                int curm = -1; f32x4 cA[4], cB[4], cC[4];
#pragma unroll
                for (int j = 0; j < 4; ++j) { cA[j] = (f32x4){0.f, 0.f, 0.f, 0.f}; cB[j] = cA[j]; cC[j] = cA[j]; }
                for (int rr = 0; rr < 12; ++rr) {
                    const int row = chunk * 12 + rr, midx = mod_index(row);
                    if (midx != curm) { curm = midx; const int ln = has_next ? l + 1 : l; const float* cf = MOD + (size_t)(l * 9 + midx) * 3072; const float* cfn = MOD + (size_t)(ln * 9 + midx) * 3072;
#pragma unroll
                        for (int j = 0; j < 4; ++j) { const int c = 4 * lane + 256 * j; cA[j] = *(const f32x4*)(cf + c); cB[j] = *(const f32x4*)(cfn + 1024 + c); cC[j] = *(const f32x4*)(cfn + 2048 + c); } }
                    const float* xr = (l == 0) ? (row < RP ? xin0 + (size_t)row * D : xin1 + (size_t)(row - RP) * D) : out + (size_t)row * D;
                    f32x4 xv[4], ov[4]; float ss = 0.f;
#pragma unroll
                    for (int j = 0; j < 4; ++j) { xv[j] = *(const f32x4*)(xr + 4 * lane + 256 * j); const u32x2 w = *(const u32x2*)(Hb + (size_t)row * D + 4 * lane + 256 * j);
                        ov[j] = (f32x4){bflo(w.x), bfhi(w.x), bflo(w.y), bfhi(w.y)}; ss += ov[j][0] * ov[j][0] + ov[j][1] * ov[j][1] + ov[j][2] * ov[j][2] + ov[j][3] * ov[j][3]; }
                    const float rstd = 1.f / sqrtf(wave_sum(ss) * (1.f / D) + EPS); float s2 = 0.f;
#pragma unroll
                    for (int j = 0; j < 4; ++j) { xv[j] = xv[j] + ov[j] * rstd * cA[j]; *(f32x4*)(out + (size_t)row * D + 4 * lane + 256 * j) = xv[j]; s2 += xv[j][0] * xv[j][0] + xv[j][1] * xv[j][1] + xv[j][2] * xv[j][2] + xv[j][3] * xv[j][3]; }
                    if (has_next) { const float r2 = 1.f / sqrtf(wave_sum(s2) * (1.f / D) + EPS);
#pragma unroll
                        for (int j = 0; j < 4; ++j) { const f32x4 h = xv[j] * r2 * cB[j] + cC[j]; u32x2 w; w.x = pk2(h[0], h[1]); w.y = pk2(h[2], h[3]); *(u32x2*)(Hb + (size_t)row * D + 4 * lane + 256 * j) = w; } }
                }
            }
        }
        END_PH();
    }
#undef IN_PH
#undef END_PH
}


extern "C" void kernel_launch(void* const* d_in, const int* in_sizes, int n_in, void* d_out, int out_size, void* d_ws, size_t ws_size, hipStream_t stream) {
    static int grid = 0;
    if (grid == 0) {
        if (n_in != 23 || out_size != OUT_TOTAL || ws_size < WS_END) { fprintf(stderr, "kernel_launch: unexpected shapes (n_in %d out %d ws %zu)\n", n_in, out_size, ws_size); grid = -1; return; }
        int dev = 0, cus = 0;
        if (hipGetDevice(&dev) != hipSuccess || hipDeviceGetAttribute(&cus, hipDeviceAttributeMultiprocessorCount, dev) != hipSuccess) { grid = -1; return; }
        if (hipFuncSetAttribute((const void*)fwd_kernel, hipFuncAttributeMaxDynamicSharedMemorySize, LDS_BYTES) != hipSuccess) { fprintf(stderr, "kernel_launch: hipFuncSetAttribute failed\n"); grid = -1; return; }
        int per_cu = 0;
        if (hipOccupancyMaxActiveBlocksPerMultiprocessor(&per_cu, (const void*)fwd_kernel, NWAVES * 64, LDS_BYTES) != hipSuccess || per_cu < 1) { fprintf(stderr, "kernel_launch: occupancy query says %d\n", per_cu); }
        (void)hipGetLastError();
        grid = cus;
    }
    if (grid < 0) return;
    (void)hipMemsetAsync((char*)d_ws + WS_CTL, 0, CTL_ZERO_BYTES, stream);
    Args a{};
    for (int i = 0; i < 23; ++i) a.in[i] = (const float*)d_in[i];
    a.out = (float*)d_out; a.ws = (unsigned char*)d_ws;
#if MK_PER_PHASE
    for (int p = 0; p < N_PHASES; ++p) { a.ph_lo = p; a.ph_hi = p + 1; hipLaunchKernelGGL(fwd_kernel, dim3(grid), dim3(NWAVES * 64), LDS_BYTES, stream, a); }
#else
    a.ph_lo = 0; a.ph_hi = N_PHASES;
    hipLaunchKernelGGL(fwd_kernel, dim3(grid), dim3(NWAVES * 64), LDS_BYTES, stream, a);
#endif
}
```

```cpp
#include <hip/hip_runtime.h>
#include <cstdio>
#include <cstdint>

#define PROBE_DUP 0x0u
#define PROBE_BAR2 0
#ifndef MK_PER_PHASE
#define MK_PER_PHASE 0
#endif

#define GAS __attribute__((address_space(1)))
#define LAS __attribute__((address_space(3)))
typedef unsigned short bf16;
typedef short bf16x8 __attribute__((ext_vector_type(8)));
typedef short s16x4 __attribute__((ext_vector_type(4)));
typedef float f32x4 __attribute__((ext_vector_type(4)));
typedef float f32x2 __attribute__((ext_vector_type(2)));
typedef float f32x16 __attribute__((ext_vector_type(16)));
typedef unsigned u32x4 __attribute__((ext_vector_type(4)));
typedef unsigned u32x2 __attribute__((ext_vector_type(2)));
typedef __bf16 bf16x2_t __attribute__((ext_vector_type(2)));

constexpr int D = 1024, RP = 8192, RS = 16384, R = RP + RS;
constexpr int RK = RP + 8 * 2304;
constexpr int NL = 4;
constexpr float EPS = 1e-6f, LOG2E = 1.4426950408889634f;
constexpr float MLA_SC = 0.10206207261596577f * LOG2E;
constexpr float SWA_SC = 0.125f * LOG2E;
constexpr int OFF_CKV = 25165824, OFF_KR = 29360128, OFF_K = 29884416, OFF_V = 34078720, OUT_TOTAL = 38273024;

constexpr size_t MiB = 1u << 20;
constexpr size_t WS_CTL = 0, CTL_ZERO_BYTES = 128 * 1024;
constexpr int CW_CNT = 8192, CW_QH = 16384, CW_TMO = 17408;
constexpr size_t WS_MOD = 1 * MiB;
constexpr size_t WS_ROPE8 = 1 * MiB + 512 * 1024;
constexpr size_t WS_ROPE16 = WS_ROPE8 + 4096;
constexpr size_t SZ_WIN_MLA = 2304ull * 1024 * 2, SZ_WUQ = 768ull * 384 * 2, SZ_WUKV = 1024ull * 256 * 2, SZ_WPOOL = 512ull * 512 * 2,
                 SZ_WOUT = 1024ull * 1024 * 2, SZ_WIN_SWA = 2560ull * 1024 * 2;
constexpr size_t WS_W = 2 * MiB;
constexpr size_t SZ_W_MLA = SZ_WIN_MLA + SZ_WUQ + SZ_WUKV + SZ_WPOOL + SZ_WOUT, SZ_W_SWA = SZ_WIN_SWA + SZ_WOUT;
constexpr size_t WS_W_MLA0 = WS_W, WS_W_MLA1 = WS_W + SZ_W_MLA, WS_W_SWA0 = WS_W + 2 * SZ_W_MLA, WS_W_SWA1 = WS_W_SWA0 + SZ_W_SWA;
static_assert(WS_W_SWA1 + SZ_W_SWA <= 34 * MiB, "weights");
constexpr size_t WS_H = 34 * MiB;
constexpr size_t WS_GAB = 82 * MiB;
constexpr size_t WS_CQ = 130 * MiB;
constexpr size_t WS_CKV = 148 * MiB;
constexpr size_t WS_KRB = 161 * MiB;
constexpr size_t WS_KRF = 163 * MiB;
constexpr size_t WS_KN = 166 * MiB;
constexpr size_t WS_V = 192 * MiB;
constexpr size_t WS_PO = 218 * MiB;
constexpr size_t WS_SK = 178 * MiB;
constexpr size_t WS_SV = 191 * MiB;
constexpr size_t WS_MODP = 242 * MiB;
constexpr size_t WS_END = 244 * MiB;

__device__ __forceinline__ unsigned f2bf(float f) { unsigned u = __builtin_bit_cast(unsigned, f); return (u + 0x7fffu + ((u >> 16) & 1u)) >> 16; }
__device__ __forceinline__ unsigned pk2(float lo, float hi) { f32x2 v = {lo, hi}; bf16x2_t b = __builtin_convertvector(v, bf16x2_t); return __builtin_bit_cast(unsigned, b); }
__device__ __forceinline__ float bflo(unsigned w) { return __uint_as_float(w << 16); }
__device__ __forceinline__ float bfhi(unsigned w) { return __uint_as_float(w & 0xffff0000u); }
__device__ __forceinline__ float silu_fast(float x) { return x * __builtin_amdgcn_rcpf(1.f + __builtin_amdgcn_exp2f(-x * LOG2E)); }
#define DPP_ADD(v, ctrl) ((v) + __int_as_float(__builtin_amdgcn_update_dpp(0, __float_as_int(v), (ctrl), 0xf, 0xf, true)))
__device__ __forceinline__ float wave_sum(float v) {
    v = DPP_ADD(v, 0xB1); v = DPP_ADD(v, 0x4E); v = DPP_ADD(v, 0x124); v = DPP_ADD(v, 0x128);
    { auto rr = __builtin_amdgcn_permlane16_swap(__float_as_uint(v), __float_as_uint(v), false, false); v = __uint_as_float(rr[0]) + __uint_as_float(rr[1]); }
    { auto rr = __builtin_amdgcn_permlane32_swap(__float_as_uint(v), __float_as_uint(v), false, false); v = __uint_as_float(rr[0]) + __uint_as_float(rr[1]); }
    return v;
}
#define LDS_WAIT() asm volatile("s_waitcnt lgkmcnt(0)" ::: "memory")
__device__ __forceinline__ int opaque_tid() { int t = threadIdx.x; asm volatile("" : "+v"(t)); return t; }

namespace pg8 {
typedef unsigned short bf16_t;
constexpr int BM = 256, BK = 64, HALF = 128, HTB = HALF * BK * 2, STAGE_BYTES = 8 * HTB, NXCD = 8, WGM = 8;
__host__ __device__ __forceinline__ int lds_byte(int r, int c) { const int st = (r >> 4) * 2 + (c >> 5), rr = r & 15, cc = c & 31, ob = rr * 64 + cc * 2; return st * 1024 + (ob ^ (((ob >> 9) & 1) << 5)); }
__host__ __device__ __forceinline__ void stage_rc(int b, int& Rr, int& C) { const int st = b / 1024, sb = b % 1024, swz = sb ^ (((sb >> 9) & 1) << 5); Rr = (st >> 1) * 16 + swz / 64; C = (st & 1) * 32 + (swz % 64) / 2; }
__host__ __device__ __forceinline__ int perm32(int rho) { const int n = rho >> 4, i = rho & 15; return 8 * (i >> 2) + 4 * n + (i & 3); }
struct Unit { int pm, pn; };
struct Gemm { const bf16_t* A; const bf16_t* Bt; int M, N, K, lda; };
struct StaticOrder {
    int nM, nN, nwg, G, c;
    __device__ void init(int M, int N, int G_, int c_) { nM = M / BM; nN = N / BM; nwg = nM * nN; G = G_; c = c_; }
    __device__ bool next(int i, Unit& u) const {
        const long L = (long)i * G + c; if (L >= nwg) return false;
        int wgid = (int)L; { const int q = nwg / NXCD, r = nwg % NXCD, xcd = wgid % NXCD, off = wgid / NXCD; wgid = (xcd < r ? xcd * (q + 1) : r * (q + 1) + (xcd - r) * q) + off; }
        const int nig = WGM * nN, gid = wgid / nig, fm = gid * WGM, gsz = (nM - fm) < WGM ? (nM - fm) : WGM;
        u.pm = fm + ((wgid % nig) % gsz); u.pn = (wgid % nig) / gsz; return true;
    }
};
struct PanelOrder {
    int G, v, nunits;
    __device__ bool next(int i, Unit& u) const { const int L = i * G + v; if (L >= nunits) return false; u.pm = L >> 2; u.pn = L & 3; return true; }
};
template <class Epi, bool ALIGN_EPI, class Sched = StaticOrder>
__device__ __forceinline__ void gemm_phase(LAS unsigned char* lds, const Gemm g, const Sched& S, const Epi& E) {
    const int tid = opaque_tid(), wid = __builtin_amdgcn_readfirstlane(tid >> 6), lane = tid & 63, wr = wid >> 2, wc = wid & 3, fr = lane & 15, fq = lane >> 4;
    const int K = g.K, nt = K / BK, lda = g.lda;
    unsigned voffA[2], voffB[2];
#pragma unroll
    for (int i = 0; i < 2; ++i) { int Rr, C; stage_rc(tid * 16 + i * 8192, Rr, C); const int Rb = Epi::PERM ? ((Rr & ~31) + perm32(Rr & 31)) : Rr;
        voffA[i] = (unsigned)(Rr * lda + C) * 2u; voffB[i] = (unsigned)(Rb * K + C) * 2u; }
    const size_t kstep = (size_t)(BK * 2);
    const size_t hA = (size_t)HALF * lda * 2, hB = (size_t)HALF * K * 2, tA = 2 * hA, tB = 2 * hB;
    const unsigned ldsw = (unsigned)wid * 1024u;
    const int aoff = lds_byte(wr * 64 + fr, fq * 8), boff = lds_byte(wc * 32 + fr, fq * 8);
#define PG8_SA(b, h) (((b) * 2 + (h)) * HTB)
#define PG8_SB(b, h) ((4 + (b) * 2 + (h)) * HTB)
#define PG8_STAGE(bufoff, gbase, voff) do { _Pragma("unroll") for (int _i = 0; _i < 2; ++_i) \
        __builtin_amdgcn_global_load_lds((const unsigned*)((const char*)(gbase) + (voff)[_i]), (LAS unsigned*)(lds + (bufoff) + ldsw + _i * 8192), 16, 0, 0); } while (0)
#define PG8_LDA(dst, b, h) do { _Pragma("unroll") for (int m = 0; m < 4; ++m) _Pragma("unroll") for (int k = 0; k < 2; ++k) dst[m][k] = *(const LAS bf16x8*)(lds + PG8_SA(b, h) + aoff + m * 2048 + k * 1024); } while (0)
#define PG8_LDB(dst, b, h) do { _Pragma("unroll") for (int n = 0; n < 2; ++n) _Pragma("unroll") for (int k = 0; k < 2; ++k) dst[n][k] = *(const LAS bf16x8*)(lds + PG8_SB(b, h) + boff + n * 2048 + k * 1024); } while (0)
#define PG8_MMA(ai, bj, At, Bt) do { __builtin_amdgcn_s_setprio(1); _Pragma("unroll") for (int m = 0; m < 4; ++m) _Pragma("unroll") for (int n = 0; n < 2; ++n) _Pragma("unroll") for (int k = 0; k < 2; ++k) \
        acc[ai][bj][m][n] = __builtin_amdgcn_mfma_f32_16x16x32_bf16(Bt[n][k], At[m][k], acc[ai][bj][m][n], 0, 0, 0); __builtin_amdgcn_s_setprio(0); } while (0)
#define PG8_WAIT_V(n) asm volatile("s_waitcnt vmcnt(" #n ")" ::: "memory")
#define PG8_WAIT_L(n) asm volatile("s_waitcnt lgkmcnt(" #n ")" ::: "memory")
#define PG8_BAR __builtin_amdgcn_s_barrier()
#define PG8_SCHED __builtin_amdgcn_sched_barrier(0)
    Unit cur, nxt; int ui = 0;
    if (!S.next(0, cur)) return;
    f32x4 acc[2][2][4][2];
#pragma unroll
    for (int a = 0; a < 2; ++a)
#pragma unroll
        for (int b = 0; b < 2; ++b)
#pragma unroll
            for (int m = 0; m < 4; ++m)
#pragma unroll
                for (int n = 0; n < 2; ++n) acc[a][b][m][n] = (f32x4){0.f, 0.f, 0.f, 0.f};
    const char* cA = (const char*)g.A + (size_t)cur.pm * tA; const char* cB = (const char*)g.Bt + (size_t)cur.pn * tB;
    PG8_STAGE(PG8_SB(0, 0), cB, voffB); PG8_STAGE(PG8_SB(0, 1), cB + hB, voffB); PG8_STAGE(PG8_SA(0, 0), cA, voffA); PG8_STAGE(PG8_SA(0, 1), cA + hA, voffA);
    if (wr == 1) PG8_BAR;
    PG8_WAIT_V(2); PG8_BAR;
    PG8_STAGE(PG8_SB(1, 0), cB + kstep, voffB); PG8_STAGE(PG8_SA(1, 0), cA + kstep, voffA); PG8_STAGE(PG8_SB(1, 1), cB + hB + kstep, voffB);
    PG8_WAIT_V(6); PG8_BAR;
    for (;;) {
        const bool has_next = S.next(ui + 1, nxt);
        const char* nA = has_next ? (const char*)g.A + (size_t)nxt.pm * tA : cA; const char* nB = has_next ? (const char*)g.Bt + (size_t)nxt.pn * tB : cB;
#pragma nounroll
        for (int t = 0; t < nt; t += 2) {
            const bool last = (t == nt - 2);
            bf16x8 At[4][2], B0[2][2], B1[2][2];
            const char* a1 = cA + (size_t)(t + 1) * kstep;
            const char* a2 = last ? nA : cA + (size_t)(t + 2) * kstep; const char* b2 = last ? nB : cB + (size_t)(t + 2) * kstep;
            const char* a3 = a2 + kstep; const char* b3 = b2 + kstep;
            PG8_LDB(B0, 0, 0); PG8_LDB(B1, 0, 1); PG8_SCHED; PG8_LDA(At, 0, 0); PG8_STAGE(PG8_SA(1, 1), a1 + hA, voffA);
            PG8_WAIT_V(8); PG8_WAIT_L(0); PG8_BAR; PG8_MMA(0, 0, At, B0); PG8_MMA(0, 1, At, B1); PG8_BAR; PG8_SCHED;
            PG8_LDA(At, 0, 1); PG8_STAGE(PG8_SB(0, 0), b2, voffB); PG8_STAGE(PG8_SB(0, 1), b2 + hB, voffB); PG8_STAGE(PG8_SA(0, 0), a2, voffA);
            PG8_WAIT_V(8); PG8_WAIT_L(0); PG8_BAR; PG8_MMA(1, 0, At, B0); PG8_MMA(1, 1, At, B1); PG8_BAR; PG8_SCHED;
            PG8_LDB(B0, 1, 0); PG8_LDB(B1, 1, 1); PG8_SCHED; PG8_LDA(At, 1, 0); PG8_STAGE(PG8_SA(0, 1), a2 + hA, voffA);
            PG8_WAIT_V(8); PG8_WAIT_L(0); PG8_BAR; PG8_MMA(0, 0, At, B0); PG8_MMA(0, 1, At, B1); PG8_BAR; PG8_SCHED;
            PG8_LDA(At, 1, 1); PG8_STAGE(PG8_SB(1, 0), b3, voffB); PG8_STAGE(PG8_SB(1, 1), b3 + hB, voffB); PG8_STAGE(PG8_SA(1, 0), a3, voffA);
            PG8_WAIT_V(8); PG8_WAIT_L(0); PG8_BAR; PG8_MMA(1, 0, At, B0); PG8_MMA(1, 1, At, B1); PG8_BAR; PG8_SCHED;
        }
        if constexpr (ALIGN_EPI) { if (wr == 0) PG8_BAR; }
        E(acc, cur, wr, wc, fr, fq);
        if (!has_next) break;
#pragma unroll
        for (int a = 0; a < 2; ++a)
#pragma unroll
            for (int b = 0; b < 2; ++b)
#pragma unroll
                for (int m = 0; m < 4; ++m)
#pragma unroll
                    for (int n = 0; n < 2; ++n) acc[a][b][m][n] = (f32x4){0.f, 0.f, 0.f, 0.f};
        cur = nxt; cA = nA; cB = nB; ++ui;
        if constexpr (ALIGN_EPI) { if (wr == 1) PG8_BAR; }
    }
    PG8_WAIT_V(0);
    if constexpr (!ALIGN_EPI) { if (wr == 0) PG8_BAR; }
    PG8_BAR;
#undef PG8_SA
#undef PG8_SB
#undef PG8_STAGE
#undef PG8_LDA
#undef PG8_LDB
#undef PG8_MMA
#undef PG8_WAIT_V
#undef PG8_WAIT_L
#undef PG8_BAR
#undef PG8_SCHED
}

__device__ __forceinline__ int rk_base(int pm) { return pm < 32 ? pm * 256 : RP + ((pm - 32) >> 3) * 2304 + ((pm - 32) & 7) * 256; }

struct EpiBf16 {
    static constexpr bool PERM = true;
    bf16* O; int ldc; int split_cols; size_t split_stride; int nostore;
    __device__ __forceinline__ void operator()(const f32x4 (&acc)[2][2][4][2], const Unit& u, int wr, int wc, int fr, int fq) const {
        const int row0 = u.pm * BM + wr * 64 + fr; int colt = u.pn * BM; bf16* base = O;
        if (split_cols) { const int t = colt / split_cols; base += (size_t)t * split_stride; colt -= t * split_cols; }
        const int col0 = colt + wc * 32 + 8 * fq;
#pragma unroll
        for (int ai = 0; ai < 2; ++ai)
#pragma unroll
            for (int m = 0; m < 4; ++m) { bf16* rowp = base + (size_t)(row0 + ai * HALF + m * 16) * ldc + col0;
#pragma unroll
                for (int bj = 0; bj < 2; ++bj) { const f32x4 v0 = acc[ai][bj][m][0], v1 = acc[ai][bj][m][1];
                    u32x4 w; w.x = pk2(v0[0], v0[1]); w.y = pk2(v0[2], v0[3]); w.z = pk2(v1[0], v1[1]); w.w = pk2(v1[2], v1[3]);
                    if (nostore) asm volatile("" :: "v"(w)); else *(u32x4*)(rowp + bj * HALF) = w; } }
    }
};
struct EpiOutPub {
    static constexpr bool PERM = true;
    bf16* O; unsigned* cnt;
    __device__ __forceinline__ void operator()(const f32x4 (&acc)[2][2][4][2], const Unit& u, int wr, int wc, int fr, int fq) const {
        const __amdgpu_buffer_rsrc_t rs = __builtin_amdgcn_make_buffer_rsrc((void*)O, (short)0, R * 1024 * 2, 0x00020000);
        const int row0 = u.pm * BM + wr * 64 + fr; const int col0 = u.pn * BM + wc * 32 + 8 * fq;
#pragma unroll
        for (int ai = 0; ai < 2; ++ai)
#pragma unroll
            for (int m = 0; m < 4; ++m) { const int off = ((row0 + ai * HALF + m * 16) * 1024 + col0) * 2;
#pragma unroll
                for (int bj = 0; bj < 2; ++bj) { const f32x4 v0 = acc[ai][bj][m][0], v1 = acc[ai][bj][m][1];
                    u32x4 w; w.x = pk2(v0[0], v0[1]); w.y = pk2(v0[2], v0[3]); w.z = pk2(v1[0], v1[1]); w.w = pk2(v1[2], v1[3]);
                    __builtin_amdgcn_raw_buffer_store_b128(w, rs, off + bj * HALF * 2, 0, 16); } }
        asm volatile("s_waitcnt vmcnt(0)" ::: "memory");
        if ((fr | fq) == 0) __hip_atomic_fetch_add(cnt + 16 * u.pm, 1u, __ATOMIC_RELAXED, __HIP_MEMORY_SCOPE_AGENT);
    }
};
struct EpiPool {
    static constexpr bool PERM = true;
    bf16* GB;
    __device__ __forceinline__ void operator()(const f32x4 (&acc)[2][2][4][2], const Unit& u, int wr, int wc, int fr, int fq) const {
        const int row0 = u.pm * BM + wr * 64 + fr; const int col0 = u.pn * BM + wc * 32 + 8 * fq;
#pragma unroll
        for (int ai = 0; ai < 2; ++ai)
#pragma unroll
            for (int m = 0; m < 4; ++m) { bf16* rowp = GB + (size_t)(row0 + ai * HALF + m * 16) * 1024 + col0;
#pragma unroll
                for (int bj = 0; bj < 2; ++bj) { const f32x4 v0 = acc[ai][bj][m][0], v1 = acc[ai][bj][m][1];
                    const u32x4 gg = *(const u32x4*)(rowp + bj * HALF);
                    u32x4 w;
                    w.x = pk2(v0[0] * silu_fast(bflo(gg.x)), v0[1] * silu_fast(bfhi(gg.x))); w.y = pk2(v0[2] * silu_fast(bflo(gg.y)), v0[3] * silu_fast(bfhi(gg.y)));
                    w.z = pk2(v1[0] * silu_fast(bflo(gg.z)), v1[1] * silu_fast(bfhi(gg.z))); w.w = pk2(v1[2] * silu_fast(bflo(gg.w)), v1[3] * silu_fast(bfhi(gg.w)));
                    *(u32x4*)(rowp + bj * HALF) = w; } }
    }
};
struct EpiMlaIn {
    static constexpr bool PERM = true;
    bf16 *CQ, *CKV, *GAB, *VP; float* KRF;
    __device__ __forceinline__ void operator()(const f32x4 (&acc)[2][2][4][2], const Unit& u, int wr, int wc, int fr, int fq) const {
        const int rt = wr * 64 + fr, grow0 = u.pm * BM, rk0 = rk_base(u.pm), cc = wc * 32 + 8 * fq;
#pragma unroll
        for (int bj = 0; bj < 2; ++bj) {
            const int U = 2 * u.pn + bj;
            if (U == 5) {
                if (wc == 0) {
#pragma unroll
                    for (int ai = 0; ai < 2; ++ai)
#pragma unroll
                        for (int m = 0; m < 4; ++m) { float* p = KRF + (size_t)(grow0 + rt + ai * HALF + m * 16) * 32 + 8 * fq;
                            *(f32x4*)p = acc[ai][bj][m][0]; *(f32x4*)(p + 4) = acc[ai][bj][m][1]; }
                }
                continue;
            }
            bf16* p; int ld, rb = grow0;
            if (U < 3) { p = CQ + 128 * U; ld = 384; }
            else if (U < 5) { p = CKV + 128 * (U - 3); ld = 256; rb = rk0; }
            else if (U < 10) { p = GAB + 128 * (U - 6); ld = 1024; }
            else if (U < 14) { p = VP + 128 * (U - 10); ld = 512; }
            else { p = GAB + 512 + 128 * (U - 14); ld = 1024; }
            p += (size_t)(rb + rt) * ld + cc;
#pragma unroll
            for (int ai = 0; ai < 2; ++ai)
#pragma unroll
                for (int m = 0; m < 4; ++m) { const f32x4 v0 = acc[ai][bj][m][0], v1 = acc[ai][bj][m][1];
                    u32x4 w; w.x = pk2(v0[0], v0[1]); w.y = pk2(v0[2], v0[3]); w.z = pk2(v1[0], v1[1]); w.w = pk2(v1[2], v1[3]);
                    *(u32x4*)(p + (size_t)(ai * HALF + m * 16) * ld) = w; }
        }
    }
};
__device__ __forceinline__ void rope_perm(f32x4& a, f32x4& b, const float* tb) {
#pragma unroll
    for (int j = 0; j < 4; ++j) { auto rr = __builtin_amdgcn_permlane32_swap(__float_as_uint(a[j]), __float_as_uint(b[j]), false, false); a[j] = __uint_as_float(rr[0]); b[j] = __uint_as_float(rr[1]); }
    const f32x4 c0 = *(const f32x4*)tb, c1 = *(const f32x4*)(tb + 4);
    const f32x4 cs = {c0[0], c0[2], c1[0], c1[2]}, sn = {c0[1], c0[3], c1[1], c1[3]};
    const f32x4 o1 = a * cs - b * sn, o2 = a * sn + b * cs;
    a = o1; b = o2;
#pragma unroll
    for (int j = 0; j < 4; ++j) { auto rr = __builtin_amdgcn_permlane32_swap(__float_as_uint(a[j]), __float_as_uint(b[j]), false, false); a[j] = __uint_as_float(rr[0]); b[j] = __uint_as_float(rr[1]); }
}
struct EpiQ {
    static constexpr bool PERM = true;
    bf16* Q; const float* rope8;
    __device__ __forceinline__ void operator()(const f32x4 (&acc)[2][2][4][2], const Unit& u, int wr, int wc, int fr, int fq) const {
        const int rt = wr * 64 + fr, grow0 = u.pm * BM; const bool sample = u.pm >= 32; const int t0 = ((u.pm - 32) & 7) * 256;
#pragma unroll
        for (int bj = 0; bj < 2; ++bj) {
            const int g32 = 8 * u.pn + 4 * bj + wc; const bool rot = sample && (g32 % 3 == 2);
#pragma unroll
            for (int ai = 0; ai < 2; ++ai)
#pragma unroll
                for (int m = 0; m < 4; ++m) { const int r = rt + ai * HALF + m * 16; f32x4 x1 = acc[ai][bj][m][0], x2 = acc[ai][bj][m][1];
                    if (rot) { const int t = t0 + r, pos = (fq & 1) ? (t & 63) : (t >> 6); rope_perm(x1, x2, rope8 + (pos * 8 + ((fq >> 1) ? 4 : 0)) * 2); }
                    u32x4 w; w.x = pk2(x1[0], x1[1]); w.y = pk2(x1[2], x1[3]); w.z = pk2(x2[0], x2[1]); w.w = pk2(x2[2], x2[3]);
                    *(u32x4*)(Q + (size_t)(grow0 + r) * 768 + 32 * g32 + 8 * fq) = w; }
        }
    }
};
struct EpiSwaIn {
    static constexpr bool PERM = true;
    bf16 *Q, *K, *V, *G; float *stK, *stV; const float* rope16;
    __device__ __forceinline__ void operator()(const f32x4 (&acc)[2][2][4][2], const Unit& u, int wr, int wc, int fr, int fq) const {
        const int rt = wr * 64 + fr, grow0 = u.pm * BM, rk0 = rk_base(u.pm); const bool sample = u.pm >= 32; const int t0 = ((u.pm - 32) & 7) * 256;
        const int pn = u.pn;
#pragma unroll
        for (int bj = 0; bj < 2; ++bj) {
            const int cb = 128 * bj + 32 * wc + 8 * fq;
            const bool rot = sample && pn < 5;
#pragma unroll
            for (int ai = 0; ai < 2; ++ai)
#pragma unroll
                for (int m = 0; m < 4; ++m) { const int r = rt + ai * HALF + m * 16; f32x4 x1 = acc[ai][bj][m][0], x2 = acc[ai][bj][m][1];
                    if (rot) { const int t = t0 + r, pos = (wc & 1) ? (t & 63) : (t >> 6); rope_perm(x1, x2, rope16 + (pos * 16 + 8 * (fq & 1) + ((fq >> 1) ? 4 : 0)) * 2); }
                    bf16* p;
                    if (pn < 4) p = Q + (size_t)(grow0 + r) * 1024 + 256 * pn + cb;
                    else if (pn == 4) p = K + (size_t)(rk0 + r) * 256 + cb;
                    else if (pn == 5) p = V + (size_t)(rk0 + r) * 256 + cb;
                    else p = G + (size_t)(grow0 + r) * 1024 + 256 * (pn - 6) + cb;
                    if (!sample && (pn == 4 || pn == 5)) { float* st = (pn == 4 ? stK : stV) + (size_t)(u.pm * 2 * 256 + r) * 256 + cb; *(f32x4*)st = x1; *(f32x4*)(st + 4) = x2; }
                    u32x4 w; w.x = pk2(x1[0], x1[1]); w.y = pk2(x1[2], x1[3]); w.z = pk2(x2[0], x2[1]); w.w = pk2(x2[2], x2[3]);
                    *(u32x4*)p = w; }
        }
    }
};
}

namespace att {
__device__ __forceinline__ int crow(int r, int hi) { return (r & 3) + 8 * (r >> 2) + 4 * hi; }
typedef short v4i16_t __attribute__((ext_vector_type(4)));
__device__ __forceinline__ s16x4 vtr(const LAS char* p) { return __builtin_bit_cast(s16x4, __builtin_amdgcn_ds_read_tr16_b64_v4i16((LAS v4i16_t*)p)); }
__device__ __forceinline__ float xhalf_max(float x) { auto rr = __builtin_amdgcn_permlane32_swap(__float_as_uint(x), __float_as_uint(x), false, false); return __builtin_fmaxf(__uint_as_float(rr[0]), __uint_as_float(rr[1])); }
__device__ __forceinline__ float xhalf_sum(float x) { auto rr = __builtin_amdgcn_permlane32_swap(__float_as_uint(x), __float_as_uint(x), false, false); return __uint_as_float(rr[0]) + __uint_as_float(rr[1]); }
#define SBAR() __builtin_amdgcn_sched_barrier(0)
#define PIN(x) asm volatile("" : "+v"(x))
__device__ __forceinline__ float max3f(float a, float b, float c) { float r; asm("v_max3_f32 %0, %1, %2, %3" : "=v"(r) : "v"(a), "v"(b), "v"(c)); return r; }
__device__ __forceinline__ float max2f(float a, float b) { float r; asm("v_max_f32_e32 %0, %1, %2" : "=v"(r) : "v"(a), "v"(b)); return r; }
struct Desc {
    const bf16* qptr; int ldq;
    const bf16* k0; int ldk0;
    const bf16* k1;
    const bf16* v; int ldv;
    int n_a, row_a, n_b, row_b, key_b;
    int qpos; float sink2; int has_sink;
    bf16* optr; int ldo;
    const bf16* gptr; int ldg;
};
constexpr float THR = 8.f;
__device__ __forceinline__ int tile_row(const Desc& d, int t) { return t < d.n_a ? d.row_a + 64 * t : d.row_b + 64 * (t - d.n_a); }
template <int MODE, class MK>
__device__ __forceinline__ void attn_phase(LAS char* lds, const MK& mk, int first, int stride, int nunits) {
    constexpr int DQK = MODE == 0 ? 96 : 64, NCH = DQK / 8, ND0 = DQK / 16, KB = NCH * 1024, VOFF = 3 * KB, NG = 2 * ND0, NHELD = 8, NLATE = NG - NHELD, STG_OFF = VOFF + 2 * 8192;
    static_assert(STG_OFF + 8 * 32 * 272 <= 131072, "attention LDS map");
    int un = first; if (un >= nunits) return;
    const int tid = opaque_tid(), lane = tid & 63, r32 = lane & 31, hi = lane >> 5; const int wid = __builtin_amdgcn_readfirstlane(tid >> 6);
    const int kdst = wid * 1024, k1dst = (8 + (wid & 3)) * 1024, vdst = VOFF + wid * 1024;
    const int vlane = ((lane >> 4) & 1) * 32 + (lane & 3) * 8 + (4 * hi + ((lane & 15) >> 2)) * 64;
    const int kfo = hi * 1024 + r32 * 16;
    Desc d; mk(un, d);
#define SRC_K(dd) ((dd).k0 + (size_t)lane * (dd).ldk0 + wid * 8)
#define SRC_K1(dd) ((MODE == 0) ? (dd).k1 + (size_t)lane * 32 + (wid & 3) * 8 : (const bf16*)nullptr)
#define SRC_V(dd) ((dd).v + (size_t)(16 * (wid & 3) + (lane >> 2)) * (dd).ldv + (wid >> 2) * 32 + (lane & 3) * 8)
    const bf16* ksrc = SRC_K(d); const bf16* k1src = SRC_K1(d); const bf16* vsrc = SRC_V(d);
#define GLDS16(g, l) __builtin_amdgcn_global_load_lds((const unsigned*)(g), (LAS unsigned*)(l), 16, 0, 0)
#define DMAK_(dd, ks_, k1s_, t, soff) do { const size_t _r = (size_t)tile_row(dd, t); GLDS16((ks_) + _r * (dd).ldk0, lds + (soff) + kdst); if (MODE == 0 && wid < 4) GLDS16((k1s_) + _r * 32, lds + (soff) + k1dst); } while (0)
#define DMAV_(dd, vs_, t, vslot) do { const size_t _r = (size_t)tile_row(dd, t); GLDS16((vs_) + _r * (dd).ldv, lds + (vslot) * 8192 + vdst); } while (0)
#define DMAK(t, soff) DMAK_(d, ksrc, k1src, t, soff)
#define DMAV(t, vslot) DMAV_(d, vsrc, t, vslot)
    int sl_cur = 0, sl_nxt = KB, sl_fre = 2 * KB;
    int vpar = 0;
    DMAK(0, sl_cur); DMAK(1, sl_nxt); DMAV(0, vpar);
    bf16x8 qr[ND0];
#pragma unroll
    for (int d0 = 0; d0 < ND0; ++d0) qr[d0] = *(const bf16x8*)(d.qptr + (size_t)r32 * d.ldq + d0 * 16 + hi * 8);
    __syncthreads();
#define ROT() do { const int o_ = sl_cur; sl_cur = sl_nxt; sl_nxt = sl_fre; sl_fre = o_; } while (0)
#define KFADDR(i, soff) (lds + (soff) + kfo + ((i) >> 1) * 2048 + ((i) & 1) * 512)
#define PE(P0, P1, e) ((e) < 16 ? P0[(e) & 15] : P1[(e) & 15])
#define FILL_A(P0, P1, g) do { \
        _Pragma("unroll") for (int e_ = (32 * (g)) / NG; e_ < (32 * ((g) + 1)) / NG; ++e_) sacc += PE(P0, P1, e_); \
        PIN(sacc); \
        _Pragma("unroll") for (int k_ = (16 * (g)) / NG; k_ < (16 * ((g) + 1)) / NG; ++k_) { pw[k_ >> 2][k_ & 3] = pk2(PE(P0, P1, 2 * k_), PE(P0, P1, 2 * k_ + 1)); PIN(pw[k_ >> 2]); } } while (0)
#define QK_PHASE(C0, C1, P0, P1, HAVE_P) do { \
        bf16x8 kl_[NLATE > 0 ? NLATE : 1]; \
        _Pragma("unroll") for (int i_ = 0; i_ < NLATE; ++i_) kl_[i_] = *(const LAS bf16x8*)KFADDR(NHELD + i_, sl_cur); \
        _Pragma("unroll") for (int g_ = 0; g_ < NG; ++g_) { const int d0_ = g_ >> 1; \
            const bf16x8 kk_ = g_ < NHELD ? kf[g_ < NHELD ? g_ : 0] : kl_[g_ >= NHELD ? g_ - NHELD : 0]; \
            if ((g_ & 1) == 0) C0 = __builtin_amdgcn_mfma_f32_32x32x16_bf16(kk_, qr[d0_], d0_ == 0 ? negm : C0, 0, 0, 0); \
            else C1 = __builtin_amdgcn_mfma_f32_32x32x16_bf16(kk_, qr[d0_], d0_ == 0 ? negm : C1, 0, 0, 0); \
            if (HAVE_P) FILL_A(P0, P1, g_); \
            SBAR(); } } while (0)
#define MASKT(C0, C1, t_) do { if (MODE == 1 && (t_) >= d.n_a) { const int key0_ = d.key_b + 64 * ((t_) - d.n_a); \
        if (key0_ - (qb0 + 31) < -128 || key0_ + 63 - qb0 > 128) { const int k0p_ = key0_ - d.qpos; \
            _Pragma("unroll") for (int r = 0; r < 16; ++r) { const int d_ = k0p_ + crow(r, hi); if (d_ > 128 || d_ < -128) C0[r] = -1e30f; if (d_ + 32 > 128 || d_ + 32 < -128) C1[r] = -1e30f; } } } } while (0)
#define DECIDE(C0, C1) do { \
        float a_ = max2f(C0[0], C1[0]), b_ = max2f(C0[1], C1[1]); \
        _Pragma("unroll") for (int r = 2; r < 16; r += 2) { a_ = max3f(a_, C0[r], C1[r]); b_ = max3f(b_, C0[r + 1], C1[r + 1]); } \
        a_ = xhalf_max(max2f(a_, b_)); resc = false; \
        if (__any(a_ > THR)) { const float dl_ = fmaxf(a_, 0.f); mref += dl_; \
            _Pragma("unroll") for (int r = 0; r < 16; ++r) { C0[r] -= dl_; C1[r] -= dl_; } \
            _Pragma("unroll") for (int r = 0; r < 16; ++r) negm[r] = -mref; \
            fsc = __builtin_amdgcn_exp2f(-dl_); lsum *= fsc; resc = true; } } while (0)
#define EXP4(C0, C1, j) do { _Pragma("unroll") for (int e_ = 4 * (j); e_ < 4 * (j) + 4; ++e_) { if (e_ < 16) C0[e_ & 15] = __builtin_amdgcn_exp2f(C0[e_ & 15]); else C1[e_ & 15] = __builtin_amdgcn_exp2f(C1[e_ & 15]); } \
        if (4 * (j) < 16) PIN(C0); else PIN(C1); } while (0)
#define VOFFS(j) ((((j) & 1) * 4096) + (((j) >> 1) * 1024))
#define PV_PHASE(C0, C1, HAVE_C, HAVE_K, tp_) do { \
        const LAS char* vp_ = lds + VOFF + (((tp_) + vpar) & 1) * 8192 + vlane; \
        s16x4 vl_[8], vh_[8]; \
        vl_[0] = vtr(vp_ + VOFFS(0)); vh_[0] = vtr(vp_ + VOFFS(0) + 512); vl_[1] = vtr(vp_ + VOFFS(1)); vh_[1] = vtr(vp_ + VOFFS(1) + 512); \
        _Pragma("unroll") for (int j = 0; j < 8; ++j) { const int ks = j >> 1, dd = j & 1; \
            if (j + 2 < 8) { vl_[j + 2] = vtr(vp_ + VOFFS(j + 2)); vh_[j + 2] = vtr(vp_ + VOFFS(j + 2) + 512); } \
            if (HAVE_K) kf[j] = *(const LAS bf16x8*)KFADDR(j, sl_nxt); \
            const bf16x8 vf_ = {vl_[j][0], vl_[j][1], vl_[j][2], vl_[j][3], vh_[j][0], vh_[j][1], vh_[j][2], vh_[j][3]}; \
            if (dd == 0) o0 = __builtin_amdgcn_mfma_f32_32x32x16_bf16(vf_, __builtin_bit_cast(bf16x8, pw[ks]), o0, 0, 0, 0); \
            else o1 = __builtin_amdgcn_mfma_f32_32x32x16_bf16(vf_, __builtin_bit_cast(bf16x8, pw[ks]), o1, 0, 0, 0); \
            if (HAVE_C) EXP4(C0, C1, j); \
            SBAR(); } } while (0)
#define STEP(C0, C1, P0, P1, t_) do { \
        if ((t_) + 2 < NT) DMAK((t_) + 2, sl_fre); \
        DMAV(t_, ((t_) + vpar) & 1); \
        float sacc = 0.f; \
        QK_PHASE(C0, C1, P0, P1, true); \
        lsum += sacc; \
        MASKT(C0, C1, t_); \
        DECIDE(C0, C1); \
        SBAR(); \
        PV_PHASE(C0, C1, true, true, (t_) - 1); \
        __syncthreads(); \
        ROT(); \
        if (resc) { o0 *= fsc; o1 *= fsc; } } while (0)
    for (;;) {
        const int NT = d.n_a + d.n_b;
        const int qb0 = __builtin_amdgcn_readfirstlane(d.qpos);
        float mref = 0.f, lsum = 0.f, fsc = 1.f; bool resc = false;
        f32x16 o0 = (f32x16){}, o1 = (f32x16){}, negm = (f32x16){};
        f32x16 cA0 = (f32x16){}, cA1 = (f32x16){}, cB0 = (f32x16){}, cB1 = (f32x16){};
        u32x4 pw[4];
#pragma unroll
        for (int i = 0; i < 4; ++i) pw[i] = (u32x4){0u, 0u, 0u, 0u};
        bf16x8 kf[NHELD];
#pragma unroll
        for (int i = 0; i < NHELD; ++i) kf[i] = *(const LAS bf16x8*)KFADDR(i, sl_cur);
        {
            if (2 < NT) DMAK(2, sl_fre);
            float sacc = 0.f; (void)sacc;
            QK_PHASE(cA0, cA1, cA0, cA1, false);
            MASKT(cA0, cA1, 0);
            DECIDE(cA0, cA1);
#pragma unroll
            for (int j = 0; j < 8; ++j) { kf[j] = *(const LAS bf16x8*)KFADDR(j, sl_nxt); EXP4(cA0, cA1, j); SBAR(); }
            __syncthreads();
            ROT();
        }
        int t = 1;
        for (; t + 1 < NT; t += 2) { STEP(cB0, cB1, cA0, cA1, t); STEP(cA0, cA1, cB0, cB1, t + 1); }
        const bool odd_tail = t < NT;
        if (odd_tail) STEP(cB0, cB1, cA0, cA1, t);
        const int un_next = un + stride; const bool has_next = un_next < nunits;
        Desc dn = d; bf16x8 qn[ND0];
#pragma unroll
        for (int d0 = 0; d0 < ND0; ++d0) qn[d0] = qr[d0];
        const bf16* ksrc_n = ksrc; const bf16* k1src_n = k1src; const bf16* vsrc_n = vsrc;
        if (has_next) {
            mk(un_next, dn);
            ksrc_n = SRC_K(dn); k1src_n = SRC_K1(dn); vsrc_n = SRC_V(dn);
            DMAK_(dn, ksrc_n, k1src_n, 0, sl_cur); DMAK_(dn, ksrc_n, k1src_n, 1, sl_nxt); DMAV_(dn, vsrc_n, 0, (NT + vpar) & 1);
#pragma unroll
            for (int d0 = 0; d0 < ND0; ++d0) qn[d0] = *(const bf16x8*)(dn.qptr + (size_t)r32 * dn.ldq + d0 * 16 + hi * 8);
        }
        if (odd_tail) {
            float sacc = 0.f;
#pragma unroll
            for (int g = 0; g < NG; ++g) FILL_A(cB0, cB1, g);
            lsum += sacc;
            PV_PHASE(cB0, cB1, false, false, NT - 1);
        } else {
            float sacc = 0.f;
#pragma unroll
            for (int g = 0; g < NG; ++g) FILL_A(cA0, cA1, g);
            lsum += sacc;
            PV_PHASE(cA0, cA1, false, false, NT - 1);
        }
        float lt = xhalf_sum(lsum);
        if (d.has_sink) lt += __builtin_amdgcn_exp2f(d.sink2 - mref);
        const float inv = 1.0f / lt;
        {
            LAS char* stg = lds + STG_OFF + wid * (32 * 272);
#pragma unroll
            for (int d0 = 0; d0 < 2; ++d0)
#pragma unroll
                for (int g = 0; g < 4; ++g) { const f32x16& o = d0 ? o1 : o0;
                    const f32x4 v = {o[4 * g] * inv, o[4 * g + 1] * inv, o[4 * g + 2] * inv, o[4 * g + 3] * inv};
                    *(LAS f32x4*)(stg + r32 * 272 + (32 * d0 + 8 * g + 4 * hi) * 4) = v; }
#pragma unroll
            for (int i2 = 0; i2 < 4; ++i2) { const int row = i2 * 8 + (lane >> 3), ch = lane & 7;
                const f32x4 va = *(const LAS f32x4*)(stg + row * 272 + ch * 32), vb = *(const LAS f32x4*)(stg + row * 272 + ch * 32 + 16);
                const u32x4 gg = *(const u32x4*)(d.gptr + (size_t)row * d.ldg + ch * 8);
                u32x4 w;
                w.x = pk2(va[0] * silu_fast(bflo(gg.x)), va[1] * silu_fast(bfhi(gg.x))); w.y = pk2(va[2] * silu_fast(bflo(gg.y)), va[3] * silu_fast(bfhi(gg.y)));
                w.z = pk2(vb[0] * silu_fast(bflo(gg.z)), vb[1] * silu_fast(bfhi(gg.z))); w.w = pk2(vb[2] * silu_fast(bflo(gg.w)), vb[3] * silu_fast(bfhi(gg.w)));
                *(u32x4*)(d.optr + (size_t)row * d.ldo + ch * 8) = w; }
        }
        __syncthreads();
        if (!has_next) break;
        vpar = (NT + vpar) & 1;
        d = dn; un = un_next; ksrc = ksrc_n; k1src = k1src_n; vsrc = vsrc_n;
#pragma unroll
        for (int d0 = 0; d0 < ND0; ++d0) qr[d0] = qn[d0];
    }
#undef SRC_K
#undef SRC_K1
#undef SRC_V
#undef GLDS16
#undef DMAK_
#undef DMAV_
#undef DMAK
#undef DMAV
#undef ROT
#undef KFADDR
#undef PE
#undef FILL_A
#undef QK_PHASE
#undef MASKT
#undef DECIDE
#undef EXP4
#undef VOFFS
#undef PV_PHASE
#undef STEP
}
#undef SBAR
}

#define XB_TMO      128
#define XB_XCNT(j)  (256  + 64 * (j))
#define XB_XSUB(j)  (1280 + 64 * (j))
#define XB_XGEN(j)  (2304 + 64 * (j))
#define XB_TOP      3328
#define XB_TOPGEN   3392
#define XCD_BAR_WORDS 3456
#define XB_SPIN_CAP (1u << 20)
__device__ __forceinline__ unsigned xb_ld(unsigned* p)              { return __hip_atomic_load(p, __ATOMIC_RELAXED, __HIP_MEMORY_SCOPE_AGENT); }
__device__ __forceinline__ unsigned xb_add(unsigned* p, unsigned v) { return __hip_atomic_fetch_add(p, v, __ATOMIC_RELAXED, __HIP_MEMORY_SCOPE_AGENT); }
__device__ __forceinline__ unsigned xb_xcc_id() { return (unsigned)__builtin_amdgcn_s_getreg((3 << 11) | 20) & 0xFu; }
#define XB_SPIN(cond, bar) do { unsigned _sp = 0; while (cond) { __builtin_amdgcn_s_sleep(1); \
    if ((++_sp & 255u) == 0u) { if (xb_ld(&(bar)[XB_TMO])) break; if (_sp > XB_SPIN_CAP) { atomicAdd(&(bar)[XB_TMO], 1u); break; } } } } while (0)
struct XcdBarrier { unsigned* bar; unsigned x; volatile LAS unsigned* st; };
__device__ __forceinline__ XcdBarrier xcd_barrier_post(unsigned* bar, volatile LAS unsigned* st) {
    XcdBarrier b; b.bar = bar; b.x = xb_xcc_id(); b.st = st;
    if (threadIdx.x == 0) (void)xb_add(&bar[XB_XCNT(b.x)], 1u);
    return b;
}
__device__ __forceinline__ void xcd_barrier_complete(unsigned* bar, unsigned x, unsigned& nloc, unsigned& nx) {
    const unsigned G = gridDim.x * gridDim.y * gridDim.z;
    unsigned sum, cnt, mine, sp = 0u;
    for (;;) {
        sum = 0u; cnt = 0u; mine = 0u;
#pragma unroll
        for (unsigned j = 0; j < 16; ++j) { const unsigned c = xb_ld(&bar[XB_XCNT(j)]); sum += c; cnt += (c > 0u) ? 1u : 0u; mine = (j == x) ? c : mine; }
        if (sum == G) break;
        __builtin_amdgcn_s_sleep(1);
        if ((++sp & 255u) == 0u) { if (xb_ld(&bar[XB_TMO])) break; if (sp > XB_SPIN_CAP) { atomicAdd(&bar[XB_TMO], 1u); break; } }
    }
    nloc = mine > 0u ? mine : 1u; nx = cnt > 0u ? cnt : 1u;
}
__device__ __forceinline__ void xcd_barrier(const XcdBarrier& b0) {
    asm volatile("s_waitcnt vmcnt(0)" ::: "memory");
    __syncthreads();
    if (threadIdx.x == 0) {
        XcdBarrier b = b0; b.x = xb_xcc_id();
        unsigned* bar = b.bar; asm volatile("" : "+s"(bar));
        __builtin_amdgcn_s_waitcnt(0);
        unsigned nloc = b.st[0], nx = b.st[1];
        if (nloc == 0u) { xcd_barrier_complete(bar, b.x, nloc, nx); b.st[0] = nloc; b.st[1] = nx; }
        const unsigned old = xb_add(&bar[XB_XSUB(b.x)], 1u);
        const unsigned gen = old / nloc;
        if (old + 1u == (gen + 1u) * nloc) {
            __builtin_amdgcn_fence(__ATOMIC_RELEASE, "agent");
            asm volatile("s_waitcnt vmcnt(0)" ::: "memory");
            const unsigned og = xb_add(&bar[XB_TOP], 1u);
            const unsigned tg = og / nx;
            if (og + 1u == (tg + 1u) * nx) xb_add(&bar[XB_TOPGEN], 1u);
            else XB_SPIN(xb_ld(&bar[XB_TOPGEN]) == tg, bar);
            __builtin_amdgcn_fence(__ATOMIC_ACQUIRE, "agent");
            xb_add(&bar[XB_XGEN(b.x)], 1u);
            asm volatile("s_waitcnt vmcnt(0)" ::: "memory");
        } else {
            XB_SPIN(xb_ld(&bar[XB_XGEN(b.x)]) == gen, bar);
            __builtin_amdgcn_fence(__ATOMIC_ACQUIRE, "agent");
            asm volatile("s_waitcnt vmcnt(0)" ::: "memory");
        }
    }
    __syncthreads();
}

struct Args { const float* in[23]; float* out; unsigned char* ws; int ph_lo, ph_hi; };
constexpr int NWAVES = 8;
constexpr int N_PHASES = 2 + 5 + 3 + 5 + 3;
constexpr int RING_BYTES = 131072, MISC_OFF = RING_BYTES + 320, LDS_BYTES = 147456;

struct TMap { int kind, row_off, col_off, ldw; const float* nscale; float scale; };
__device__ __forceinline__ void tmap(const TMap& tm, int n, int& drow, float& sc) {
    drow = n + tm.row_off; sc = tm.scale;
    switch (tm.kind) {
        case 1: if (n >= 672) drow += 96; break;
        case 2: { const int e = n % 96; if (e >= 64) { const int d = e - 64; const int p = (d & 7) | ((d & 8) << 1) | ((d & 16) >> 1); drow = n - e + 64 + p; } } break;
        case 3: { const int h = n >> 7, e = n & 127; drow = (e < 64) ? h * 64 + e : 512 + h * 64 + (e - 64); } break;
        case 4: sc = tm.nscale[n]; break;
        case 5: if (n >= 1024) sc = 1.f; break;
        default: break;
    }
}
__device__ __forceinline__ void transpose_item(const float* W, int K, int N, bf16* WT, const TMap& tm, LAS float* scr, int item, int lane) {
    const int nblk = N / 32, kb = item / nblk, nb = item % nblk, k0 = 64 * kb, n0 = 32 * nb;
#pragma unroll 8
    for (int i = 0; i < 32; ++i) { const int kk = 2 * i + (lane >> 5); scr[kk * 33 + (lane & 31)] = W[(size_t)(k0 + kk) * N + n0 + (lane & 31)]; }
    LDS_WAIT(); asm volatile("" ::: "memory");
    const int c = lane & 7;
#pragma unroll
    for (int j = 0; j < 4; ++j) { const int n = (lane >> 3) + 8 * j; const LAS float* s = scr + (8 * c) * 33 + n;
        int drow; float sc; tmap(tm, n0 + n, drow, sc);
        u32x4 o; o.x = pk2(s[0 * 33] * sc, s[1 * 33] * sc); o.y = pk2(s[2 * 33] * sc, s[3 * 33] * sc); o.z = pk2(s[4 * 33] * sc, s[5 * 33] * sc); o.w = pk2(s[6 * 33] * sc, s[7 * 33] * sc);
        *(u32x4*)(WT + (size_t)drow * tm.ldw + tm.col_off + k0 + 8 * c) = o; }
    LDS_WAIT(); asm volatile("" ::: "memory");
}

typedef __attribute__((address_space(4))) const char* kptr_t;
__device__ __forceinline__ const void* arg_ptr(int k) { kptr_t ka = (kptr_t)__builtin_amdgcn_kernarg_segment_ptr(); asm volatile("" : "+s"(ka)); return *(const void* __attribute__((address_space(4)))*)(ka + 8 * k); }
#define ARG_IN(k) ((const float*)arg_ptr(k))
__device__ __forceinline__ f32x4 mod_load(const float* MODPp, const float* ada_b, int l, int midx, int off) {
    f32x4 s = *(const f32x4*)(ada_b + l * 3072 + off);
#pragma unroll
    for (int kq = 0; kq < 4; ++kq) s += *(const f32x4*)(MODPp + ((size_t)((kq * 4 + l) * 9 + midx)) * 3072 + off);
    return s;
}
__device__ __forceinline__ int mod_index(int row) { return row < RP ? 8 : ((row - RP) >> 11); }

__global__ void __launch_bounds__(NWAVES * 64, 2) fwd_kernel(Args args) {
    extern __shared__ __attribute__((aligned(16))) unsigned char lds_raw[];
    LAS unsigned char* lds = (LAS unsigned char*)lds_raw;
    volatile LAS unsigned* MISC = (volatile LAS unsigned*)(lds + MISC_OFF);
    const int G = gridDim.x; const int bx = blockIdx.x; const int vcu = (G % 8 == 0) ? (bx % 8) * (G / 8) + bx / 8 : bx;
    const int NGW = G * NWAVES;
    { const int tid0 = threadIdx.x; for (int u = tid0; u < (LDS_BYTES - RING_BYTES) / 4; u += NWAVES * 64) ((LAS unsigned*)(lds + RING_BYTES))[u] = 0u; }
    __syncthreads();
    XcdBarrier bar; bar.bar = (unsigned*)((unsigned char*)arg_ptr(24) + WS_CTL) + 1024; bar.x = 0; bar.st = nullptr;
    if (!MK_PER_PHASE) bar = xcd_barrier_post(bar.bar, MISC + 8);
    const int lo = MK_PER_PHASE ? args.ph_lo : 0, hi = MK_PER_PHASE ? args.ph_hi : N_PHASES;
    int pid = 0;
#ifndef PHASE_MASK
#define PHASE_MASK 0xFFFFFFFFu
#endif
#define IN_PH() (lo <= pid && pid < hi)
#ifndef G2M
#define G2M 7
#endif
#define PK(k) ((PHASE_MASK >> (k)) & 1u)
#ifndef PROBE_DUP
#define PROBE_DUP 0u
#endif
#define REPS(k) ((((PROBE_DUP) >> (k)) & 1u) ? 2 : 1)
#ifndef PROBE_BAR2
#define PROBE_BAR2 0
#endif
#define END_PH() do { if (!MK_PER_PHASE && lo <= pid && pid + 1 < hi) { xcd_barrier(bar); if (PROBE_BAR2) xcd_barrier(bar); } ++pid; } while (0)
#define PH_BEGIN() unsigned char* const ws = (unsigned char*)arg_ptr(24); float* const out = (float*)arg_ptr(23); \
    const int tid = opaque_tid(), lane = tid & 63, wave = __builtin_amdgcn_readfirstlane(tid >> 6), gw = vcu * NWAVES + wave; (void)out; (void)lane; (void)gw; (void)ws
#define MOD ((float*)(ws + WS_MOD))
#define ROPE8 ((float*)(ws + WS_ROPE8))
#define ROPE16 ((float*)(ws + WS_ROPE16))
#define MODP ((float*)(ws + WS_MODP))
#define Hb ((bf16*)(ws + WS_H))
#define GAB ((bf16*)(ws + WS_GAB))
#define CQ ((bf16*)(ws + WS_CQ))
#define CKV ((bf16*)(ws + WS_CKV))
#define KRB ((bf16*)(ws + WS_KRB))
#define KRF ((float*)(ws + WS_KRF))
#define KN ((bf16*)(ws + WS_KN))
#define VP ((bf16*)(ws + WS_KN))
#define VV ((bf16*)(ws + WS_V))
#define PO ((bf16*)(ws + WS_PO))
#define SQ ((bf16*)(ws + WS_CQ))
#define SK ((bf16*)(ws + WS_SK))
#define SV ((bf16*)(ws + WS_SV))

    if (IN_PH() && PK(1)) for (int rep = 0; rep < REPS(1); ++rep) { PH_BEGIN(); (void)rep;
        {
            const float* cvec = ARG_IN(6); const float* cctx = ARG_IN(7); const float* ada_w = ARG_IN(8);
            LAS float* red = (LAS float*)lds;
            for (int it = bx; it < 192; it += G) {
                const int l = it / 48, rem = it % 48, cc = rem >> 2, kq = rem & 3, k0 = kq * 256 + wave * 32;
                float sv[9];
#pragma unroll
                for (int j = 0; j < 9; ++j) { const float c = (j < 8) ? cvec[j * 1024 + k0 + (lane & 31)] : cctx[k0 + (lane & 31)]; sv[j] = c / (1.f + expf(-c)); }
                f32x4 acc[9];
#pragma unroll
                for (int j = 0; j < 9; ++j) acc[j] = (f32x4){0.f, 0.f, 0.f, 0.f};
                const float* wp = ada_w + ((size_t)l * 1024 + k0) * 3072 + cc * 256 + 4 * lane;
                f32x4 wv[32];
#pragma unroll
                for (int kk = 0; kk < 32; ++kk) wv[kk] = *(const f32x4*)(wp + (size_t)kk * 3072);
                asm volatile("" ::: "memory");
#pragma unroll
                for (int kk = 0; kk < 32; ++kk) {
#pragma unroll
                    for (int j = 0; j < 9; ++j) { const float sc = __int_as_float(__builtin_amdgcn_readlane(__float_as_int(sv[j]), kk)); acc[j] += wv[kk] * sc; }
                }
#pragma unroll
                for (int j = 0; j < 9; ++j) *(LAS f32x4*)(red + (wave * 9 + j) * 256 + 4 * lane) = acc[j];
                __syncthreads();
                for (int idx = tid; idx < 9 * 256; idx += NWAVES * 64) { const int j = idx >> 8, col = idx & 255; float sm = 0.f;
#pragma unroll
                    for (int w = 0; w < 8; ++w) sm += red[(w * 9 + j) * 256 + col];
                    MODP[((size_t)((kq * 4 + l) * 9 + j)) * 3072 + cc * 256 + col] = sm; }
                __syncthreads();
            }
        }
        for (int e = bx * 512 + tid; e < 64 * 8 + 64 * 16; e += G * 512) {
            if (e < 512) { const int pos = e >> 3, i = e & 7; const float inv = powf(10000.f, -(float)i / 8.f), a = (float)pos * inv; ROPE8[2 * e] = cosf(a); ROPE8[2 * e + 1] = sinf(a); }
            else { const int f = e - 512, pos = f >> 4, i = f & 15; const float inv = powf(10000.f, -(float)i / 16.f), a = (float)pos * inv; ROPE16[2 * f] = cosf(a); ROPE16[2 * f + 1] = sinf(a); }
        }
        LAS float* scr = (LAS float*)(lds + wave * 16384);
        constexpr int I1 = 1104, I2 = 144, I3 = 128, I4 = 32, I5 = 512, I6 = 1280, I7 = 512, IMLA = I1 + I2 + I3 + I4 + I5, ISWA = I6 + I7, ITOT = 2 * (IMLA + ISWA);
        for (int it = gw; it < ITOT; it += NGW) {
            int r = it; const int i = (r >= IMLA + ISWA) ? 1 : 0; r -= i * (IMLA + ISWA);
            unsigned char* wm = ws + (i ? WS_W_MLA1 : WS_W_MLA0); unsigned char* wsw = ws + (i ? WS_W_SWA1 : WS_W_SWA0);
            if (r < I1) { TMap tm{1, 0, 0, 1024, nullptr, 1.f}; transpose_item(ARG_IN(12) + (size_t)i * 1024 * 2208, 1024, 2208, (bf16*)wm, tm, scr, r, lane); continue; } r -= I1;
            if (r < I2) { TMap tm{2, 0, 0, 384, nullptr, MLA_SC}; transpose_item(ARG_IN(15) + (size_t)i * 384 * 768, 384, 768, (bf16*)(wm + SZ_WIN_MLA), tm, scr, r, lane); continue; } r -= I2;
            if (r < I3) { TMap tm{3, 0, 0, 256, nullptr, 1.f}; transpose_item(ARG_IN(16) + (size_t)i * 256 * 1024, 256, 1024, (bf16*)(wm + SZ_WIN_MLA + SZ_WUQ), tm, scr, r, lane); continue; } r -= I3;
            if (r < I4) { const int g = r >> 3; TMap tm{4, g * 128, g * 128, 512, ARG_IN(18) + i * 512 + g * 128, 1.f};
                transpose_item(ARG_IN(17) + ((size_t)i * 4 + g) * 128 * 128, 128, 128, (bf16*)(wm + SZ_WIN_MLA + SZ_WUQ + SZ_WUKV), tm, scr, r & 7, lane); continue; } r -= I4;
            if (r < I5) { TMap tm{0, 0, 0, 1024, nullptr, 1.f}; transpose_item(ARG_IN(19) + (size_t)i * 1024 * 1024, 1024, 1024, (bf16*)(wm + SZ_WIN_MLA + SZ_WUQ + SZ_WUKV + SZ_WPOOL), tm, scr, r, lane); continue; } r -= I5;
            if (r < I6) { TMap tm{5, 0, 0, 1024, nullptr, SWA_SC}; transpose_item(ARG_IN(20) + (size_t)i * 1024 * 2560, 1024, 2560, (bf16*)wsw, tm, scr, r, lane); continue; } r -= I6;
            { TMap tm{0, 0, 0, 1024, nullptr, 1.f}; transpose_item(ARG_IN(22) + (size_t)i * 1024 * 1024, 1024, 1024, (bf16*)(wsw + SZ_WIN_SWA), tm, scr, r, lane); }
        }
        const u32x4 z = {0u, 0u, 0u, 0u};
        for (int e = bx * 512 + tid; e < 2 * 96 * 128; e += G * 512) { const int i = e / (96 * 128), f = e % (96 * 128);
            *(u32x4*)(ws + (i ? WS_W_MLA1 : WS_W_MLA0) + (size_t)672 * 2048 + (size_t)f * 16) = z; }
        for (int e = bx * 512 + tid; e < 2 * 512 * 64; e += G * 512) { const int i = e / (512 * 64), f = e % (512 * 64), n = f >> 6, kc = f & 63;
            if ((n >> 7) != (kc >> 4)) *(u32x4*)(ws + (i ? WS_W_MLA1 : WS_W_MLA0) + SZ_WIN_MLA + SZ_WUQ + SZ_WUKV + (size_t)n * 1024 + (size_t)kc * 16) = z; }
    }
    END_PH();

    if (IN_PH() && PK(2)) for (int rep = 0; rep < REPS(2); ++rep) { PH_BEGIN(); (void)rep;
        const float* npre = ARG_IN(10); const float* xin0 = ARG_IN(0); const float* xin1 = ARG_IN(1); const float* adab = ARG_IN(9);
        {
            const float* npost0 = ARG_IN(11);
            for (int it = bx; it < 36; it += G) { const int l = it / 9, j = it % 9;
                for (int c = tid * 4; c < 1024; c += NWAVES * 64 * 4) { float* cf = MOD + (size_t)(l * 9 + j) * 3072;
                    *(f32x4*)(cf + c) = mod_load(MODP, adab, l, j, 2048 + c) * *(const f32x4*)(npost0 + l * 1024 + c);
                    *(f32x4*)(cf + 1024 + c) = *(const f32x4*)(npre + l * 1024 + c) * (mod_load(MODP, adab, l, j, 1024 + c) + 1.f);
                    *(f32x4*)(cf + 2048 + c) = mod_load(MODP, adab, l, j, c); } }
        }
        for (int chunk = gw; chunk < R / 12; chunk += NGW) {
            int curm = -1; f32x4 cB[4], cC[4];
#pragma unroll
            for (int j = 0; j < 4; ++j) { cB[j] = (f32x4){0.f, 0.f, 0.f, 0.f}; cC[j] = cB[j]; }
            for (int rr = 0; rr < 12; ++rr) {
                const int row = chunk * 12 + rr, midx = mod_index(row);
                if (midx != curm) { curm = midx;
#pragma unroll
                    for (int j = 0; j < 4; ++j) { const int c = 8 * lane + 512 * (j >> 1) + 4 * (j & 1); const f32x4 g = *(const f32x4*)(npre + c), sc = mod_load(MODP, adab, 0, midx, 1024 + c); cB[j] = g * (sc + 1.f); cC[j] = mod_load(MODP, adab, 0, midx, c); } }
                const float* xr = row < RP ? xin0 + (size_t)row * D : xin1 + (size_t)(row - RP) * D;
                f32x4 v[4]; float ss = 0.f;
#pragma unroll
                for (int j = 0; j < 4; ++j) { v[j] = *(const f32x4*)(xr + 8 * lane + 512 * (j >> 1) + 4 * (j & 1)); ss += v[j][0] * v[j][0] + v[j][1] * v[j][1] + v[j][2] * v[j][2] + v[j][3] * v[j][3]; }
                const float rstd = 1.f / sqrtf(wave_sum(ss) * (1.f / D) + EPS);
#pragma unroll
                for (int j2 = 0; j2 < 2; ++j2) { const f32x4 ha = v[2 * j2] * rstd * cB[2 * j2] + cC[2 * j2], hc = v[2 * j2 + 1] * rstd * cB[2 * j2 + 1] + cC[2 * j2 + 1];
                    u32x4 w; w.x = pk2(ha[0], ha[1]); w.y = pk2(ha[2], ha[3]); w.z = pk2(hc[0], hc[1]); w.w = pk2(hc[2], hc[3]); *(u32x4*)(Hb + (size_t)row * D + 8 * lane + 512 * j2) = w; }
            }
        }
    }
    END_PH();

    for (int l = 0; l < NL; ++l) {
        const int i = l >> 1;
        if ((l & 1) == 0) {
#define WM_BASE (ws + (i ? WS_W_MLA1 : WS_W_MLA0))
#define M_WinT ((const bf16*)WM_BASE)
#define M_WuqT ((const bf16*)(WM_BASE + SZ_WIN_MLA))
#define M_WukvT ((const bf16*)(WM_BASE + SZ_WIN_MLA + SZ_WUQ))
#define M_WpT ((const bf16*)(WM_BASE + SZ_WIN_MLA + SZ_WUQ + SZ_WUKV))
#define M_WoT ((const bf16*)(WM_BASE + SZ_WIN_MLA + SZ_WUQ + SZ_WUKV + SZ_WPOOL))
            if (IN_PH() && PK(3)) for (int rep = 0; rep < REPS(3); ++rep) { PH_BEGIN(); (void)rep;
                pg8::Gemm g{Hb, M_WinT, R, 2304, 1024, 1024}; pg8::StaticOrder S; S.init(R, 2304, G, bx);
                pg8::EpiMlaIn E{CQ, CKV, GAB, VP, KRF};
                pg8::gemm_phase<pg8::EpiMlaIn, true>(lds, g, S, E);
            }
            END_PH();
            if (IN_PH() && PK(4)) for (int rep = 0; rep < REPS(4); ++rep) { PH_BEGIN(); (void)rep;
                const float* gq = ARG_IN(13) + i * 384; const float* gkv = ARG_IN(14) + i * 256;
                const float* cckv = ARG_IN(2); const float* ckr = ARG_IN(3);
                const int half = 1 << (lane >> 4);
                float pm[16];
#pragma unroll
                for (int k = 0; k < 16; ++k) pm[k] = (k - 8 >= -half && k - 8 < half) ? 1.f : 0.f;
                for (int chunk = gw; chunk < (R + 2048) / 13; chunk += NGW) {
                    const int r0 = chunk * 13;
                    const int s0 = r0 < RP ? (r0 & ~255) : RP + ((r0 - RP) & ~2047), s1 = s0 + (r0 < RP ? 256 : 2048);
                    const bool fast = (r0 + 13 <= R) && (r0 - 8 >= s0) && (r0 + 20 <= s1);
                    u32x4 win[28];
#pragma unroll
                    for (int k = 0; k < 28; ++k) win[k] = (u32x4){0u, 0u, 0u, 0u};
                    if (fast) {
#pragma unroll
                        for (int k = 0; k < 28; ++k) win[k] = *(const u32x4*)(VP + (size_t)(r0 - 8 + k) * 512 + 8 * lane);
                    }
                    for (int ri = 0; ri < 13; ++ri) {
                    const int row = r0 + ri;
                    if (row < R) {
                        const bool prompt = row < RP; const int b = prompt ? row >> 8 : (row - RP) >> 11, t = prompt ? row & 255 : (row - RP) & 2047, T = prompt ? 256 : 2048;
                        const int rk = prompt ? row : RP + b * 2304 + t;
                        { float v[8]; float ss = 0.f; u32x4 w = {0u, 0u, 0u, 0u}; if (lane < 48) w = *(const u32x4*)(CQ + (size_t)row * 384 + 8 * lane);
                          v[0] = bflo(w.x); v[1] = bfhi(w.x); v[2] = bflo(w.y); v[3] = bfhi(w.y); v[4] = bflo(w.z); v[5] = bfhi(w.z); v[6] = bflo(w.w); v[7] = bfhi(w.w);
#pragma unroll
                          for (int e = 0; e < 8; ++e) ss += v[e] * v[e];
                          const float rstd = 1.f / sqrtf(wave_sum(ss) * (1.f / 384.f) + EPS);
                          if (lane < 48) { const f32x4 g0 = *(const f32x4*)(gq + 8 * lane), g1 = *(const f32x4*)(gq + 8 * lane + 4);
                              u32x4 o; o.x = pk2(v[0] * rstd * g0[0], v[1] * rstd * g0[1]); o.y = pk2(v[2] * rstd * g0[2], v[3] * rstd * g0[3]); o.z = pk2(v[4] * rstd * g1[0], v[5] * rstd * g1[1]); o.w = pk2(v[6] * rstd * g1[2], v[7] * rstd * g1[3]);
                              if (!(REPS(4) == 2 && rep == 0)) *(u32x4*)(CQ + (size_t)row * 384 + 8 * lane) = o; } }
                        { float v[8]; float ss = 0.f; u32x4 w = {0u, 0u, 0u, 0u}; if (lane < 32) w = *(const u32x4*)(CKV + (size_t)rk * 256 + 8 * lane);
                          v[0] = bflo(w.x); v[1] = bfhi(w.x); v[2] = bflo(w.y); v[3] = bfhi(w.y); v[4] = bflo(w.z); v[5] = bfhi(w.z); v[6] = bflo(w.w); v[7] = bfhi(w.w);
#pragma unroll
                          for (int e = 0; e < 8; ++e) ss += v[e] * v[e];
                          const float rstd = 1.f / sqrtf(wave_sum(ss) * (1.f / 256.f) + EPS);
                          if (lane < 32) { const f32x4 g0 = *(const f32x4*)(gkv + 8 * lane), g1 = *(const f32x4*)(gkv + 8 * lane + 4);
                              const f32x4 y0 = {v[0] * rstd * g0[0], v[1] * rstd * g0[1], v[2] * rstd * g0[2], v[3] * rstd * g0[3]}, y1 = {v[4] * rstd * g1[0], v[5] * rstd * g1[1], v[6] * rstd * g1[2], v[7] * rstd * g1[3]};
                              u32x4 o; o.x = pk2(y0[0], y0[1]); o.y = pk2(y0[2], y0[3]); o.z = pk2(y1[0], y1[1]); o.w = pk2(y1[2], y1[3]);
                              if (!(REPS(4) == 2 && rep == 0)) *(u32x4*)(CKV + (size_t)rk * 256 + 8 * lane) = o;
                              if (prompt) { float* s = out + OFF_CKV + ((size_t)(b * 2 + i) * 256 + t) * 256 + 8 * lane; *(f32x4*)s = y0; *(f32x4*)(s + 4) = y1; } } }
                        { if (lane < 32) { const float kv = KRF[(size_t)row * 32 + lane]; if (prompt) out[OFF_KR + ((size_t)(b * 2 + i) * 256 + t) * 32 + lane] = kv; }
                          if (lane < 16) { const int part = lane >> 3, fi = lane & 7; float x1 = KRF[(size_t)row * 32 + part * 16 + fi], x2 = KRF[(size_t)row * 32 + part * 16 + fi + 8];
                              if (!prompt) { const int pos = part ? (t & 63) : (t >> 6); const float cs = ROPE8[(pos * 8 + fi) * 2], sn = ROPE8[(pos * 8 + fi) * 2 + 1]; const float o1 = x1 * cs - x2 * sn, o2 = x1 * sn + x2 * cs; x1 = o1; x2 = o2; }
                              KRB[(size_t)rk * 32 + lane] = (bf16)f2bf(x1); KRB[(size_t)rk * 32 + 16 + lane] = (bf16)f2bf(x2); } }
                        if (!fast) { const bf16* vb = VP + (size_t)(row - t) * 512 + 8 * lane; float s[8];
#pragma unroll
                          for (int e = 0; e < 8; ++e) s[e] = 0.f;
#pragma unroll
                          for (int dt = -8; dt < 8; ++dt) { const int tt = t + dt; if (dt >= -half && dt < half && tt >= 0 && tt < T) { const u32x4 w = *(const u32x4*)(vb + (size_t)tt * 512);
                                  s[0] += bflo(w.x); s[1] += bfhi(w.x); s[2] += bflo(w.y); s[3] += bfhi(w.y); s[4] += bflo(w.z); s[5] += bfhi(w.z); s[6] += bflo(w.w); s[7] += bfhi(w.w); } }
                          const int plo = (t - half) > 0 ? (t - half) : 0, phi = (t + half) < T ? (t + half) : T; const float ic = 1.f / (float)(phi - plo);
                          const u32x4 w = *(const u32x4*)(vb + (size_t)t * 512);
                          u32x4 o; o.x = pk2(s[0] * ic - bflo(w.x), s[1] * ic - bfhi(w.x)); o.y = pk2(s[2] * ic - bflo(w.y), s[3] * ic - bfhi(w.y)); o.z = pk2(s[4] * ic - bflo(w.z), s[5] * ic - bfhi(w.z)); o.w = pk2(s[6] * ic - bflo(w.w), s[7] * ic - bfhi(w.w));
                          *(u32x4*)(PO + (size_t)row * 512 + 8 * lane) = o; }
                    } else {
                        const int ci = row - R, b = ci >> 8, p = ci & 255, rk = RP + b * 2304 + 2048 + p;
                        if (lane < 32) { const float* s = cckv + ((size_t)(b * 2 + i) * 256 + p) * 256 + 8 * lane; const f32x4 y0 = *(const f32x4*)s, y1 = *(const f32x4*)(s + 4);
                            u32x4 o; o.x = pk2(y0[0], y0[1]); o.y = pk2(y0[2], y0[3]); o.z = pk2(y1[0], y1[1]); o.w = pk2(y1[2], y1[3]); *(u32x4*)(CKV + (size_t)rk * 256 + 8 * lane) = o; }
                        if (lane < 16) { const int part = lane >> 3, fi = lane & 7; const float* s = ckr + ((size_t)(b * 2 + i) * 256 + p) * 32 + part * 16 + fi;
                            KRB[(size_t)rk * 32 + lane] = (bf16)f2bf(s[0]); KRB[(size_t)rk * 32 + 16 + lane] = (bf16)f2bf(s[8]); }
                    }
                    }
                    if (fast) {
                        const float ic = 0.5f / (float)half;
#pragma unroll
                        for (int ri = 0; ri < 13; ++ri) {
                            float sA[8];
#pragma unroll
                            for (int e = 0; e < 8; ++e) sA[e] = 0.f;
#pragma unroll
                            for (int k = 0; k < 16; ++k) { const u32x4 w = win[ri + k];
                                sA[0] += bflo(w.x) * pm[k]; sA[1] += bfhi(w.x) * pm[k]; sA[2] += bflo(w.y) * pm[k]; sA[3] += bfhi(w.y) * pm[k];
                                sA[4] += bflo(w.z) * pm[k]; sA[5] += bfhi(w.z) * pm[k]; sA[6] += bflo(w.w) * pm[k]; sA[7] += bfhi(w.w) * pm[k]; }
                            const u32x4 w = win[ri + 8];
                            u32x4 o; o.x = pk2(sA[0] * ic - bflo(w.x), sA[1] * ic - bfhi(w.x)); o.y = pk2(sA[2] * ic - bflo(w.y), sA[3] * ic - bfhi(w.y)); o.z = pk2(sA[4] * ic - bflo(w.z), sA[5] * ic - bfhi(w.z)); o.w = pk2(sA[6] * ic - bflo(w.w), sA[7] * ic - bfhi(w.w));
                            *(u32x4*)(PO + (size_t)(r0 + ri) * 512 + 8 * lane) = o;
                        }
                    }
                }
            }
            END_PH();
            if (IN_PH() && PK(5)) for (int rep = 0; rep < REPS(5); ++rep) { PH_BEGIN(); (void)rep;
                if (G2M & 1) { pg8::Gemm g{CQ, M_WuqT, R, 768, 384, 384}; pg8::StaticOrder S; S.init(R, 768, G, (bx + 64) % G); pg8::EpiQ E{Hb, ROPE8}; pg8::gemm_phase<pg8::EpiQ, true>(lds, g, S, E); }
                if (G2M & 2) { pg8::Gemm g{CKV, M_WukvT, RK, 1024, 256, 256}; pg8::StaticOrder S; S.init(RK, 1024, G, (bx + 160) % G); pg8::EpiBf16 E{KN, 512, 512, (size_t)(WS_V - WS_KN) / 2, 0}; pg8::gemm_phase<pg8::EpiBf16, true>(lds, g, S, E); }
                if ((G2M & 4) && (REPS(5) == 1 || rep == 1)) { pg8::Gemm g{PO, M_WpT, R, 512, 512, 512}; pg8::StaticOrder S; S.init(R, 512, G, bx); pg8::EpiPool E{GAB + 512}; pg8::gemm_phase<pg8::EpiPool, true>(lds, g, S, E); }
            }
            END_PH();
            if (IN_PH() && PK(6)) { PH_BEGIN();
                struct MlaMk { bf16 *hb, *kn, *vv, *gab, *krb; int wave;
                    __device__ __forceinline__ void operator()(int un, att::Desc& d) const {
                        d.ldq = 768; d.ldk0 = 512; d.ldv = 512; d.ldo = 1024; d.n_b = 0; d.row_b = 0; d.key_b = 0; d.qpos = 0; d.sink2 = 0.f; d.has_sink = 0; d.k1 = krb;
                        int h, qrow, krow;
                        if (un < 512) { const int b = un >> 6, qb = un & 7; h = (un >> 3) & 7; qrow = RP + b * 2048 + qb * 256 + wave * 32; krow = RP + b * 2304; d.n_a = 36; }
                        else { const int v = un - 512, b = v >> 3; h = v & 7; qrow = b * 256 + wave * 32; krow = b * 256; d.n_a = 4; }
                        d.row_a = krow; d.qptr = hb + (size_t)qrow * 768 + h * 96; d.k0 = kn + h * 64; d.v = vv + h * 64; d.optr = gab + (size_t)qrow * 1024 + h * 64; d.gptr = d.optr; d.ldg = 1024; } };
                const MlaMk mk{Hb, KN, VV, GAB, KRB, wave};
                att::attn_phase<0, MlaMk>((LAS char*)lds, mk, vcu, G, 768);
            }
            END_PH();
        } else {
#define WS_BASE (ws + (i ? WS_W_SWA1 : WS_W_SWA0))
#define S_WinT ((const bf16*)WS_BASE)
#define S_WoT ((const bf16*)(WS_BASE + SZ_WIN_SWA))
            if (IN_PH() && PK(8)) for (int rep = 0; rep < REPS(8); ++rep) { PH_BEGIN(); (void)rep;
                const float* ck = ARG_IN(4); const float* cv = ARG_IN(5);
                for (int e = bx * 512 + tid; e < 2 * 2048 * 32; e += G * 512) {
                    const int which = e / (2048 * 32), f = e % (2048 * 32), rowi = f >> 5, ch = f & 31, b = rowi >> 8, p = rowi & 255;
                    const float* s = (which ? cv : ck) + ((size_t)(b * 2 + i) * 256 + p) * 256 + 8 * ch; const f32x4 y0 = *(const f32x4*)s, y1 = *(const f32x4*)(s + 4);
                    u32x4 o; o.x = pk2(y0[0], y0[1]); o.y = pk2(y0[2], y0[3]); o.z = pk2(y1[0], y1[1]); o.w = pk2(y1[2], y1[3]);
                    *(u32x4*)((which ? SV : SK) + (size_t)(RP + b * 2304 + 2048 + p) * 256 + 8 * ch) = o;
                }
                pg8::Gemm g{Hb, S_WinT, R, 2560, 1024, 1024}; pg8::StaticOrder S; S.init(R, 2560, G, bx);
                pg8::EpiSwaIn E{SQ, SK, SV, GAB, out + OFF_K + (size_t)i * 65536, out + OFF_V + (size_t)i * 65536, ROPE16};
                pg8::gemm_phase<pg8::EpiSwaIn, true>(lds, g, S, E);
            }
            END_PH();
            if (IN_PH() && PK(9)) { PH_BEGIN();
                struct SwaMk { bf16 *sq, *sk, *sv, *gab; const float* sink; int wave, lane;
                    __device__ __forceinline__ void operator()(int un, att::Desc& d) const {
                        d.ldq = 1024; d.ldk0 = 256; d.ldv = 256; d.ldo = 1024; d.k1 = nullptr; d.has_sink = 1; d.n_a = 4;
                        int kvh, qrow, q0;
                        if (un < 1024) { const int b = un >> 7, blk = un & 31; kvh = (un >> 5) & 3; q0 = blk * 64; const int kb = RP + b * 2304;
                            qrow = RP + b * 2048 + q0 + (wave & 1) * 32; d.row_a = kb + 2048;
                            const int kfirst = q0 - 128 > 0 ? q0 - 128 : 0, klast = q0 + 128 < 2048 - 64 ? q0 + 128 : 2048 - 64;
                            d.key_b = kfirst; d.row_b = kb + kfirst; d.n_b = (klast - kfirst) / 64 + 1; }
                        else { const int v = un - 1024, b = v >> 4, blk = v & 3; kvh = (v >> 2) & 3; q0 = blk * 64; qrow = b * 256 + q0 + (wave & 1) * 32; d.row_a = b * 256; d.n_b = 0; d.row_b = 0; d.key_b = 0; }
                        const int head = kvh * 4 + (wave >> 1);
                        d.qpos = q0 + (wave & 1) * 32 + (lane & 31); d.sink2 = sink[head] * LOG2E;
                        d.qptr = sq + (size_t)qrow * 1024 + head * 64; d.k0 = sk + kvh * 64; d.v = sv + kvh * 64; d.optr = gab + (size_t)qrow * 1024 + head * 64; d.gptr = d.optr; d.ldg = 1024; } };
                const SwaMk mk{SQ, SK, SV, GAB, ARG_IN(21) + i * 16, wave, lane};
                att::attn_phase<1, SwaMk>((LAS char*)lds, mk, vcu, G, 1536);
            }
            END_PH();
        }
        if (IN_PH() && PK(11)) { PH_BEGIN();
            unsigned* ctlw = (unsigned*)(ws + WS_CTL); unsigned* cnt = ctlw + CW_CNT + l * 2048; unsigned* qh = ctlw + CW_QH + l * 16; unsigned* tmo = ctlw + CW_TMO;
            {
                const bf16* WoT = (l & 1) ? (const bf16*)(ws + (i ? WS_W_SWA1 : WS_W_SWA0) + SZ_WIN_SWA) : (const bf16*)(ws + (i ? WS_W_MLA1 : WS_W_MLA0) + SZ_WIN_MLA + SZ_WUQ + SZ_WUKV + SZ_WPOOL);
                pg8::Gemm g{GAB, WoT, R, 1024, 1024, 1024}; pg8::PanelOrder S{G, vcu, 384}; pg8::EpiOutPub E{Hb, cnt};
                pg8::gemm_phase<pg8::EpiOutPub, true, pg8::PanelOrder>(lds, g, S, E);
            }
            const float* xin0 = ARG_IN(0); const float* xin1 = ARG_IN(1); const bool has_next = l + 1 < NL;
            const int panel = vcu >= 128 ? (vcu - 128) >> 1 : 64 + (vcu >> 2);
            const int rbase = vcu >= 128 ? panel * 256 + ((vcu - 128) & 1) * 128 : panel * 256 + (vcu & 3) * 64;
            const int nrw = vcu >= 128 ? 16 : 8;
            if (wave == 0) {
                unsigned sp = 0;
                while (__hip_atomic_load(cnt + 16 * panel, __ATOMIC_RELAXED, __HIP_MEMORY_SCOPE_AGENT) < 32u) { __builtin_amdgcn_s_sleep(2);
                    if ((++sp & 1023u) == 0u) { if (__hip_atomic_load(tmo, __ATOMIC_RELAXED, __HIP_MEMORY_SCOPE_AGENT) || sp > (1u << 22)) { __hip_atomic_store(tmo, 1u, __ATOMIC_RELAXED, __HIP_MEMORY_SCOPE_AGENT); break; } } }
                __builtin_amdgcn_fence(__ATOMIC_ACQUIRE, "agent");
                asm volatile("s_waitcnt vmcnt(0)" ::: "memory");
            }
            __syncthreads();
            {
                const int row0 = rbase + wave * nrw, midx = mod_index(row0); const int ln = has_next ? l + 1 : l;
                const float* cf = MOD + (size_t)(l * 9 + midx) * 3072; const float* cfn = MOD + (size_t)(ln * 9 + midx) * 3072;
                f32x4 cA[4], cB[4], cC[4];
#pragma unroll
                for (int k = 0; k < 4; ++k) { const int c = 8 * lane + 512 * (k >> 1) + 4 * (k & 1); cA[k] = *(const f32x4*)(cf + c); cB[k] = *(const f32x4*)(cfn + 1024 + c); cC[k] = *(const f32x4*)(cfn + 2048 + c); }
                for (int rr = 0; rr < nrw; ++rr) {
                    const int row = row0 + rr;
                    f32x4 xv[4], ov[4];
                    if (l == 0) { const float* xr = row < RP ? xin0 + (size_t)row * D : xin1 + (size_t)(row - RP) * D;
#pragma unroll
                        for (int k = 0; k < 4; ++k) xv[k] = *(const f32x4*)(xr + 8 * lane + 512 * (k >> 1) + 4 * (k & 1)); }
                    else { const bf16* xb = (const bf16*)out + (size_t)row * 2048;
#pragma unroll
                        for (int j2 = 0; j2 < 2; ++j2) { const u32x4 wx = *(const u32x4*)(xb + 8 * lane + 512 * j2);
                            xv[2 * j2] = (f32x4){bflo(wx.x), bfhi(wx.x), bflo(wx.y), bfhi(wx.y)}; xv[2 * j2 + 1] = (f32x4){bflo(wx.z), bfhi(wx.z), bflo(wx.w), bfhi(wx.w)}; } }
                    float ss = 0.f;
#pragma unroll
                    for (int j2 = 0; j2 < 2; ++j2) { const u32x4 w = *(const u32x4*)(Hb + (size_t)row * D + 8 * lane + 512 * j2);
                        ov[2 * j2] = (f32x4){bflo(w.x), bfhi(w.x), bflo(w.y), bfhi(w.y)}; ov[2 * j2 + 1] = (f32x4){bflo(w.z), bfhi(w.z), bflo(w.w), bfhi(w.w)}; }
#pragma unroll
                    for (int k = 0; k < 4; ++k) ss += ov[k][0] * ov[k][0] + ov[k][1] * ov[k][1] + ov[k][2] * ov[k][2] + ov[k][3] * ov[k][3];
                    const float rstd = 1.f / sqrtf(wave_sum(ss) * (1.f / D) + EPS); float s2 = 0.f;
#pragma unroll
                    for (int k = 0; k < 4; ++k) { xv[k] = xv[k] + ov[k] * rstd * cA[k]; s2 += xv[k][0] * xv[k][0] + xv[k][1] * xv[k][1] + xv[k][2] * xv[k][2] + xv[k][3] * xv[k][3]; }
                    if (has_next) {
                        const float r2 = 1.f / sqrtf(wave_sum(s2) * (1.f / D) + EPS);
#pragma unroll
                        for (int j2 = 0; j2 < 2; ++j2) { const f32x4 xa = xv[2 * j2], xc = xv[2 * j2 + 1];
                            u32x4 wx; wx.x = pk2(xa[0], xa[1]); wx.y = pk2(xa[2], xa[3]); wx.z = pk2(xc[0], xc[1]); wx.w = pk2(xc[2], xc[3]);
                            *(u32x4*)((bf16*)out + (size_t)row * 2048 + 8 * lane + 512 * j2) = wx;
                            const f32x4 ha = xa * r2 * cB[2 * j2] + cC[2 * j2], hc = xc * r2 * cB[2 * j2 + 1] + cC[2 * j2 + 1];
                            u32x4 wh; wh.x = pk2(ha[0], ha[1]); wh.y = pk2(ha[2], ha[3]); wh.z = pk2(hc[0], hc[1]); wh.w = pk2(hc[2], hc[3]);
                            *(u32x4*)(Hb + (size_t)row * D + 8 * lane + 512 * j2) = wh; }
                    } else {
#pragma unroll
                        for (int k = 0; k < 4; ++k) *(f32x4*)(out + (size_t)row * D + 8 * lane + 512 * (k >> 1) + 4 * (k & 1)) = xv[k];
                    }
                }
            }
        }
        END_PH();
    }
#undef IN_PH
#undef END_PH
}


extern "C" void kernel_launch(void* const* d_in, const int* in_sizes, int n_in, void* d_out, int out_size, void* d_ws, size_t ws_size, hipStream_t stream) {
    static int grid = 0;
    if (grid == 0) {
        if (n_in != 23 || out_size != OUT_TOTAL || ws_size < WS_END) { fprintf(stderr, "kernel_launch: unexpected shapes (n_in %d out %d ws %zu)\n", n_in, out_size, ws_size); grid = -1; return; }
        int dev = 0, cus = 0;
        if (hipGetDevice(&dev) != hipSuccess || hipDeviceGetAttribute(&cus, hipDeviceAttributeMultiprocessorCount, dev) != hipSuccess) { grid = -1; return; }
        if (hipFuncSetAttribute((const void*)fwd_kernel, hipFuncAttributeMaxDynamicSharedMemorySize, LDS_BYTES) != hipSuccess) { fprintf(stderr, "kernel_launch: hipFuncSetAttribute failed\n"); grid = -1; return; }
        int per_cu = 0;
        if (hipOccupancyMaxActiveBlocksPerMultiprocessor(&per_cu, (const void*)fwd_kernel, NWAVES * 64, LDS_BYTES) != hipSuccess || per_cu < 1) { fprintf(stderr, "kernel_launch: occupancy query says %d\n", per_cu); }
        (void)hipGetLastError();
        grid = cus;
    }
    if (grid < 0) return;
    (void)hipMemsetAsync((char*)d_ws + WS_CTL, 0, CTL_ZERO_BYTES, stream);
    Args a{};
    for (int i = 0; i < 23; ++i) a.in[i] = (const float*)d_in[i];
    a.out = (float*)d_out; a.ws = (unsigned char*)d_ws;
#if MK_PER_PHASE
    for (int p = 0; p < N_PHASES; ++p) { a.ph_lo = p; a.ph_hi = p + 1; hipLaunchKernelGGL(fwd_kernel, dim3(grid), dim3(NWAVES * 64), LDS_BYTES, stream, a); }
#else
    a.ph_lo = 0; a.ph_hi = N_PHASES;
    hipLaunchKernelGGL(fwd_kernel, dim3(grid), dim3(NWAVES * 64), LDS_BYTES, stream, a);
#endif
}
```

```cpp
#include <hip/hip_runtime.h>
#include <cstdio>
#include <cstdint>

#define PROBE_DUP 0x0u
#define PROBE_BAR2 0
#ifndef TS_A
#define TS_A (-1)
#define TS_B (-1)
#endif
#define TS_SCALE 100.0f
#ifndef TS_MODE
#define TS_MODE 1
#endif
#ifndef TS_BLK
#define TS_BLK 0
#endif
#ifndef ATT_LOWREG
#define ATT_LOWREG (TS_A >= 0)
#endif
#ifndef MK_PER_PHASE
#define MK_PER_PHASE 0
#endif

#define GAS __attribute__((address_space(1)))
#define LAS __attribute__((address_space(3)))
typedef unsigned short bf16;
typedef short bf16x8 __attribute__((ext_vector_type(8)));
typedef short s16x4 __attribute__((ext_vector_type(4)));
typedef float f32x4 __attribute__((ext_vector_type(4)));
typedef float f32x2 __attribute__((ext_vector_type(2)));
typedef float f32x16 __attribute__((ext_vector_type(16)));
typedef unsigned u32x4 __attribute__((ext_vector_type(4)));
typedef unsigned u32x2 __attribute__((ext_vector_type(2)));
typedef __bf16 bf16x2_t __attribute__((ext_vector_type(2)));

constexpr int D = 1024, RP = 8192, RS = 16384, R = RP + RS;
constexpr int RK = RP + 8 * 2304;
constexpr int NL = 4;
constexpr float EPS = 1e-6f, LOG2E = 1.4426950408889634f;
constexpr float MLA_SC = 0.10206207261596577f * LOG2E;
constexpr float SWA_SC = 0.125f * LOG2E;
constexpr int OFF_CKV = 25165824, OFF_KR = 29360128, OFF_K = 29884416, OFF_V = 34078720, OUT_TOTAL = 38273024;

constexpr size_t MiB = 1u << 20;
constexpr size_t WS_CTL = 0, CTL_ZERO_BYTES = 128 * 1024;
constexpr int CW_CNT = 8192, CW_QH = 16384, CW_TMO = 17408;
constexpr size_t WS_MOD = 1 * MiB;
constexpr size_t WS_ROPE8 = 1 * MiB + 512 * 1024;
constexpr size_t WS_ROPE16 = WS_ROPE8 + 4096;
constexpr size_t SZ_WIN_MLA = 2304ull * 1024 * 2, SZ_WUQ = 768ull * 384 * 2, SZ_WUKV = 1024ull * 256 * 2, SZ_WPOOL = 512ull * 512 * 2,
                 SZ_WOUT = 1024ull * 1024 * 2, SZ_WIN_SWA = 2560ull * 1024 * 2;
constexpr size_t WS_W = 2 * MiB;
constexpr size_t SZ_W_MLA = SZ_WIN_MLA + SZ_WUQ + SZ_WUKV + SZ_WPOOL + SZ_WOUT, SZ_W_SWA = SZ_WIN_SWA + SZ_WOUT;
constexpr size_t WS_W_MLA0 = WS_W, WS_W_MLA1 = WS_W + SZ_W_MLA, WS_W_SWA0 = WS_W + 2 * SZ_W_MLA, WS_W_SWA1 = WS_W_SWA0 + SZ_W_SWA;
static_assert(WS_W_SWA1 + SZ_W_SWA <= 34 * MiB, "weights");
constexpr size_t WS_H = 34 * MiB;
constexpr size_t WS_GAB = 82 * MiB;
constexpr size_t WS_CQ = 130 * MiB;
constexpr size_t WS_CKV = 148 * MiB;
constexpr size_t WS_KRB = 161 * MiB;
constexpr size_t WS_KRF = 163 * MiB;
constexpr size_t WS_KN = 166 * MiB;
constexpr size_t WS_V = 192 * MiB;
constexpr size_t WS_PO = 218 * MiB;
constexpr size_t WS_SK = 178 * MiB;
constexpr size_t WS_SV = 191 * MiB;
constexpr size_t WS_MODP = 242 * MiB;
constexpr size_t WS_END = 244 * MiB;

__device__ __forceinline__ unsigned f2bf(float f) { unsigned u = __builtin_bit_cast(unsigned, f); return (u + 0x7fffu + ((u >> 16) & 1u)) >> 16; }
__device__ __forceinline__ unsigned pk2(float lo, float hi) { f32x2 v = {lo, hi}; bf16x2_t b = __builtin_convertvector(v, bf16x2_t); return __builtin_bit_cast(unsigned, b); }
__device__ __forceinline__ float bflo(unsigned w) { return __uint_as_float(w << 16); }
__device__ __forceinline__ float bfhi(unsigned w) { return __uint_as_float(w & 0xffff0000u); }
__device__ __forceinline__ float silu_fast(float x) { return x * __builtin_amdgcn_rcpf(1.f + __builtin_amdgcn_exp2f(-x * LOG2E)); }
#define DPP_ADD(v, ctrl) ((v) + __int_as_float(__builtin_amdgcn_update_dpp(0, __float_as_int(v), (ctrl), 0xf, 0xf, true)))
__device__ __forceinline__ float wave_sum(float v) {
    v = DPP_ADD(v, 0xB1); v = DPP_ADD(v, 0x4E); v = DPP_ADD(v, 0x124); v = DPP_ADD(v, 0x128);
    { auto rr = __builtin_amdgcn_permlane16_swap(__float_as_uint(v), __float_as_uint(v), false, false); v = __uint_as_float(rr[0]) + __uint_as_float(rr[1]); }
    { auto rr = __builtin_amdgcn_permlane32_swap(__float_as_uint(v), __float_as_uint(v), false, false); v = __uint_as_float(rr[0]) + __uint_as_float(rr[1]); }
    return v;
}
#define LDS_WAIT() asm volatile("s_waitcnt lgkmcnt(0)" ::: "memory")
__device__ __forceinline__ int opaque_tid() { int t = threadIdx.x; asm volatile("" : "+v"(t)); return t; }

namespace pg8 {
typedef unsigned short bf16_t;
constexpr int BM = 256, BK = 64, HALF = 128, HTB = HALF * BK * 2, STAGE_BYTES = 8 * HTB, NXCD = 8, WGM = 8;
__host__ __device__ __forceinline__ int lds_byte(int r, int c) { const int st = (r >> 4) * 2 + (c >> 5), rr = r & 15, cc = c & 31, ob = rr * 64 + cc * 2; return st * 1024 + (ob ^ (((ob >> 9) & 1) << 5)); }
__host__ __device__ __forceinline__ void stage_rc(int b, int& Rr, int& C) { const int st = b / 1024, sb = b % 1024, swz = sb ^ (((sb >> 9) & 1) << 5); Rr = (st >> 1) * 16 + swz / 64; C = (st & 1) * 32 + (swz % 64) / 2; }
__host__ __device__ __forceinline__ int perm32(int rho) { const int n = rho >> 4, i = rho & 15; return 8 * (i >> 2) + 4 * n + (i & 3); }
struct Unit { int pm, pn; };
struct Gemm { const bf16_t* A; const bf16_t* Bt; int M, N, K, lda; };
struct StaticOrder {
    int nM, nN, nwg, G, c;
    __device__ void init(int M, int N, int G_, int c_) { nM = M / BM; nN = N / BM; nwg = nM * nN; G = G_; c = c_; }
    __device__ bool next(int i, Unit& u) const {
        const long L = (long)i * G + c; if (L >= nwg) return false;
        int wgid = (int)L; { const int q = nwg / NXCD, r = nwg % NXCD, xcd = wgid % NXCD, off = wgid / NXCD; wgid = (xcd < r ? xcd * (q + 1) : r * (q + 1) + (xcd - r) * q) + off; }
        const int nig = WGM * nN, gid = wgid / nig, fm = gid * WGM, gsz = (nM - fm) < WGM ? (nM - fm) : WGM;
        u.pm = fm + ((wgid % nig) % gsz); u.pn = (wgid % nig) / gsz; return true;
    }
};
struct PanelOrder {
    int G, v, nunits;
    __device__ bool next(int i, Unit& u) const { const int L = i * G + v; if (L >= nunits) return false; u.pm = L >> 2; u.pn = L & 3; return true; }
};
template <class Epi, bool ALIGN_EPI, class Sched = StaticOrder>
__device__ __forceinline__ void gemm_phase(LAS unsigned char* lds, const Gemm g, const Sched& S, const Epi& E) {
    const int tid = opaque_tid(), wid = __builtin_amdgcn_readfirstlane(tid >> 6), lane = tid & 63, wr = wid >> 2, wc = wid & 3, fr = lane & 15, fq = lane >> 4;
    const int K = g.K, nt = K / BK, lda = g.lda;
    unsigned voffA[2], voffB[2];
#pragma unroll
    for (int i = 0; i < 2; ++i) { int Rr, C; stage_rc(tid * 16 + i * 8192, Rr, C); const int Rb = Epi::PERM ? ((Rr & ~31) + perm32(Rr & 31)) : Rr;
        voffA[i] = (unsigned)(Rr * lda + C) * 2u; voffB[i] = (unsigned)(Rb * K + C) * 2u; }
    const size_t kstep = (size_t)(BK * 2);
    const size_t hA = (size_t)HALF * lda * 2, hB = (size_t)HALF * K * 2, tA = 2 * hA, tB = 2 * hB;
    const unsigned ldsw = (unsigned)wid * 1024u;
    const int aoff = lds_byte(wr * 64 + fr, fq * 8), boff = lds_byte(wc * 32 + fr, fq * 8);
#define PG8_SA(b, h) (((b) * 2 + (h)) * HTB)
#define PG8_SB(b, h) ((4 + (b) * 2 + (h)) * HTB)
#define PG8_STAGE(bufoff, gbase, voff) do { _Pragma("unroll") for (int _i = 0; _i < 2; ++_i) \
        __builtin_amdgcn_global_load_lds((const unsigned*)((const char*)(gbase) + (voff)[_i]), (LAS unsigned*)(lds + (bufoff) + ldsw + _i * 8192), 16, 0, 0); } while (0)
#define PG8_LDA(dst, b, h) do { _Pragma("unroll") for (int m = 0; m < 4; ++m) _Pragma("unroll") for (int k = 0; k < 2; ++k) dst[m][k] = *(const LAS bf16x8*)(lds + PG8_SA(b, h) + aoff + m * 2048 + k * 1024); } while (0)
#define PG8_LDB(dst, b, h) do { _Pragma("unroll") for (int n = 0; n < 2; ++n) _Pragma("unroll") for (int k = 0; k < 2; ++k) dst[n][k] = *(const LAS bf16x8*)(lds + PG8_SB(b, h) + boff + n * 2048 + k * 1024); } while (0)
#define PG8_MMA(ai, bj, At, Bt) do { __builtin_amdgcn_s_setprio(1); _Pragma("unroll") for (int m = 0; m < 4; ++m) _Pragma("unroll") for (int n = 0; n < 2; ++n) _Pragma("unroll") for (int k = 0; k < 2; ++k) \
        acc[ai][bj][m][n] = __builtin_amdgcn_mfma_f32_16x16x32_bf16(Bt[n][k], At[m][k], acc[ai][bj][m][n], 0, 0, 0); __builtin_amdgcn_s_setprio(0); } while (0)
#define PG8_WAIT_V(n) asm volatile("s_waitcnt vmcnt(" #n ")" ::: "memory")
#define PG8_WAIT_L(n) asm volatile("s_waitcnt lgkmcnt(" #n ")" ::: "memory")
#define PG8_BAR __builtin_amdgcn_s_barrier()
#define PG8_SCHED __builtin_amdgcn_sched_barrier(0)
    Unit cur, nxt; int ui = 0;
    if (!S.next(0, cur)) return;
    f32x4 acc[2][2][4][2];
#pragma unroll
    for (int a = 0; a < 2; ++a)
#pragma unroll
        for (int b = 0; b < 2; ++b)
#pragma unroll
            for (int m = 0; m < 4; ++m)
#pragma unroll
                for (int n = 0; n < 2; ++n) acc[a][b][m][n] = (f32x4){0.f, 0.f, 0.f, 0.f};
    const char* cA = (const char*)g.A + (size_t)cur.pm * tA; const char* cB = (const char*)g.Bt + (size_t)cur.pn * tB;
    PG8_STAGE(PG8_SB(0, 0), cB, voffB); PG8_STAGE(PG8_SB(0, 1), cB + hB, voffB); PG8_STAGE(PG8_SA(0, 0), cA, voffA); PG8_STAGE(PG8_SA(0, 1), cA + hA, voffA);
    if (wr == 1) PG8_BAR;
    PG8_WAIT_V(2); PG8_BAR;
    PG8_STAGE(PG8_SB(1, 0), cB + kstep, voffB); PG8_STAGE(PG8_SA(1, 0), cA + kstep, voffA); PG8_STAGE(PG8_SB(1, 1), cB + hB + kstep, voffB);
    PG8_WAIT_V(6); PG8_BAR;
    for (;;) {
        const bool has_next = S.next(ui + 1, nxt);
        const char* nA = has_next ? (const char*)g.A + (size_t)nxt.pm * tA : cA; const char* nB = has_next ? (const char*)g.Bt + (size_t)nxt.pn * tB : cB;
#pragma nounroll
        for (int t = 0; t < nt; t += 2) {
            const bool last = (t == nt - 2);
            bf16x8 At[4][2], B0[2][2], B1[2][2];
            const char* a1 = cA + (size_t)(t + 1) * kstep;
            const char* a2 = last ? nA : cA + (size_t)(t + 2) * kstep; const char* b2 = last ? nB : cB + (size_t)(t + 2) * kstep;
            const char* a3 = a2 + kstep; const char* b3 = b2 + kstep;
            PG8_LDB(B0, 0, 0); PG8_LDB(B1, 0, 1); PG8_SCHED; PG8_LDA(At, 0, 0); PG8_STAGE(PG8_SA(1, 1), a1 + hA, voffA);
            PG8_WAIT_V(8); PG8_WAIT_L(0); PG8_BAR; PG8_MMA(0, 0, At, B0); PG8_MMA(0, 1, At, B1); PG8_BAR; PG8_SCHED;
            PG8_LDA(At, 0, 1); PG8_STAGE(PG8_SB(0, 0), b2, voffB); PG8_STAGE(PG8_SB(0, 1), b2 + hB, voffB); PG8_STAGE(PG8_SA(0, 0), a2, voffA);
            PG8_WAIT_V(8); PG8_WAIT_L(0); PG8_BAR; PG8_MMA(1, 0, At, B0); PG8_MMA(1, 1, At, B1); PG8_BAR; PG8_SCHED;
            PG8_LDB(B0, 1, 0); PG8_LDB(B1, 1, 1); PG8_SCHED; PG8_LDA(At, 1, 0); PG8_STAGE(PG8_SA(0, 1), a2 + hA, voffA);
            PG8_WAIT_V(8); PG8_WAIT_L(0); PG8_BAR; PG8_MMA(0, 0, At, B0); PG8_MMA(0, 1, At, B1); PG8_BAR; PG8_SCHED;
            PG8_LDA(At, 1, 1); PG8_STAGE(PG8_SB(1, 0), b3, voffB); PG8_STAGE(PG8_SB(1, 1), b3 + hB, voffB); PG8_STAGE(PG8_SA(1, 0), a3, voffA);
            PG8_WAIT_V(8); PG8_WAIT_L(0); PG8_BAR; PG8_MMA(1, 0, At, B0); PG8_MMA(1, 1, At, B1); PG8_BAR; PG8_SCHED;
        }
        if constexpr (ALIGN_EPI) { if (wr == 0) PG8_BAR; }
        E(acc, cur, wr, wc, fr, fq);
        if (!has_next) break;
#pragma unroll
        for (int a = 0; a < 2; ++a)
#pragma unroll
            for (int b = 0; b < 2; ++b)
#pragma unroll
                for (int m = 0; m < 4; ++m)
#pragma unroll
                    for (int n = 0; n < 2; ++n) acc[a][b][m][n] = (f32x4){0.f, 0.f, 0.f, 0.f};
        cur = nxt; cA = nA; cB = nB; ++ui;
        if constexpr (ALIGN_EPI) { if (wr == 1) PG8_BAR; }
    }
    PG8_WAIT_V(0);
    if constexpr (!ALIGN_EPI) { if (wr == 0) PG8_BAR; }
    PG8_BAR;
#undef PG8_SA
#undef PG8_SB
#undef PG8_STAGE
#undef PG8_LDA
#undef PG8_LDB
#undef PG8_MMA
#undef PG8_WAIT_V
#undef PG8_WAIT_L
#undef PG8_BAR
#undef PG8_SCHED
}

__device__ __forceinline__ int rk_base(int pm) { return pm < 32 ? pm * 256 : RP + ((pm - 32) >> 3) * 2304 + ((pm - 32) & 7) * 256; }

struct EpiBf16 {
    static constexpr bool PERM = true;
    bf16* O; int ldc; int split_cols; size_t split_stride; int nostore;
    __device__ __forceinline__ void operator()(const f32x4 (&acc)[2][2][4][2], const Unit& u, int wr, int wc, int fr, int fq) const {
        const int row0 = u.pm * BM + wr * 64 + fr; int colt = u.pn * BM; bf16* base = O;
        if (split_cols) { const int t = colt / split_cols; base += (size_t)t * split_stride; colt -= t * split_cols; }
        const int col0 = colt + wc * 32 + 8 * fq;
#pragma unroll
        for (int ai = 0; ai < 2; ++ai)
#pragma unroll
            for (int m = 0; m < 4; ++m) { bf16* rowp = base + (size_t)(row0 + ai * HALF + m * 16) * ldc + col0;
#pragma unroll
                for (int bj = 0; bj < 2; ++bj) { const f32x4 v0 = acc[ai][bj][m][0], v1 = acc[ai][bj][m][1];
                    u32x4 w; w.x = pk2(v0[0], v0[1]); w.y = pk2(v0[2], v0[3]); w.z = pk2(v1[0], v1[1]); w.w = pk2(v1[2], v1[3]);
                    if (nostore) asm volatile("" :: "v"(w)); else *(u32x4*)(rowp + bj * HALF) = w; } }
    }
};
struct EpiOutPub {
    static constexpr bool PERM = true;
    bf16* O; unsigned* cnt;
    __device__ __forceinline__ void operator()(const f32x4 (&acc)[2][2][4][2], const Unit& u, int wr, int wc, int fr, int fq) const {
        const __amdgpu_buffer_rsrc_t rs = __builtin_amdgcn_make_buffer_rsrc((void*)O, (short)0, R * 1024 * 2, 0x00020000);
        const int row0 = u.pm * BM + wr * 64 + fr; const int col0 = u.pn * BM + wc * 32 + 8 * fq;
#pragma unroll
        for (int ai = 0; ai < 2; ++ai)
#pragma unroll
            for (int m = 0; m < 4; ++m) { const int off = ((row0 + ai * HALF + m * 16) * 1024 + col0) * 2;
#pragma unroll
                for (int bj = 0; bj < 2; ++bj) { const f32x4 v0 = acc[ai][bj][m][0], v1 = acc[ai][bj][m][1];
                    u32x4 w; w.x = pk2(v0[0], v0[1]); w.y = pk2(v0[2], v0[3]); w.z = pk2(v1[0], v1[1]); w.w = pk2(v1[2], v1[3]);
                    __builtin_amdgcn_raw_buffer_store_b128(w, rs, off + bj * HALF * 2, 0, 16); } }
        asm volatile("s_waitcnt vmcnt(0)" ::: "memory");
        if ((fr | fq) == 0) __hip_atomic_fetch_add(cnt + 16 * u.pm, 1u, __ATOMIC_RELAXED, __HIP_MEMORY_SCOPE_AGENT);
    }
};
struct EpiPool {
    static constexpr bool PERM = true;
    bf16* GB;
    __device__ __forceinline__ void operator()(const f32x4 (&acc)[2][2][4][2], const Unit& u, int wr, int wc, int fr, int fq) const {
        const int row0 = u.pm * BM + wr * 64 + fr; const int col0 = u.pn * BM + wc * 32 + 8 * fq;
#pragma unroll
        for (int ai = 0; ai < 2; ++ai)
#pragma unroll
            for (int m = 0; m < 4; ++m) { bf16* rowp = GB + (size_t)(row0 + ai * HALF + m * 16) * 1024 + col0;
#pragma unroll
                for (int bj = 0; bj < 2; ++bj) { const f32x4 v0 = acc[ai][bj][m][0], v1 = acc[ai][bj][m][1];
                    const u32x4 gg = *(const u32x4*)(rowp + bj * HALF);
                    u32x4 w;
                    w.x = pk2(v0[0] * silu_fast(bflo(gg.x)), v0[1] * silu_fast(bfhi(gg.x))); w.y = pk2(v0[2] * silu_fast(bflo(gg.y)), v0[3] * silu_fast(bfhi(gg.y)));
                    w.z = pk2(v1[0] * silu_fast(bflo(gg.z)), v1[1] * silu_fast(bfhi(gg.z))); w.w = pk2(v1[2] * silu_fast(bflo(gg.w)), v1[3] * silu_fast(bfhi(gg.w)));
                    *(u32x4*)(rowp + bj * HALF) = w; } }
    }
};
struct EpiMlaIn {
    static constexpr bool PERM = true;
    bf16 *CQ, *CKV, *GAB, *VP; float* KRF;
    __device__ __forceinline__ void operator()(const f32x4 (&acc)[2][2][4][2], const Unit& u, int wr, int wc, int fr, int fq) const {
        const int rt = wr * 64 + fr, grow0 = u.pm * BM, rk0 = rk_base(u.pm), cc = wc * 32 + 8 * fq;
#pragma unroll
        for (int bj = 0; bj < 2; ++bj) {
            const int U = 2 * u.pn + bj;
            if (U == 5) {
                if (wc == 0) {
#pragma unroll
                    for (int ai = 0; ai < 2; ++ai)
#pragma unroll
                        for (int m = 0; m < 4; ++m) { float* p = KRF + (size_t)(grow0 + rt + ai * HALF + m * 16) * 32 + 8 * fq;
                            *(f32x4*)p = acc[ai][bj][m][0]; *(f32x4*)(p + 4) = acc[ai][bj][m][1]; }
                }
                continue;
            }
            bf16* p; int ld, rb = grow0;
            if (U < 3) { p = CQ + 128 * U; ld = 384; }
            else if (U < 5) { p = CKV + 128 * (U - 3); ld = 256; rb = rk0; }
            else if (U < 10) { p = GAB + 128 * (U - 6); ld = 1024; }
            else if (U < 14) { p = VP + 128 * (U - 10); ld = 512; }
            else { p = GAB + 512 + 128 * (U - 14); ld = 1024; }
            p += (size_t)(rb + rt) * ld + cc;
#pragma unroll
            for (int ai = 0; ai < 2; ++ai)
#pragma unroll
                for (int m = 0; m < 4; ++m) { const f32x4 v0 = acc[ai][bj][m][0], v1 = acc[ai][bj][m][1];
                    u32x4 w; w.x = pk2(v0[0], v0[1]); w.y = pk2(v0[2], v0[3]); w.z = pk2(v1[0], v1[1]); w.w = pk2(v1[2], v1[3]);
                    *(u32x4*)(p + (size_t)(ai * HALF + m * 16) * ld) = w; }
        }
    }
};
__device__ __forceinline__ void rope_perm(f32x4& a, f32x4& b, const float* tb) {
#pragma unroll
    for (int j = 0; j < 4; ++j) { auto rr = __builtin_amdgcn_permlane32_swap(__float_as_uint(a[j]), __float_as_uint(b[j]), false, false); a[j] = __uint_as_float(rr[0]); b[j] = __uint_as_float(rr[1]); }
    const f32x4 c0 = *(const f32x4*)tb, c1 = *(const f32x4*)(tb + 4);
    const f32x4 cs = {c0[0], c0[2], c1[0], c1[2]}, sn = {c0[1], c0[3], c1[1], c1[3]};
    const f32x4 o1 = a * cs - b * sn, o2 = a * sn + b * cs;
    a = o1; b = o2;
#pragma unroll
    for (int j = 0; j < 4; ++j) { auto rr = __builtin_amdgcn_permlane32_swap(__float_as_uint(a[j]), __float_as_uint(b[j]), false, false); a[j] = __uint_as_float(rr[0]); b[j] = __uint_as_float(rr[1]); }
}
struct EpiQ {
    static constexpr bool PERM = true;
    bf16* Q; const float* rope8;
    __device__ __forceinline__ void operator()(const f32x4 (&acc)[2][2][4][2], const Unit& u, int wr, int wc, int fr, int fq) const {
        const int rt = wr * 64 + fr, grow0 = u.pm * BM; const bool sample = u.pm >= 32; const int t0 = ((u.pm - 32) & 7) * 256;
#pragma unroll
        for (int bj = 0; bj < 2; ++bj) {
            const int g32 = 8 * u.pn + 4 * bj + wc; const bool rot = sample && (g32 % 3 == 2);
#pragma unroll
            for (int ai = 0; ai < 2; ++ai)
#pragma unroll
                for (int m = 0; m < 4; ++m) { const int r = rt + ai * HALF + m * 16; f32x4 x1 = acc[ai][bj][m][0], x2 = acc[ai][bj][m][1];
                    if (rot) { const int t = t0 + r, pos = (fq & 1) ? (t & 63) : (t >> 6); rope_perm(x1, x2, rope8 + (pos * 8 + ((fq >> 1) ? 4 : 0)) * 2); }
                    u32x4 w; w.x = pk2(x1[0], x1[1]); w.y = pk2(x1[2], x1[3]); w.z = pk2(x2[0], x2[1]); w.w = pk2(x2[2], x2[3]);
                    *(u32x4*)(Q + (size_t)(grow0 + r) * 768 + 32 * g32 + 8 * fq) = w; }
        }
    }
};
struct EpiSwaIn {
    static constexpr bool PERM = true;
    bf16 *Q, *K, *V, *G; float *stK, *stV; const float* rope16;
    __device__ __forceinline__ void operator()(const f32x4 (&acc)[2][2][4][2], const Unit& u, int wr, int wc, int fr, int fq) const {
        const int rt = wr * 64 + fr, grow0 = u.pm * BM, rk0 = rk_base(u.pm); const bool sample = u.pm >= 32; const int t0 = ((u.pm - 32) & 7) * 256;
        const int pn = u.pn;
#pragma unroll
        for (int bj = 0; bj < 2; ++bj) {
            const int cb = 128 * bj + 32 * wc + 8 * fq;
            const bool rot = sample && pn < 5;
#pragma unroll
            for (int ai = 0; ai < 2; ++ai)
#pragma unroll
                for (int m = 0; m < 4; ++m) { const int r = rt + ai * HALF + m * 16; f32x4 x1 = acc[ai][bj][m][0], x2 = acc[ai][bj][m][1];
                    if (rot) { const int t = t0 + r, pos = (wc & 1) ? (t & 63) : (t >> 6); rope_perm(x1, x2, rope16 + (pos * 16 + 8 * (fq & 1) + ((fq >> 1) ? 4 : 0)) * 2); }
                    bf16* p;
                    if (pn < 4) p = Q + (size_t)(grow0 + r) * 1024 + 256 * pn + cb;
                    else if (pn == 4) p = K + (size_t)(rk0 + r) * 256 + cb;
                    else if (pn == 5) p = V + (size_t)(rk0 + r) * 256 + cb;
                    else p = G + (size_t)(grow0 + r) * 1024 + 256 * (pn - 6) + cb;
                    if (!sample && (pn == 4 || pn == 5)) { float* st = (pn == 4 ? stK : stV) + (size_t)(u.pm * 2 * 256 + r) * 256 + cb; *(f32x4*)st = x1; *(f32x4*)(st + 4) = x2; }
                    u32x4 w; w.x = pk2(x1[0], x1[1]); w.y = pk2(x1[2], x1[3]); w.z = pk2(x2[0], x2[1]); w.w = pk2(x2[2], x2[3]);
                    *(u32x4*)p = w; }
        }
    }
};
}

typedef __attribute__((address_space(4))) const char* kptr_t;
__device__ __forceinline__ const void* arg_ptr(int k) { kptr_t ka = (kptr_t)__builtin_amdgcn_kernarg_segment_ptr(); asm volatile("" : "+s"(ka)); return *(const void* __attribute__((address_space(4)))*)(ka + 8 * k); }
#define ARG_IN(k) ((const float*)arg_ptr(k))
namespace att {
__device__ __forceinline__ int crow(int r, int hi) { return (r & 3) + 8 * (r >> 2) + 4 * hi; }
typedef short v4i16_t __attribute__((ext_vector_type(4)));
__device__ __forceinline__ s16x4 vtr(const LAS char* p) { return __builtin_bit_cast(s16x4, __builtin_amdgcn_ds_read_tr16_b64_v4i16((LAS v4i16_t*)p)); }
__device__ __forceinline__ float xhalf_max(float x) { auto rr = __builtin_amdgcn_permlane32_swap(__float_as_uint(x), __float_as_uint(x), false, false); return __builtin_fmaxf(__uint_as_float(rr[0]), __uint_as_float(rr[1])); }
__device__ __forceinline__ float xhalf_sum(float x) { auto rr = __builtin_amdgcn_permlane32_swap(__float_as_uint(x), __float_as_uint(x), false, false); return __uint_as_float(rr[0]) + __uint_as_float(rr[1]); }
#define SBAR() __builtin_amdgcn_sched_barrier(0)
#define PIN(x) asm volatile("" : "+v"(x))
__device__ __forceinline__ float max3f(float a, float b, float c) { float r; asm("v_max3_f32 %0, %1, %2, %3" : "=v"(r) : "v"(a), "v"(b), "v"(c)); return r; }
__device__ __forceinline__ float max2f(float a, float b) { float r; asm("v_max_f32_e32 %0, %1, %2" : "=v"(r) : "v"(a), "v"(b)); return r; }
struct Desc {
    const bf16* qptr;
    const bf16* k0;
    const bf16* k1;
    const bf16* v;
    int n_a, row_a, n_b, row_b, key_b;
    int qpos; float sink2; int has_sink;
    bf16* optr;
};
constexpr float THR = 8.f;
__device__ __forceinline__ int tile_row(const Desc& d, int t) { return t < d.n_a ? d.row_a + 64 * t : d.row_b + 64 * (t - d.n_a); }
template <int MODE, class MK>
__device__ __forceinline__ void attn_phase(LAS char* lds, const MK& mk, int first, int stride, int nunits) {
    constexpr int DQK = MODE == 0 ? 96 : 64, NCH = DQK / 8, ND0 = DQK / 16, KB = NCH * 1024, VOFF = 3 * KB, NG = 2 * ND0, NHELD = 8, NLATE = NG - NHELD, STG_OFF = VOFF + 2 * 8192;
    static_assert(STG_OFF + 8 * 32 * 272 <= 131072, "attention LDS map");
    constexpr int LDQ = MODE == 0 ? 768 : 1024, LDK0 = MODE == 0 ? 512 : 256, LDV = LDK0, LDO = 1024;
    int un = first; if (un >= nunits) return;
    const int tid = opaque_tid(), lane = tid & 63, r32 = lane & 31, hi = lane >> 5; const int wid = __builtin_amdgcn_readfirstlane(tid >> 6);
    const int kdst = wid * 1024, k1dst = (8 + (wid & 3)) * 1024, vdst = VOFF + wid * 1024;
    const int vlane = ((lane >> 4) & 1) * 32 + (lane & 3) * 8 + (4 * hi + ((lane & 15) >> 2)) * 64;
    const int kfo = hi * 1024 + r32 * 16;
    Desc d; mk(un, d);
#define SRC_K(dd) ((dd).k0 + (size_t)lane * LDK0 + wid * 8)
#define SRC_K1(dd) ((MODE == 0) ? (dd).k1 + (size_t)lane * 32 + (wid & 3) * 8 : (const bf16*)nullptr)
#define SRC_V(dd) ((dd).v + (size_t)(16 * (wid & 3) + (lane >> 2)) * LDV + (wid >> 2) * 32 + (lane & 3) * 8)
    const bf16* ksrc = SRC_K(d); const bf16* k1src = SRC_K1(d); const bf16* vsrc = SRC_V(d);
#define GLDS16(g, l) __builtin_amdgcn_global_load_lds((const unsigned*)(g), (LAS unsigned*)(l), 16, 0, 0)
#define DMAK_(dd, ks_, k1s_, t, soff) do { const size_t _r = (size_t)tile_row(dd, t); GLDS16((ks_) + _r * LDK0, lds + (soff) + kdst); if (MODE == 0 && wid < 4) GLDS16((k1s_) + _r * 32, lds + (soff) + k1dst); } while (0)
#define DMAV_(dd, vs_, t, vslot) do { const size_t _r = (size_t)tile_row(dd, t); GLDS16((vs_) + _r * LDV, lds + (vslot) * 8192 + vdst); } while (0)
#define DMAK(t, soff) DMAK_(d, ksrc, k1src, t, soff)
#define DMAV(t, vslot) DMAV_(d, vsrc, t, vslot)
    int sl_cur = 0, sl_nxt = KB, sl_fre = 2 * KB;
    int vpar = 0;
    DMAK(0, sl_cur); DMAK(1, sl_nxt); DMAV(0, vpar);
    bf16x8 qr[ND0];
#pragma unroll
    for (int d0 = 0; d0 < ND0; ++d0) qr[d0] = *(const bf16x8*)(d.qptr + (size_t)r32 * LDQ + d0 * 16 + hi * 8);
    __syncthreads();
#define ROT() do { const int o_ = sl_cur; sl_cur = sl_nxt; sl_nxt = sl_fre; sl_fre = o_; } while (0)
#define KFADDR(i, soff) (lds + (soff) + kfo + ((i) >> 1) * 2048 + ((i) & 1) * 512)
#define PE(P0, P1, e) ((e) < 16 ? P0[(e) & 15] : P1[(e) & 15])
#define FILL_A(P0, P1, g) do { \
        _Pragma("unroll") for (int e_ = (32 * (g)) / NG; e_ < (32 * ((g) + 1)) / NG; ++e_) sacc += PE(P0, P1, e_); \
        PIN(sacc); \
        _Pragma("unroll") for (int k_ = (16 * (g)) / NG; k_ < (16 * ((g) + 1)) / NG; ++k_) { pw[k_ >> 2][k_ & 3] = pk2(PE(P0, P1, 2 * k_), PE(P0, P1, 2 * k_ + 1)); PIN(pw[k_ >> 2]); } } while (0)
#define QK_PHASE(C0, C1, P0, P1, HAVE_P) do { \
        bf16x8 kl_[NLATE > 0 ? NLATE : 1]; \
        _Pragma("unroll") for (int i_ = 0; i_ < NLATE; ++i_) kl_[i_] = *(const LAS bf16x8*)KFADDR(NHELD + i_, sl_cur); \
        _Pragma("unroll") for (int g_ = 0; g_ < NG; ++g_) { const int d0_ = g_ >> 1; \
            const bf16x8 kk_ = g_ < NHELD ? kf[g_ < NHELD ? g_ : 0] : kl_[g_ >= NHELD ? g_ - NHELD : 0]; \
            if ((g_ & 1) == 0) C0 = __builtin_amdgcn_mfma_f32_32x32x16_bf16(kk_, qr[d0_], d0_ == 0 ? negm : C0, 0, 0, 0); \
            else C1 = __builtin_amdgcn_mfma_f32_32x32x16_bf16(kk_, qr[d0_], d0_ == 0 ? negm : C1, 0, 0, 0); \
            if (HAVE_P) FILL_A(P0, P1, g_); \
            SBAR(); } } while (0)
#define MASKT(C0, C1, t_) do { if (MODE == 1 && (t_) >= d.n_a) { const int key0_ = d.key_b + 64 * ((t_) - d.n_a); \
        if (key0_ - (qb0 + 31) < -128 || key0_ + 63 - qb0 > 128) { const int k0p_ = key0_ - d.qpos; \
            _Pragma("unroll") for (int r = 0; r < 16; ++r) { const int d_ = k0p_ + crow(r, hi); if (d_ > 128 || d_ < -128) C0[r] = -1e30f; if (d_ + 32 > 128 || d_ + 32 < -128) C1[r] = -1e30f; } } } } while (0)
#define DECIDE(C0, C1) do { \
        float a_ = max2f(C0[0], C1[0]), b_ = max2f(C0[1], C1[1]); \
        _Pragma("unroll") for (int r = 2; r < 16; r += 2) { a_ = max3f(a_, C0[r], C1[r]); b_ = max3f(b_, C0[r + 1], C1[r + 1]); } \
        a_ = xhalf_max(max2f(a_, b_)); resc = false; \
        if (__any(a_ > THR)) { const float dl_ = fmaxf(a_, 0.f); mref += dl_; \
            _Pragma("unroll") for (int r = 0; r < 16; ++r) { C0[r] -= dl_; C1[r] -= dl_; } \
            _Pragma("unroll") for (int r = 0; r < 16; ++r) negm[r] = -mref; \
            fsc = __builtin_amdgcn_exp2f(-dl_); lsum *= fsc; resc = true; } } while (0)
#define EXP4(C0, C1, j) do { _Pragma("unroll") for (int e_ = 4 * (j); e_ < 4 * (j) + 4; ++e_) { if (e_ < 16) C0[e_ & 15] = __builtin_amdgcn_exp2f(C0[e_ & 15]); else C1[e_ & 15] = __builtin_amdgcn_exp2f(C1[e_ & 15]); } \
        if (4 * (j) < 16) PIN(C0); else PIN(C1); } while (0)
#define VOFFS(j) ((((j) & 1) * 4096) + (((j) >> 1) * 1024))
#define PV_PHASE(C0, C1, HAVE_C, HAVE_K, tp_) do { \
        const LAS char* vp_ = lds + VOFF + (((tp_) + vpar) & 1) * 8192 + vlane; \
        s16x4 vl_[8], vh_[8]; \
        vl_[0] = vtr(vp_ + VOFFS(0)); vh_[0] = vtr(vp_ + VOFFS(0) + 512); vl_[1] = vtr(vp_ + VOFFS(1)); vh_[1] = vtr(vp_ + VOFFS(1) + 512); \
        _Pragma("unroll") for (int j = 0; j < 8; ++j) { const int ks = j >> 1, dd = j & 1; \
            if (j + 2 < 8) { vl_[j + 2] = vtr(vp_ + VOFFS(j + 2)); vh_[j + 2] = vtr(vp_ + VOFFS(j + 2) + 512); } \
            if (HAVE_K) kf[j] = *(const LAS bf16x8*)KFADDR(j, sl_nxt); \
            const bf16x8 vf_ = {vl_[j][0], vl_[j][1], vl_[j][2], vl_[j][3], vh_[j][0], vh_[j][1], vh_[j][2], vh_[j][3]}; \
            if (dd == 0) o0 = __builtin_amdgcn_mfma_f32_32x32x16_bf16(vf_, __builtin_bit_cast(bf16x8, pw[ks]), o0, 0, 0, 0); \
            else o1 = __builtin_amdgcn_mfma_f32_32x32x16_bf16(vf_, __builtin_bit_cast(bf16x8, pw[ks]), o1, 0, 0, 0); \
            if (HAVE_C) EXP4(C0, C1, j); \
            SBAR(); } } while (0)
#define STEP(C0, C1, P0, P1, t_) do { \
        if ((t_) + 2 < NT) DMAK((t_) + 2, sl_fre); \
        DMAV(t_, ((t_) + vpar) & 1); \
        float sacc = 0.f; \
        QK_PHASE(C0, C1, P0, P1, true); \
        lsum += sacc; \
        MASKT(C0, C1, t_); \
        DECIDE(C0, C1); \
        SBAR(); \
        PV_PHASE(C0, C1, true, true, (t_) - 1); \
        __syncthreads(); \
        ROT(); \
        if (resc) { o0 *= fsc; o1 *= fsc; } } while (0)
    for (;;) {
        const int NT = d.n_a + d.n_b;
        const int qb0 = __builtin_amdgcn_readfirstlane(d.qpos);
        float mref = 0.f, lsum = 0.f, fsc = 1.f; bool resc = false;
        f32x16 o0 = (f32x16){}, o1 = (f32x16){}, negm = (f32x16){};
        f32x16 cA0 = (f32x16){}, cA1 = (f32x16){}, cB0 = (f32x16){}, cB1 = (f32x16){};
        u32x4 pw[4];
#pragma unroll
        for (int i = 0; i < 4; ++i) pw[i] = (u32x4){0u, 0u, 0u, 0u};
        bf16x8 kf[NHELD];
#pragma unroll
        for (int i = 0; i < NHELD; ++i) kf[i] = *(const LAS bf16x8*)KFADDR(i, sl_cur);
        {
            if (2 < NT) DMAK(2, sl_fre);
            float sacc = 0.f; (void)sacc;
            QK_PHASE(cA0, cA1, cA0, cA1, false);
            MASKT(cA0, cA1, 0);
            DECIDE(cA0, cA1);
#pragma unroll
            for (int j = 0; j < 8; ++j) { kf[j] = *(const LAS bf16x8*)KFADDR(j, sl_nxt); EXP4(cA0, cA1, j); SBAR(); }
            __syncthreads();
            ROT();
        }
        int t = 1;
        for (; t + 1 < NT; t += 2) { STEP(cB0, cB1, cA0, cA1, t); STEP(cA0, cA1, cB0, cB1, t + 1); }
        const bool odd_tail = t < NT;
        if (odd_tail) STEP(cB0, cB1, cA0, cA1, t);
        const int un_next = un + stride; const bool has_next = un_next < nunits;
        Desc dn = d;
        const bf16* ksrc_n = ksrc; const bf16* k1src_n = k1src; const bf16* vsrc_n = vsrc;
        u32x4 gpre[4];
#if !ATT_LOWREG
#pragma unroll
        for (int i2 = 0; i2 < 4; ++i2) gpre[i2] = *(const u32x4*)(d.optr + (size_t)(i2 * 8 + (lane >> 3)) * LDO + (lane & 7) * 8);
        bf16x8 qn[ND0];
#pragma unroll
        for (int d0 = 0; d0 < ND0; ++d0) qn[d0] = qr[d0];
#endif
        if (has_next) {
            mk(un_next, dn);
            ksrc_n = SRC_K(dn); k1src_n = SRC_K1(dn); vsrc_n = SRC_V(dn);
            DMAK_(dn, ksrc_n, k1src_n, 0, sl_cur); DMAK_(dn, ksrc_n, k1src_n, 1, sl_nxt); DMAV_(dn, vsrc_n, 0, (NT + vpar) & 1);
#if !ATT_LOWREG
#pragma unroll
            for (int d0 = 0; d0 < ND0; ++d0) qn[d0] = *(const bf16x8*)(dn.qptr + (size_t)r32 * LDQ + d0 * 16 + hi * 8);
#endif
        }
        if (odd_tail) {
            float sacc = 0.f;
#pragma unroll
            for (int g = 0; g < NG; ++g) FILL_A(cB0, cB1, g);
            lsum += sacc;
            PV_PHASE(cB0, cB1, false, false, NT - 1);
        } else {
            float sacc = 0.f;
#pragma unroll
            for (int g = 0; g < NG; ++g) FILL_A(cA0, cA1, g);
            lsum += sacc;
            PV_PHASE(cA0, cA1, false, false, NT - 1);
        }
        float lt = xhalf_sum(lsum);
        if (d.has_sink) lt += __builtin_amdgcn_exp2f(d.sink2 - mref);
        const float inv = 1.0f / lt;
        {
            LAS char* stg = lds + STG_OFF + wid * (32 * 272);
#pragma unroll
            for (int d0 = 0; d0 < 2; ++d0)
#pragma unroll
                for (int g = 0; g < 4; ++g) { const f32x16& o = d0 ? o1 : o0;
                    const f32x4 v = {o[4 * g] * inv, o[4 * g + 1] * inv, o[4 * g + 2] * inv, o[4 * g + 3] * inv};
                    *(LAS f32x4*)(stg + r32 * 272 + (32 * d0 + 8 * g + 4 * hi) * 4) = v; }
#pragma unroll
            for (int i2 = 0; i2 < 4; ++i2) { const int row = i2 * 8 + (lane >> 3), ch = lane & 7;
                const f32x4 va = *(const LAS f32x4*)(stg + row * 272 + ch * 32), vb = *(const LAS f32x4*)(stg + row * 272 + ch * 32 + 16);
#if ATT_LOWREG
                gpre[i2] = *(const u32x4*)(d.optr + (size_t)row * LDO + ch * 8);
#endif
                const u32x4 gg = gpre[i2];
                u32x4 w;
                w.x = pk2(va[0] * silu_fast(bflo(gg.x)), va[1] * silu_fast(bfhi(gg.x))); w.y = pk2(va[2] * silu_fast(bflo(gg.y)), va[3] * silu_fast(bfhi(gg.y)));
                w.z = pk2(vb[0] * silu_fast(bflo(gg.z)), vb[1] * silu_fast(bfhi(gg.z))); w.w = pk2(vb[2] * silu_fast(bflo(gg.w)), vb[3] * silu_fast(bfhi(gg.w)));
                *(u32x4*)(d.optr + (size_t)row * LDO + ch * 8) = w; }
        }
        __syncthreads();
        if (TS_A >= 0 && MODE == TS_MODE && blockIdx.x == 0 && threadIdx.x == 0) { unsigned long long* tsp = (unsigned long long*)((unsigned char*)arg_ptr(24) + WS_CTL + 100 * 1024); const int k = (un - first) / stride; if (tsp[40 + k] == 0ull) tsp[40 + k] = __builtin_amdgcn_s_memrealtime(); }
        if (!has_next) break;
        vpar = (NT + vpar) & 1;
        d = dn; un = un_next; ksrc = ksrc_n; k1src = k1src_n; vsrc = vsrc_n;
#if ATT_LOWREG
#pragma unroll
        for (int d0 = 0; d0 < ND0; ++d0) qr[d0] = *(const bf16x8*)(d.qptr + (size_t)r32 * LDQ + d0 * 16 + hi * 8);
#else
#pragma unroll
        for (int d0 = 0; d0 < ND0; ++d0) qr[d0] = qn[d0];
#endif
    }
#undef SRC_K
#undef SRC_K1
#undef SRC_V
#undef GLDS16
#undef DMAK_
#undef DMAV_
#undef DMAK
#undef DMAV
#undef ROT
#undef KFADDR
#undef PE
#undef FILL_A
#undef QK_PHASE
#undef MASKT
#undef DECIDE
#undef EXP4
#undef VOFFS
#undef PV_PHASE
#undef STEP
}
#undef SBAR
}

#define XB_TMO      128
#define XB_XCNT(j)  (256  + 64 * (j))
#define XB_XSUB(j)  (1280 + 64 * (j))
#define XB_XGEN(j)  (2304 + 64 * (j))
#define XB_TOP      3328
#define XB_TOPGEN   3392
#define XCD_BAR_WORDS 3456
#define XB_SPIN_CAP (1u << 20)
__device__ __forceinline__ unsigned xb_ld(unsigned* p)              { return __hip_atomic_load(p, __ATOMIC_RELAXED, __HIP_MEMORY_SCOPE_AGENT); }
__device__ __forceinline__ unsigned xb_add(unsigned* p, unsigned v) { return __hip_atomic_fetch_add(p, v, __ATOMIC_RELAXED, __HIP_MEMORY_SCOPE_AGENT); }
__device__ __forceinline__ unsigned xb_xcc_id() { return (unsigned)__builtin_amdgcn_s_getreg((3 << 11) | 20) & 0xFu; }
#define XB_SPIN(cond, bar) do { unsigned _sp = 0; while (cond) { __builtin_amdgcn_s_sleep(1); \
    if ((++_sp & 255u) == 0u) { if (xb_ld(&(bar)[XB_TMO])) break; if (_sp > XB_SPIN_CAP) { atomicAdd(&(bar)[XB_TMO], 1u); break; } } } } while (0)
struct XcdBarrier { unsigned* bar; unsigned x; volatile LAS unsigned* st; };
__device__ __forceinline__ XcdBarrier xcd_barrier_post(unsigned* bar, volatile LAS unsigned* st) {
    XcdBarrier b; b.bar = bar; b.x = xb_xcc_id(); b.st = st;
    if (threadIdx.x == 0) (void)xb_add(&bar[XB_XCNT(b.x)], 1u);
    return b;
}
__device__ __forceinline__ void xcd_barrier_complete(unsigned* bar, unsigned x, unsigned& nloc, unsigned& nx) {
    const unsigned G = gridDim.x * gridDim.y * gridDim.z;
    unsigned sum, cnt, mine, sp = 0u;
    for (;;) {
        sum = 0u; cnt = 0u; mine = 0u;
#pragma unroll
        for (unsigned j = 0; j < 16; ++j) { const unsigned c = xb_ld(&bar[XB_XCNT(j)]); sum += c; cnt += (c > 0u) ? 1u : 0u; mine = (j == x) ? c : mine; }
        if (sum == G) break;
        __builtin_amdgcn_s_sleep(1);
        if ((++sp & 255u) == 0u) { if (xb_ld(&bar[XB_TMO])) break; if (sp > XB_SPIN_CAP) { atomicAdd(&bar[XB_TMO], 1u); break; } }
    }
    nloc = mine > 0u ? mine : 1u; nx = cnt > 0u ? cnt : 1u;
}
__device__ __forceinline__ void xcd_barrier(const XcdBarrier& b0) {
    asm volatile("s_waitcnt vmcnt(0)" ::: "memory");
    __syncthreads();
    if (threadIdx.x == 0) {
        XcdBarrier b = b0; b.x = xb_xcc_id();
        unsigned* bar = b.bar; asm volatile("" : "+s"(bar));
        __builtin_amdgcn_s_waitcnt(0);
        unsigned nloc = b.st[0], nx = b.st[1];
        if (nloc == 0u) { xcd_barrier_complete(bar, b.x, nloc, nx); b.st[0] = nloc; b.st[1] = nx; }
        const unsigned old = xb_add(&bar[XB_XSUB(b.x)], 1u);
        const unsigned gen = old / nloc;
        if (old + 1u == (gen + 1u) * nloc) {
            __builtin_amdgcn_fence(__ATOMIC_RELEASE, "agent");
            asm volatile("s_waitcnt vmcnt(0)" ::: "memory");
            const unsigned og = xb_add(&bar[XB_TOP], 1u);
            const unsigned tg = og / nx;
            if (og + 1u == (tg + 1u) * nx) xb_add(&bar[XB_TOPGEN], 1u);
            else XB_SPIN(xb_ld(&bar[XB_TOPGEN]) == tg, bar);
            __builtin_amdgcn_fence(__ATOMIC_ACQUIRE, "agent");
            xb_add(&bar[XB_XGEN(b.x)], 1u);
            asm volatile("s_waitcnt vmcnt(0)" ::: "memory");
        } else {
            XB_SPIN(xb_ld(&bar[XB_XGEN(b.x)]) == gen, bar);
            __builtin_amdgcn_fence(__ATOMIC_ACQUIRE, "agent");
            asm volatile("s_waitcnt vmcnt(0)" ::: "memory");
        }
    }
    __syncthreads();
}

struct Args { const float* in[23]; float* out; unsigned char* ws; int ph_lo, ph_hi; };
constexpr int NWAVES = 8;
constexpr int N_PHASES = 2 + 5 + 3 + 5 + 3;
constexpr int RING_BYTES = 131072, MISC_OFF = RING_BYTES + 320, LDS_BYTES = 147456;

struct TMap { int kind, row_off, col_off, ldw; const float* nscale; float scale; };
__device__ __forceinline__ void tmap(const TMap& tm, int n, int& drow, float& sc) {
    drow = n + tm.row_off; sc = tm.scale;
    switch (tm.kind) {
        case 1: if (n >= 672) drow += 96; break;
        case 2: { const int e = n % 96; if (e >= 64) { const int d = e - 64; const int p = (d & 7) | ((d & 8) << 1) | ((d & 16) >> 1); drow = n - e + 64 + p; } } break;
        case 3: { const int h = n >> 7, e = n & 127; drow = (e < 64) ? h * 64 + e : 512 + h * 64 + (e - 64); } break;
        case 4: sc = tm.nscale[n]; break;
        case 5: if (n >= 1024) sc = 1.f; break;
        default: break;
    }
}
__device__ __forceinline__ void transpose_item(const float* W, int K, int N, bf16* WT, const TMap& tm, LAS float* scr, int item, int lane) {
    const int nblk = N / 32, kb = item / nblk, nb = item % nblk, k0 = 64 * kb, n0 = 32 * nb;
    f32x4 wv[8];
#pragma unroll
    for (int i = 0; i < 8; ++i) wv[i] = *(const f32x4*)(W + (size_t)(k0 + 8 * i + (lane >> 3)) * N + n0 + 4 * (lane & 7));
#pragma unroll
    for (int i = 0; i < 8; ++i) { LAS float* d = scr + (8 * i + (lane >> 3)) * 33 + 4 * (lane & 7); d[0] = wv[i][0]; d[1] = wv[i][1]; d[2] = wv[i][2]; d[3] = wv[i][3]; }
    LDS_WAIT(); asm volatile("" ::: "memory");
    const int c = lane & 7;
#pragma unroll
    for (int j = 0; j < 4; ++j) { const int n = (lane >> 3) + 8 * j; const LAS float* s = scr + (8 * c) * 33 + n;
        int drow; float sc; tmap(tm, n0 + n, drow, sc);
        u32x4 o; o.x = pk2(s[0 * 33] * sc, s[1 * 33] * sc); o.y = pk2(s[2 * 33] * sc, s[3 * 33] * sc); o.z = pk2(s[4 * 33] * sc, s[5 * 33] * sc); o.w = pk2(s[6 * 33] * sc, s[7 * 33] * sc);
        *(u32x4*)(WT + (size_t)drow * tm.ldw + tm.col_off + k0 + 8 * c) = o; }
    LDS_WAIT(); asm volatile("" ::: "memory");
}

__device__ __forceinline__ f32x4 mod_load(const float* MODPp, const float* ada_b, int l, int midx, int off) {
    f32x4 s = *(const f32x4*)(ada_b + l * 3072 + off);
#pragma unroll
    for (int kq = 0; kq < 4; ++kq) s += *(const f32x4*)(MODPp + ((size_t)((kq * 4 + l) * 9 + midx)) * 3072 + off);
    return s;
}
__device__ __forceinline__ void ada_item(int it, const float* cvec, const float* cctx, const float* ada_w, float* modp, LAS unsigned char* lds, int tid, int lane, int wave) {
    LAS float* red = (LAS float*)lds;
    const int l = it / 48, rem = it % 48, cc = rem >> 2, kq = rem & 3, k0 = kq * 256 + wave * 32;
    float sv[9];
#pragma unroll
    for (int j = 0; j < 9; ++j) { const float c = (j < 8) ? cvec[j * 1024 + k0 + (lane & 31)] : cctx[k0 + (lane & 31)]; sv[j] = c / (1.f + expf(-c)); }
    f32x4 acc[9];
#pragma unroll
    for (int j = 0; j < 9; ++j) acc[j] = (f32x4){0.f, 0.f, 0.f, 0.f};
    const float* wp = ada_w + ((size_t)l * 1024 + k0) * 3072 + cc * 256 + 4 * lane;
    f32x4 wv[32];
#pragma unroll
    for (int kk = 0; kk < 32; ++kk) wv[kk] = *(const f32x4*)(wp + (size_t)kk * 3072);
    asm volatile("" ::: "memory");
#pragma unroll
    for (int kk = 0; kk < 32; ++kk) {
#pragma unroll
        for (int j = 0; j < 9; ++j) { const float sc = __int_as_float(__builtin_amdgcn_readlane(__float_as_int(sv[j]), kk)); acc[j] += wv[kk] * sc; }
    }
#pragma unroll
    for (int j = 0; j < 9; ++j) *(LAS f32x4*)(red + (wave * 9 + j) * 256 + 4 * lane) = acc[j];
    __syncthreads();
    for (int idx = tid; idx < 9 * 256; idx += NWAVES * 64) { const int j = idx >> 8, col = idx & 255; float sm = 0.f;
#pragma unroll
        for (int w = 0; w < 8; ++w) sm += red[(w * 9 + j) * 256 + col];
        modp[((size_t)((kq * 4 + l) * 9 + j)) * 3072 + cc * 256 + col] = sm; }
    __syncthreads();
}
constexpr int CI1 = 1104, CI2 = 144, CI3 = 128, CI4 = 32, CI5 = 512, CI6 = 1280, CI7 = 512, CIMLA = CI1 + CI2 + CI3 + CI4 + CI5, CISWA = CI6 + CI7;
__device__ __forceinline__ void conv_item(int r, int i, unsigned char* ws, LAS float* scr, int lane) {
    unsigned char* wm = ws + (i ? WS_W_MLA1 : WS_W_MLA0); unsigned char* wsw = ws + (i ? WS_W_SWA1 : WS_W_SWA0);
    if (r < CI1) { TMap tm{1, 0, 0, 1024, nullptr, 1.f}; transpose_item(ARG_IN(12) + (size_t)i * 1024 * 2208, 1024, 2208, (bf16*)wm, tm, scr, r, lane); return; } r -= CI1;
    if (r < CI2) { TMap tm{2, 0, 0, 384, nullptr, MLA_SC}; transpose_item(ARG_IN(15) + (size_t)i * 384 * 768, 384, 768, (bf16*)(wm + SZ_WIN_MLA), tm, scr, r, lane); return; } r -= CI2;
    if (r < CI3) { TMap tm{3, 0, 0, 256, nullptr, 1.f}; transpose_item(ARG_IN(16) + (size_t)i * 256 * 1024, 256, 1024, (bf16*)(wm + SZ_WIN_MLA + SZ_WUQ), tm, scr, r, lane); return; } r -= CI3;
    if (r < CI4) { const int g = r >> 3; TMap tm{4, g * 128, g * 128, 512, ARG_IN(18) + i * 512 + g * 128, 1.f};
        transpose_item(ARG_IN(17) + ((size_t)i * 4 + g) * 128 * 128, 128, 128, (bf16*)(wm + SZ_WIN_MLA + SZ_WUQ + SZ_WUKV), tm, scr, r & 7, lane); return; } r -= CI4;
    if (r < CI5) { TMap tm{0, 0, 0, 1024, nullptr, 1.f}; transpose_item(ARG_IN(19) + (size_t)i * 1024 * 1024, 1024, 1024, (bf16*)(wm + SZ_WIN_MLA + SZ_WUQ + SZ_WUKV + SZ_WPOOL), tm, scr, r, lane); return; } r -= CI5;
    if (r < CI6) { TMap tm{5, 0, 0, 1024, nullptr, SWA_SC}; transpose_item(ARG_IN(20) + (size_t)i * 1024 * 2560, 1024, 2560, (bf16*)wsw, tm, scr, r, lane); return; } r -= CI6;
    { TMap tm{0, 0, 0, 1024, nullptr, 1.f}; transpose_item(ARG_IN(22) + (size_t)i * 1024 * 1024, 1024, 1024, (bf16*)(wsw + SZ_WIN_SWA), tm, scr, r, lane); }
}
__device__ __forceinline__ int mod_index(int row) { return row < RP ? 8 : ((row - RP) >> 11); }

__global__ void __launch_bounds__(NWAVES * 64, 2) fwd_kernel(Args args) {
    extern __shared__ __attribute__((aligned(16))) unsigned char lds_raw[];
    LAS unsigned char* lds = (LAS unsigned char*)lds_raw;
    volatile LAS unsigned* MISC = (volatile LAS unsigned*)(lds + MISC_OFF);
    const int G = gridDim.x; const int bx = blockIdx.x; const int vcu = (G % 8 == 0) ? (bx % 8) * (G / 8) + bx / 8 : bx;
    const int NGW = G * NWAVES;
    { const int tid0 = threadIdx.x; for (int u = tid0; u < (LDS_BYTES - RING_BYTES) / 4; u += NWAVES * 64) ((LAS unsigned*)(lds + RING_BYTES))[u] = 0u; }
    __syncthreads();
    XcdBarrier bar; bar.bar = (unsigned*)((unsigned char*)arg_ptr(24) + WS_CTL) + 1024; bar.x = 0; bar.st = nullptr;
    if (!MK_PER_PHASE) bar = xcd_barrier_post(bar.bar, MISC + 8);
    const int lo = MK_PER_PHASE ? args.ph_lo : 0, hi = MK_PER_PHASE ? args.ph_hi : N_PHASES;
    int pid = 0;
    if (TS_A >= 0 && blockIdx.x == 0 && threadIdx.x == 0) ((unsigned long long*)((unsigned char*)arg_ptr(24) + WS_CTL + 100 * 1024))[0] = __builtin_amdgcn_s_memrealtime();
#ifndef PHASE_MASK
#define PHASE_MASK 0xFFFFFFFFu
#endif
#define IN_PH() (lo <= pid && pid < hi)
#ifndef G2M
#define G2M 7
#endif
#define PK(k) ((PHASE_MASK >> (k)) & 1u)
#ifndef PROBE_DUP
#define PROBE_DUP 0u
#endif
#define REPS(k) ((((PROBE_DUP) >> (k)) & 1u) ? 2 : 1)
#ifndef PROBE_BAR2
#define PROBE_BAR2 0
#endif
#define END_PH() do { if (!MK_PER_PHASE && lo <= pid && pid + 1 < hi) { xcd_barrier(bar); if (PROBE_BAR2) xcd_barrier(bar); } ++pid; \
        if (TS_A >= 0 && blockIdx.x == 0 && threadIdx.x == 0) ((unsigned long long*)((unsigned char*)arg_ptr(24) + WS_CTL + 100 * 1024))[pid] = __builtin_amdgcn_s_memrealtime(); } while (0)
#define PH_BEGIN() unsigned char* const ws = (unsigned char*)arg_ptr(24); float* const out = (float*)arg_ptr(23); \
    const int tid = opaque_tid(), lane = tid & 63, wave = __builtin_amdgcn_readfirstlane(tid >> 6), gw = vcu * NWAVES + wave; (void)out; (void)lane; (void)gw; (void)ws
#define MOD ((float*)(ws + WS_MOD))
#define ROPE8 ((float*)(ws + WS_ROPE8))
#define ROPE16 ((float*)(ws + WS_ROPE16))
#define MODP ((float*)(ws + WS_MODP))
#define Hb ((bf16*)(ws + WS_H))
#define GAB ((bf16*)(ws + WS_GAB))
#define CQ ((bf16*)(ws + WS_CQ))
#define CKV ((bf16*)(ws + WS_CKV))
#define KRB ((bf16*)(ws + WS_KRB))
#define KRF ((float*)(ws + WS_KRF))
#define KN ((bf16*)(ws + WS_KN))
#define VP ((bf16*)(ws + WS_KN))
#define VV ((bf16*)(ws + WS_V))
#define PO ((bf16*)(ws + WS_PO))
#define SQ ((bf16*)(ws + WS_CQ))
#define SK ((bf16*)(ws + WS_SK))
#define SV ((bf16*)(ws + WS_SV))

    if (IN_PH() && PK(1)) for (int rep = 0; rep < REPS(1); ++rep) { PH_BEGIN(); (void)rep;
        { const float* cvec = ARG_IN(6); const float* cctx = ARG_IN(7); const float* ada_w = ARG_IN(8);
          for (int it = bx; it < 48; it += G) ada_item(it, cvec, cctx, ada_w, MODP, lds, tid, lane, wave); }
        for (int e = bx * 512 + tid; e < 64 * 8 + 64 * 16; e += G * 512) {
            if (e < 512) { const int pos = e >> 3, i = e & 7; const float inv = powf(10000.f, -(float)i / 8.f), a = (float)pos * inv; ROPE8[2 * e] = cosf(a); ROPE8[2 * e + 1] = sinf(a); }
            else { const int f = e - 512, pos = f >> 4, i = f & 15; const float inv = powf(10000.f, -(float)i / 16.f), a = (float)pos * inv; ROPE16[2 * f] = cosf(a); ROPE16[2 * f + 1] = sinf(a); }
        }
        LAS float* scr = (LAS float*)(lds + wave * 16384);
        for (int it = gw; it < CIMLA; it += NGW) conv_item(it, 0, ws, scr, lane);
        const u32x4 z = {0u, 0u, 0u, 0u};
        for (int e = bx * 512 + tid; e < 2 * 96 * 128; e += G * 512) { const int i = e / (96 * 128), f = e % (96 * 128);
            *(u32x4*)(ws + (i ? WS_W_MLA1 : WS_W_MLA0) + (size_t)672 * 2048 + (size_t)f * 16) = z; }
        for (int e = bx * 512 + tid; e < 2 * 512 * 64; e += G * 512) { const int i = e / (512 * 64), f = e % (512 * 64), n = f >> 6, kc = f & 63;
            if ((n >> 7) != (kc >> 4)) *(u32x4*)(ws + (i ? WS_W_MLA1 : WS_W_MLA0) + SZ_WIN_MLA + SZ_WUQ + SZ_WUKV + (size_t)n * 1024 + (size_t)kc * 16) = z; }
    }
    END_PH();

    if (IN_PH() && PK(2)) for (int rep = 0; rep < REPS(2); ++rep) { PH_BEGIN(); (void)rep;
        const float* npre = ARG_IN(10); const float* xin0 = ARG_IN(0); const float* xin1 = ARG_IN(1); const float* adab = ARG_IN(9);
        {
            const float* npost0 = ARG_IN(11);
            for (int it = bx; it < 9; it += G) { const int l = 0, j = it;
                for (int c = tid * 4; c < 1024; c += NWAVES * 64 * 4) { float* cf = MOD + (size_t)(l * 9 + j) * 3072;
                    *(f32x4*)(cf + c) = mod_load(MODP, adab, l, j, 2048 + c) * *(const f32x4*)(npost0 + l * 1024 + c);
                    *(f32x4*)(cf + 1024 + c) = *(const f32x4*)(npre + l * 1024 + c) * (mod_load(MODP, adab, l, j, 1024 + c) + 1.f);
                    *(f32x4*)(cf + 2048 + c) = mod_load(MODP, adab, l, j, c); } }
        }
        for (int chunk = gw; chunk < R / 12; chunk += NGW) {
            int curm = -1; f32x4 cB[4], cC[4];
#pragma unroll
            for (int j = 0; j < 4; ++j) { cB[j] = (f32x4){0.f, 0.f, 0.f, 0.f}; cC[j] = cB[j]; }
            for (int rr = 0; rr < 12; rr += 2) {
                f32x4 v[2][4];
#pragma unroll
                for (int q = 0; q < 2; ++q) { const int row = chunk * 12 + rr + q; const float* xr = row < RP ? xin0 + (size_t)row * D : xin1 + (size_t)(row - RP) * D;
#pragma unroll
                    for (int j = 0; j < 4; ++j) v[q][j] = *(const f32x4*)(xr + 8 * lane + 512 * (j >> 1) + 4 * (j & 1)); }
#pragma unroll
                for (int q = 0; q < 2; ++q) { const int row = chunk * 12 + rr + q, midx = mod_index(row);
                    if (midx != curm) { curm = midx;
#pragma unroll
                        for (int j = 0; j < 4; ++j) { const int c = 8 * lane + 512 * (j >> 1) + 4 * (j & 1); const f32x4 g = *(const f32x4*)(npre + c), sc = mod_load(MODP, adab, 0, midx, 1024 + c); cB[j] = g * (sc + 1.f); cC[j] = mod_load(MODP, adab, 0, midx, c); } }
                    float ss = 0.f;
#pragma unroll
                    for (int j = 0; j < 4; ++j) ss += v[q][j][0] * v[q][j][0] + v[q][j][1] * v[q][j][1] + v[q][j][2] * v[q][j][2] + v[q][j][3] * v[q][j][3];
                    const float rstd = 1.f / sqrtf(wave_sum(ss) * (1.f / D) + EPS);
#pragma unroll
                    for (int j2 = 0; j2 < 2; ++j2) { const f32x4 ha = v[q][2 * j2] * rstd * cB[2 * j2] + cC[2 * j2], hc = v[q][2 * j2 + 1] * rstd * cB[2 * j2 + 1] + cC[2 * j2 + 1];
                        u32x4 w; w.x = pk2(ha[0], ha[1]); w.y = pk2(ha[2], ha[3]); w.z = pk2(hc[0], hc[1]); w.w = pk2(hc[2], hc[3]); *(u32x4*)(Hb + (size_t)row * D + 8 * lane + 512 * j2) = w; }
                }
            }
        }
    }
    END_PH();

    for (int l = 0; l < NL; ++l) {
        const int i = l >> 1;
        if ((l & 1) == 0) {
#define WM_BASE (ws + (i ? WS_W_MLA1 : WS_W_MLA0))
#define M_WinT ((const bf16*)WM_BASE)
#define M_WuqT ((const bf16*)(WM_BASE + SZ_WIN_MLA))
#define M_WukvT ((const bf16*)(WM_BASE + SZ_WIN_MLA + SZ_WUQ))
#define M_WpT ((const bf16*)(WM_BASE + SZ_WIN_MLA + SZ_WUQ + SZ_WUKV))
#define M_WoT ((const bf16*)(WM_BASE + SZ_WIN_MLA + SZ_WUQ + SZ_WUKV + SZ_WPOOL))
            if (IN_PH() && PK(3)) for (int rep = 0; rep < REPS(3); ++rep) { PH_BEGIN(); (void)rep;
                pg8::Gemm g{Hb, M_WinT, R, 2304, 1024, 1024}; pg8::StaticOrder S; S.init(R, 2304, G, bx);
                pg8::EpiMlaIn E{CQ, CKV, GAB, VP, KRF};
                pg8::gemm_phase<pg8::EpiMlaIn, true>(lds, g, S, E);
                if (l == 0) {
                    const float* cvec = ARG_IN(6); const float* cctx = ARG_IN(7); const float* ada_w = ARG_IN(8);
                    unsigned* qt = (unsigned*)(ws + WS_CTL) + CW_QH + 64; LAS float* scr = (LAS float*)(lds + wave * 16384);
                    for (;;) {
                        __syncthreads();
                        if (tid == 0) MISC[0] = __hip_atomic_fetch_add(qt, 1u, __ATOMIC_RELAXED, __HIP_MEMORY_SCOPE_AGENT);
                        __syncthreads();
                        const int item = (int)MISC[0];
                        if (item >= 144 + 688) break;
                        if (item < 144) ada_item(48 + item, cvec, cctx, ada_w, MODP, lds, tid, lane, wave);
                        else { const int r2 = (item - 144) * 8 + wave;
                            if (r2 < CISWA) conv_item(CIMLA + r2, 0, ws, scr, lane); else conv_item(r2 - CISWA, 1, ws, scr, lane); }
                    }
                }
            }
            END_PH();
            if (IN_PH() && PK(4)) for (int rep = 0; rep < REPS(4); ++rep) { PH_BEGIN(); (void)rep;
                const float* gq = ARG_IN(13) + i * 384; const float* gkv = ARG_IN(14) + i * 256;
                const float* cckv = ARG_IN(2); const float* ckr = ARG_IN(3);
                if (l == 0) {
                    const float* npost0 = ARG_IN(11); const float* npre0 = ARG_IN(10); const float* adab = ARG_IN(9);
                    for (int it = bx; it < 27; it += G) { const int l2 = 1 + it / 9, j = it % 9;
                        for (int c = tid * 4; c < 1024; c += NWAVES * 64 * 4) { float* cf = MOD + (size_t)(l2 * 9 + j) * 3072;
                            *(f32x4*)(cf + c) = mod_load(MODP, adab, l2, j, 2048 + c) * *(const f32x4*)(npost0 + l2 * 1024 + c);
                            *(f32x4*)(cf + 1024 + c) = *(const f32x4*)(npre0 + l2 * 1024 + c) * (mod_load(MODP, adab, l2, j, 1024 + c) + 1.f);
                            *(f32x4*)(cf + 2048 + c) = mod_load(MODP, adab, l2, j, c); } }
                }
                const int half = 1 << (lane >> 4);
                float pm[16];
#pragma unroll
                for (int k = 0; k < 16; ++k) pm[k] = (k - 8 >= -half && k - 8 < half) ? 1.f : 0.f;
                f32x4 gq0 = {0.f, 0.f, 0.f, 0.f}, gq1 = gq0, gk0 = gq0, gk1 = gq0;
                if (lane < 48) { gq0 = *(const f32x4*)(gq + 8 * lane); gq1 = *(const f32x4*)(gq + 8 * lane + 4); }
                if (lane < 32) { gk0 = *(const f32x4*)(gkv + 8 * lane); gk1 = *(const f32x4*)(gkv + 8 * lane + 4); }
                for (int chunk = gw; chunk < R / 12; chunk += NGW) {
                    const int r0 = chunk * 12;
                    const int xl = r0 + 18; const int Bs = xl < RP ? (xl & ~255) : (xl >= R ? R : RP + ((xl - RP) & ~2047)); const bool hasB = Bs > r0 - 8;
                    u32x4 win[27];
#pragma unroll
                    for (int k = 0; k < 27; ++k) { int x = r0 - 8 + k; x = x < 0 ? 0 : (x >= R ? R - 1 : x); win[k] = *(const u32x4*)(VP + (size_t)x * 512 + 8 * lane); }
                    {
#pragma unroll
                        for (int hb = 0; hb < 2; ++hb) {
                            u32x4 wq[6], wk[6]; float kr[6];
#pragma unroll
                            for (int q = 0; q < 6; ++q) { const int row = r0 + 6 * hb + q; const bool prompt = row < RP; const int rk = prompt ? row : RP + ((row - RP) >> 11) * 2304 + ((row - RP) & 2047);
                                wq[q] = (u32x4){0u, 0u, 0u, 0u}; wk[q] = wq[q]; kr[q] = 0.f;
                                if (lane < 48) wq[q] = *(const u32x4*)(CQ + (size_t)row * 384 + 8 * lane);
                                if (lane < 32) { wk[q] = *(const u32x4*)(CKV + (size_t)rk * 256 + 8 * lane); kr[q] = KRF[(size_t)row * 32 + lane]; } }
#pragma unroll
                            for (int q = 0; q < 6; ++q) { const int row = r0 + 6 * hb + q; const bool prompt = row < RP; const int b = prompt ? row >> 8 : (row - RP) >> 11, t = prompt ? row & 255 : (row - RP) & 2047;
                                const int rk = prompt ? row : RP + b * 2304 + t;
                                { const u32x4 w = wq[q]; float v[8] = {bflo(w.x), bfhi(w.x), bflo(w.y), bfhi(w.y), bflo(w.z), bfhi(w.z), bflo(w.w), bfhi(w.w)}; float ss = 0.f;
#pragma unroll
                                  for (int e = 0; e < 8; ++e) ss += v[e] * v[e];
                                  const float rstd = 1.f / sqrtf(wave_sum(ss) * (1.f / 384.f) + EPS);
                                  if (lane < 48) { u32x4 o; o.x = pk2(v[0] * rstd * gq0[0], v[1] * rstd * gq0[1]); o.y = pk2(v[2] * rstd * gq0[2], v[3] * rstd * gq0[3]); o.z = pk2(v[4] * rstd * gq1[0], v[5] * rstd * gq1[1]); o.w = pk2(v[6] * rstd * gq1[2], v[7] * rstd * gq1[3]);
                                      if (!(REPS(4) == 2 && rep == 0)) *(u32x4*)(CQ + (size_t)row * 384 + 8 * lane) = o; } }
                                { const u32x4 w = wk[q]; float v[8] = {bflo(w.x), bfhi(w.x), bflo(w.y), bfhi(w.y), bflo(w.z), bfhi(w.z), bflo(w.w), bfhi(w.w)}; float ss = 0.f;
#pragma unroll
                                  for (int e = 0; e < 8; ++e) ss += v[e] * v[e];
                                  const float rstd = 1.f / sqrtf(wave_sum(ss) * (1.f / 256.f) + EPS);
                                  if (lane < 32) { const f32x4 y0 = {v[0] * rstd * gk0[0], v[1] * rstd * gk0[1], v[2] * rstd * gk0[2], v[3] * rstd * gk0[3]}, y1 = {v[4] * rstd * gk1[0], v[5] * rstd * gk1[1], v[6] * rstd * gk1[2], v[7] * rstd * gk1[3]};
                                      u32x4 o; o.x = pk2(y0[0], y0[1]); o.y = pk2(y0[2], y0[3]); o.z = pk2(y1[0], y1[1]); o.w = pk2(y1[2], y1[3]);
                                      if (!(REPS(4) == 2 && rep == 0)) *(u32x4*)(CKV + (size_t)rk * 256 + 8 * lane) = o;
                                      if (prompt) { float* st = out + OFF_CKV + ((size_t)(b * 2 + i) * 256 + t) * 256 + 8 * lane; *(f32x4*)st = y0; *(f32x4*)(st + 4) = y1; } } }
                                { const float kv = kr[q];
                                  const float pr = __int_as_float(__builtin_amdgcn_update_dpp(0, __float_as_int(kv), 0x128, 0xf, 0xf, true));
                                  if (lane < 32) { if (prompt) out[OFF_KR + ((size_t)(b * 2 + i) * 256 + t) * 32 + lane] = kv;
                                      const int part = lane >> 4, fi = lane & 7; const bool isx2 = (lane & 8) != 0; const float x1 = isx2 ? pr : kv, x2 = isx2 ? kv : pr;
                                      float o1 = x1, o2 = x2;
                                      if (!prompt) { const int pos = part ? (t & 63) : (t >> 6); const float cs = ROPE8[(pos * 8 + fi) * 2], sn = ROPE8[(pos * 8 + fi) * 2 + 1]; o1 = x1 * cs - x2 * sn; o2 = x1 * sn + x2 * cs; }
                                      KRB[(size_t)rk * 32 + (isx2 ? 16 : 0) + part * 8 + fi] = (bf16)f2bf(isx2 ? o2 : o1); } }
                            }
                            asm volatile("" ::: "memory");
                        }
                    }
#pragma unroll
                    for (int ri = 0; ri < 12; ++ri) {
                        const bool sideR = (r0 + ri) >= Bs;
                        float sA[8]; float cntf = 0.f;
#pragma unroll
                        for (int e = 0; e < 8; ++e) sA[e] = 0.f;
#pragma unroll
                        for (int k = 0; k < 16; ++k) { const int x = r0 + ri + k - 8; const bool valid = !hasB || ((x >= Bs) == sideR); const float m = valid ? pm[k] : 0.f; const u32x4 w = win[ri + k]; cntf += m;
                            sA[0] += bflo(w.x) * m; sA[1] += bfhi(w.x) * m; sA[2] += bflo(w.y) * m; sA[3] += bfhi(w.y) * m;
                            sA[4] += bflo(w.z) * m; sA[5] += bfhi(w.z) * m; sA[6] += bflo(w.w) * m; sA[7] += bfhi(w.w) * m; }
                        const float ic = 1.f / cntf; const u32x4 w = win[ri + 8];
                        u32x4 o; o.x = pk2(sA[0] * ic - bflo(w.x), sA[1] * ic - bfhi(w.x)); o.y = pk2(sA[2] * ic - bflo(w.y), sA[3] * ic - bfhi(w.y)); o.z = pk2(sA[4] * ic - bflo(w.z), sA[5] * ic - bfhi(w.z)); o.w = pk2(sA[6] * ic - bflo(w.w), sA[7] * ic - bfhi(w.w));
                        *(u32x4*)(PO + (size_t)(r0 + ri) * 512 + 8 * lane) = o;
                    }
                }
                for (int ci = gw; ci < 2048; ci += NGW) {
                    const int b = ci >> 8, p = ci & 255, rk = RP + b * 2304 + 2048 + p;
                    if (lane < 32) { const float* sp = cckv + ((size_t)(b * 2 + i) * 256 + p) * 256 + 8 * lane; const f32x4 y0 = *(const f32x4*)sp, y1 = *(const f32x4*)(sp + 4);
                        u32x4 o; o.x = pk2(y0[0], y0[1]); o.y = pk2(y0[2], y0[3]); o.z = pk2(y1[0], y1[1]); o.w = pk2(y1[2], y1[3]); *(u32x4*)(CKV + (size_t)rk * 256 + 8 * lane) = o; }
                    if (lane < 16) { const int part = lane >> 3, fi = lane & 7; const float* sp = ckr + ((size_t)(b * 2 + i) * 256 + p) * 32 + part * 16 + fi;
                        KRB[(size_t)rk * 32 + lane] = (bf16)f2bf(sp[0]); KRB[(size_t)rk * 32 + 16 + lane] = (bf16)f2bf(sp[8]); }
                }
            }
            END_PH();
            if (IN_PH() && PK(5)) for (int rep = 0; rep < REPS(5); ++rep) { PH_BEGIN(); (void)rep;
                if (G2M & 1) { pg8::Gemm g{CQ, M_WuqT, R, 768, 384, 384}; pg8::StaticOrder S; S.init(R, 768, G, (bx + 64) % G); pg8::EpiQ E{Hb, ROPE8}; pg8::gemm_phase<pg8::EpiQ, true>(lds, g, S, E); }
                if (G2M & 2) { pg8::Gemm g{CKV, M_WukvT, RK, 1024, 256, 256}; pg8::StaticOrder S; S.init(RK, 1024, G, (bx + 160) % G); pg8::EpiBf16 E{KN, 512, 512, (size_t)(WS_V - WS_KN) / 2, 0}; pg8::gemm_phase<pg8::EpiBf16, true>(lds, g, S, E); }
                if ((G2M & 4) && (REPS(5) == 1 || rep == 1)) { pg8::Gemm g{PO, M_WpT, R, 512, 512, 512}; pg8::StaticOrder S; S.init(R, 512, G, bx); pg8::EpiPool E{GAB + 512}; pg8::gemm_phase<pg8::EpiPool, true>(lds, g, S, E); }
            }
            END_PH();
            if (IN_PH() && PK(6)) { PH_BEGIN();
                struct MlaMk { bf16 *hb, *kn, *vv, *gab, *krb; int wave;
                    __device__ __forceinline__ void operator()(int un, att::Desc& d) const {
                        d.n_b = 0; d.row_b = 0; d.key_b = 0; d.qpos = 0; d.sink2 = 0.f; d.has_sink = 0; d.k1 = krb;
                        int h, qrow, krow;
                        if (un < 512) { const int b = un >> 6, qb = un & 7; h = (un >> 3) & 7; qrow = RP + b * 2048 + qb * 256 + wave * 32; krow = RP + b * 2304; d.n_a = 36; }
                        else { const int v = un - 512, b = v >> 3; h = v & 7; qrow = b * 256 + wave * 32; krow = b * 256; d.n_a = 4; }
                        d.row_a = krow; d.qptr = hb + (size_t)qrow * 768 + h * 96; d.k0 = kn + h * 64; d.v = vv + h * 64; d.optr = gab + (size_t)qrow * 1024 + h * 64; } };
                const MlaMk mk{Hb, KN, VV, GAB, KRB, wave};
                att::attn_phase<0, MlaMk>((LAS char*)lds, mk, vcu, G, 768);
            }
            END_PH();
        } else {
#define WS_BASE (ws + (i ? WS_W_SWA1 : WS_W_SWA0))
#define S_WinT ((const bf16*)WS_BASE)
#define S_WoT ((const bf16*)(WS_BASE + SZ_WIN_SWA))
            if (IN_PH() && PK(8)) for (int rep = 0; rep < REPS(8); ++rep) { PH_BEGIN(); (void)rep;
                const float* ck = ARG_IN(4); const float* cv = ARG_IN(5);
                for (int e = bx * 512 + tid; e < 2 * 2048 * 32; e += G * 512) {
                    const int which = e / (2048 * 32), f = e % (2048 * 32), rowi = f >> 5, ch = f & 31, b = rowi >> 8, p = rowi & 255;
                    const float* s = (which ? cv : ck) + ((size_t)(b * 2 + i) * 256 + p) * 256 + 8 * ch; const f32x4 y0 = *(const f32x4*)s, y1 = *(const f32x4*)(s + 4);
                    u32x4 o; o.x = pk2(y0[0], y0[1]); o.y = pk2(y0[2], y0[3]); o.z = pk2(y1[0], y1[1]); o.w = pk2(y1[2], y1[3]);
                    *(u32x4*)((which ? SV : SK) + (size_t)(RP + b * 2304 + 2048 + p) * 256 + 8 * ch) = o;
                }
                pg8::Gemm g{Hb, S_WinT, R, 2560, 1024, 1024}; pg8::StaticOrder S; S.init(R, 2560, G, bx);
                pg8::EpiSwaIn E{SQ, SK, SV, GAB, out + OFF_K + (size_t)i * 65536, out + OFF_V + (size_t)i * 65536, ROPE16};
                pg8::gemm_phase<pg8::EpiSwaIn, true>(lds, g, S, E);
            }
            END_PH();
            if (IN_PH() && PK(9)) { PH_BEGIN();
                struct SwaMk { bf16 *sq, *sk, *sv, *gab; const float* sink; int wave, lane;
                    __device__ __forceinline__ void operator()(int un, att::Desc& d) const {
                        d.k1 = nullptr; d.has_sink = 1; d.n_a = 4;
                        int kvh, qrow, q0;
                        if (un < 1024) { const int b = un >> 7, blk = un & 31; kvh = (un >> 5) & 3; q0 = blk * 64; const int kb = RP + b * 2304;
                            qrow = RP + b * 2048 + q0 + (wave & 1) * 32; d.row_a = kb + 2048;
                            const int kfirst = q0 - 128 > 0 ? q0 - 128 : 0, klast = q0 + 128 < 2048 - 64 ? q0 + 128 : 2048 - 64;
                            d.key_b = kfirst; d.row_b = kb + kfirst; d.n_b = (klast - kfirst) / 64 + 1; }
                        else { const int v = un - 1024, b = v >> 4, blk = v & 3; kvh = (v >> 2) & 3; q0 = blk * 64; qrow = b * 256 + q0 + (wave & 1) * 32; d.row_a = b * 256; d.n_b = 0; d.row_b = 0; d.key_b = 0; }
                        const int head = kvh * 4 + (wave >> 1);
                        d.qpos = q0 + (wave & 1) * 32 + (lane & 31); d.sink2 = sink[head] * LOG2E;
                        d.qptr = sq + (size_t)qrow * 1024 + head * 64; d.k0 = sk + kvh * 64; d.v = sv + kvh * 64; d.optr = gab + (size_t)qrow * 1024 + head * 64; } };
                const SwaMk mk{SQ, SK, SV, GAB, ARG_IN(21) + i * 16, wave, lane};
                att::attn_phase<1, SwaMk>((LAS char*)lds, mk, vcu, G, 1536);
            }
            END_PH();
        }
        if (IN_PH() && PK(11)) { PH_BEGIN();
            unsigned* ctlw = (unsigned*)(ws + WS_CTL); unsigned* cnt = ctlw + CW_CNT + l * 2048; unsigned* qh = ctlw + CW_QH + l * 16; unsigned* tmo = ctlw + CW_TMO;
            {
                const bf16* WoT = (l & 1) ? (const bf16*)(ws + (i ? WS_W_SWA1 : WS_W_SWA0) + SZ_WIN_SWA) : (const bf16*)(ws + (i ? WS_W_MLA1 : WS_W_MLA0) + SZ_WIN_MLA + SZ_WUQ + SZ_WUKV + SZ_WPOOL);
                pg8::Gemm g{GAB, WoT, R, 1024, 1024, 1024}; pg8::PanelOrder S{G, vcu, 384}; pg8::EpiOutPub E{Hb, cnt};
                pg8::gemm_phase<pg8::EpiOutPub, true, pg8::PanelOrder>(lds, g, S, E);
            }
            if (TS_A >= 0 && l == 1 && threadIdx.x == 0 && blockIdx.x == 4) ((unsigned long long*)((unsigned char*)arg_ptr(24) + WS_CTL + 100 * 1024))[20] = __builtin_amdgcn_s_memrealtime();
            const float* xin0 = ARG_IN(0); const float* xin1 = ARG_IN(1); const bool has_next = l + 1 < NL;
            const int panel = vcu >= 128 ? (vcu - 128) >> 1 : 64 + (vcu >> 2);
            const int rbase = vcu >= 128 ? panel * 256 + ((vcu - 128) & 1) * 128 : panel * 256 + (vcu & 3) * 64;
            const int nrw = vcu >= 128 ? 16 : 8;
#define WAIT_PANEL() do { if (wave == 0) { unsigned sp = 0; \
                while (__hip_atomic_load(cnt + 16 * panel, __ATOMIC_RELAXED, __HIP_MEMORY_SCOPE_AGENT) < 32u) { __builtin_amdgcn_s_sleep(2); \
                    if ((++sp & 1023u) == 0u) { if (__hip_atomic_load(tmo, __ATOMIC_RELAXED, __HIP_MEMORY_SCOPE_AGENT) || sp > (1u << 22)) { __hip_atomic_store(tmo, 1u, __ATOMIC_RELAXED, __HIP_MEMORY_SCOPE_AGENT); break; } } } \
                __builtin_amdgcn_fence(__ATOMIC_ACQUIRE, "agent"); asm volatile("s_waitcnt vmcnt(0)" ::: "memory"); } \
            __syncthreads(); } while (0)
            {
                const int row0 = rbase + wave * nrw, midx = mod_index(row0); const int ln = has_next ? l + 1 : l;
                const float* cf = MOD + (size_t)(l * 9 + midx) * 3072; const float* cfn = MOD + (size_t)(ln * 9 + midx) * 3072;
                f32x4 cA[4], cB[4], cC[4];
#pragma unroll
                for (int k = 0; k < 4; ++k) { const int c = 8 * lane + 512 * (k >> 1) + 4 * (k & 1); cA[k] = *(const f32x4*)(cf + c); cB[k] = *(const f32x4*)(cfn + 1024 + c); cC[k] = *(const f32x4*)(cfn + 2048 + c); }
#define FINAL_ROW(row, xv, ov) do { float ss = 0.f; \
                    _Pragma("unroll") for (int k = 0; k < 4; ++k) ss += ov[k][0] * ov[k][0] + ov[k][1] * ov[k][1] + ov[k][2] * ov[k][2] + ov[k][3] * ov[k][3]; \
                    const float rstd = 1.f / sqrtf(wave_sum(ss) * (1.f / D) + EPS); float s2 = 0.f; \
                    _Pragma("unroll") for (int k = 0; k < 4; ++k) { xv[k] = xv[k] + ov[k] * rstd * cA[k]; s2 += xv[k][0] * xv[k][0] + xv[k][1] * xv[k][1] + xv[k][2] * xv[k][2] + xv[k][3] * xv[k][3]; } \
                    if (has_next) { const float r2 = 1.f / sqrtf(wave_sum(s2) * (1.f / D) + EPS); \
                        _Pragma("unroll") for (int j2 = 0; j2 < 2; ++j2) { const f32x4 xa = xv[2 * j2], xc = xv[2 * j2 + 1]; \
                            u32x4 wx; wx.x = pk2(xa[0], xa[1]); wx.y = pk2(xa[2], xa[3]); wx.z = pk2(xc[0], xc[1]); wx.w = pk2(xc[2], xc[3]); \
                            *(u32x4*)((bf16*)out + (size_t)(row) * 2048 + 8 * lane + 512 * j2) = wx; \
                            const f32x4 ha = xa * r2 * cB[2 * j2] + cC[2 * j2], hc = xc * r2 * cB[2 * j2 + 1] + cC[2 * j2 + 1]; \
                            u32x4 wh; wh.x = pk2(ha[0], ha[1]); wh.y = pk2(ha[2], ha[3]); wh.z = pk2(hc[0], hc[1]); wh.w = pk2(hc[2], hc[3]); \
                            *(u32x4*)(Hb + (size_t)(row) * D + 8 * lane + 512 * j2) = wh; } \
                    } else { _Pragma("unroll") for (int k = 0; k < 4; ++k) *(f32x4*)(out + (size_t)(row) * D + 8 * lane + 512 * (k >> 1) + 4 * (k & 1)) = xv[k]; } } while (0)
#define UNPK(W_, LO_, HI_) do { const u32x4 t_ = (W_); LO_ = (f32x4){bflo(t_.x), bfhi(t_.x), bflo(t_.y), bfhi(t_.y)}; HI_ = (f32x4){bflo(t_.z), bfhi(t_.z), bflo(t_.w), bfhi(t_.w)}; } while (0)
                if (l == 0) {
                    WAIT_PANEL();
                    for (int rr = 0; rr < nrw; rr += 4) {
                        f32x4 xq[4][4]; u32x4 oq[4][2];
#pragma unroll
                        for (int q = 0; q < 4; ++q) { const int row = row0 + rr + q; const float* xr = row < RP ? xin0 + (size_t)row * D : xin1 + (size_t)(row - RP) * D;
#pragma unroll
                            for (int k = 0; k < 4; ++k) xq[q][k] = *(const f32x4*)(xr + 8 * lane + 512 * (k >> 1) + 4 * (k & 1));
#pragma unroll
                            for (int j2 = 0; j2 < 2; ++j2) oq[q][j2] = *(const u32x4*)(Hb + (size_t)row * D + 8 * lane + 512 * j2); }
#pragma unroll
                        for (int q = 0; q < 4; ++q) { f32x4 ov[4]; UNPK(oq[q][0], ov[0], ov[1]); UNPK(oq[q][1], ov[2], ov[3]); FINAL_ROW(row0 + rr + q, xq[q], ov); }
                    }
                } else {
                    u32x4 xw[8][2], ow[8][2];
#pragma unroll
                    for (int q = 0; q < 8; ++q)
#pragma unroll
                        for (int j2 = 0; j2 < 2; ++j2) xw[q][j2] = *(const u32x4*)((const bf16*)out + (size_t)(row0 + q) * 2048 + 8 * lane + 512 * j2);
                    WAIT_PANEL();
                    for (int rr = 0; rr < nrw; rr += 8) {
                        if (rr > 0) {
#pragma unroll
                            for (int q = 0; q < 8; ++q)
#pragma unroll
                                for (int j2 = 0; j2 < 2; ++j2) xw[q][j2] = *(const u32x4*)((const bf16*)out + (size_t)(row0 + rr + q) * 2048 + 8 * lane + 512 * j2);
                        }
#pragma unroll
                        for (int q = 0; q < 8; ++q)
#pragma unroll
                            for (int j2 = 0; j2 < 2; ++j2) ow[q][j2] = *(const u32x4*)(Hb + (size_t)(row0 + rr + q) * D + 8 * lane + 512 * j2);
#pragma unroll
                        for (int q = 0; q < 8; ++q) { f32x4 xv[4], ov[4]; UNPK(xw[q][0], xv[0], xv[1]); UNPK(xw[q][1], xv[2], xv[3]); UNPK(ow[q][0], ov[0], ov[1]); UNPK(ow[q][1], ov[2], ov[3]); FINAL_ROW(row0 + rr + q, xv, ov); }
                    }
                }
#undef FINAL_ROW
#undef UNPK
#undef WAIT_PANEL
            }
            if (TS_A >= 0 && l == 1 && threadIdx.x == 0 && blockIdx.x == 4) { asm volatile("s_waitcnt vmcnt(0)" ::: "memory"); ((unsigned long long*)((unsigned char*)arg_ptr(24) + WS_CTL + 100 * 1024))[21] = __builtin_amdgcn_s_memrealtime(); }
        }
        END_PH();
    }
    if (TS_A >= 0 && blockIdx.x == 0 && threadIdx.x == 0) { const unsigned long long* ts = (const unsigned long long*)((unsigned char*)arg_ptr(24) + WS_CTL + 100 * 1024);
        const float us = (float)(ts[TS_B] - ts[TS_A]) * 0.01f; ((float*)arg_ptr(23))[OFF_KR] += 0.5f + us / TS_SCALE; }
#undef IN_PH
#undef END_PH
}


extern "C" void kernel_launch(void* const* d_in, const int* in_sizes, int n_in, void* d_out, int out_size, void* d_ws, size_t ws_size, hipStream_t stream) {
    static int grid = 0;
    if (grid == 0) {
        if (n_in != 23 || out_size != OUT_TOTAL || ws_size < WS_END) { fprintf(stderr, "kernel_launch: unexpected shapes (n_in %d out %d ws %zu)\n", n_in, out_size, ws_size); grid = -1; return; }
        int dev = 0, cus = 0;
        if (hipGetDevice(&dev) != hipSuccess || hipDeviceGetAttribute(&cus, hipDeviceAttributeMultiprocessorCount, dev) != hipSuccess) { grid = -1; return; }
        if (hipFuncSetAttribute((const void*)fwd_kernel, hipFuncAttributeMaxDynamicSharedMemorySize, LDS_BYTES) != hipSuccess) { fprintf(stderr, "kernel_launch: hipFuncSetAttribute failed\n"); grid = -1; return; }
        int per_cu = 0;
        if (hipOccupancyMaxActiveBlocksPerMultiprocessor(&per_cu, (const void*)fwd_kernel, NWAVES * 64, LDS_BYTES) != hipSuccess || per_cu < 1) { fprintf(stderr, "kernel_launch: occupancy query says %d\n", per_cu); }
        (void)hipGetLastError();
        grid = cus;
    }
    if (grid < 0) return;
    (void)hipMemsetAsync((char*)d_ws + WS_CTL, 0, CTL_ZERO_BYTES, stream);
    Args a{};
    for (int i = 0; i < 23; ++i) a.in[i] = (const float*)d_in[i];
    a.out = (float*)d_out; a.ws = (unsigned char*)d_ws;
#if MK_PER_PHASE
    for (int p = 0; p < N_PHASES; ++p) { a.ph_lo = p; a.ph_hi = p + 1; hipLaunchKernelGGL(fwd_kernel, dim3(grid), dim3(NWAVES * 64), LDS_BYTES, stream, a); }
#else
    a.ph_lo = 0; a.ph_hi = N_PHASES;
    hipLaunchKernelGGL(fwd_kernel, dim3(grid), dim3(NWAVES * 64), LDS_BYTES, stream, a);
#endif
}
```

```cpp
#include <hip/hip_runtime.h>
#include <cstdio>
#include <cstdint>

#define PROBE_DUP 0x0u
#define PROBE_BAR2 0
#ifndef TS_A
#define TS_A (-1)
#define TS_B (-1)
#endif
#define TS_SCALE 100.0f
#ifndef TS_MODE
#define TS_MODE 1
#endif
#ifndef TS_BLK
#define TS_BLK 0
#endif
#ifndef ATT_LOWREG
#define ATT_LOWREG (TS_A >= 0)
#endif
#ifndef MK_PER_PHASE
#define MK_PER_PHASE 0
#endif

#define GAS __attribute__((address_space(1)))
#define LAS __attribute__((address_space(3)))
typedef unsigned short bf16;
typedef short bf16x8 __attribute__((ext_vector_type(8)));
typedef short s16x4 __attribute__((ext_vector_type(4)));
typedef float f32x4 __attribute__((ext_vector_type(4)));
typedef float f32x2 __attribute__((ext_vector_type(2)));
typedef float f32x16 __attribute__((ext_vector_type(16)));
typedef unsigned u32x4 __attribute__((ext_vector_type(4)));
typedef unsigned u32x2 __attribute__((ext_vector_type(2)));
typedef __bf16 bf16x2_t __attribute__((ext_vector_type(2)));

constexpr int D = 1024, RP = 8192, RS = 16384, R = RP + RS;
constexpr int RK = RP + 8 * 2304;
constexpr int NL = 4;
constexpr float EPS = 1e-6f, LOG2E = 1.4426950408889634f;
constexpr float MLA_SC = 0.10206207261596577f * LOG2E;
constexpr float SWA_SC = 0.125f * LOG2E;
constexpr int OFF_CKV = 25165824, OFF_KR = 29360128, OFF_K = 29884416, OFF_V = 34078720, OUT_TOTAL = 38273024;

constexpr size_t MiB = 1u << 20;
constexpr size_t WS_CTL = 0, CTL_ZERO_BYTES = 128 * 1024;
constexpr int CW_CNT = 8192, CW_QH = 16384, CW_TMO = 17408;
constexpr size_t WS_MOD = 1 * MiB;
constexpr size_t WS_ROPE8 = 1 * MiB + 512 * 1024;
constexpr size_t WS_ROPE16 = WS_ROPE8 + 4096;
constexpr size_t SZ_WIN_MLA = 2304ull * 1024 * 2, SZ_WUQ = 768ull * 384 * 2, SZ_WUKV = 1024ull * 256 * 2, SZ_WPOOL = 512ull * 512 * 2,
                 SZ_WOUT = 1024ull * 1024 * 2, SZ_WIN_SWA = 2560ull * 1024 * 2;
constexpr size_t WS_W = 2 * MiB;
constexpr size_t SZ_W_MLA = SZ_WIN_MLA + SZ_WUQ + SZ_WUKV + SZ_WPOOL + SZ_WOUT, SZ_W_SWA = SZ_WIN_SWA + SZ_WOUT;
constexpr size_t WS_W_MLA0 = WS_W, WS_W_MLA1 = WS_W + SZ_W_MLA, WS_W_SWA0 = WS_W + 2 * SZ_W_MLA, WS_W_SWA1 = WS_W_SWA0 + SZ_W_SWA;
static_assert(WS_W_SWA1 + SZ_W_SWA <= 34 * MiB, "weights");
constexpr size_t WS_H = 34 * MiB;
constexpr size_t WS_GAB = 82 * MiB;
constexpr size_t WS_CQ = 130 * MiB;
constexpr size_t WS_CKV = 148 * MiB;
constexpr size_t WS_KRB = 161 * MiB;
constexpr size_t WS_KRF = 163 * MiB;
constexpr size_t WS_KN = 166 * MiB;
constexpr size_t WS_V = 192 * MiB;
constexpr size_t WS_PO = 218 * MiB;
constexpr size_t WS_SK = 178 * MiB;
constexpr size_t WS_SV = 191 * MiB;
constexpr size_t WS_MODP = 242 * MiB;
constexpr size_t WS_END = 244 * MiB;

__device__ __forceinline__ unsigned f2bf(float f) { unsigned u = __builtin_bit_cast(unsigned, f); return (u + 0x7fffu + ((u >> 16) & 1u)) >> 16; }
__device__ __forceinline__ unsigned pk2(float lo, float hi) { f32x2 v = {lo, hi}; bf16x2_t b = __builtin_convertvector(v, bf16x2_t); return __builtin_bit_cast(unsigned, b); }
__device__ __forceinline__ float bflo(unsigned w) { return __uint_as_float(w << 16); }
__device__ __forceinline__ float bfhi(unsigned w) { return __uint_as_float(w & 0xffff0000u); }
__device__ __forceinline__ float silu_fast(float x) { return x * __builtin_amdgcn_rcpf(1.f + __builtin_amdgcn_exp2f(-x * LOG2E)); }
#define DPP_ADD(v, ctrl) ((v) + __int_as_float(__builtin_amdgcn_update_dpp(0, __float_as_int(v), (ctrl), 0xf, 0xf, true)))
__device__ __forceinline__ float wave_sum(float v) {
    v = DPP_ADD(v, 0xB1); v = DPP_ADD(v, 0x4E); v = DPP_ADD(v, 0x124); v = DPP_ADD(v, 0x128);
    { auto rr = __builtin_amdgcn_permlane16_swap(__float_as_uint(v), __float_as_uint(v), false, false); v = __uint_as_float(rr[0]) + __uint_as_float(rr[1]); }
    { auto rr = __builtin_amdgcn_permlane32_swap(__float_as_uint(v), __float_as_uint(v), false, false); v = __uint_as_float(rr[0]) + __uint_as_float(rr[1]); }
    return v;
}
#define LDS_WAIT() asm volatile("s_waitcnt lgkmcnt(0)" ::: "memory")
__device__ __forceinline__ int opaque_tid() { int t = threadIdx.x; asm volatile("" : "+v"(t)); return t; }

namespace pg8 {
typedef unsigned short bf16_t;
constexpr int BM = 256, BK = 64, HALF = 128, HTB = HALF * BK * 2, STAGE_BYTES = 8 * HTB, NXCD = 8, WGM = 8;
__host__ __device__ __forceinline__ int lds_byte(int r, int c) { const int st = (r >> 4) * 2 + (c >> 5), rr = r & 15, cc = c & 31, ob = rr * 64 + cc * 2; return st * 1024 + (ob ^ (((ob >> 9) & 1) << 5)); }
__host__ __device__ __forceinline__ void stage_rc(int b, int& Rr, int& C) { const int st = b / 1024, sb = b % 1024, swz = sb ^ (((sb >> 9) & 1) << 5); Rr = (st >> 1) * 16 + swz / 64; C = (st & 1) * 32 + (swz % 64) / 2; }
__host__ __device__ __forceinline__ int perm32(int rho) { const int n = rho >> 4, i = rho & 15; return 8 * (i >> 2) + 4 * n + (i & 3); }
struct Unit { int pm, pn; };
struct Gemm { const bf16_t* A; const bf16_t* Bt; int M, N, K, lda; };
struct StaticOrder {
    int nM, nN, nwg, G, c;
    __device__ void init(int M, int N, int G_, int c_) { nM = M / BM; nN = N / BM; nwg = nM * nN; G = G_; c = c_; }
    __device__ bool next(int i, Unit& u) const {
        const long L = (long)i * G + c; if (L >= nwg) return false;
        int wgid = (int)L; { const int q = nwg / NXCD, r = nwg % NXCD, xcd = wgid % NXCD, off = wgid / NXCD; wgid = (xcd < r ? xcd * (q + 1) : r * (q + 1) + (xcd - r) * q) + off; }
        const int nig = WGM * nN, gid = wgid / nig, fm = gid * WGM, gsz = (nM - fm) < WGM ? (nM - fm) : WGM;
        u.pm = fm + ((wgid % nig) % gsz); u.pn = (wgid % nig) / gsz; return true;
    }
};
struct PanelOrder {
    int G, v, nunits;
    __device__ bool next(int i, Unit& u) const { const int L = i * G + v; if (L >= nunits) return false; u.pm = L >> 2; u.pn = L & 3; return true; }
};
template <class Epi, bool ALIGN_EPI, class Sched = StaticOrder>
__device__ __forceinline__ void gemm_phase(LAS unsigned char* lds, const Gemm g, const Sched& S, const Epi& E) {
    const int tid = opaque_tid(), wid = __builtin_amdgcn_readfirstlane(tid >> 6), lane = tid & 63, wr = wid >> 2, wc = wid & 3, fr = lane & 15, fq = lane >> 4;
    const int K = g.K, nt = K / BK, lda = g.lda;
    unsigned voffA[2], voffB[2];
#pragma unroll
    for (int i = 0; i < 2; ++i) { int Rr, C; stage_rc(tid * 16 + i * 8192, Rr, C); const int Rb = Epi::PERM ? ((Rr & ~31) + perm32(Rr & 31)) : Rr;
        voffA[i] = (unsigned)(Rr * lda + C) * 2u; voffB[i] = (unsigned)(Rb * K + C) * 2u; }
    const size_t kstep = (size_t)(BK * 2);
    const size_t hA = (size_t)HALF * lda * 2, hB = (size_t)HALF * K * 2, tA = 2 * hA, tB = 2 * hB;
    const unsigned ldsw = (unsigned)wid * 1024u;
    const int aoff = lds_byte(wr * 64 + fr, fq * 8), boff = lds_byte(wc * 32 + fr, fq * 8);
#define PG8_SA(b, h) (((b) * 2 + (h)) * HTB)
#define PG8_SB(b, h) ((4 + (b) * 2 + (h)) * HTB)
#define PG8_STAGE(bufoff, gbase, voff) do { _Pragma("unroll") for (int _i = 0; _i < 2; ++_i) \
        __builtin_amdgcn_global_load_lds((const unsigned*)((const char*)(gbase) + (voff)[_i]), (LAS unsigned*)(lds + (bufoff) + ldsw + _i * 8192), 16, 0, 0); } while (0)
#define PG8_LDA(dst, b, h) do { _Pragma("unroll") for (int m = 0; m < 4; ++m) _Pragma("unroll") for (int k = 0; k < 2; ++k) dst[m][k] = *(const LAS bf16x8*)(lds + PG8_SA(b, h) + aoff + m * 2048 + k * 1024); } while (0)
#define PG8_LDB(dst, b, h) do { _Pragma("unroll") for (int n = 0; n < 2; ++n) _Pragma("unroll") for (int k = 0; k < 2; ++k) dst[n][k] = *(const LAS bf16x8*)(lds + PG8_SB(b, h) + boff + n * 2048 + k * 1024); } while (0)
#define PG8_MMA(ai, bj, At, Bt) do { __builtin_amdgcn_s_setprio(1); _Pragma("unroll") for (int m = 0; m < 4; ++m) _Pragma("unroll") for (int n = 0; n < 2; ++n) _Pragma("unroll") for (int k = 0; k < 2; ++k) \
        acc[ai][bj][m][n] = __builtin_amdgcn_mfma_f32_16x16x32_bf16(Bt[n][k], At[m][k], acc[ai][bj][m][n], 0, 0, 0); __builtin_amdgcn_s_setprio(0); } while (0)
#define PG8_WAIT_V(n) asm volatile("s_waitcnt vmcnt(" #n ")" ::: "memory")
#define PG8_WAIT_L(n) asm volatile("s_waitcnt lgkmcnt(" #n ")" ::: "memory")
#define PG8_BAR __builtin_amdgcn_s_barrier()
#define PG8_SCHED __builtin_amdgcn_sched_barrier(0)
    Unit cur, nxt; int ui = 0;
    if (!S.next(0, cur)) return;
    f32x4 acc[2][2][4][2];
#pragma unroll
    for (int a = 0; a < 2; ++a)
#pragma unroll
        for (int b = 0; b < 2; ++b)
#pragma unroll
            for (int m = 0; m < 4; ++m)
#pragma unroll
                for (int n = 0; n < 2; ++n) acc[a][b][m][n] = (f32x4){0.f, 0.f, 0.f, 0.f};
    const char* cA = (const char*)g.A + (size_t)cur.pm * tA; const char* cB = (const char*)g.Bt + (size_t)cur.pn * tB;
    PG8_STAGE(PG8_SB(0, 0), cB, voffB); PG8_STAGE(PG8_SB(0, 1), cB + hB, voffB); PG8_STAGE(PG8_SA(0, 0), cA, voffA); PG8_STAGE(PG8_SA(0, 1), cA + hA, voffA);
    if (wr == 1) PG8_BAR;
    PG8_WAIT_V(2); PG8_BAR;
    PG8_STAGE(PG8_SB(1, 0), cB + kstep, voffB); PG8_STAGE(PG8_SA(1, 0), cA + kstep, voffA); PG8_STAGE(PG8_SB(1, 1), cB + hB + kstep, voffB);
    PG8_WAIT_V(6); PG8_BAR;
    for (;;) {
        const bool has_next = S.next(ui + 1, nxt);
        const char* nA = has_next ? (const char*)g.A + (size_t)nxt.pm * tA : cA; const char* nB = has_next ? (const char*)g.Bt + (size_t)nxt.pn * tB : cB;
#pragma nounroll
        for (int t = 0; t < nt; t += 2) {
            const bool last = (t == nt - 2);
            bf16x8 At[4][2], B0[2][2], B1[2][2];
            const char* a1 = cA + (size_t)(t + 1) * kstep;
            const char* a2 = last ? nA : cA + (size_t)(t + 2) * kstep; const char* b2 = last ? nB : cB + (size_t)(t + 2) * kstep;
            const char* a3 = a2 + kstep; const char* b3 = b2 + kstep;
            PG8_LDB(B0, 0, 0); PG8_LDB(B1, 0, 1); PG8_SCHED; PG8_LDA(At, 0, 0); PG8_STAGE(PG8_SA(1, 1), a1 + hA, voffA);
            PG8_WAIT_V(8); PG8_WAIT_L(0); PG8_BAR; PG8_MMA(0, 0, At, B0); PG8_MMA(0, 1, At, B1); PG8_BAR; PG8_SCHED;
            PG8_LDA(At, 0, 1); PG8_STAGE(PG8_SB(0, 0), b2, voffB); PG8_STAGE(PG8_SB(0, 1), b2 + hB, voffB); PG8_STAGE(PG8_SA(0, 0), a2, voffA);
            PG8_WAIT_V(8); PG8_WAIT_L(0); PG8_BAR; PG8_MMA(1, 0, At, B0); PG8_MMA(1, 1, At, B1); PG8_BAR; PG8_SCHED;
            PG8_LDB(B0, 1, 0); PG8_LDB(B1, 1, 1); PG8_SCHED; PG8_LDA(At, 1, 0); PG8_STAGE(PG8_SA(0, 1), a2 + hA, voffA);
            PG8_WAIT_V(8); PG8_WAIT_L(0); PG8_BAR; PG8_MMA(0, 0, At, B0); PG8_MMA(0, 1, At, B1); PG8_BAR; PG8_SCHED;
            PG8_LDA(At, 1, 1); PG8_STAGE(PG8_SB(1, 0), b3, voffB); PG8_STAGE(PG8_SB(1, 1), b3 + hB, voffB); PG8_STAGE(PG8_SA(1, 0), a3, voffA);
            PG8_WAIT_V(8); PG8_WAIT_L(0); PG8_BAR; PG8_MMA(1, 0, At, B0); PG8_MMA(1, 1, At, B1); PG8_BAR; PG8_SCHED;
        }
        if constexpr (ALIGN_EPI) { if (wr == 0) PG8_BAR; }
        E(acc, cur, wr, wc, fr, fq);
        if (!has_next) break;
#pragma unroll
        for (int a = 0; a < 2; ++a)
#pragma unroll
            for (int b = 0; b < 2; ++b)
#pragma unroll
                for (int m = 0; m < 4; ++m)
#pragma unroll
                    for (int n = 0; n < 2; ++n) acc[a][b][m][n] = (f32x4){0.f, 0.f, 0.f, 0.f};
        cur = nxt; cA = nA; cB = nB; ++ui;
        if constexpr (ALIGN_EPI) { if (wr == 1) PG8_BAR; }
    }
    PG8_WAIT_V(0);
    if constexpr (!ALIGN_EPI) { if (wr == 0) PG8_BAR; }
    PG8_BAR;
#undef PG8_SA
#undef PG8_SB
#undef PG8_STAGE
#undef PG8_LDA
#undef PG8_LDB
#undef PG8_MMA
#undef PG8_WAIT_V
#undef PG8_WAIT_L
#undef PG8_BAR
#undef PG8_SCHED
}

__device__ __forceinline__ int rk_base(int pm) { return pm < 32 ? pm * 256 : RP + ((pm - 32) >> 3) * 2304 + ((pm - 32) & 7) * 256; }

struct EpiBf16 {
    static constexpr bool PERM = true;
    bf16* O; int ldc; int split_cols; size_t split_stride; int nostore;
    __device__ __forceinline__ void operator()(const f32x4 (&acc)[2][2][4][2], const Unit& u, int wr, int wc, int fr, int fq) const {
        const int row0 = u.pm * BM + wr * 64 + fr; int colt = u.pn * BM; bf16* base = O;
        if (split_cols) { const int t = colt / split_cols; base += (size_t)t * split_stride; colt -= t * split_cols; }
        const int col0 = colt + wc * 32 + 8 * fq;
#pragma unroll
        for (int ai = 0; ai < 2; ++ai)
#pragma unroll
            for (int m = 0; m < 4; ++m) { bf16* rowp = base + (size_t)(row0 + ai * HALF + m * 16) * ldc + col0;
#pragma unroll
                for (int bj = 0; bj < 2; ++bj) { const f32x4 v0 = acc[ai][bj][m][0], v1 = acc[ai][bj][m][1];
                    u32x4 w; w.x = pk2(v0[0], v0[1]); w.y = pk2(v0[2], v0[3]); w.z = pk2(v1[0], v1[1]); w.w = pk2(v1[2], v1[3]);
                    if (nostore) asm volatile("" :: "v"(w)); else *(u32x4*)(rowp + bj * HALF) = w; } }
    }
};
struct EpiOutPub {
    static constexpr bool PERM = true;
    bf16* O; unsigned* cnt;
    __device__ __forceinline__ void operator()(const f32x4 (&acc)[2][2][4][2], const Unit& u, int wr, int wc, int fr, int fq) const {
        const __amdgpu_buffer_rsrc_t rs = __builtin_amdgcn_make_buffer_rsrc((void*)O, (short)0, R * 1024 * 2, 0x00020000);
        const int row0 = u.pm * BM + wr * 64 + fr; const int col0 = u.pn * BM + wc * 32 + 8 * fq;
#pragma unroll
        for (int ai = 0; ai < 2; ++ai)
#pragma unroll
            for (int m = 0; m < 4; ++m) { const int off = ((row0 + ai * HALF + m * 16) * 1024 + col0) * 2;
#pragma unroll
                for (int bj = 0; bj < 2; ++bj) { const f32x4 v0 = acc[ai][bj][m][0], v1 = acc[ai][bj][m][1];
                    u32x4 w; w.x = pk2(v0[0], v0[1]); w.y = pk2(v0[2], v0[3]); w.z = pk2(v1[0], v1[1]); w.w = pk2(v1[2], v1[3]);
                    __builtin_amdgcn_raw_buffer_store_b128(w, rs, off + bj * HALF * 2, 0, 16); } }
        asm volatile("s_waitcnt vmcnt(0)" ::: "memory");
        if ((fr | fq) == 0) __hip_atomic_fetch_add(cnt + 16 * u.pm, 1u, __ATOMIC_RELAXED, __HIP_MEMORY_SCOPE_AGENT);
    }
};
struct EpiPool {
    static constexpr bool PERM = true;
    bf16* GB;
    __device__ __forceinline__ void operator()(const f32x4 (&acc)[2][2][4][2], const Unit& u, int wr, int wc, int fr, int fq) const {
        const int row0 = u.pm * BM + wr * 64 + fr; const int col0 = u.pn * BM + wc * 32 + 8 * fq;
#pragma unroll
        for (int ai = 0; ai < 2; ++ai)
#pragma unroll
            for (int m = 0; m < 4; ++m) { bf16* rowp = GB + (size_t)(row0 + ai * HALF + m * 16) * 1024 + col0;
#pragma unroll
                for (int bj = 0; bj < 2; ++bj) { const f32x4 v0 = acc[ai][bj][m][0], v1 = acc[ai][bj][m][1];
                    const u32x4 gg = *(const u32x4*)(rowp + bj * HALF);
                    u32x4 w;
                    w.x = pk2(v0[0] * silu_fast(bflo(gg.x)), v0[1] * silu_fast(bfhi(gg.x))); w.y = pk2(v0[2] * silu_fast(bflo(gg.y)), v0[3] * silu_fast(bfhi(gg.y)));
                    w.z = pk2(v1[0] * silu_fast(bflo(gg.z)), v1[1] * silu_fast(bfhi(gg.z))); w.w = pk2(v1[2] * silu_fast(bflo(gg.w)), v1[3] * silu_fast(bfhi(gg.w)));
                    *(u32x4*)(rowp + bj * HALF) = w; } }
    }
};
struct EpiMlaIn {
    static constexpr bool PERM = true;
    bf16 *CQ, *CKV, *GAB, *VP; float* KRF;
    __device__ __forceinline__ void operator()(const f32x4 (&acc)[2][2][4][2], const Unit& u, int wr, int wc, int fr, int fq) const {
        const int rt = wr * 64 + fr, grow0 = u.pm * BM, rk0 = rk_base(u.pm), cc = wc * 32 + 8 * fq;
#pragma unroll
        for (int bj = 0; bj < 2; ++bj) {
            const int U = 2 * u.pn + bj;
            if (U == 5) {
                if (wc == 0) {
#pragma unroll
                    for (int ai = 0; ai < 2; ++ai)
#pragma unroll
                        for (int m = 0; m < 4; ++m) { float* p = KRF + (size_t)(grow0 + rt + ai * HALF + m * 16) * 32 + 8 * fq;
                            *(f32x4*)p = acc[ai][bj][m][0]; *(f32x4*)(p + 4) = acc[ai][bj][m][1]; }
                }
                continue;
            }
            bf16* p; int ld, rb = grow0;
            if (U < 3) { p = CQ + 128 * U; ld = 384; }
            else if (U < 5) { p = CKV + 128 * (U - 3); ld = 256; rb = rk0; }
            else if (U < 10) { p = GAB + 128 * (U - 6); ld = 1024; }
            else if (U < 14) { p = VP + 128 * (U - 10); ld = 512; }
            else { p = GAB + 512 + 128 * (U - 14); ld = 1024; }
            p += (size_t)(rb + rt) * ld + cc;
            const bool isgate = (U >= 6 && U < 10) || U >= 14;
#pragma unroll
            for (int ai = 0; ai < 2; ++ai)
#pragma unroll
                for (int m = 0; m < 4; ++m) { f32x4 v0 = acc[ai][bj][m][0], v1 = acc[ai][bj][m][1];
                    if (isgate) { v0 = (f32x4){silu_fast(v0[0]), silu_fast(v0[1]), silu_fast(v0[2]), silu_fast(v0[3])}; v1 = (f32x4){silu_fast(v1[0]), silu_fast(v1[1]), silu_fast(v1[2]), silu_fast(v1[3])}; }
                    u32x4 w; w.x = pk2(v0[0], v0[1]); w.y = pk2(v0[2], v0[3]); w.z = pk2(v1[0], v1[1]); w.w = pk2(v1[2], v1[3]);
                    *(u32x4*)(p + (size_t)(ai * HALF + m * 16) * ld) = w; }
        }
    }
};
__device__ __forceinline__ void rope_perm(f32x4& a, f32x4& b, const float* tb) {
#pragma unroll
    for (int j = 0; j < 4; ++j) { auto rr = __builtin_amdgcn_permlane32_swap(__float_as_uint(a[j]), __float_as_uint(b[j]), false, false); a[j] = __uint_as_float(rr[0]); b[j] = __uint_as_float(rr[1]); }
    const f32x4 c0 = *(const f32x4*)tb, c1 = *(const f32x4*)(tb + 4);
    const f32x4 cs = {c0[0], c0[2], c1[0], c1[2]}, sn = {c0[1], c0[3], c1[1], c1[3]};
    const f32x4 o1 = a * cs - b * sn, o2 = a * sn + b * cs;
    a = o1; b = o2;
#pragma unroll
    for (int j = 0; j < 4; ++j) { auto rr = __builtin_amdgcn_permlane32_swap(__float_as_uint(a[j]), __float_as_uint(b[j]), false, false); a[j] = __uint_as_float(rr[0]); b[j] = __uint_as_float(rr[1]); }
}
struct EpiQ {
    static constexpr bool PERM = true;
    bf16* Q; const float* rope8;
    __device__ __forceinline__ void operator()(const f32x4 (&acc)[2][2][4][2], const Unit& u, int wr, int wc, int fr, int fq) const {
        const int rt = wr * 64 + fr, grow0 = u.pm * BM; const bool sample = u.pm >= 32; const int t0 = ((u.pm - 32) & 7) * 256;
#pragma unroll
        for (int bj = 0; bj < 2; ++bj) {
            const int g32 = 8 * u.pn + 4 * bj + wc; const bool rot = sample && (g32 % 3 == 2);
#pragma unroll
            for (int ai = 0; ai < 2; ++ai)
#pragma unroll
                for (int m = 0; m < 4; ++m) { const int r = rt + ai * HALF + m * 16; f32x4 x1 = acc[ai][bj][m][0], x2 = acc[ai][bj][m][1];
                    if (rot) { const int t = t0 + r, pos = (fq & 1) ? (t & 63) : (t >> 6); rope_perm(x1, x2, rope8 + (pos * 8 + ((fq >> 1) ? 4 : 0)) * 2); }
                    u32x4 w; w.x = pk2(x1[0], x1[1]); w.y = pk2(x1[2], x1[3]); w.z = pk2(x2[0], x2[1]); w.w = pk2(x2[2], x2[3]);
                    *(u32x4*)(Q + (size_t)(grow0 + r) * 768 + 32 * g32 + 8 * fq) = w; }
        }
    }
};
struct EpiSwaIn {
    static constexpr bool PERM = true;
    bf16 *Q, *K, *V, *G; float *stK, *stV; const float* rope16;
    __device__ __forceinline__ void operator()(const f32x4 (&acc)[2][2][4][2], const Unit& u, int wr, int wc, int fr, int fq) const {
        const int rt = wr * 64 + fr, grow0 = u.pm * BM, rk0 = rk_base(u.pm); const bool sample = u.pm >= 32; const int t0 = ((u.pm - 32) & 7) * 256;
        const int pn = u.pn;
#pragma unroll
        for (int bj = 0; bj < 2; ++bj) {
            const int cb = 128 * bj + 32 * wc + 8 * fq;
            const bool rot = sample && pn < 5;
#pragma unroll
            for (int ai = 0; ai < 2; ++ai)
#pragma unroll
                for (int m = 0; m < 4; ++m) { const int r = rt + ai * HALF + m * 16; f32x4 x1 = acc[ai][bj][m][0], x2 = acc[ai][bj][m][1];
                    if (rot) { const int t = t0 + r, pos = (wc & 1) ? (t & 63) : (t >> 6); rope_perm(x1, x2, rope16 + (pos * 16 + 8 * (fq & 1) + ((fq >> 1) ? 4 : 0)) * 2); }
                    bf16* p;
                    if (pn < 4) p = Q + (size_t)(grow0 + r) * 1024 + 256 * pn + cb;
                    else if (pn == 4) p = K + (size_t)(rk0 + r) * 256 + cb;
                    else if (pn == 5) p = V + (size_t)(rk0 + r) * 256 + cb;
                    else p = G + (size_t)(grow0 + r) * 1024 + 256 * (pn - 6) + cb;
                    if (pn >= 6) { x1 = (f32x4){silu_fast(x1[0]), silu_fast(x1[1]), silu_fast(x1[2]), silu_fast(x1[3])}; x2 = (f32x4){silu_fast(x2[0]), silu_fast(x2[1]), silu_fast(x2[2]), silu_fast(x2[3])}; }
                    if (!sample && (pn == 4 || pn == 5)) { float* st = (pn == 4 ? stK : stV) + (size_t)(u.pm * 2 * 256 + r) * 256 + cb; *(f32x4*)st = x1; *(f32x4*)(st + 4) = x2; }
                    u32x4 w; w.x = pk2(x1[0], x1[1]); w.y = pk2(x1[2], x1[3]); w.z = pk2(x2[0], x2[1]); w.w = pk2(x2[2], x2[3]);
                    *(u32x4*)p = w; }
        }
    }
};
}

typedef __attribute__((address_space(4))) const char* kptr_t;
__device__ __forceinline__ const void* arg_ptr(int k) { kptr_t ka = (kptr_t)__builtin_amdgcn_kernarg_segment_ptr(); asm volatile("" : "+s"(ka)); return *(const void* __attribute__((address_space(4)))*)(ka + 8 * k); }
#define ARG_IN(k) ((const float*)arg_ptr(k))
namespace att {
__device__ __forceinline__ int crow(int r, int hi) { return (r & 3) + 8 * (r >> 2) + 4 * hi; }
typedef short v4i16_t __attribute__((ext_vector_type(4)));
__device__ __forceinline__ s16x4 vtr(const LAS char* p) { return __builtin_bit_cast(s16x4, __builtin_amdgcn_ds_read_tr16_b64_v4i16((LAS v4i16_t*)p)); }
__device__ __forceinline__ float xhalf_max(float x) { auto rr = __builtin_amdgcn_permlane32_swap(__float_as_uint(x), __float_as_uint(x), false, false); return __builtin_fmaxf(__uint_as_float(rr[0]), __uint_as_float(rr[1])); }
__device__ __forceinline__ float xhalf_sum(float x) { auto rr = __builtin_amdgcn_permlane32_swap(__float_as_uint(x), __float_as_uint(x), false, false); return __uint_as_float(rr[0]) + __uint_as_float(rr[1]); }
#define SBAR() __builtin_amdgcn_sched_barrier(0)
#define PIN(x) asm volatile("" : "+v"(x))
__device__ __forceinline__ float max3f(float a, float b, float c) { float r; asm("v_max3_f32 %0, %1, %2, %3" : "=v"(r) : "v"(a), "v"(b), "v"(c)); return r; }
__device__ __forceinline__ float max2f(float a, float b) { float r; asm("v_max_f32_e32 %0, %1, %2" : "=v"(r) : "v"(a), "v"(b)); return r; }
struct Desc {
    const bf16* qptr;
    const bf16* k0;
    const bf16* k1;
    const bf16* v;
    int n_a, row_a, n_b, row_b, key_b;
    int qpos; float sink2; int has_sink;
    bf16* optr;
};
constexpr float THR = 8.f;
__device__ __forceinline__ int tile_row(const Desc& d, int t) { return t < d.n_a ? d.row_a + 64 * t : d.row_b + 64 * (t - d.n_a); }
template <int MODE, class MK>
__device__ __forceinline__ void attn_phase(LAS char* lds, const MK& mk, int first, int stride, int nunits) {
    constexpr int DQK = MODE == 0 ? 96 : 64, NCH = DQK / 8, ND0 = DQK / 16, KB = NCH * 1024, VOFF = 3 * KB, NG = 2 * ND0, NHELD = 8, NLATE = NG - NHELD, STG_OFF = VOFF + 2 * 8192;
    static_assert(STG_OFF + 8 * 32 * 272 <= 131072, "attention LDS map");
    constexpr int LDQ = MODE == 0 ? 768 : 1024, LDK0 = MODE == 0 ? 512 : 256, LDV = LDK0, LDO = 1024;
    int un = first; if (un >= nunits) return;
    const int tid = opaque_tid(), lane = tid & 63, r32 = lane & 31, hi = lane >> 5; const int wid = __builtin_amdgcn_readfirstlane(tid >> 6);
    const int kdst = wid * 1024, k1dst = (8 + (wid & 3)) * 1024, vdst = VOFF + wid * 1024;
    const int vlane = ((lane >> 4) & 1) * 32 + (lane & 3) * 8 + (4 * hi + ((lane & 15) >> 2)) * 64;
    const int kfo = hi * 1024 + r32 * 16;
    Desc d; mk(un, d);
#define SRC_K(dd) ((dd).k0 + (size_t)lane * LDK0 + wid * 8)
#define SRC_K1(dd) ((MODE == 0) ? (dd).k1 + (size_t)lane * 32 + (wid & 3) * 8 : (const bf16*)nullptr)
#define SRC_V(dd) ((dd).v + (size_t)(16 * (wid & 3) + (lane >> 2)) * LDV + (wid >> 2) * 32 + (lane & 3) * 8)
    const bf16* ksrc = SRC_K(d); const bf16* k1src = SRC_K1(d); const bf16* vsrc = SRC_V(d);
#define GLDS16(g, l) __builtin_amdgcn_global_load_lds((const unsigned*)(g), (LAS unsigned*)(l), 16, 0, 0)
#define DMAK_(dd, ks_, k1s_, t, soff) do { const size_t _r = (size_t)tile_row(dd, t); GLDS16((ks_) + _r * LDK0, lds + (soff) + kdst); if (MODE == 0 && wid < 4) GLDS16((k1s_) + _r * 32, lds + (soff) + k1dst); } while (0)
#define DMAV_(dd, vs_, t, vslot) do { const size_t _r = (size_t)tile_row(dd, t); GLDS16((vs_) + _r * LDV, lds + (vslot) * 8192 + vdst); } while (0)
#define DMAK(t, soff) DMAK_(d, ksrc, k1src, t, soff)
#define DMAV(t, vslot) DMAV_(d, vsrc, t, vslot)
    int sl_cur = 0, sl_nxt = KB, sl_fre = 2 * KB;
    int vpar = 0;
    DMAK(0, sl_cur); DMAK(1, sl_nxt); DMAV(0, vpar);
    bf16x8 qr[ND0];
#pragma unroll
    for (int d0 = 0; d0 < ND0; ++d0) qr[d0] = *(const bf16x8*)(d.qptr + (size_t)r32 * LDQ + d0 * 16 + hi * 8);
    __syncthreads();
#define ROT() do { const int o_ = sl_cur; sl_cur = sl_nxt; sl_nxt = sl_fre; sl_fre = o_; } while (0)
#define KFADDR(i, soff) (lds + (soff) + kfo + ((i) >> 1) * 2048 + ((i) & 1) * 512)
#define PE(P0, P1, e) ((e) < 16 ? P0[(e) & 15] : P1[(e) & 15])
#define FILL_A(P0, P1, g) do { \
        _Pragma("unroll") for (int e_ = (32 * (g)) / NG; e_ < (32 * ((g) + 1)) / NG; ++e_) sacc += PE(P0, P1, e_); \
        PIN(sacc); \
        _Pragma("unroll") for (int k_ = (16 * (g)) / NG; k_ < (16 * ((g) + 1)) / NG; ++k_) { pw[k_ >> 2][k_ & 3] = pk2(PE(P0, P1, 2 * k_), PE(P0, P1, 2 * k_ + 1)); PIN(pw[k_ >> 2]); } } while (0)
#define QK_PHASE(C0, C1, P0, P1, HAVE_P) do { \
        bf16x8 kl_[NLATE > 0 ? NLATE : 1]; \
        _Pragma("unroll") for (int i_ = 0; i_ < NLATE; ++i_) kl_[i_] = *(const LAS bf16x8*)KFADDR(NHELD + i_, sl_cur); \
        _Pragma("unroll") for (int g_ = 0; g_ < NG; ++g_) { const int d0_ = g_ >> 1; \
            const bf16x8 kk_ = g_ < NHELD ? kf[g_ < NHELD ? g_ : 0] : kl_[g_ >= NHELD ? g_ - NHELD : 0]; \
            if ((g_ & 1) == 0) C0 = __builtin_amdgcn_mfma_f32_32x32x16_bf16(kk_, qr[d0_], d0_ == 0 ? negm : C0, 0, 0, 0); \
            else C1 = __builtin_amdgcn_mfma_f32_32x32x16_bf16(kk_, qr[d0_], d0_ == 0 ? negm : C1, 0, 0, 0); \
            if (HAVE_P) FILL_A(P0, P1, g_); \
            SBAR(); } } while (0)
#define MASKT(C0, C1, t_) do { if (MODE == 1 && (t_) >= d.n_a) { const int key0_ = d.key_b + 64 * ((t_) - d.n_a); \
        if (key0_ - (qb0 + 31) < -128 || key0_ + 63 - qb0 > 128) { const int k0p_ = key0_ - d.qpos; \
            _Pragma("unroll") for (int r = 0; r < 16; ++r) { const int d_ = k0p_ + crow(r, hi); if (d_ > 128 || d_ < -128) C0[r] = -1e30f; if (d_ + 32 > 128 || d_ + 32 < -128) C1[r] = -1e30f; } } } } while (0)
#define DECIDE(C0, C1) do { \
        float a_ = max2f(C0[0], C1[0]), b_ = max2f(C0[1], C1[1]); \
        _Pragma("unroll") for (int r = 2; r < 16; r += 2) { a_ = max3f(a_, C0[r], C1[r]); b_ = max3f(b_, C0[r + 1], C1[r + 1]); } \
        a_ = xhalf_max(max2f(a_, b_)); resc = false; \
        if (__any(a_ > THR)) { const float dl_ = fmaxf(a_, 0.f); mref += dl_; \
            _Pragma("unroll") for (int r = 0; r < 16; ++r) { C0[r] -= dl_; C1[r] -= dl_; } \
            _Pragma("unroll") for (int r = 0; r < 16; ++r) negm[r] = -mref; \
            fsc = __builtin_amdgcn_exp2f(-dl_); lsum *= fsc; resc = true; } } while (0)
#define EXP4(C0, C1, j) do { _Pragma("unroll") for (int e_ = 4 * (j); e_ < 4 * (j) + 4; ++e_) { if (e_ < 16) C0[e_ & 15] = __builtin_amdgcn_exp2f(C0[e_ & 15]); else C1[e_ & 15] = __builtin_amdgcn_exp2f(C1[e_ & 15]); } \
        if (4 * (j) < 16) PIN(C0); else PIN(C1); } while (0)
#define VOFFS(j) ((((j) & 1) * 4096) + (((j) >> 1) * 1024))
#define PV_PHASE(C0, C1, HAVE_C, HAVE_K, tp_) do { \
        const LAS char* vp_ = lds + VOFF + (((tp_) + vpar) & 1) * 8192 + vlane; \
        s16x4 vl_[8], vh_[8]; \
        vl_[0] = vtr(vp_ + VOFFS(0)); vh_[0] = vtr(vp_ + VOFFS(0) + 512); vl_[1] = vtr(vp_ + VOFFS(1)); vh_[1] = vtr(vp_ + VOFFS(1) + 512); \
        _Pragma("unroll") for (int j = 0; j < 8; ++j) { const int ks = j >> 1, dd = j & 1; \
            if (j + 2 < 8) { vl_[j + 2] = vtr(vp_ + VOFFS(j + 2)); vh_[j + 2] = vtr(vp_ + VOFFS(j + 2) + 512); } \
            if (HAVE_K) kf[j] = *(const LAS bf16x8*)KFADDR(j, sl_nxt); \
            const bf16x8 vf_ = {vl_[j][0], vl_[j][1], vl_[j][2], vl_[j][3], vh_[j][0], vh_[j][1], vh_[j][2], vh_[j][3]}; \
            if (dd == 0) o0 = __builtin_amdgcn_mfma_f32_32x32x16_bf16(vf_, __builtin_bit_cast(bf16x8, pw[ks]), o0, 0, 0, 0); \
            else o1 = __builtin_amdgcn_mfma_f32_32x32x16_bf16(vf_, __builtin_bit_cast(bf16x8, pw[ks]), o1, 0, 0, 0); \
            if (HAVE_C) EXP4(C0, C1, j); \
            SBAR(); } } while (0)
#define STEP(C0, C1, P0, P1, t_) do { \
        if ((t_) + 2 < NT) DMAK((t_) + 2, sl_fre); \
        DMAV(t_, ((t_) + vpar) & 1); \
        float sacc = 0.f; \
        QK_PHASE(C0, C1, P0, P1, true); \
        lsum += sacc; \
        MASKT(C0, C1, t_); \
        DECIDE(C0, C1); \
        SBAR(); \
        PV_PHASE(C0, C1, true, true, (t_) - 1); \
        __syncthreads(); \
        ROT(); \
        if (resc) { o0 *= fsc; o1 *= fsc; } } while (0)
    for (;;) {
        const int NT = d.n_a + d.n_b;
        const int qb0 = __builtin_amdgcn_readfirstlane(d.qpos);
        float mref = 0.f, lsum = 0.f, fsc = 1.f; bool resc = false;
        f32x16 o0 = (f32x16){}, o1 = (f32x16){}, negm = (f32x16){};
        f32x16 cA0 = (f32x16){}, cA1 = (f32x16){}, cB0 = (f32x16){}, cB1 = (f32x16){};
        u32x4 pw[4];
#pragma unroll
        for (int i = 0; i < 4; ++i) pw[i] = (u32x4){0u, 0u, 0u, 0u};
        bf16x8 kf[NHELD];
#pragma unroll
        for (int i = 0; i < NHELD; ++i) kf[i] = *(const LAS bf16x8*)KFADDR(i, sl_cur);
        {
            if (2 < NT) DMAK(2, sl_fre);
            float sacc = 0.f; (void)sacc;
            QK_PHASE(cA0, cA1, cA0, cA1, false);
            MASKT(cA0, cA1, 0);
            DECIDE(cA0, cA1);
#pragma unroll
            for (int j = 0; j < 8; ++j) { kf[j] = *(const LAS bf16x8*)KFADDR(j, sl_nxt); EXP4(cA0, cA1, j); SBAR(); }
            __syncthreads();
            ROT();
        }
        int t = 1;
        for (; t + 1 < NT; t += 2) { STEP(cB0, cB1, cA0, cA1, t); STEP(cA0, cA1, cB0, cB1, t + 1); }
        const bool odd_tail = t < NT;
        if (odd_tail) STEP(cB0, cB1, cA0, cA1, t);
        const int un_next = un + stride; const bool has_next = un_next < nunits;
        Desc dn = d;
        const bf16* ksrc_n = ksrc; const bf16* k1src_n = k1src; const bf16* vsrc_n = vsrc;
        u32x4 gpre[4];
#if !ATT_LOWREG
#pragma unroll
        for (int i2 = 0; i2 < 4; ++i2) gpre[i2] = *(const u32x4*)(d.optr + (size_t)(i2 * 8 + (lane >> 3)) * LDO + (lane & 7) * 8);
        bf16x8 qn[ND0];
#pragma unroll
        for (int d0 = 0; d0 < ND0; ++d0) qn[d0] = qr[d0];
#endif
        if (has_next) {
            mk(un_next, dn);
            ksrc_n = SRC_K(dn); k1src_n = SRC_K1(dn); vsrc_n = SRC_V(dn);
            DMAK_(dn, ksrc_n, k1src_n, 0, sl_cur); DMAK_(dn, ksrc_n, k1src_n, 1, sl_nxt); DMAV_(dn, vsrc_n, 0, (NT + vpar) & 1);
#if !ATT_LOWREG
#pragma unroll
            for (int d0 = 0; d0 < ND0; ++d0) qn[d0] = *(const bf16x8*)(dn.qptr + (size_t)r32 * LDQ + d0 * 16 + hi * 8);
#endif
        }
        if (odd_tail) {
            float sacc = 0.f;
#pragma unroll
            for (int g = 0; g < NG; ++g) FILL_A(cB0, cB1, g);
            lsum += sacc;
            PV_PHASE(cB0, cB1, false, false, NT - 1);
        } else {
            float sacc = 0.f;
#pragma unroll
            for (int g = 0; g < NG; ++g) FILL_A(cA0, cA1, g);
            lsum += sacc;
            PV_PHASE(cA0, cA1, false, false, NT - 1);
        }
        float lt = xhalf_sum(lsum);
        if (d.has_sink) lt += __builtin_amdgcn_exp2f(d.sink2 - mref);
        const float inv = 1.0f / lt;
        {
            LAS char* stg = lds + STG_OFF + wid * (32 * 272);
#pragma unroll
            for (int d0 = 0; d0 < 2; ++d0)
#pragma unroll
                for (int g = 0; g < 4; ++g) { const f32x16& o = d0 ? o1 : o0;
                    const f32x4 v = {o[4 * g] * inv, o[4 * g + 1] * inv, o[4 * g + 2] * inv, o[4 * g + 3] * inv};
                    *(LAS f32x4*)(stg + r32 * 272 + (32 * d0 + 8 * g + 4 * hi) * 4) = v; }
#pragma unroll
            for (int i2 = 0; i2 < 4; ++i2) { const int row = i2 * 8 + (lane >> 3), ch = lane & 7;
                const f32x4 va = *(const LAS f32x4*)(stg + row * 272 + ch * 32), vb = *(const LAS f32x4*)(stg + row * 272 + ch * 32 + 16);
#if ATT_LOWREG
                gpre[i2] = *(const u32x4*)(d.optr + (size_t)row * LDO + ch * 8);
#endif
                const u32x4 gg = gpre[i2];
                u32x4 w;
                w.x = pk2(va[0] * bflo(gg.x), va[1] * bfhi(gg.x)); w.y = pk2(va[2] * bflo(gg.y), va[3] * bfhi(gg.y));
                w.z = pk2(vb[0] * bflo(gg.z), vb[1] * bfhi(gg.z)); w.w = pk2(vb[2] * bflo(gg.w), vb[3] * bfhi(gg.w));
                *(u32x4*)(d.optr + (size_t)row * LDO + ch * 8) = w; }
        }
        __syncthreads();
        if (TS_A >= 0 && MODE == TS_MODE && blockIdx.x == 0 && threadIdx.x == 0) { unsigned long long* tsp = (unsigned long long*)((unsigned char*)arg_ptr(24) + WS_CTL + 100 * 1024); const int k = (un - first) / stride; if (tsp[40 + k] == 0ull) tsp[40 + k] = __builtin_amdgcn_s_memrealtime(); }
        if (!has_next) break;
        vpar = (NT + vpar) & 1;
        d = dn; un = un_next; ksrc = ksrc_n; k1src = k1src_n; vsrc = vsrc_n;
#if ATT_LOWREG
#pragma unroll
        for (int d0 = 0; d0 < ND0; ++d0) qr[d0] = *(const bf16x8*)(d.qptr + (size_t)r32 * LDQ + d0 * 16 + hi * 8);
#else
#pragma unroll
        for (int d0 = 0; d0 < ND0; ++d0) qr[d0] = qn[d0];
#endif
    }
#undef SRC_K
#undef SRC_K1
#undef SRC_V
#undef GLDS16
#undef DMAK_
#undef DMAV_
#undef DMAK
#undef DMAV
#undef ROT
#undef KFADDR
#undef PE
#undef FILL_A
#undef QK_PHASE
#undef MASKT
#undef DECIDE
#undef EXP4
#undef VOFFS
#undef PV_PHASE
#undef STEP
}
#undef SBAR
}

#define XB_TMO      128
#define XB_XCNT(j)  (256  + 64 * (j))
#define XB_XSUB(j)  (1280 + 64 * (j))
#define XB_XGEN(j)  (2304 + 64 * (j))
#define XB_TOP      3328
#define XB_TOPGEN   3392
#define XCD_BAR_WORDS 3456
#define XB_SPIN_CAP (1u << 20)
__device__ __forceinline__ unsigned xb_ld(unsigned* p)              { return __hip_atomic_load(p, __ATOMIC_RELAXED, __HIP_MEMORY_SCOPE_AGENT); }
__device__ __forceinline__ unsigned xb_add(unsigned* p, unsigned v) { return __hip_atomic_fetch_add(p, v, __ATOMIC_RELAXED, __HIP_MEMORY_SCOPE_AGENT); }
__device__ __forceinline__ unsigned xb_xcc_id() { return (unsigned)__builtin_amdgcn_s_getreg((3 << 11) | 20) & 0xFu; }
#define XB_SPIN(cond, bar) do { unsigned _sp = 0; while (cond) { __builtin_amdgcn_s_sleep(1); \
    if ((++_sp & 255u) == 0u) { if (xb_ld(&(bar)[XB_TMO])) break; if (_sp > XB_SPIN_CAP) { atomicAdd(&(bar)[XB_TMO], 1u); break; } } } } while (0)
struct XcdBarrier { unsigned* bar; unsigned x; volatile LAS unsigned* st; };
__device__ __forceinline__ XcdBarrier xcd_barrier_post(unsigned* bar, volatile LAS unsigned* st) {
    XcdBarrier b; b.bar = bar; b.x = xb_xcc_id(); b.st = st;
    if (threadIdx.x == 0) (void)xb_add(&bar[XB_XCNT(b.x)], 1u);
    return b;
}
__device__ __forceinline__ void xcd_barrier_complete(unsigned* bar, unsigned x, unsigned& nloc, unsigned& nx) {
    const unsigned G = gridDim.x * gridDim.y * gridDim.z;
    unsigned sum, cnt, mine, sp = 0u;
    for (;;) {
        sum = 0u; cnt = 0u; mine = 0u;
#pragma unroll
        for (unsigned j = 0; j < 16; ++j) { const unsigned c = xb_ld(&bar[XB_XCNT(j)]); sum += c; cnt += (c > 0u) ? 1u : 0u; mine = (j == x) ? c : mine; }
        if (sum == G) break;
        __builtin_amdgcn_s_sleep(1);
        if ((++sp & 255u) == 0u) { if (xb_ld(&bar[XB_TMO])) break; if (sp > XB_SPIN_CAP) { atomicAdd(&bar[XB_TMO], 1u); break; } }
    }
    nloc = mine > 0u ? mine : 1u; nx = cnt > 0u ? cnt : 1u;
}
__device__ __forceinline__ void xcd_barrier(const XcdBarrier& b0) {
    asm volatile("s_waitcnt vmcnt(0)" ::: "memory");
    __syncthreads();
    if (threadIdx.x == 0) {
        XcdBarrier b = b0; b.x = xb_xcc_id();
        unsigned* bar = b.bar; asm volatile("" : "+s"(bar));
        __builtin_amdgcn_s_waitcnt(0);
        unsigned nloc = b.st[0], nx = b.st[1];
        if (nloc == 0u) { xcd_barrier_complete(bar, b.x, nloc, nx); b.st[0] = nloc; b.st[1] = nx; }
        const unsigned old = xb_add(&bar[XB_XSUB(b.x)], 1u);
        const unsigned gen = old / nloc;
        if (old + 1u == (gen + 1u) * nloc) {
            __builtin_amdgcn_fence(__ATOMIC_RELEASE, "agent");
            asm volatile("s_waitcnt vmcnt(0)" ::: "memory");
            const unsigned og = xb_add(&bar[XB_TOP], 1u);
            const unsigned tg = og / nx;
            if (og + 1u == (tg + 1u) * nx) xb_add(&bar[XB_TOPGEN], 1u);
            else XB_SPIN(xb_ld(&bar[XB_TOPGEN]) == tg, bar);
            __builtin_amdgcn_fence(__ATOMIC_ACQUIRE, "agent");
            xb_add(&bar[XB_XGEN(b.x)], 1u);
            asm volatile("s_waitcnt vmcnt(0)" ::: "memory");
        } else {
            XB_SPIN(xb_ld(&bar[XB_XGEN(b.x)]) == gen, bar);
            __builtin_amdgcn_fence(__ATOMIC_ACQUIRE, "agent");
            asm volatile("s_waitcnt vmcnt(0)" ::: "memory");
        }
    }
    __syncthreads();
}

struct Args { const float* in[23]; float* out; unsigned char* ws; int ph_lo, ph_hi; };
constexpr int NWAVES = 8;
constexpr int N_PHASES = 2 + 5 + 3 + 5 + 3;
constexpr int RING_BYTES = 131072, MISC_OFF = RING_BYTES + 320, LDS_BYTES = 147456;

struct TMap { int kind, row_off, col_off, ldw; const float* nscale; float scale; };
__device__ __forceinline__ void tmap(const TMap& tm, int n, int& drow, float& sc) {
    drow = n + tm.row_off; sc = tm.scale;
    switch (tm.kind) {
        case 1: if (n >= 672) drow += 96; break;
        case 2: { const int e = n % 96; if (e >= 64) { const int d = e - 64; const int p = (d & 7) | ((d & 8) << 1) | ((d & 16) >> 1); drow = n - e + 64 + p; } } break;
        case 3: { const int h = n >> 7, e = n & 127; drow = (e < 64) ? h * 64 + e : 512 + h * 64 + (e - 64); } break;
        case 4: sc = tm.nscale[n]; break;
        case 5: if (n >= 1024) sc = 1.f; break;
        default: break;
    }
}
__device__ __forceinline__ void transpose_item(const float* W, int K, int N, bf16* WT, const TMap& tm, LAS float* scr, int item, int lane) {
    const int nblk = N / 32, kb = item / nblk, nb = item % nblk, k0 = 64 * kb, n0 = 32 * nb;
    f32x4 wv[8];
#pragma unroll
    for (int i = 0; i < 8; ++i) wv[i] = *(const f32x4*)(W + (size_t)(k0 + 8 * i + (lane >> 3)) * N + n0 + 4 * (lane & 7));
#pragma unroll
    for (int i = 0; i < 8; ++i) { LAS float* d = scr + (8 * i + (lane >> 3)) * 33 + 4 * (lane & 7); d[0] = wv[i][0]; d[1] = wv[i][1]; d[2] = wv[i][2]; d[3] = wv[i][3]; }
    LDS_WAIT(); asm volatile("" ::: "memory");
    const int c = lane & 7;
#pragma unroll
    for (int j = 0; j < 4; ++j) { const int n = (lane >> 3) + 8 * j; const LAS float* s = scr + (8 * c) * 33 + n;
        int drow; float sc; tmap(tm, n0 + n, drow, sc);
        u32x4 o; o.x = pk2(s[0 * 33] * sc, s[1 * 33] * sc); o.y = pk2(s[2 * 33] * sc, s[3 * 33] * sc); o.z = pk2(s[4 * 33] * sc, s[5 * 33] * sc); o.w = pk2(s[6 * 33] * sc, s[7 * 33] * sc);
        *(u32x4*)(WT + (size_t)drow * tm.ldw + tm.col_off + k0 + 8 * c) = o; }
    LDS_WAIT(); asm volatile("" ::: "memory");
}

__device__ __forceinline__ f32x4 mod_load(const float* MODPp, const float* ada_b, int l, int midx, int off) {
    f32x4 s = *(const f32x4*)(ada_b + l * 3072 + off);
#pragma unroll
    for (int kq = 0; kq < 4; ++kq) s += *(const f32x4*)(MODPp + ((size_t)((kq * 4 + l) * 9 + midx)) * 3072 + off);
    return s;
}
__device__ __forceinline__ void ada_item(int it, const float* cvec, const float* cctx, const float* ada_w, float* modp, LAS unsigned char* lds, int tid, int lane, int wave) {
    LAS float* red = (LAS float*)lds;
    const int l = it / 48, rem = it % 48, cc = rem >> 2, kq = rem & 3, k0 = kq * 256 + wave * 32;
    float sv[9];
#pragma unroll
    for (int j = 0; j < 9; ++j) { const float c = (j < 8) ? cvec[j * 1024 + k0 + (lane & 31)] : cctx[k0 + (lane & 31)]; sv[j] = c / (1.f + expf(-c)); }
    f32x4 acc[9];
#pragma unroll
    for (int j = 0; j < 9; ++j) acc[j] = (f32x4){0.f, 0.f, 0.f, 0.f};
    const float* wp = ada_w + ((size_t)l * 1024 + k0) * 3072 + cc * 256 + 4 * lane;
    f32x4 wv[32];
#pragma unroll
    for (int kk = 0; kk < 32; ++kk) wv[kk] = *(const f32x4*)(wp + (size_t)kk * 3072);
    asm volatile("" ::: "memory");
#pragma unroll
    for (int kk = 0; kk < 32; ++kk) {
#pragma unroll
        for (int j = 0; j < 9; ++j) { const float sc = __int_as_float(__builtin_amdgcn_readlane(__float_as_int(sv[j]), kk)); acc[j] += wv[kk] * sc; }
    }
#pragma unroll
    for (int j = 0; j < 9; ++j) *(LAS f32x4*)(red + (wave * 9 + j) * 256 + 4 * lane) = acc[j];
    __syncthreads();
    for (int idx = tid; idx < 9 * 256; idx += NWAVES * 64) { const int j = idx >> 8, col = idx & 255; float sm = 0.f;
#pragma unroll
        for (int w = 0; w < 8; ++w) sm += red[(w * 9 + j) * 256 + col];
        modp[((size_t)((kq * 4 + l) * 9 + j)) * 3072 + cc * 256 + col] = sm; }
    __syncthreads();
}
constexpr int CI1 = 1104, CI2 = 144, CI3 = 128, CI4 = 1024, CI5 = 512, CI6 = 1280, CI7 = 512, CIMLA = CI1 + CI2 + CI3 + CI4 + CI5, CISWA = CI6 + CI7;
__device__ __forceinline__ void conv_item(int r, int i, unsigned char* ws, LAS float* scr, int lane) {
    unsigned char* wm = ws + (i ? WS_W_MLA1 : WS_W_MLA0); unsigned char* wsw = ws + (i ? WS_W_SWA1 : WS_W_SWA0);
    if (r < CI1) { const int nb = r % 69; if (nb >= 37 && nb < 53) return;
        TMap tm{1, 0, 0, 1024, nullptr, 1.f}; transpose_item(ARG_IN(12) + (size_t)i * 1024 * 2208, 1024, 2208, (bf16*)wm, tm, scr, r, lane); return; } r -= CI1;
    if (r < CI2) { TMap tm{2, 0, 0, 384, nullptr, MLA_SC}; transpose_item(ARG_IN(15) + (size_t)i * 384 * 768, 384, 768, (bf16*)(wm + SZ_WIN_MLA), tm, scr, r, lane); return; } r -= CI2;
    if (r < CI3) { TMap tm{3, 0, 0, 256, nullptr, 1.f}; transpose_item(ARG_IN(16) + (size_t)i * 256 * 1024, 256, 1024, (bf16*)(wm + SZ_WIN_MLA + SZ_WUQ), tm, scr, r, lane); return; } r -= CI3;
    if (r < CI4) {
        const int g = r >> 8, kb = (r >> 4) & 15, eb = r & 15, k = kb * 64 + lane;
        const float* wi = ARG_IN(12) + (size_t)i * 1024 * 2208 + (size_t)k * 2208 + 1184 + g * 128;
        const float* wp = ARG_IN(17) + ((size_t)i * 4 + g) * 128 * 128 + eb * 8; const float* sp = ARG_IN(18) + i * 512 + g * 128 + eb * 8;
#pragma unroll
        for (int q = 0; q < 4; ++q) { const int c = 32 * q + (lane >> 1); *(LAS f32x4*)(scr + c * 8 + 4 * (lane & 1)) = *(const f32x4*)(wp + (size_t)c * 128 + 4 * (lane & 1)); }
        LDS_WAIT(); asm volatile("" ::: "memory");
        float acc[8];
#pragma unroll
        for (int e = 0; e < 8; ++e) acc[e] = 0.f;
#pragma nounroll
        for (int hc = 0; hc < 2; ++hc) {
            f32x4 arow[16];
#pragma unroll
            for (int q = 0; q < 16; ++q) arow[q] = *(const f32x4*)(wi + 64 * hc + 4 * q);
            const LAS float* sw = scr + 64 * hc * 8;
#pragma unroll
            for (int q = 0; q < 16; ++q) {
#pragma unroll
                for (int cc = 0; cc < 4; ++cc) { const float a = arow[q][cc];
                    const f32x4 w0 = *(const LAS f32x4*)(sw + (4 * q + cc) * 8), w1 = *(const LAS f32x4*)(sw + (4 * q + cc) * 8 + 4);
                    acc[0] += a * w0[0]; acc[1] += a * w0[1]; acc[2] += a * w0[2]; acc[3] += a * w0[3]; acc[4] += a * w1[0]; acc[5] += a * w1[1]; acc[6] += a * w1[2]; acc[7] += a * w1[3]; } }
        }
        bf16* dst = (bf16*)wm + (size_t)(1280 + g * 128 + eb * 8) * 1024 + k;
#pragma unroll
        for (int e = 0; e < 8; ++e) dst[(size_t)e * 1024] = (bf16)f2bf(acc[e] * sp[e]);
        LDS_WAIT(); asm volatile("" ::: "memory");
        return; } r -= CI4;
    if (r < CI5) { TMap tm{0, 0, 0, 1024, nullptr, 1.f}; transpose_item(ARG_IN(19) + (size_t)i * 1024 * 1024, 1024, 1024, (bf16*)(wm + SZ_WIN_MLA + SZ_WUQ + SZ_WUKV + SZ_WPOOL), tm, scr, r, lane); return; } r -= CI5;
    if (r < CI6) { TMap tm{5, 0, 0, 1024, nullptr, SWA_SC}; transpose_item(ARG_IN(20) + (size_t)i * 1024 * 2560, 1024, 2560, (bf16*)wsw, tm, scr, r, lane); return; } r -= CI6;
    { TMap tm{0, 0, 0, 1024, nullptr, 1.f}; transpose_item(ARG_IN(22) + (size_t)i * 1024 * 1024, 1024, 1024, (bf16*)(wsw + SZ_WIN_SWA), tm, scr, r, lane); }
}
__device__ __forceinline__ int mod_index(int row) { return row < RP ? 8 : ((row - RP) >> 11); }

__global__ void __launch_bounds__(NWAVES * 64, 2) fwd_kernel(Args args) {
    extern __shared__ __attribute__((aligned(16))) unsigned char lds_raw[];
    LAS unsigned char* lds = (LAS unsigned char*)lds_raw;
    volatile LAS unsigned* MISC = (volatile LAS unsigned*)(lds + MISC_OFF);
    const int G = gridDim.x; const int bx = blockIdx.x; const int vcu = (G % 8 == 0) ? (bx % 8) * (G / 8) + bx / 8 : bx;
    const int NGW = G * NWAVES;
    { const int tid0 = threadIdx.x; for (int u = tid0; u < (LDS_BYTES - RING_BYTES) / 4; u += NWAVES * 64) ((LAS unsigned*)(lds + RING_BYTES))[u] = 0u; }
    __syncthreads();
    XcdBarrier bar; bar.bar = (unsigned*)((unsigned char*)arg_ptr(24) + WS_CTL) + 1024; bar.x = 0; bar.st = nullptr;
    if (!MK_PER_PHASE) bar = xcd_barrier_post(bar.bar, MISC + 8);
    const int lo = MK_PER_PHASE ? args.ph_lo : 0, hi = MK_PER_PHASE ? args.ph_hi : N_PHASES;
    int pid = 0;
    if (TS_A >= 0 && blockIdx.x == 0 && threadIdx.x == 0) ((unsigned long long*)((unsigned char*)arg_ptr(24) + WS_CTL + 100 * 1024))[0] = __builtin_amdgcn_s_memrealtime();
#ifndef PHASE_MASK
#define PHASE_MASK 0xFFFFFFFFu
#endif
#define IN_PH() (lo <= pid && pid < hi)
#ifndef G2M
#define G2M 7
#endif
#define PK(k) ((PHASE_MASK >> (k)) & 1u)
#ifndef PROBE_DUP
#define PROBE_DUP 0u
#endif
#define REPS(k) ((((PROBE_DUP) >> (k)) & 1u) ? 2 : 1)
#ifndef PROBE_BAR2
#define PROBE_BAR2 0
#endif
#define END_PH() do { if (!MK_PER_PHASE && lo <= pid && pid + 1 < hi) { xcd_barrier(bar); if (PROBE_BAR2) xcd_barrier(bar); } ++pid; \
        if (TS_A >= 0 && blockIdx.x == 0 && threadIdx.x == 0) ((unsigned long long*)((unsigned char*)arg_ptr(24) + WS_CTL + 100 * 1024))[pid] = __builtin_amdgcn_s_memrealtime(); } while (0)
#define PH_BEGIN() unsigned char* const ws = (unsigned char*)arg_ptr(24); float* const out = (float*)arg_ptr(23); \
    const int tid = opaque_tid(), lane = tid & 63, wave = __builtin_amdgcn_readfirstlane(tid >> 6), gw = vcu * NWAVES + wave; (void)out; (void)lane; (void)gw; (void)ws
#define MOD ((float*)(ws + WS_MOD))
#define ROPE8 ((float*)(ws + WS_ROPE8))
#define ROPE16 ((float*)(ws + WS_ROPE16))
#define MODP ((float*)(ws + WS_MODP))
#define Hb ((bf16*)(ws + WS_H))
#define GAB ((bf16*)(ws + WS_GAB))
#define CQ ((bf16*)(ws + WS_CQ))
#define CKV ((bf16*)(ws + WS_CKV))
#define KRB ((bf16*)(ws + WS_KRB))
#define KRF ((float*)(ws + WS_KRF))
#define KN ((bf16*)(ws + WS_KN))
#define VP ((bf16*)(ws + WS_KN))
#define VV ((bf16*)(ws + WS_V))
#define PO ((bf16*)(ws + WS_PO))
#define SQ ((bf16*)(ws + WS_CQ))
#define SK ((bf16*)(ws + WS_SK))
#define SV ((bf16*)(ws + WS_SV))

    if (IN_PH() && PK(1)) for (int rep = 0; rep < REPS(1); ++rep) { PH_BEGIN(); (void)rep;
        { const float* cvec = ARG_IN(6); const float* cctx = ARG_IN(7); const float* ada_w = ARG_IN(8);
          for (int it = bx; it < 48; it += G) ada_item(it, cvec, cctx, ada_w, MODP, lds, tid, lane, wave); }
        for (int e = bx * 512 + tid; e < 64 * 8 + 64 * 16; e += G * 512) {
            if (e < 512) { const int pos = e >> 3, i = e & 7; const float inv = powf(10000.f, -(float)i / 8.f), a = (float)pos * inv; ROPE8[2 * e] = cosf(a); ROPE8[2 * e + 1] = sinf(a); }
            else { const int f = e - 512, pos = f >> 4, i = f & 15; const float inv = powf(10000.f, -(float)i / 16.f), a = (float)pos * inv; ROPE16[2 * f] = cosf(a); ROPE16[2 * f + 1] = sinf(a); }
        }
        LAS float* scr = (LAS float*)(lds + wave * 16384);
        for (int it = gw; it < CIMLA; it += NGW) if (!(it >= CI1 + CI2 + CI3 && it < CI1 + CI2 + CI3 + CI4)) conv_item(it, 0, ws, scr, lane);
        const u32x4 z = {0u, 0u, 0u, 0u};
        for (int e = bx * 512 + tid; e < 2 * 96 * 128; e += G * 512) { const int i = e / (96 * 128), f = e % (96 * 128);
            *(u32x4*)(ws + (i ? WS_W_MLA1 : WS_W_MLA0) + (size_t)672 * 2048 + (size_t)f * 16) = z; }
    }
    END_PH();

    if (IN_PH() && PK(2)) for (int rep = 0; rep < REPS(2); ++rep) { PH_BEGIN(); (void)rep;
        const float* npre = ARG_IN(10); const float* xin0 = ARG_IN(0); const float* xin1 = ARG_IN(1); const float* adab = ARG_IN(9);
        {
            const float* npost0 = ARG_IN(11);
            for (int it = bx; it < 9; it += G) { const int l = 0, j = it;
                for (int c = tid * 4; c < 1024; c += NWAVES * 64 * 4) { float* cf = MOD + (size_t)(l * 9 + j) * 3072;
                    *(f32x4*)(cf + c) = mod_load(MODP, adab, l, j, 2048 + c) * *(const f32x4*)(npost0 + l * 1024 + c);
                    *(f32x4*)(cf + 1024 + c) = *(const f32x4*)(npre + l * 1024 + c) * (mod_load(MODP, adab, l, j, 1024 + c) + 1.f);
                    *(f32x4*)(cf + 2048 + c) = mod_load(MODP, adab, l, j, c); } }
        }
        {
            LAS float* scr = (LAS float*)(lds + wave * 16384);
            for (int it = gw; it < 2 * CI4; it += NGW) conv_item(CI1 + CI2 + CI3 + (it & (CI4 - 1)), it >= CI4 ? 1 : 0, ws, scr, lane);
        }
        for (int chunk = gw; chunk < R / 12; chunk += NGW) {
            int curm = -1; f32x4 cB[4], cC[4];
#pragma unroll
            for (int j = 0; j < 4; ++j) { cB[j] = (f32x4){0.f, 0.f, 0.f, 0.f}; cC[j] = cB[j]; }
            for (int rr = 0; rr < 12; rr += 2) {
                f32x4 v[2][4];
#pragma unroll
                for (int q = 0; q < 2; ++q) { const int row = chunk * 12 + rr + q; const float* xr = row < RP ? xin0 + (size_t)row * D : xin1 + (size_t)(row - RP) * D;
#pragma unroll
                    for (int j = 0; j < 4; ++j) v[q][j] = *(const f32x4*)(xr + 8 * lane + 512 * (j >> 1) + 4 * (j & 1)); }
#pragma unroll
                for (int q = 0; q < 2; ++q) { const int row = chunk * 12 + rr + q, midx = mod_index(row);
                    if (midx != curm) { curm = midx;
#pragma unroll
                        for (int j = 0; j < 4; ++j) { const int c = 8 * lane + 512 * (j >> 1) + 4 * (j & 1); const f32x4 g = *(const f32x4*)(npre + c), sc = mod_load(MODP, adab, 0, midx, 1024 + c); cB[j] = g * (sc + 1.f); cC[j] = mod_load(MODP, adab, 0, midx, c); } }
                    float ss = 0.f;
#pragma unroll
                    for (int j = 0; j < 4; ++j) ss += v[q][j][0] * v[q][j][0] + v[q][j][1] * v[q][j][1] + v[q][j][2] * v[q][j][2] + v[q][j][3] * v[q][j][3];
                    const float rstd = 1.f / sqrtf(wave_sum(ss) * (1.f / D) + EPS);
#pragma unroll
                    for (int j2 = 0; j2 < 2; ++j2) { const f32x4 ha = v[q][2 * j2] * rstd * cB[2 * j2] + cC[2 * j2], hc = v[q][2 * j2 + 1] * rstd * cB[2 * j2 + 1] + cC[2 * j2 + 1];
                        u32x4 w; w.x = pk2(ha[0], ha[1]); w.y = pk2(ha[2], ha[3]); w.z = pk2(hc[0], hc[1]); w.w = pk2(hc[2], hc[3]); *(u32x4*)(Hb + (size_t)row * D + 8 * lane + 512 * j2) = w; }
                }
            }
        }
    }
    END_PH();

    for (int l = 0; l < NL; ++l) {
        const int i = l >> 1;
        if ((l & 1) == 0) {
#define WM_BASE (ws + (i ? WS_W_MLA1 : WS_W_MLA0))
#define M_WinT ((const bf16*)WM_BASE)
#define M_WuqT ((const bf16*)(WM_BASE + SZ_WIN_MLA))
#define M_WukvT ((const bf16*)(WM_BASE + SZ_WIN_MLA + SZ_WUQ))
#define M_WpT ((const bf16*)(WM_BASE + SZ_WIN_MLA + SZ_WUQ + SZ_WUKV))
#define M_WoT ((const bf16*)(WM_BASE + SZ_WIN_MLA + SZ_WUQ + SZ_WUKV + SZ_WPOOL))
            if (IN_PH() && PK(3)) for (int rep = 0; rep < REPS(3); ++rep) { PH_BEGIN(); (void)rep;
                pg8::Gemm g{Hb, M_WinT, R, 2304, 1024, 1024}; pg8::StaticOrder S; S.init(R, 2304, G, bx);
                pg8::EpiMlaIn E{CQ, CKV, GAB, VP, KRF};
                pg8::gemm_phase<pg8::EpiMlaIn, true>(lds, g, S, E);
                if (l == 0) {
                    const float* cvec = ARG_IN(6); const float* cctx = ARG_IN(7); const float* ada_w = ARG_IN(8);
                    unsigned* qt = (unsigned*)(ws + WS_CTL) + CW_QH + 64; LAS float* scr = (LAS float*)(lds + wave * 16384);
                    constexpr int NCH_SWA = (CISWA + 7) / 8;
                    for (;;) {
                        __syncthreads();
                        if (tid == 0) MISC[0] = __hip_atomic_fetch_add(qt, 1u, __ATOMIC_RELAXED, __HIP_MEMORY_SCOPE_AGENT);
                        __syncthreads();
                        const int item = (int)MISC[0];
                        if (item >= 144 + 2 * NCH_SWA) break;
                        if (item < 144) ada_item(48 + item, cvec, cctx, ada_w, MODP, lds, tid, lane, wave);
                        else { const int c2 = item - 144, inst = c2 >= NCH_SWA ? 1 : 0, r2 = (c2 - inst * NCH_SWA) * 8 + wave; if (r2 < CISWA) conv_item(CIMLA + r2, inst, ws, scr, lane); }
                    }
                }
            }
            END_PH();
            if (IN_PH() && PK(4)) for (int rep = 0; rep < REPS(4); ++rep) { PH_BEGIN(); (void)rep;
                const float* gq = ARG_IN(13) + i * 384; const float* gkv = ARG_IN(14) + i * 256;
                const float* cckv = ARG_IN(2); const float* ckr = ARG_IN(3);
                if (l == 0) {
                    const float* npost0 = ARG_IN(11); const float* npre0 = ARG_IN(10); const float* adab = ARG_IN(9);
                    for (int it = bx; it < 27; it += G) { const int l2 = 1 + it / 9, j = it % 9;
                        for (int c = tid * 4; c < 1024; c += NWAVES * 64 * 4) { float* cf = MOD + (size_t)(l2 * 9 + j) * 3072;
                            *(f32x4*)(cf + c) = mod_load(MODP, adab, l2, j, 2048 + c) * *(const f32x4*)(npost0 + l2 * 1024 + c);
                            *(f32x4*)(cf + 1024 + c) = *(const f32x4*)(npre0 + l2 * 1024 + c) * (mod_load(MODP, adab, l2, j, 1024 + c) + 1.f);
                            *(f32x4*)(cf + 2048 + c) = mod_load(MODP, adab, l2, j, c); } }
                }
                const int half = 1 << (lane >> 4);
                float pm[16];
#pragma unroll
                for (int k = 0; k < 16; ++k) pm[k] = (k - 8 >= -half && k - 8 < half) ? 1.f : 0.f;
                f32x4 gq0 = {0.f, 0.f, 0.f, 0.f}, gq1 = gq0, gk0 = gq0, gk1 = gq0;
                if (lane < 48) { gq0 = *(const f32x4*)(gq + 8 * lane); gq1 = *(const f32x4*)(gq + 8 * lane + 4); }
                if (lane < 32) { gk0 = *(const f32x4*)(gkv + 8 * lane); gk1 = *(const f32x4*)(gkv + 8 * lane + 4); }
                for (int chunk = gw; chunk < R / 12; chunk += NGW) {
                    const int r0 = chunk * 12;
                    const int xl = r0 + 18; const int Bs = xl < RP ? (xl & ~255) : (xl >= R ? R : RP + ((xl - RP) & ~2047)); const bool hasB = Bs > r0 - 8;
                    u32x4 win[27];
#pragma unroll
                    for (int k = 0; k < 27; ++k) { int x = r0 - 8 + k; x = x < 0 ? 0 : (x >= R ? R - 1 : x); win[k] = *(const u32x4*)(VP + (size_t)x * 512 + 8 * lane); }
                    {
#pragma unroll
                        for (int hb = 0; hb < 2; ++hb) {
                            u32x4 wq[6], wk[6]; float kr[6];
#pragma unroll
                            for (int q = 0; q < 6; ++q) { const int row = r0 + 6 * hb + q; const bool prompt = row < RP; const int rk = prompt ? row : RP + ((row - RP) >> 11) * 2304 + ((row - RP) & 2047);
                                wq[q] = (u32x4){0u, 0u, 0u, 0u}; wk[q] = wq[q]; kr[q] = 0.f;
                                if (lane < 48) wq[q] = *(const u32x4*)(CQ + (size_t)row * 384 + 8 * lane);
                                if (lane < 32) { wk[q] = *(const u32x4*)(CKV + (size_t)rk * 256 + 8 * lane); kr[q] = KRF[(size_t)row * 32 + lane]; } }
#pragma unroll
                            for (int q = 0; q < 6; ++q) { const int row = r0 + 6 * hb + q; const bool prompt = row < RP; const int b = prompt ? row >> 8 : (row - RP) >> 11, t = prompt ? row & 255 : (row - RP) & 2047;
                                const int rk = prompt ? row : RP + b * 2304 + t;
                                { const u32x4 w = wq[q]; float v[8] = {bflo(w.x), bfhi(w.x), bflo(w.y), bfhi(w.y), bflo(w.z), bfhi(w.z), bflo(w.w), bfhi(w.w)}; float ss = 0.f;
#pragma unroll
                                  for (int e = 0; e < 8; ++e) ss += v[e] * v[e];
                                  const float rstd = 1.f / sqrtf(wave_sum(ss) * (1.f / 384.f) + EPS);
                                  if (lane < 48) { u32x4 o; o.x = pk2(v[0] * rstd * gq0[0], v[1] * rstd * gq0[1]); o.y = pk2(v[2] * rstd * gq0[2], v[3] * rstd * gq0[3]); o.z = pk2(v[4] * rstd * gq1[0], v[5] * rstd * gq1[1]); o.w = pk2(v[6] * rstd * gq1[2], v[7] * rstd * gq1[3]);
                                      if (!(REPS(4) == 2 && rep == 0)) *(u32x4*)(CQ + (size_t)row * 384 + 8 * lane) = o; } }
                                { const u32x4 w = wk[q]; float v[8] = {bflo(w.x), bfhi(w.x), bflo(w.y), bfhi(w.y), bflo(w.z), bfhi(w.z), bflo(w.w), bfhi(w.w)}; float ss = 0.f;
#pragma unroll
                                  for (int e = 0; e < 8; ++e) ss += v[e] * v[e];
                                  const float rstd = 1.f / sqrtf(wave_sum(ss) * (1.f / 256.f) + EPS);
                                  if (lane < 32) { const f32x4 y0 = {v[0] * rstd * gk0[0], v[1] * rstd * gk0[1], v[2] * rstd * gk0[2], v[3] * rstd * gk0[3]}, y1 = {v[4] * rstd * gk1[0], v[5] * rstd * gk1[1], v[6] * rstd * gk1[2], v[7] * rstd * gk1[3]};
                                      u32x4 o; o.x = pk2(y0[0], y0[1]); o.y = pk2(y0[2], y0[3]); o.z = pk2(y1[0], y1[1]); o.w = pk2(y1[2], y1[3]);
                                      if (!(REPS(4) == 2 && rep == 0)) *(u32x4*)(CKV + (size_t)rk * 256 + 8 * lane) = o;
                                      if (prompt) { float* st = out + OFF_CKV + ((size_t)(b * 2 + i) * 256 + t) * 256 + 8 * lane; *(f32x4*)st = y0; *(f32x4*)(st + 4) = y1; } } }
                                { const float kv = kr[q];
                                  const float pr = __int_as_float(__builtin_amdgcn_update_dpp(0, __float_as_int(kv), 0x128, 0xf, 0xf, true));
                                  if (lane < 32) { if (prompt) out[OFF_KR + ((size_t)(b * 2 + i) * 256 + t) * 32 + lane] = kv;
                                      const int part = lane >> 4, fi = lane & 7; const bool isx2 = (lane & 8) != 0; const float x1 = isx2 ? pr : kv, x2 = isx2 ? kv : pr;
                                      float o1 = x1, o2 = x2;
                                      if (!prompt) { const int pos = part ? (t & 63) : (t >> 6); const float cs = ROPE8[(pos * 8 + fi) * 2], sn = ROPE8[(pos * 8 + fi) * 2 + 1]; o1 = x1 * cs - x2 * sn; o2 = x1 * sn + x2 * cs; }
                                      KRB[(size_t)rk * 32 + (isx2 ? 16 : 0) + part * 8 + fi] = (bf16)f2bf(isx2 ? o2 : o1); } }
                            }
                            asm volatile("" ::: "memory");
                        }
                    }
#pragma unroll
                    for (int ri = 0; ri < 12; ++ri) {
                        const bool sideR = (r0 + ri) >= Bs;
                        float sA[8]; float cntf = 0.f;
#pragma unroll
                        for (int e = 0; e < 8; ++e) sA[e] = 0.f;
#pragma unroll
                        for (int k = 0; k < 16; ++k) { const int x = r0 + ri + k - 8; const bool valid = !hasB || ((x >= Bs) == sideR); const float m = valid ? pm[k] : 0.f; const u32x4 w = win[ri + k]; cntf += m;
                            sA[0] += bflo(w.x) * m; sA[1] += bfhi(w.x) * m; sA[2] += bflo(w.y) * m; sA[3] += bfhi(w.y) * m;
                            sA[4] += bflo(w.z) * m; sA[5] += bfhi(w.z) * m; sA[6] += bflo(w.w) * m; sA[7] += bfhi(w.w) * m; }
                        const float ic = 1.f / cntf; const u32x4 w = win[ri + 8];
                        bf16* gp = GAB + (size_t)(r0 + ri) * 1024 + 512 + 8 * lane; const u32x4 gg = *(const u32x4*)gp;
                        u32x4 o; o.x = pk2((sA[0] * ic - bflo(w.x)) * bflo(gg.x), (sA[1] * ic - bfhi(w.x)) * bfhi(gg.x)); o.y = pk2((sA[2] * ic - bflo(w.y)) * bflo(gg.y), (sA[3] * ic - bfhi(w.y)) * bfhi(gg.y));
                        o.z = pk2((sA[4] * ic - bflo(w.z)) * bflo(gg.z), (sA[5] * ic - bfhi(w.z)) * bfhi(gg.z)); o.w = pk2((sA[6] * ic - bflo(w.w)) * bflo(gg.w), (sA[7] * ic - bfhi(w.w)) * bfhi(gg.w));
                        if (!(REPS(4) == 2 && rep == 0)) *(u32x4*)gp = o;
                    }
                }
                for (int ci = gw; ci < 2048; ci += NGW) {
                    const int b = ci >> 8, p = ci & 255, rk = RP + b * 2304 + 2048 + p;
                    if (lane < 32) { const float* sp = cckv + ((size_t)(b * 2 + i) * 256 + p) * 256 + 8 * lane; const f32x4 y0 = *(const f32x4*)sp, y1 = *(const f32x4*)(sp + 4);
                        u32x4 o; o.x = pk2(y0[0], y0[1]); o.y = pk2(y0[2], y0[3]); o.z = pk2(y1[0], y1[1]); o.w = pk2(y1[2], y1[3]); *(u32x4*)(CKV + (size_t)rk * 256 + 8 * lane) = o; }
                    if (lane < 16) { const int part = lane >> 3, fi = lane & 7; const float* sp = ckr + ((size_t)(b * 2 + i) * 256 + p) * 32 + part * 16 + fi;
                        KRB[(size_t)rk * 32 + lane] = (bf16)f2bf(sp[0]); KRB[(size_t)rk * 32 + 16 + lane] = (bf16)f2bf(sp[8]); }
                }
            }
            END_PH();
            if (IN_PH() && PK(5)) for (int rep = 0; rep < REPS(5); ++rep) { PH_BEGIN(); (void)rep;
                if (G2M & 1) { pg8::Gemm g{CQ, M_WuqT, R, 768, 384, 384}; pg8::StaticOrder S; S.init(R, 768, G, (bx + 64) % G); pg8::EpiQ E{Hb, ROPE8}; pg8::gemm_phase<pg8::EpiQ, true>(lds, g, S, E); }
                if (G2M & 2) { pg8::Gemm g{CKV, M_WukvT, RK, 1024, 256, 256}; pg8::StaticOrder S; S.init(RK, 1024, G, (bx + 160) % G); pg8::EpiBf16 E{KN, 512, 512, (size_t)(WS_V - WS_KN) / 2, 0}; pg8::gemm_phase<pg8::EpiBf16, true>(lds, g, S, E); }
            }
            END_PH();
            if (IN_PH() && PK(6)) { PH_BEGIN();
                struct MlaMk { bf16 *hb, *kn, *vv, *gab, *krb; int wave;
                    __device__ __forceinline__ void operator()(int un, att::Desc& d) const {
                        d.n_b = 0; d.row_b = 0; d.key_b = 0; d.qpos = 0; d.sink2 = 0.f; d.has_sink = 0; d.k1 = krb;
                        int h, qrow, krow;
                        if (un < 512) { const int b = un >> 6, qb = un & 7; h = (un >> 3) & 7; qrow = RP + b * 2048 + qb * 256 + wave * 32; krow = RP + b * 2304; d.n_a = 36; }
                        else { const int v = un - 512, b = v >> 3; h = v & 7; qrow = b * 256 + wave * 32; krow = b * 256; d.n_a = 4; }
                        d.row_a = krow; d.qptr = hb + (size_t)qrow * 768 + h * 96; d.k0 = kn + h * 64; d.v = vv + h * 64; d.optr = gab + (size_t)qrow * 1024 + h * 64; } };
                const MlaMk mk{Hb, KN, VV, GAB, KRB, wave};
                att::attn_phase<0, MlaMk>((LAS char*)lds, mk, vcu, G, 768);
            }
            END_PH();
        } else {
#define WS_BASE (ws + (i ? WS_W_SWA1 : WS_W_SWA0))
#define S_WinT ((const bf16*)WS_BASE)
#define S_WoT ((const bf16*)(WS_BASE + SZ_WIN_SWA))
            if (IN_PH() && PK(8)) for (int rep = 0; rep < REPS(8); ++rep) { PH_BEGIN(); (void)rep;
                const float* ck = ARG_IN(4); const float* cv = ARG_IN(5);
                for (int e = bx * 512 + tid; e < 2 * 2048 * 32; e += G * 512) {
                    const int which = e / (2048 * 32), f = e % (2048 * 32), rowi = f >> 5, ch = f & 31, b = rowi >> 8, p = rowi & 255;
                    const float* s = (which ? cv : ck) + ((size_t)(b * 2 + i) * 256 + p) * 256 + 8 * ch; const f32x4 y0 = *(const f32x4*)s, y1 = *(const f32x4*)(s + 4);
                    u32x4 o; o.x = pk2(y0[0], y0[1]); o.y = pk2(y0[2], y0[3]); o.z = pk2(y1[0], y1[1]); o.w = pk2(y1[2], y1[3]);
                    *(u32x4*)((which ? SV : SK) + (size_t)(RP + b * 2304 + 2048 + p) * 256 + 8 * ch) = o;
                }
                pg8::Gemm g{Hb, S_WinT, R, 2560, 1024, 1024}; pg8::StaticOrder S; S.init(R, 2560, G, bx);
                pg8::EpiSwaIn E{SQ, SK, SV, GAB, out + OFF_K + (size_t)i * 65536, out + OFF_V + (size_t)i * 65536, ROPE16};
                pg8::gemm_phase<pg8::EpiSwaIn, true>(lds, g, S, E);
                if (l == 1) {
                    unsigned* qt = (unsigned*)(ws + WS_CTL) + CW_QH + 80; LAS float* scr = (LAS float*)(lds + wave * 16384);
                    constexpr int NCH_MLA = (CIMLA + 7) / 8;
                    for (;;) {
                        __syncthreads();
                        if (tid == 0) MISC[0] = __hip_atomic_fetch_add(qt, 1u, __ATOMIC_RELAXED, __HIP_MEMORY_SCOPE_AGENT);
                        __syncthreads();
                        const int item = (int)MISC[0];
                        if (item >= NCH_MLA) break;
                        const int r2 = item * 8 + wave; if (r2 < CIMLA && !(r2 >= CI1 + CI2 + CI3 && r2 < CI1 + CI2 + CI3 + CI4)) conv_item(r2, 1, ws, scr, lane);
                    }
                }
            }
            END_PH();
            if (IN_PH() && PK(9)) { PH_BEGIN();
                struct SwaMk { bf16 *sq, *sk, *sv, *gab; const float* sink; int wave, lane;
                    __device__ __forceinline__ void operator()(int un, att::Desc& d) const {
                        d.k1 = nullptr; d.has_sink = 1; d.n_a = 4;
                        int kvh, qrow, q0;
                        if (un < 1024) { const int b = un >> 7, blk = un & 31; kvh = (un >> 5) & 3; q0 = blk * 64; const int kb = RP + b * 2304;
                            qrow = RP + b * 2048 + q0 + (wave & 1) * 32; d.row_a = kb + 2048;
                            const int kfirst = q0 - 128 > 0 ? q0 - 128 : 0, klast = q0 + 128 < 2048 - 64 ? q0 + 128 : 2048 - 64;
                            d.key_b = kfirst; d.row_b = kb + kfirst; d.n_b = (klast - kfirst) / 64 + 1; }
                        else { const int v = un - 1024, b = v >> 4, blk = v & 3; kvh = (v >> 2) & 3; q0 = blk * 64; qrow = b * 256 + q0 + (wave & 1) * 32; d.row_a = b * 256; d.n_b = 0; d.row_b = 0; d.key_b = 0; }
                        const int head = kvh * 4 + (wave >> 1);
                        d.qpos = q0 + (wave & 1) * 32 + (lane & 31); d.sink2 = sink[head] * LOG2E;
                        d.qptr = sq + (size_t)qrow * 1024 + head * 64; d.k0 = sk + kvh * 64; d.v = sv + kvh * 64; d.optr = gab + (size_t)qrow * 1024 + head * 64; } };
                const SwaMk mk{SQ, SK, SV, GAB, ARG_IN(21) + i * 16, wave, lane};
                att::attn_phase<1, SwaMk>((LAS char*)lds, mk, vcu, G, 1536);
            }
            END_PH();
        }
        if (IN_PH() && PK(11)) { PH_BEGIN();
            unsigned* ctlw = (unsigned*)(ws + WS_CTL); unsigned* cnt = ctlw + CW_CNT + l * 2048; unsigned* qh = ctlw + CW_QH + l * 16; unsigned* tmo = ctlw + CW_TMO;
            {
                const bf16* WoT = (l & 1) ? (const bf16*)(ws + (i ? WS_W_SWA1 : WS_W_SWA0) + SZ_WIN_SWA) : (const bf16*)(ws + (i ? WS_W_MLA1 : WS_W_MLA0) + SZ_WIN_MLA + SZ_WUQ + SZ_WUKV + SZ_WPOOL);
                pg8::Gemm g{GAB, WoT, R, 1024, 1024, 1024}; pg8::PanelOrder S{G, vcu, 384}; pg8::EpiOutPub E{Hb, cnt};
                pg8::gemm_phase<pg8::EpiOutPub, true, pg8::PanelOrder>(lds, g, S, E);
            }
            if (TS_A >= 0 && l == 1 && threadIdx.x == 0 && blockIdx.x == 4) ((unsigned long long*)((unsigned char*)arg_ptr(24) + WS_CTL + 100 * 1024))[20] = __builtin_amdgcn_s_memrealtime();
            const float* xin0 = ARG_IN(0); const float* xin1 = ARG_IN(1); const bool has_next = l + 1 < NL;
            const int panel = vcu >= 128 ? (vcu - 128) >> 1 : 64 + (vcu >> 2);
            const int rbase = vcu >= 128 ? panel * 256 + ((vcu - 128) & 1) * 128 : panel * 256 + (vcu & 3) * 64;
            const int nrw = vcu >= 128 ? 16 : 8;
#define WAIT_PANEL() do { if (wave == 0) { unsigned sp = 0; \
                while (__hip_atomic_load(cnt + 16 * panel, __ATOMIC_RELAXED, __HIP_MEMORY_SCOPE_AGENT) < 32u) { __builtin_amdgcn_s_sleep(2); \
                    if ((++sp & 1023u) == 0u) { if (__hip_atomic_load(tmo, __ATOMIC_RELAXED, __HIP_MEMORY_SCOPE_AGENT) || sp > (1u << 22)) { __hip_atomic_store(tmo, 1u, __ATOMIC_RELAXED, __HIP_MEMORY_SCOPE_AGENT); break; } } } \
                __builtin_amdgcn_fence(__ATOMIC_ACQUIRE, "agent"); asm volatile("s_waitcnt vmcnt(0)" ::: "memory"); } \
            __syncthreads(); } while (0)
            {
                const int row0 = rbase + wave * nrw, midx = mod_index(row0); const int ln = has_next ? l + 1 : l;
                const float* cf = MOD + (size_t)(l * 9 + midx) * 3072; const float* cfn = MOD + (size_t)(ln * 9 + midx) * 3072;
                f32x4 cA[4], cB[4], cC[4];
#pragma unroll
                for (int k = 0; k < 4; ++k) { const int c = 8 * lane + 512 * (k >> 1) + 4 * (k & 1); cA[k] = *(const f32x4*)(cf + c); cB[k] = *(const f32x4*)(cfn + 1024 + c); cC[k] = *(const f32x4*)(cfn + 2048 + c); }
#define FINAL_ROW(row, xv, ov) do { float ss = 0.f; \
                    _Pragma("unroll") for (int k = 0; k < 4; ++k) ss += ov[k][0] * ov[k][0] + ov[k][1] * ov[k][1] + ov[k][2] * ov[k][2] + ov[k][3] * ov[k][3]; \
                    const float rstd = 1.f / sqrtf(wave_sum(ss) * (1.f / D) + EPS); float s2 = 0.f; \
                    _Pragma("unroll") for (int k = 0; k < 4; ++k) { xv[k] = xv[k] + ov[k] * rstd * cA[k]; s2 += xv[k][0] * xv[k][0] + xv[k][1] * xv[k][1] + xv[k][2] * xv[k][2] + xv[k][3] * xv[k][3]; } \
                    if (has_next) { const float r2 = 1.f / sqrtf(wave_sum(s2) * (1.f / D) + EPS); \
                        _Pragma("unroll") for (int j2 = 0; j2 < 2; ++j2) { const f32x4 xa = xv[2 * j2], xc = xv[2 * j2 + 1]; \
                            u32x4 wx; wx.x = pk2(xa[0], xa[1]); wx.y = pk2(xa[2], xa[3]); wx.z = pk2(xc[0], xc[1]); wx.w = pk2(xc[2], xc[3]); \
                            *(u32x4*)((bf16*)out + (size_t)(row) * 2048 + 8 * lane + 512 * j2) = wx; \
                            const f32x4 ha = xa * r2 * cB[2 * j2] + cC[2 * j2], hc = xc * r2 * cB[2 * j2 + 1] + cC[2 * j2 + 1]; \
                            u32x4 wh; wh.x = pk2(ha[0], ha[1]); wh.y = pk2(ha[2], ha[3]); wh.z = pk2(hc[0], hc[1]); wh.w = pk2(hc[2], hc[3]); \
                            *(u32x4*)(Hb + (size_t)(row) * D + 8 * lane + 512 * j2) = wh; } \
                    } else { _Pragma("unroll") for (int k = 0; k < 4; ++k) *(f32x4*)(out + (size_t)(row) * D + 8 * lane + 512 * (k >> 1) + 4 * (k & 1)) = xv[k]; } } while (0)
#define UNPK(W_, LO_, HI_) do { const u32x4 t_ = (W_); LO_ = (f32x4){bflo(t_.x), bfhi(t_.x), bflo(t_.y), bfhi(t_.y)}; HI_ = (f32x4){bflo(t_.z), bfhi(t_.z), bflo(t_.w), bfhi(t_.w)}; } while (0)
                if (l == 0) {
                    WAIT_PANEL();
                    for (int rr = 0; rr < nrw; rr += 4) {
                        f32x4 xq[4][4]; u32x4 oq[4][2];
#pragma unroll
                        for (int q = 0; q < 4; ++q) { const int row = row0 + rr + q; const float* xr = row < RP ? xin0 + (size_t)row * D : xin1 + (size_t)(row - RP) * D;
#pragma unroll
                            for (int k = 0; k < 4; ++k) xq[q][k] = *(const f32x4*)(xr + 8 * lane + 512 * (k >> 1) + 4 * (k & 1));
#pragma unroll
                            for (int j2 = 0; j2 < 2; ++j2) oq[q][j2] = *(const u32x4*)(Hb + (size_t)row * D + 8 * lane + 512 * j2); }
#pragma unroll
                        for (int q = 0; q < 4; ++q) { f32x4 ov[4]; UNPK(oq[q][0], ov[0], ov[1]); UNPK(oq[q][1], ov[2], ov[3]); FINAL_ROW(row0 + rr + q, xq[q], ov); }
                    }
                } else {
                    u32x4 xw[8][2], ow[8][2];
#pragma unroll
                    for (int q = 0; q < 8; ++q)
#pragma unroll
                        for (int j2 = 0; j2 < 2; ++j2) xw[q][j2] = *(const u32x4*)((const bf16*)out + (size_t)(row0 + q) * 2048 + 8 * lane + 512 * j2);
                    WAIT_PANEL();
                    for (int rr = 0; rr < nrw; rr += 8) {
                        if (rr > 0) {
#pragma unroll
                            for (int q = 0; q < 8; ++q)
#pragma unroll
                                for (int j2 = 0; j2 < 2; ++j2) xw[q][j2] = *(const u32x4*)((const bf16*)out + (size_t)(row0 + rr + q) * 2048 + 8 * lane + 512 * j2);
                        }
#pragma unroll
                        for (int q = 0; q < 8; ++q)
#pragma unroll
                            for (int j2 = 0; j2 < 2; ++j2) ow[q][j2] = *(const u32x4*)(Hb + (size_t)(row0 + rr + q) * D + 8 * lane + 512 * j2);
#pragma unroll
                        for (int q = 0; q < 8; ++q) { f32x4 xv[4], ov[4]; UNPK(xw[q][0], xv[0], xv[1]); UNPK(xw[q][1], xv[2], xv[3]); UNPK(ow[q][0], ov[0], ov[1]); UNPK(ow[q][1], ov[2], ov[3]); FINAL_ROW(row0 + rr + q, xv, ov); }
                    }
                }
#undef FINAL_ROW
#undef UNPK
#undef WAIT_PANEL
            }
            if (TS_A >= 0 && l == 1 && threadIdx.x == 0 && blockIdx.x == 4) { asm volatile("s_waitcnt vmcnt(0)" ::: "memory"); ((unsigned long long*)((unsigned char*)arg_ptr(24) + WS_CTL + 100 * 1024))[21] = __builtin_amdgcn_s_memrealtime(); }
        }
        END_PH();
    }
    if (TS_A >= 0 && blockIdx.x == 0 && threadIdx.x == 0) { const unsigned long long* ts = (const unsigned long long*)((unsigned char*)arg_ptr(24) + WS_CTL + 100 * 1024);
        const float us = (float)(ts[TS_B] - ts[TS_A]) * 0.01f; ((float*)arg_ptr(23))[OFF_KR] += 0.5f + us / TS_SCALE; }
#undef IN_PH
#undef END_PH
}


extern "C" void kernel_launch(void* const* d_in, const int* in_sizes, int n_in, void* d_out, int out_size, void* d_ws, size_t ws_size, hipStream_t stream) {
    static int grid = 0;
    if (grid == 0) {
        if (n_in != 23 || out_size != OUT_TOTAL || ws_size < WS_END) { fprintf(stderr, "kernel_launch: unexpected shapes (n_in %d out %d ws %zu)\n", n_in, out_size, ws_size); grid = -1; return; }
        int dev = 0, cus = 0;
        if (hipGetDevice(&dev) != hipSuccess || hipDeviceGetAttribute(&cus, hipDeviceAttributeMultiprocessorCount, dev) != hipSuccess) { grid = -1; return; }
        if (hipFuncSetAttribute((const void*)fwd_kernel, hipFuncAttributeMaxDynamicSharedMemorySize, LDS_BYTES) != hipSuccess) { fprintf(stderr, "kernel_launch: hipFuncSetAttribute failed\n"); grid = -1; return; }
        int per_cu = 0;
        if (hipOccupancyMaxActiveBlocksPerMultiprocessor(&per_cu, (const void*)fwd_kernel, NWAVES * 64, LDS_BYTES) != hipSuccess || per_cu < 1) { fprintf(stderr, "kernel_launch: occupancy query says %d\n", per_cu); }
        (void)hipGetLastError();
        grid = cus;
    }
    if (grid < 0) return;
    (void)hipMemsetAsync((char*)d_ws + WS_CTL, 0, CTL_ZERO_BYTES, stream);
    Args a{};
    for (int i = 0; i < 23; ++i) a.in[i] = (const float*)d_in[i];
    a.out = (float*)d_out; a.ws = (unsigned char*)d_ws;
#if MK_PER_PHASE
    for (int p = 0; p < N_PHASES; ++p) { a.ph_lo = p; a.ph_hi = p + 1; hipLaunchKernelGGL(fwd_kernel, dim3(grid), dim3(NWAVES * 64), LDS_BYTES, stream, a); }
#else
    a.ph_lo = 0; a.ph_hi = N_PHASES;
    hipLaunchKernelGGL(fwd_kernel, dim3(grid), dim3(NWAVES * 64), LDS_BYTES, stream, a);
#endif
}
```

```cpp
#include <hip/hip_runtime.h>
#include <cstdio>
#include <cstdint>

#ifndef MK_PER_PHASE
#define MK_PER_PHASE 0
#endif

#define GAS __attribute__((address_space(1)))
#define LAS __attribute__((address_space(3)))
typedef unsigned short bf16;
typedef short bf16x8 __attribute__((ext_vector_type(8)));
typedef short s16x4 __attribute__((ext_vector_type(4)));
typedef float f32x4 __attribute__((ext_vector_type(4)));
typedef float f32x2 __attribute__((ext_vector_type(2)));
typedef float f32x16 __attribute__((ext_vector_type(16)));
typedef unsigned u32x4 __attribute__((ext_vector_type(4)));
typedef unsigned u32x2 __attribute__((ext_vector_type(2)));
typedef __bf16 bf16x2_t __attribute__((ext_vector_type(2)));

constexpr int D = 1024, RP = 8192, RS = 16384, R = RP + RS;
constexpr int RK = RP + 8 * 2304;
constexpr int NL = 4;
constexpr float EPS = 1e-6f, LOG2E = 1.4426950408889634f;
constexpr float MLA_SC = 0.10206207261596577f * LOG2E;
constexpr float SWA_SC = 0.125f * LOG2E;
constexpr int OFF_CKV = 25165824, OFF_KR = 29360128, OFF_K = 29884416, OFF_V = 34078720, OUT_TOTAL = 38273024;

constexpr size_t MiB = 1u << 20;
constexpr size_t WS_CTL = 0, CTL_ZERO_BYTES = 128 * 1024;
constexpr int CW_CNT = 8192, CW_QH = 16384, CW_TMO = 17408;
constexpr size_t WS_MOD = 1 * MiB;
constexpr size_t WS_ROPE8 = 1 * MiB + 512 * 1024;
constexpr size_t WS_ROPE16 = WS_ROPE8 + 4096;
constexpr size_t SZ_WIN_MLA = 2304ull * 1024 * 2, SZ_WUQ = 768ull * 384 * 2, SZ_WUKV = 1024ull * 256 * 2, SZ_WPOOL = 512ull * 512 * 2,
                 SZ_WOUT = 1024ull * 1024 * 2, SZ_WIN_SWA = 2560ull * 1024 * 2;
constexpr size_t WS_W = 2 * MiB;
constexpr size_t SZ_W_MLA = SZ_WIN_MLA + SZ_WUQ + SZ_WUKV + SZ_WPOOL + SZ_WOUT, SZ_W_SWA = SZ_WIN_SWA + SZ_WOUT;
constexpr size_t WS_W_MLA0 = WS_W, WS_W_MLA1 = WS_W + SZ_W_MLA, WS_W_SWA0 = WS_W + 2 * SZ_W_MLA, WS_W_SWA1 = WS_W_SWA0 + SZ_W_SWA;
static_assert(WS_W_SWA1 + SZ_W_SWA <= 34 * MiB, "weights");
constexpr size_t WS_H = 34 * MiB;
constexpr size_t WS_GAB = 82 * MiB;
constexpr size_t WS_CQ = 130 * MiB;
constexpr size_t WS_CKV = 148 * MiB;
constexpr size_t WS_KRB = 161 * MiB;
constexpr size_t WS_KRF = 163 * MiB;
constexpr size_t WS_KN = 166 * MiB;
constexpr size_t WS_V = 192 * MiB;
constexpr size_t WS_PO = 218 * MiB;
constexpr size_t WS_SK = 178 * MiB;
constexpr size_t WS_SV = 191 * MiB;
constexpr size_t WS_MODP = 242 * MiB;
constexpr size_t WS_END = 244 * MiB;

__device__ __forceinline__ unsigned f2bf(float f) { unsigned u = __builtin_bit_cast(unsigned, f); return (u + 0x7fffu + ((u >> 16) & 1u)) >> 16; }
__device__ __forceinline__ unsigned pk2(float lo, float hi) { f32x2 v = {lo, hi}; bf16x2_t b = __builtin_convertvector(v, bf16x2_t); return __builtin_bit_cast(unsigned, b); }
__device__ __forceinline__ float bflo(unsigned w) { return __uint_as_float(w << 16); }
__device__ __forceinline__ float bfhi(unsigned w) { return __uint_as_float(w & 0xffff0000u); }
__device__ __forceinline__ float silu_fast(float x) { return x * __builtin_amdgcn_rcpf(1.f + __builtin_amdgcn_exp2f(-x * LOG2E)); }
#define DPP_ADD(v, ctrl) ((v) + __int_as_float(__builtin_amdgcn_update_dpp(0, __float_as_int(v), (ctrl), 0xf, 0xf, true)))
__device__ __forceinline__ float wave_sum(float v) {
    v = DPP_ADD(v, 0xB1); v = DPP_ADD(v, 0x4E); v = DPP_ADD(v, 0x124); v = DPP_ADD(v, 0x128);
    { auto rr = __builtin_amdgcn_permlane16_swap(__float_as_uint(v), __float_as_uint(v), false, false); v = __uint_as_float(rr[0]) + __uint_as_float(rr[1]); }
    { auto rr = __builtin_amdgcn_permlane32_swap(__float_as_uint(v), __float_as_uint(v), false, false); v = __uint_as_float(rr[0]) + __uint_as_float(rr[1]); }
    return v;
}
#define LDS_WAIT() asm volatile("s_waitcnt lgkmcnt(0)" ::: "memory")
__device__ __forceinline__ int opaque_tid() { int t = threadIdx.x; asm volatile("" : "+v"(t)); return t; }

namespace pg8 {
typedef unsigned short bf16_t;
constexpr int BM = 256, BK = 64, HALF = 128, HTB = HALF * BK * 2, STAGE_BYTES = 8 * HTB, NXCD = 8, WGM = 8;
__host__ __device__ __forceinline__ int lds_byte(int r, int c) { const int st = (r >> 4) * 2 + (c >> 5), rr = r & 15, cc = c & 31, ob = rr * 64 + cc * 2; return st * 1024 + (ob ^ (((ob >> 9) & 1) << 5)); }
__host__ __device__ __forceinline__ void stage_rc(int b, int& Rr, int& C) { const int st = b / 1024, sb = b % 1024, swz = sb ^ (((sb >> 9) & 1) << 5); Rr = (st >> 1) * 16 + swz / 64; C = (st & 1) * 32 + (swz % 64) / 2; }
__host__ __device__ __forceinline__ int perm32(int rho) { const int n = rho >> 4, i = rho & 15; return 8 * (i >> 2) + 4 * n + (i & 3); }
struct Unit { int pm, pn; };
struct Gemm { const bf16_t* A; const bf16_t* Bt; int M, N, K, lda; };
struct StaticOrder {
    int nM, nN, nwg, G, c;
    __device__ void init(int M, int N, int G_, int c_) { nM = M / BM; nN = N / BM; nwg = nM * nN; G = G_; c = c_; }
    __device__ bool next(int i, Unit& u) const {
        const long L = (long)i * G + c; if (L >= nwg) return false;
        int wgid = (int)L; { const int q = nwg / NXCD, r = nwg % NXCD, xcd = wgid % NXCD, off = wgid / NXCD; wgid = (xcd < r ? xcd * (q + 1) : r * (q + 1) + (xcd - r) * q) + off; }
        const int nig = WGM * nN, gid = wgid / nig, fm = gid * WGM, gsz = (nM - fm) < WGM ? (nM - fm) : WGM;
        u.pm = fm + ((wgid % nig) % gsz); u.pn = (wgid % nig) / gsz; return true;
    }
};
struct PanelOrder {
    int G, v, nunits;
    __device__ bool next(int i, Unit& u) const { const int L = i * G + v; if (L >= nunits) return false; u.pm = L >> 2; u.pn = L & 3; return true; }
};
template <class Epi, bool ALIGN_EPI, class Sched = StaticOrder>
__device__ __forceinline__ void gemm_phase(LAS unsigned char* lds, const Gemm g, const Sched& S, const Epi& E) {
    const int tid = opaque_tid(), wid = __builtin_amdgcn_readfirstlane(tid >> 6), lane = tid & 63, wr = wid >> 2, wc = wid & 3, fr = lane & 15, fq = lane >> 4;
    const int K = g.K, nt = K / BK, lda = g.lda;
    unsigned voffA[2], voffB[2];
#pragma unroll
    for (int i = 0; i < 2; ++i) { int Rr, C; stage_rc(tid * 16 + i * 8192, Rr, C); const int Rb = Epi::PERM ? ((Rr & ~31) + perm32(Rr & 31)) : Rr;
        voffA[i] = (unsigned)(Rr * lda + C) * 2u; voffB[i] = (unsigned)(Rb * K + C) * 2u; }
    const size_t kstep = (size_t)(BK * 2);
    const size_t hA = (size_t)HALF * lda * 2, hB = (size_t)HALF * K * 2, tA = 2 * hA, tB = 2 * hB;
    const unsigned ldsw = (unsigned)wid * 1024u;
    const int aoff = lds_byte(wr * 64 + fr, fq * 8), boff = lds_byte(wc * 32 + fr, fq * 8);
#define PG8_SA(b, h) (((b) * 2 + (h)) * HTB)
#define PG8_SB(b, h) ((4 + (b) * 2 + (h)) * HTB)
#define PG8_STAGE(bufoff, gbase, voff) do { _Pragma("unroll") for (int _i = 0; _i < 2; ++_i) \
        __builtin_amdgcn_global_load_lds((const unsigned*)((const char*)(gbase) + (voff)[_i]), (LAS unsigned*)(lds + (bufoff) + ldsw + _i * 8192), 16, 0, 0); } while (0)
#define PG8_LDA(dst, b, h) do { _Pragma("unroll") for (int m = 0; m < 4; ++m) _Pragma("unroll") for (int k = 0; k < 2; ++k) dst[m][k] = *(const LAS bf16x8*)(lds + PG8_SA(b, h) + aoff + m * 2048 + k * 1024); } while (0)
#define PG8_LDB(dst, b, h) do { _Pragma("unroll") for (int n = 0; n < 2; ++n) _Pragma("unroll") for (int k = 0; k < 2; ++k) dst[n][k] = *(const LAS bf16x8*)(lds + PG8_SB(b, h) + boff + n * 2048 + k * 1024); } while (0)
#define PG8_MMA(ai, bj, At, Bt) do { __builtin_amdgcn_s_setprio(1); _Pragma("unroll") for (int m = 0; m < 4; ++m) _Pragma("unroll") for (int n = 0; n < 2; ++n) _Pragma("unroll") for (int k = 0; k < 2; ++k) \
        acc[ai][bj][m][n] = __builtin_amdgcn_mfma_f32_16x16x32_bf16(Bt[n][k], At[m][k], acc[ai][bj][m][n], 0, 0, 0); __builtin_amdgcn_s_setprio(0); } while (0)
#define PG8_WAIT_V(n) asm volatile("s_waitcnt vmcnt(" #n ")" ::: "memory")
#define PG8_WAIT_L(n) asm volatile("s_waitcnt lgkmcnt(" #n ")" ::: "memory")
#define PG8_BAR __builtin_amdgcn_s_barrier()
#define PG8_SCHED __builtin_amdgcn_sched_barrier(0)
    Unit cur, nxt; int ui = 0;
    if (!S.next(0, cur)) return;
    f32x4 acc[2][2][4][2];
#pragma unroll
    for (int a = 0; a < 2; ++a)
#pragma unroll
        for (int b = 0; b < 2; ++b)
#pragma unroll
            for (int m = 0; m < 4; ++m)
#pragma unroll
                for (int n = 0; n < 2; ++n) acc[a][b][m][n] = (f32x4){0.f, 0.f, 0.f, 0.f};
    const char* cA = (const char*)g.A + (size_t)cur.pm * tA; const char* cB = (const char*)g.Bt + (size_t)cur.pn * tB;
    PG8_STAGE(PG8_SB(0, 0), cB, voffB); PG8_STAGE(PG8_SB(0, 1), cB + hB, voffB); PG8_STAGE(PG8_SA(0, 0), cA, voffA); PG8_STAGE(PG8_SA(0, 1), cA + hA, voffA);
    if (wr == 1) PG8_BAR;
    PG8_WAIT_V(2); PG8_BAR;
    PG8_STAGE(PG8_SB(1, 0), cB + kstep, voffB); PG8_STAGE(PG8_SA(1, 0), cA + kstep, voffA); PG8_STAGE(PG8_SB(1, 1), cB + hB + kstep, voffB);
    PG8_WAIT_V(6); PG8_BAR;
    for (;;) {
        const bool has_next = S.next(ui + 1, nxt);
        const char* nA = has_next ? (const char*)g.A + (size_t)nxt.pm * tA : cA; const char* nB = has_next ? (const char*)g.Bt + (size_t)nxt.pn * tB : cB;
#pragma nounroll
        for (int t = 0; t < nt; t += 2) {
            const bool last = (t == nt - 2);
            bf16x8 At[4][2], B0[2][2], B1[2][2];
            const char* a1 = cA + (size_t)(t + 1) * kstep;
            const char* a2 = last ? nA : cA + (size_t)(t + 2) * kstep; const char* b2 = last ? nB : cB + (size_t)(t + 2) * kstep;
            const char* a3 = a2 + kstep; const char* b3 = b2 + kstep;
            PG8_LDB(B0, 0, 0); PG8_LDB(B1, 0, 1); PG8_SCHED; PG8_LDA(At, 0, 0); PG8_STAGE(PG8_SA(1, 1), a1 + hA, voffA);
            PG8_WAIT_V(8); PG8_WAIT_L(0); PG8_BAR; PG8_MMA(0, 0, At, B0); PG8_MMA(0, 1, At, B1); PG8_BAR; PG8_SCHED;
            PG8_LDA(At, 0, 1); PG8_STAGE(PG8_SB(0, 0), b2, voffB); PG8_STAGE(PG8_SB(0, 1), b2 + hB, voffB); PG8_STAGE(PG8_SA(0, 0), a2, voffA);
            PG8_WAIT_V(8); PG8_WAIT_L(0); PG8_BAR; PG8_MMA(1, 0, At, B0); PG8_MMA(1, 1, At, B1); PG8_BAR; PG8_SCHED;
            PG8_LDB(B0, 1, 0); PG8_LDB(B1, 1, 1); PG8_SCHED; PG8_LDA(At, 1, 0); PG8_STAGE(PG8_SA(0, 1), a2 + hA, voffA);
            PG8_WAIT_V(8); PG8_WAIT_L(0); PG8_BAR; PG8_MMA(0, 0, At, B0); PG8_MMA(0, 1, At, B1); PG8_BAR; PG8_SCHED;
            PG8_LDA(At, 1, 1); PG8_STAGE(PG8_SB(1, 0), b3, voffB); PG8_STAGE(PG8_SB(1, 1), b3 + hB, voffB); PG8_STAGE(PG8_SA(1, 0), a3, voffA);
            PG8_WAIT_V(8); PG8_WAIT_L(0); PG8_BAR; PG8_MMA(1, 0, At, B0); PG8_MMA(1, 1, At, B1); PG8_BAR; PG8_SCHED;
        }
        if constexpr (ALIGN_EPI) { if (wr == 0) PG8_BAR; }
        E(acc, cur, wr, wc, fr, fq);
        if (!has_next) break;
#pragma unroll
        for (int a = 0; a < 2; ++a)
#pragma unroll
            for (int b = 0; b < 2; ++b)
#pragma unroll
                for (int m = 0; m < 4; ++m)
#pragma unroll
                    for (int n = 0; n < 2; ++n) acc[a][b][m][n] = (f32x4){0.f, 0.f, 0.f, 0.f};
        cur = nxt; cA = nA; cB = nB; ++ui;
        if constexpr (ALIGN_EPI) { if (wr == 1) PG8_BAR; }
    }
    PG8_WAIT_V(0);
    if constexpr (!ALIGN_EPI) { if (wr == 0) PG8_BAR; }
    PG8_BAR;
#undef PG8_SA
#undef PG8_SB
#undef PG8_STAGE
#undef PG8_LDA
#undef PG8_LDB
#undef PG8_MMA
#undef PG8_WAIT_V
#undef PG8_WAIT_L
#undef PG8_BAR
#undef PG8_SCHED
}

__device__ __forceinline__ int rk_base(int pm) { return pm < 32 ? pm * 256 : RP + ((pm - 32) >> 3) * 2304 + ((pm - 32) & 7) * 256; }

struct EpiBf16 {
    static constexpr bool PERM = true;
    bf16* O; int ldc; int split_cols; size_t split_stride;
    __device__ __forceinline__ void operator()(const f32x4 (&acc)[2][2][4][2], const Unit& u, int wr, int wc, int fr, int fq) const {
        const int row0 = u.pm * BM + wr * 64 + fr; int colt = u.pn * BM; bf16* base = O;
        if (split_cols) { const int t = colt / split_cols; base += (size_t)t * split_stride; colt -= t * split_cols; }
        const int col0 = colt + wc * 32 + 8 * fq;
#pragma unroll
        for (int ai = 0; ai < 2; ++ai)
#pragma unroll
            for (int m = 0; m < 4; ++m) { bf16* rowp = base + (size_t)(row0 + ai * HALF + m * 16) * ldc + col0;
#pragma unroll
                for (int bj = 0; bj < 2; ++bj) { const f32x4 v0 = acc[ai][bj][m][0], v1 = acc[ai][bj][m][1];
                    u32x4 w; w.x = pk2(v0[0], v0[1]); w.y = pk2(v0[2], v0[3]); w.z = pk2(v1[0], v1[1]); w.w = pk2(v1[2], v1[3]);
                    *(u32x4*)(rowp + bj * HALF) = w; } }
    }
};
struct EpiOutPub {
    static constexpr bool PERM = true;
    bf16* O; unsigned* cnt;
    __device__ __forceinline__ void operator()(const f32x4 (&acc)[2][2][4][2], const Unit& u, int wr, int wc, int fr, int fq) const {
        const __amdgpu_buffer_rsrc_t rs = __builtin_amdgcn_make_buffer_rsrc((void*)O, (short)0, R * 1024 * 2, 0x00020000);
        const int row0 = u.pm * BM + wr * 64 + fr; const int col0 = u.pn * BM + wc * 32 + 8 * fq;
#pragma unroll
        for (int ai = 0; ai < 2; ++ai)
#pragma unroll
            for (int m = 0; m < 4; ++m) { const int off = ((row0 + ai * HALF + m * 16) * 1024 + col0) * 2;
#pragma unroll
                for (int bj = 0; bj < 2; ++bj) { const f32x4 v0 = acc[ai][bj][m][0], v1 = acc[ai][bj][m][1];
                    u32x4 w; w.x = pk2(v0[0], v0[1]); w.y = pk2(v0[2], v0[3]); w.z = pk2(v1[0], v1[1]); w.w = pk2(v1[2], v1[3]);
                    __builtin_amdgcn_raw_buffer_store_b128(w, rs, off + bj * HALF * 2, 0, 16); } }
        asm volatile("s_waitcnt vmcnt(0)" ::: "memory");
        if ((fr | fq) == 0) __hip_atomic_fetch_add(cnt + 16 * u.pm, 1u, __ATOMIC_RELAXED, __HIP_MEMORY_SCOPE_AGENT);
    }
};
struct EpiPool {
    static constexpr bool PERM = true;
    bf16* GB;
    __device__ __forceinline__ void operator()(const f32x4 (&acc)[2][2][4][2], const Unit& u, int wr, int wc, int fr, int fq) const {
        const int row0 = u.pm * BM + wr * 64 + fr; const int col0 = u.pn * BM + wc * 32 + 8 * fq;
#pragma unroll
        for (int ai = 0; ai < 2; ++ai)
#pragma unroll
            for (int m = 0; m < 4; ++m) { bf16* rowp = GB + (size_t)(row0 + ai * HALF + m * 16) * 1024 + col0;
#pragma unroll
                for (int bj = 0; bj < 2; ++bj) { const f32x4 v0 = acc[ai][bj][m][0], v1 = acc[ai][bj][m][1];
                    const u32x4 gg = *(const u32x4*)(rowp + bj * HALF);
                    u32x4 w;
                    w.x = pk2(v0[0] * silu_fast(bflo(gg.x)), v0[1] * silu_fast(bfhi(gg.x))); w.y = pk2(v0[2] * silu_fast(bflo(gg.y)), v0[3] * silu_fast(bfhi(gg.y)));
                    w.z = pk2(v1[0] * silu_fast(bflo(gg.z)), v1[1] * silu_fast(bfhi(gg.z))); w.w = pk2(v1[2] * silu_fast(bflo(gg.w)), v1[3] * silu_fast(bfhi(gg.w)));
                    *(u32x4*)(rowp + bj * HALF) = w; } }
    }
};
struct EpiMlaIn {
    static constexpr bool PERM = true;
    bf16 *CQ, *CKV, *GAB, *VP; float* KRF;
    __device__ __forceinline__ void operator()(const f32x4 (&acc)[2][2][4][2], const Unit& u, int wr, int wc, int fr, int fq) const {
        const int rt = wr * 64 + fr, grow0 = u.pm * BM, rk0 = rk_base(u.pm), cc = wc * 32 + 8 * fq;
#pragma unroll
        for (int bj = 0; bj < 2; ++bj) {
            const int U = 2 * u.pn + bj;
            if (U == 5) {
                if (wc == 0) {
#pragma unroll
                    for (int ai = 0; ai < 2; ++ai)
#pragma unroll
                        for (int m = 0; m < 4; ++m) { float* p = KRF + (size_t)(grow0 + rt + ai * HALF + m * 16) * 32 + 8 * fq;
                            *(f32x4*)p = acc[ai][bj][m][0]; *(f32x4*)(p + 4) = acc[ai][bj][m][1]; }
                }
                continue;
            }
            bf16* p; int ld, rb = grow0;
            if (U < 3) { p = CQ + 128 * U; ld = 384; }
            else if (U < 5) { p = CKV + 128 * (U - 3); ld = 256; rb = rk0; }
            else if (U < 10) { p = GAB + 128 * (U - 6); ld = 1024; }
            else if (U < 14) { p = VP + 128 * (U - 10); ld = 512; }
            else { p = GAB + 512 + 128 * (U - 14); ld = 1024; }
            p += (size_t)(rb + rt) * ld + cc;
            const bool isgate = (U >= 6 && U < 10) || U >= 14;
#pragma unroll
            for (int ai = 0; ai < 2; ++ai)
#pragma unroll
                for (int m = 0; m < 4; ++m) { f32x4 v0 = acc[ai][bj][m][0], v1 = acc[ai][bj][m][1];
                    if (isgate) { v0 = (f32x4){silu_fast(v0[0]), silu_fast(v0[1]), silu_fast(v0[2]), silu_fast(v0[3])}; v1 = (f32x4){silu_fast(v1[0]), silu_fast(v1[1]), silu_fast(v1[2]), silu_fast(v1[3])}; }
                    u32x4 w; w.x = pk2(v0[0], v0[1]); w.y = pk2(v0[2], v0[3]); w.z = pk2(v1[0], v1[1]); w.w = pk2(v1[2], v1[3]);
                    *(u32x4*)(p + (size_t)(ai * HALF + m * 16) * ld) = w; }
        }
    }
};
__device__ __forceinline__ void rope_perm(f32x4& a, f32x4& b, const float* tb) {
#pragma unroll
    for (int j = 0; j < 4; ++j) { auto rr = __builtin_amdgcn_permlane32_swap(__float_as_uint(a[j]), __float_as_uint(b[j]), false, false); a[j] = __uint_as_float(rr[0]); b[j] = __uint_as_float(rr[1]); }
    const f32x4 c0 = *(const f32x4*)tb, c1 = *(const f32x4*)(tb + 4);
    const f32x4 cs = {c0[0], c0[2], c1[0], c1[2]}, sn = {c0[1], c0[3], c1[1], c1[3]};
    const f32x4 o1 = a * cs - b * sn, o2 = a * sn + b * cs;
    a = o1; b = o2;
#pragma unroll
    for (int j = 0; j < 4; ++j) { auto rr = __builtin_amdgcn_permlane32_swap(__float_as_uint(a[j]), __float_as_uint(b[j]), false, false); a[j] = __uint_as_float(rr[0]); b[j] = __uint_as_float(rr[1]); }
}
struct EpiQ {
    static constexpr bool PERM = true;
    bf16* Q; const float* rope8;
    __device__ __forceinline__ void operator()(const f32x4 (&acc)[2][2][4][2], const Unit& u, int wr, int wc, int fr, int fq) const {
        const int rt = wr * 64 + fr, grow0 = u.pm * BM; const bool sample = u.pm >= 32; const int t0 = ((u.pm - 32) & 7) * 256;
#pragma unroll
        for (int bj = 0; bj < 2; ++bj) {
            const int g32 = 8 * u.pn + 4 * bj + wc; const bool rot = sample && (g32 % 3 == 2);
#pragma unroll
            for (int ai = 0; ai < 2; ++ai)
#pragma unroll
                for (int m = 0; m < 4; ++m) { const int r = rt + ai * HALF + m * 16; f32x4 x1 = acc[ai][bj][m][0], x2 = acc[ai][bj][m][1];
                    if (rot) { const int t = t0 + r, pos = (fq & 1) ? (t & 63) : (t >> 6); rope_perm(x1, x2, rope8 + (pos * 8 + ((fq >> 1) ? 4 : 0)) * 2); }
                    u32x4 w; w.x = pk2(x1[0], x1[1]); w.y = pk2(x1[2], x1[3]); w.z = pk2(x2[0], x2[1]); w.w = pk2(x2[2], x2[3]);
                    *(u32x4*)(Q + (size_t)(grow0 + r) * 768 + 32 * g32 + 8 * fq) = w; }
        }
    }
};
struct EpiSwaIn {
    static constexpr bool PERM = true;
    bf16 *Q, *K, *V, *G; float *stK, *stV; const float* rope16;
    __device__ __forceinline__ void operator()(const f32x4 (&acc)[2][2][4][2], const Unit& u, int wr, int wc, int fr, int fq) const {
        const int rt = wr * 64 + fr, grow0 = u.pm * BM, rk0 = rk_base(u.pm); const bool sample = u.pm >= 32; const int t0 = ((u.pm - 32) & 7) * 256;
        const int pn = u.pn;
#pragma unroll
        for (int bj = 0; bj < 2; ++bj) {
            const int cb = 128 * bj + 32 * wc + 8 * fq;
            const bool rot = sample && pn < 5;
#pragma unroll
            for (int ai = 0; ai < 2; ++ai)
#pragma unroll
                for (int m = 0; m < 4; ++m) { const int r = rt + ai * HALF + m * 16; f32x4 x1 = acc[ai][bj][m][0], x2 = acc[ai][bj][m][1];
                    if (rot) { const int t = t0 + r, pos = (wc & 1) ? (t & 63) : (t >> 6); rope_perm(x1, x2, rope16 + (pos * 16 + 8 * (fq & 1) + ((fq >> 1) ? 4 : 0)) * 2); }
                    bf16* p;
                    if (pn < 4) p = Q + (size_t)(grow0 + r) * 1024 + 256 * pn + cb;
                    else if (pn == 4) p = K + (size_t)(rk0 + r) * 256 + cb;
                    else if (pn == 5) p = V + (size_t)(rk0 + r) * 256 + cb;
                    else p = G + (size_t)(grow0 + r) * 1024 + 256 * (pn - 6) + cb;
                    if (pn >= 6) { x1 = (f32x4){silu_fast(x1[0]), silu_fast(x1[1]), silu_fast(x1[2]), silu_fast(x1[3])}; x2 = (f32x4){silu_fast(x2[0]), silu_fast(x2[1]), silu_fast(x2[2]), silu_fast(x2[3])}; }
                    if (!sample && (pn == 4 || pn == 5)) { float* st = (pn == 4 ? stK : stV) + (size_t)(u.pm * 2 * 256 + r) * 256 + cb; *(f32x4*)st = x1; *(f32x4*)(st + 4) = x2; }
                    u32x4 w; w.x = pk2(x1[0], x1[1]); w.y = pk2(x1[2], x1[3]); w.z = pk2(x2[0], x2[1]); w.w = pk2(x2[2], x2[3]);
                    *(u32x4*)p = w; }
        }
    }
};
}

typedef __attribute__((address_space(4))) const char* kptr_t;
__device__ __forceinline__ const void* arg_ptr(int k) { kptr_t ka = (kptr_t)__builtin_amdgcn_kernarg_segment_ptr(); asm volatile("" : "+s"(ka)); return *(const void* __attribute__((address_space(4)))*)(ka + 8 * k); }
#define ARG_IN(k) ((const float*)arg_ptr(k))
namespace att {
__device__ __forceinline__ int crow(int r, int hi) { return (r & 3) + 8 * (r >> 2) + 4 * hi; }
typedef short v4i16_t __attribute__((ext_vector_type(4)));
__device__ __forceinline__ s16x4 vtr(const LAS char* p) { return __builtin_bit_cast(s16x4, __builtin_amdgcn_ds_read_tr16_b64_v4i16((LAS v4i16_t*)p)); }
__device__ __forceinline__ float xhalf_max(float x) { auto rr = __builtin_amdgcn_permlane32_swap(__float_as_uint(x), __float_as_uint(x), false, false); return __builtin_fmaxf(__uint_as_float(rr[0]), __uint_as_float(rr[1])); }
__device__ __forceinline__ float xhalf_sum(float x) { auto rr = __builtin_amdgcn_permlane32_swap(__float_as_uint(x), __float_as_uint(x), false, false); return __uint_as_float(rr[0]) + __uint_as_float(rr[1]); }
#define SBAR() __builtin_amdgcn_sched_barrier(0)
#define PIN(x) asm volatile("" : "+v"(x))
__device__ __forceinline__ float max3f(float a, float b, float c) { float r; asm("v_max3_f32 %0, %1, %2, %3" : "=v"(r) : "v"(a), "v"(b), "v"(c)); return r; }
__device__ __forceinline__ float max2f(float a, float b) { float r; asm("v_max_f32_e32 %0, %1, %2" : "=v"(r) : "v"(a), "v"(b)); return r; }
struct Desc {
    const bf16* qptr;
    const bf16* k0;
    const bf16* k1;
    const bf16* v;
    int n_a, row_a, n_b, row_b, key_b;
    int qpos; float sink2; int has_sink;
    bf16* optr;
};
constexpr float THR = 8.f;
__device__ __forceinline__ int tile_row(const Desc& d, int t) { return t < d.n_a ? d.row_a + 64 * t : d.row_b + 64 * (t - d.n_a); }
template <int MODE, class MK>
__device__ __forceinline__ void attn_phase(LAS char* lds, const MK& mk, int first, int stride, int nunits) {
    constexpr int DQK = MODE == 0 ? 96 : 64, NCH = DQK / 8, ND0 = DQK / 16, KB = NCH * 1024, VOFF = 3 * KB, NG = 2 * ND0, NHELD = 8, NLATE = NG - NHELD, STG_OFF = VOFF + 2 * 8192;
    static_assert(STG_OFF + 8 * 32 * 272 <= 131072, "attention LDS map");
    constexpr int LDQ = MODE == 0 ? 768 : 1024, LDK0 = MODE == 0 ? 512 : 256, LDV = LDK0, LDO = 1024;
    int un = first; if (un >= nunits) return;
    const int tid = opaque_tid(), lane = tid & 63, r32 = lane & 31, hi = lane >> 5; const int wid = __builtin_amdgcn_readfirstlane(tid >> 6);
    const int kdst = wid * 1024, k1dst = (8 + (wid & 3)) * 1024, vdst = VOFF + wid * 1024;
    const int vlane = ((lane >> 4) & 1) * 32 + (lane & 3) * 8 + (4 * hi + ((lane & 15) >> 2)) * 64;
    const int kfo = hi * 1024 + r32 * 16;
    Desc d; mk(un, d);
#define SRC_K(dd) ((dd).k0 + (size_t)lane * LDK0 + wid * 8)
#define SRC_K1(dd) ((MODE == 0) ? (dd).k1 + (size_t)lane * 32 + (wid & 3) * 8 : (const bf16*)nullptr)
#define SRC_V(dd) ((dd).v + (size_t)(16 * (wid & 3) + (lane >> 2)) * LDV + (wid >> 2) * 32 + (lane & 3) * 8)
    const bf16* ksrc = SRC_K(d); const bf16* k1src = SRC_K1(d); const bf16* vsrc = SRC_V(d);
#define GLDS16(g, l) __builtin_amdgcn_global_load_lds((const unsigned*)(g), (LAS unsigned*)(l), 16, 0, 0)
#define DMAK_(dd, ks_, k1s_, t, soff) do { const size_t _r = (size_t)tile_row(dd, t); GLDS16((ks_) + _r * LDK0, lds + (soff) + kdst); if (MODE == 0 && wid < 4) GLDS16((k1s_) + _r * 32, lds + (soff) + k1dst); } while (0)
#define DMAV_(dd, vs_, t, vslot) do { const size_t _r = (size_t)tile_row(dd, t); GLDS16((vs_) + _r * LDV, lds + (vslot) * 8192 + vdst); } while (0)
#define DMAK(t, soff) DMAK_(d, ksrc, k1src, t, soff)
#define DMAV(t, vslot) DMAV_(d, vsrc, t, vslot)
    int sl_cur = 0, sl_nxt = KB, sl_fre = 2 * KB;
    int vpar = 0;
    DMAK(0, sl_cur); DMAK(1, sl_nxt); DMAV(0, vpar);
    bf16x8 qr[ND0];
#pragma unroll
    for (int d0 = 0; d0 < ND0; ++d0) qr[d0] = *(const bf16x8*)(d.qptr + (size_t)r32 * LDQ + d0 * 16 + hi * 8);
    __syncthreads();
#define ROT() do { const int o_ = sl_cur; sl_cur = sl_nxt; sl_nxt = sl_fre; sl_fre = o_; } while (0)
#define KFADDR(i, soff) (lds + (soff) + kfo + ((i) >> 1) * 2048 + ((i) & 1) * 512)
#define PE(P0, P1, e) ((e) < 16 ? P0[(e) & 15] : P1[(e) & 15])
#define FILL_A(P0, P1, g) do { \
        _Pragma("unroll") for (int e_ = (32 * (g)) / NG; e_ < (32 * ((g) + 1)) / NG; ++e_) sacc += PE(P0, P1, e_); \
        PIN(sacc); \
        _Pragma("unroll") for (int k_ = (16 * (g)) / NG; k_ < (16 * ((g) + 1)) / NG; ++k_) { pw[k_ >> 2][k_ & 3] = pk2(PE(P0, P1, 2 * k_), PE(P0, P1, 2 * k_ + 1)); PIN(pw[k_ >> 2]); } } while (0)
#define QK_PHASE(C0, C1, P0, P1, HAVE_P) do { \
        bf16x8 kl_[NLATE > 0 ? NLATE : 1]; \
        _Pragma("unroll") for (int i_ = 0; i_ < NLATE; ++i_) kl_[i_] = *(const LAS bf16x8*)KFADDR(NHELD + i_, sl_cur); \
        _Pragma("unroll") for (int g_ = 0; g_ < NG; ++g_) { const int d0_ = g_ >> 1; \
            const bf16x8 kk_ = g_ < NHELD ? kf[g_ < NHELD ? g_ : 0] : kl_[g_ >= NHELD ? g_ - NHELD : 0]; \
            if ((g_ & 1) == 0) C0 = __builtin_amdgcn_mfma_f32_32x32x16_bf16(kk_, qr[d0_], d0_ == 0 ? negm : C0, 0, 0, 0); \
            else C1 = __builtin_amdgcn_mfma_f32_32x32x16_bf16(kk_, qr[d0_], d0_ == 0 ? negm : C1, 0, 0, 0); \
            if (HAVE_P) FILL_A(P0, P1, g_); \
            SBAR(); } } while (0)
#define MASKT(C0, C1, t_) do { if (MODE == 1 && (t_) >= d.n_a) { const int key0_ = d.key_b + 64 * ((t_) - d.n_a); \
        if (key0_ - (qb0 + 31) < -128 || key0_ + 63 - qb0 > 128) { const int k0p_ = key0_ - d.qpos; \
            _Pragma("unroll") for (int r = 0; r < 16; ++r) { const int d_ = k0p_ + crow(r, hi); if (d_ > 128 || d_ < -128) C0[r] = -1e30f; if (d_ + 32 > 128 || d_ + 32 < -128) C1[r] = -1e30f; } } } } while (0)
#define DECIDE(C0, C1) do { \
        float a_ = max2f(C0[0], C1[0]), b_ = max2f(C0[1], C1[1]); \
        _Pragma("unroll") for (int r = 2; r < 16; r += 2) { a_ = max3f(a_, C0[r], C1[r]); b_ = max3f(b_, C0[r + 1], C1[r + 1]); } \
        a_ = xhalf_max(max2f(a_, b_)); resc = false; \
        if (__any(a_ > THR)) { const float dl_ = fmaxf(a_, 0.f); mref += dl_; \
            _Pragma("unroll") for (int r = 0; r < 16; ++r) { C0[r] -= dl_; C1[r] -= dl_; } \
            _Pragma("unroll") for (int r = 0; r < 16; ++r) negm[r] = -mref; \
            fsc = __builtin_amdgcn_exp2f(-dl_); lsum *= fsc; resc = true; } } while (0)
#define EXP4(C0, C1, j) do { _Pragma("unroll") for (int e_ = 4 * (j); e_ < 4 * (j) + 4; ++e_) { if (e_ < 16) C0[e_ & 15] = __builtin_amdgcn_exp2f(C0[e_ & 15]); else C1[e_ & 15] = __builtin_amdgcn_exp2f(C1[e_ & 15]); } \
        if (4 * (j) < 16) PIN(C0); else PIN(C1); } while (0)
#define VOFFS(j) ((((j) & 1) * 4096) + (((j) >> 1) * 1024))
#define PV_PHASE(C0, C1, HAVE_C, HAVE_K, tp_) do { \
        const LAS char* vp_ = lds + VOFF + (((tp_) + vpar) & 1) * 8192 + vlane; \
        s16x4 vl_[8], vh_[8]; \
        vl_[0] = vtr(vp_ + VOFFS(0)); vh_[0] = vtr(vp_ + VOFFS(0) + 512); vl_[1] = vtr(vp_ + VOFFS(1)); vh_[1] = vtr(vp_ + VOFFS(1) + 512); \
        _Pragma("unroll") for (int j = 0; j < 8; ++j) { const int ks = j >> 1, dd = j & 1; \
            if (j + 2 < 8) { vl_[j + 2] = vtr(vp_ + VOFFS(j + 2)); vh_[j + 2] = vtr(vp_ + VOFFS(j + 2) + 512); } \
            if (HAVE_K) kf[j] = *(const LAS bf16x8*)KFADDR(j, sl_nxt); \
            const bf16x8 vf_ = {vl_[j][0], vl_[j][1], vl_[j][2], vl_[j][3], vh_[j][0], vh_[j][1], vh_[j][2], vh_[j][3]}; \
            if (dd == 0) o0 = __builtin_amdgcn_mfma_f32_32x32x16_bf16(vf_, __builtin_bit_cast(bf16x8, pw[ks]), o0, 0, 0, 0); \
            else o1 = __builtin_amdgcn_mfma_f32_32x32x16_bf16(vf_, __builtin_bit_cast(bf16x8, pw[ks]), o1, 0, 0, 0); \
            if (HAVE_C) EXP4(C0, C1, j); \
            SBAR(); } } while (0)
#define STEP(C0, C1, P0, P1, t_) do { \
        if ((t_) + 2 < NT) DMAK((t_) + 2, sl_fre); \
        DMAV(t_, ((t_) + vpar) & 1); \
        float sacc = 0.f; \
        QK_PHASE(C0, C1, P0, P1, true); \
        lsum += sacc; \
        MASKT(C0, C1, t_); \
        DECIDE(C0, C1); \
        SBAR(); \
        PV_PHASE(C0, C1, true, true, (t_) - 1); \
        __syncthreads(); \
        ROT(); \
        if (resc) { o0 *= fsc; o1 *= fsc; } } while (0)
    for (;;) {
        const int NT = d.n_a + d.n_b;
        const int qb0 = __builtin_amdgcn_readfirstlane(d.qpos);
        float mref = 0.f, lsum = 0.f, fsc = 1.f; bool resc = false;
        f32x16 o0 = (f32x16){}, o1 = (f32x16){}, negm = (f32x16){};
        f32x16 cA0 = (f32x16){}, cA1 = (f32x16){}, cB0 = (f32x16){}, cB1 = (f32x16){};
        u32x4 pw[4];
#pragma unroll
        for (int i = 0; i < 4; ++i) pw[i] = (u32x4){0u, 0u, 0u, 0u};
        bf16x8 kf[NHELD];
#pragma unroll
        for (int i = 0; i < NHELD; ++i) kf[i] = *(const LAS bf16x8*)KFADDR(i, sl_cur);
        {
            if (2 < NT) DMAK(2, sl_fre);
            float sacc = 0.f; (void)sacc;
            QK_PHASE(cA0, cA1, cA0, cA1, false);
            MASKT(cA0, cA1, 0);
            DECIDE(cA0, cA1);
#pragma unroll
            for (int j = 0; j < 8; ++j) { kf[j] = *(const LAS bf16x8*)KFADDR(j, sl_nxt); EXP4(cA0, cA1, j); SBAR(); }
            __syncthreads();
            ROT();
        }
        int t = 1;
        for (; t + 1 < NT; t += 2) { STEP(cB0, cB1, cA0, cA1, t); STEP(cA0, cA1, cB0, cB1, t + 1); }
        const bool odd_tail = t < NT;
        if (odd_tail) STEP(cB0, cB1, cA0, cA1, t);
        const int un_next = un + stride; const bool has_next = un_next < nunits;
        Desc dn = d;
        const bf16* ksrc_n = ksrc; const bf16* k1src_n = k1src; const bf16* vsrc_n = vsrc;
        u32x4 gpre[4];
#pragma unroll
        for (int i2 = 0; i2 < 4; ++i2) gpre[i2] = *(const u32x4*)(d.optr + (size_t)(i2 * 8 + (lane >> 3)) * LDO + (lane & 7) * 8);
        bf16x8 qn[ND0];
#pragma unroll
        for (int d0 = 0; d0 < ND0; ++d0) qn[d0] = qr[d0];
        if (has_next) {
            mk(un_next, dn);
            ksrc_n = SRC_K(dn); k1src_n = SRC_K1(dn); vsrc_n = SRC_V(dn);
            DMAK_(dn, ksrc_n, k1src_n, 0, sl_cur); DMAK_(dn, ksrc_n, k1src_n, 1, sl_nxt); DMAV_(dn, vsrc_n, 0, (NT + vpar) & 1);
#pragma unroll
            for (int d0 = 0; d0 < ND0; ++d0) qn[d0] = *(const bf16x8*)(dn.qptr + (size_t)r32 * LDQ + d0 * 16 + hi * 8);
        }
        if (odd_tail) {
            float sacc = 0.f;
#pragma unroll
            for (int g = 0; g < NG; ++g) FILL_A(cB0, cB1, g);
            lsum += sacc;
            PV_PHASE(cB0, cB1, false, false, NT - 1);
        } else {
            float sacc = 0.f;
#pragma unroll
            for (int g = 0; g < NG; ++g) FILL_A(cA0, cA1, g);
            lsum += sacc;
            PV_PHASE(cA0, cA1, false, false, NT - 1);
        }
        float lt = xhalf_sum(lsum);
        if (d.has_sink) lt += __builtin_amdgcn_exp2f(d.sink2 - mref);
        const float inv = 1.0f / lt;
        {
            LAS char* stg = lds + STG_OFF + wid * (32 * 272);
#pragma unroll
            for (int d0 = 0; d0 < 2; ++d0)
#pragma unroll
                for (int g = 0; g < 4; ++g) { const f32x16& o = d0 ? o1 : o0;
                    const f32x4 v = {o[4 * g] * inv, o[4 * g + 1] * inv, o[4 * g + 2] * inv, o[4 * g + 3] * inv};
                    *(LAS f32x4*)(stg + r32 * 272 + (32 * d0 + 8 * g + 4 * hi) * 4) = v; }
#pragma unroll
            for (int i2 = 0; i2 < 4; ++i2) { const int row = i2 * 8 + (lane >> 3), ch = lane & 7;
                const f32x4 va = *(const LAS f32x4*)(stg + row * 272 + ch * 32), vb = *(const LAS f32x4*)(stg + row * 272 + ch * 32 + 16);
                const u32x4 gg = gpre[i2];
                u32x4 w;
                w.x = pk2(va[0] * bflo(gg.x), va[1] * bfhi(gg.x)); w.y = pk2(va[2] * bflo(gg.y), va[3] * bfhi(gg.y));
                w.z = pk2(vb[0] * bflo(gg.z), vb[1] * bfhi(gg.z)); w.w = pk2(vb[2] * bflo(gg.w), vb[3] * bfhi(gg.w));
                *(u32x4*)(d.optr + (size_t)row * LDO + ch * 8) = w; }
        }
        __syncthreads();
        if (!has_next) break;
        vpar = (NT + vpar) & 1;
        d = dn; un = un_next; ksrc = ksrc_n; k1src = k1src_n; vsrc = vsrc_n;
#pragma unroll
        for (int d0 = 0; d0 < ND0; ++d0) qr[d0] = qn[d0];
    }
#undef SRC_K
#undef SRC_K1
#undef SRC_V
#undef GLDS16
#undef DMAK_
#undef DMAV_
#undef DMAK
#undef DMAV
#undef ROT
#undef KFADDR
#undef PE
#undef FILL_A
#undef QK_PHASE
#undef MASKT
#undef DECIDE
#undef EXP4
#undef VOFFS
#undef PV_PHASE
#undef STEP
}
#undef SBAR
}

#define XB_TMO      128
#define XB_XCNT(j)  (256  + 64 * (j))
#define XB_XSUB(j)  (1280 + 64 * (j))
#define XB_XGEN(j)  (2304 + 64 * (j))
#define XB_TOP      3328
#define XB_TOPGEN   3392
#define XCD_BAR_WORDS 3456
#define XB_SPIN_CAP (1u << 20)
__device__ __forceinline__ unsigned xb_ld(unsigned* p)              { return __hip_atomic_load(p, __ATOMIC_RELAXED, __HIP_MEMORY_SCOPE_AGENT); }
__device__ __forceinline__ unsigned xb_add(unsigned* p, unsigned v) { return __hip_atomic_fetch_add(p, v, __ATOMIC_RELAXED, __HIP_MEMORY_SCOPE_AGENT); }
__device__ __forceinline__ unsigned xb_xcc_id() { return (unsigned)__builtin_amdgcn_s_getreg((3 << 11) | 20) & 0xFu; }
#define XB_SPIN(cond, bar) do { unsigned _sp = 0; while (cond) { __builtin_amdgcn_s_sleep(1); \
    if ((++_sp & 255u) == 0u) { if (xb_ld(&(bar)[XB_TMO])) break; if (_sp > XB_SPIN_CAP) { atomicAdd(&(bar)[XB_TMO], 1u); break; } } } } while (0)
struct XcdBarrier { unsigned* bar; unsigned x; volatile LAS unsigned* st; };
__device__ __forceinline__ XcdBarrier xcd_barrier_post(unsigned* bar, volatile LAS unsigned* st) {
    XcdBarrier b; b.bar = bar; b.x = xb_xcc_id(); b.st = st;
    if (threadIdx.x == 0) (void)xb_add(&bar[XB_XCNT(b.x)], 1u);
    return b;
}
__device__ __forceinline__ void xcd_barrier_complete(unsigned* bar, unsigned x, unsigned& nloc, unsigned& nx) {
    const unsigned G = gridDim.x * gridDim.y * gridDim.z;
    unsigned sum, cnt, mine, sp = 0u;
    for (;;) {
        sum = 0u; cnt = 0u; mine = 0u;
#pragma unroll
        for (unsigned j = 0; j < 16; ++j) { const unsigned c = xb_ld(&bar[XB_XCNT(j)]); sum += c; cnt += (c > 0u) ? 1u : 0u; mine = (j == x) ? c : mine; }
        if (sum == G) break;
        __builtin_amdgcn_s_sleep(1);
        if ((++sp & 255u) == 0u) { if (xb_ld(&bar[XB_TMO])) break; if (sp > XB_SPIN_CAP) { atomicAdd(&bar[XB_TMO], 1u); break; } }
    }
    nloc = mine > 0u ? mine : 1u; nx = cnt > 0u ? cnt : 1u;
}
__device__ __forceinline__ void xcd_barrier(const XcdBarrier& b0) {
    asm volatile("s_waitcnt vmcnt(0)" ::: "memory");
    __syncthreads();
    if (threadIdx.x == 0) {
        XcdBarrier b = b0; b.x = xb_xcc_id();
        unsigned* bar = b.bar; asm volatile("" : "+s"(bar));
        __builtin_amdgcn_s_waitcnt(0);
        unsigned nloc = b.st[0], nx = b.st[1];
        if (nloc == 0u) { xcd_barrier_complete(bar, b.x, nloc, nx); b.st[0] = nloc; b.st[1] = nx; }
        const unsigned old = xb_add(&bar[XB_XSUB(b.x)], 1u);
        const unsigned gen = old / nloc;
        if (old + 1u == (gen + 1u) * nloc) {
            __builtin_amdgcn_fence(__ATOMIC_RELEASE, "agent");
            asm volatile("s_waitcnt vmcnt(0)" ::: "memory");
            const unsigned og = xb_add(&bar[XB_TOP], 1u);
            const unsigned tg = og / nx;
            if (og + 1u == (tg + 1u) * nx) xb_add(&bar[XB_TOPGEN], 1u);
            else XB_SPIN(xb_ld(&bar[XB_TOPGEN]) == tg, bar);
            __builtin_amdgcn_fence(__ATOMIC_ACQUIRE, "agent");
            xb_add(&bar[XB_XGEN(b.x)], 1u);
            asm volatile("s_waitcnt vmcnt(0)" ::: "memory");
        } else {
            XB_SPIN(xb_ld(&bar[XB_XGEN(b.x)]) == gen, bar);
            __builtin_amdgcn_fence(__ATOMIC_ACQUIRE, "agent");
            asm volatile("s_waitcnt vmcnt(0)" ::: "memory");
        }
    }
    __syncthreads();
}

struct Args { const float* in[23]; float* out; unsigned char* ws; int ph_lo, ph_hi; };
constexpr int NWAVES = 8;
constexpr int N_PHASES = 2 + 5 + 3 + 5 + 3;
constexpr int RING_BYTES = 131072, MISC_OFF = RING_BYTES + 320, LDS_BYTES = 147456;

struct TMap { int kind, row_off, col_off, ldw; const float* nscale; float scale; };
__device__ __forceinline__ void tmap(const TMap& tm, int n, int& drow, float& sc) {
    drow = n + tm.row_off; sc = tm.scale;
    switch (tm.kind) {
        case 1: if (n >= 672) drow += 96; break;
        case 2: { const int e = n % 96; if (e >= 64) { const int d = e - 64; const int p = (d & 7) | ((d & 8) << 1) | ((d & 16) >> 1); drow = n - e + 64 + p; } } break;
        case 3: { const int h = n >> 7, e = n & 127; drow = (e < 64) ? h * 64 + e : 512 + h * 64 + (e - 64); } break;
        case 4: sc = tm.nscale[n]; break;
        case 5: if (n >= 1024) sc = 1.f; break;
        default: break;
    }
}
__device__ __forceinline__ void transpose_item(const float* W, int K, int N, bf16* WT, const TMap& tm, LAS float* scr, int item, int lane) {
    const int nblk = N / 32, kb = item / nblk, nb = item % nblk, k0 = 64 * kb, n0 = 32 * nb;
    f32x4 wv[8];
#pragma unroll
    for (int i = 0; i < 8; ++i) wv[i] = *(const f32x4*)(W + (size_t)(k0 + 8 * i + (lane >> 3)) * N + n0 + 4 * (lane & 7));
#pragma unroll
    for (int i = 0; i < 8; ++i) { LAS float* d = scr + (8 * i + (lane >> 3)) * 33 + 4 * (lane & 7); d[0] = wv[i][0]; d[1] = wv[i][1]; d[2] = wv[i][2]; d[3] = wv[i][3]; }
    LDS_WAIT(); asm volatile("" ::: "memory");
    const int c = lane & 7;
#pragma unroll
    for (int j = 0; j < 4; ++j) { const int n = (lane >> 3) + 8 * j; const LAS float* s = scr + (8 * c) * 33 + n;
        int drow; float sc; tmap(tm, n0 + n, drow, sc);
        u32x4 o; o.x = pk2(s[0 * 33] * sc, s[1 * 33] * sc); o.y = pk2(s[2 * 33] * sc, s[3 * 33] * sc); o.z = pk2(s[4 * 33] * sc, s[5 * 33] * sc); o.w = pk2(s[6 * 33] * sc, s[7 * 33] * sc);
        *(u32x4*)(WT + (size_t)drow * tm.ldw + tm.col_off + k0 + 8 * c) = o; }
    LDS_WAIT(); asm volatile("" ::: "memory");
}

__device__ __forceinline__ f32x4 mod_load(const float* MODPp, const float* ada_b, int l, int midx, int off) {
    f32x4 s = *(const f32x4*)(ada_b + l * 3072 + off);
#pragma unroll
    for (int kq = 0; kq < 4; ++kq) s += *(const f32x4*)(MODPp + ((size_t)((kq * 4 + l) * 9 + midx)) * 3072 + off);
    return s;
}
__device__ __forceinline__ void ada_item(int it, const float* cvec, const float* cctx, const float* ada_w, float* modp, LAS unsigned char* lds, int tid, int lane, int wave) {
    LAS float* red = (LAS float*)lds;
    const int l = it / 48, rem = it % 48, cc = rem >> 2, kq = rem & 3, k0 = kq * 256 + wave * 32;
    float sv[9];
#pragma unroll
    for (int j = 0; j < 9; ++j) { const float c = (j < 8) ? cvec[j * 1024 + k0 + (lane & 31)] : cctx[k0 + (lane & 31)]; sv[j] = c / (1.f + expf(-c)); }
    f32x4 acc[9];
#pragma unroll
    for (int j = 0; j < 9; ++j) acc[j] = (f32x4){0.f, 0.f, 0.f, 0.f};
    const float* wp = ada_w + ((size_t)l * 1024 + k0) * 3072 + cc * 256 + 4 * lane;
    f32x4 wv[32];
#pragma unroll
    for (int kk = 0; kk < 32; ++kk) wv[kk] = *(const f32x4*)(wp + (size_t)kk * 3072);
    asm volatile("" ::: "memory");
#pragma unroll
    for (int kk = 0; kk < 32; ++kk) {
#pragma unroll
        for (int j = 0; j < 9; ++j) { const float sc = __int_as_float(__builtin_amdgcn_readlane(__float_as_int(sv[j]), kk)); acc[j] += wv[kk] * sc; }
    }
#pragma unroll
    for (int j = 0; j < 9; ++j) *(LAS f32x4*)(red + (wave * 9 + j) * 256 + 4 * lane) = acc[j];
    __syncthreads();
    for (int idx = tid; idx < 9 * 256; idx += NWAVES * 64) { const int j = idx >> 8, col = idx & 255; float sm = 0.f;
#pragma unroll
        for (int w = 0; w < 8; ++w) sm += red[(w * 9 + j) * 256 + col];
        modp[((size_t)((kq * 4 + l) * 9 + j)) * 3072 + cc * 256 + col] = sm; }
    __syncthreads();
}
constexpr int CI1 = 1104, CI2 = 144, CI3 = 128, CI4 = 1024, CI5 = 512, CI6 = 1280, CI7 = 512, CIMLA = CI1 + CI2 + CI3 + CI4 + CI5, CISWA = CI6 + CI7;
__device__ __forceinline__ void conv_item(int r, int i, unsigned char* ws, LAS float* scr, int lane) {
    unsigned char* wm = ws + (i ? WS_W_MLA1 : WS_W_MLA0); unsigned char* wsw = ws + (i ? WS_W_SWA1 : WS_W_SWA0);
    if (r < CI1) { const int nb = r % 69; if (nb >= 37 && nb < 53) return;
        TMap tm{1, 0, 0, 1024, nullptr, 1.f}; transpose_item(ARG_IN(12) + (size_t)i * 1024 * 2208, 1024, 2208, (bf16*)wm, tm, scr, r, lane); return; } r -= CI1;
    if (r < CI2) { TMap tm{2, 0, 0, 384, nullptr, MLA_SC}; transpose_item(ARG_IN(15) + (size_t)i * 384 * 768, 384, 768, (bf16*)(wm + SZ_WIN_MLA), tm, scr, r, lane); return; } r -= CI2;
    if (r < CI3) { TMap tm{3, 0, 0, 256, nullptr, 1.f}; transpose_item(ARG_IN(16) + (size_t)i * 256 * 1024, 256, 1024, (bf16*)(wm + SZ_WIN_MLA + SZ_WUQ), tm, scr, r, lane); return; } r -= CI3;
    if (r < CI4) {
        const int g = r >> 8, kb = (r >> 4) & 15, eb = r & 15, k = kb * 64 + lane;
        const float* wi = ARG_IN(12) + (size_t)i * 1024 * 2208 + (size_t)k * 2208 + 1184 + g * 128;
        const float* wp = ARG_IN(17) + ((size_t)i * 4 + g) * 128 * 128 + eb * 8; const float* sp = ARG_IN(18) + i * 512 + g * 128 + eb * 8;
#pragma unroll
        for (int q = 0; q < 4; ++q) { const int c = 32 * q + (lane >> 1); *(LAS f32x4*)(scr + c * 8 + 4 * (lane & 1)) = *(const f32x4*)(wp + (size_t)c * 128 + 4 * (lane & 1)); }
        LDS_WAIT(); asm volatile("" ::: "memory");
        float acc[8];
#pragma unroll
        for (int e = 0; e < 8; ++e) acc[e] = 0.f;
#pragma nounroll
        for (int hc = 0; hc < 2; ++hc) {
            f32x4 arow[16];
#pragma unroll
            for (int q = 0; q < 16; ++q) arow[q] = *(const f32x4*)(wi + 64 * hc + 4 * q);
            const LAS float* sw = scr + 64 * hc * 8;
#pragma unroll
            for (int q = 0; q < 16; ++q) {
#pragma unroll
                for (int cc = 0; cc < 4; ++cc) { const float a = arow[q][cc];
                    const f32x4 w0 = *(const LAS f32x4*)(sw + (4 * q + cc) * 8), w1 = *(const LAS f32x4*)(sw + (4 * q + cc) * 8 + 4);
                    acc[0] += a * w0[0]; acc[1] += a * w0[1]; acc[2] += a * w0[2]; acc[3] += a * w0[3]; acc[4] += a * w1[0]; acc[5] += a * w1[1]; acc[6] += a * w1[2]; acc[7] += a * w1[3]; } }
        }
        bf16* dst = (bf16*)wm + (size_t)(1280 + g * 128 + eb * 8) * 1024 + k;
#pragma unroll
        for (int e = 0; e < 8; ++e) dst[(size_t)e * 1024] = (bf16)f2bf(acc[e] * sp[e]);
        LDS_WAIT(); asm volatile("" ::: "memory");
        return; } r -= CI4;
    if (r < CI5) { TMap tm{0, 0, 0, 1024, nullptr, 1.f}; transpose_item(ARG_IN(19) + (size_t)i * 1024 * 1024, 1024, 1024, (bf16*)(wm + SZ_WIN_MLA + SZ_WUQ + SZ_WUKV + SZ_WPOOL), tm, scr, r, lane); return; } r -= CI5;
    if (r < CI6) { TMap tm{5, 0, 0, 1024, nullptr, SWA_SC}; transpose_item(ARG_IN(20) + (size_t)i * 1024 * 2560, 1024, 2560, (bf16*)wsw, tm, scr, r, lane); return; } r -= CI6;
    { TMap tm{0, 0, 0, 1024, nullptr, 1.f}; transpose_item(ARG_IN(22) + (size_t)i * 1024 * 1024, 1024, 1024, (bf16*)(wsw + SZ_WIN_SWA), tm, scr, r, lane); }
}
__device__ __forceinline__ int mod_index(int row) { return row < RP ? 8 : ((row - RP) >> 11); }

__global__ void __launch_bounds__(NWAVES * 64, 2) fwd_kernel(Args args) {
    extern __shared__ __attribute__((aligned(16))) unsigned char lds_raw[];
    LAS unsigned char* lds = (LAS unsigned char*)lds_raw;
    volatile LAS unsigned* MISC = (volatile LAS unsigned*)(lds + MISC_OFF);
    const int G = gridDim.x; const int bx = blockIdx.x; const int vcu = (G % 8 == 0) ? (bx % 8) * (G / 8) + bx / 8 : bx;
    const int NGW = G * NWAVES;
    { const int tid0 = threadIdx.x; for (int u = tid0; u < (LDS_BYTES - RING_BYTES) / 4; u += NWAVES * 64) ((LAS unsigned*)(lds + RING_BYTES))[u] = 0u; }
    __syncthreads();
    XcdBarrier bar; bar.bar = (unsigned*)((unsigned char*)arg_ptr(24) + WS_CTL) + 1024; bar.x = 0; bar.st = nullptr;
    if (!MK_PER_PHASE) bar = xcd_barrier_post(bar.bar, MISC + 8);
    const int lo = MK_PER_PHASE ? args.ph_lo : 0, hi = MK_PER_PHASE ? args.ph_hi : N_PHASES;
    int pid = 0;
#define IN_PH() (lo <= pid && pid < hi)
#define END_PH() do { if (!MK_PER_PHASE && lo <= pid && pid + 1 < hi) xcd_barrier(bar); ++pid; } while (0)
#define PH_BEGIN() unsigned char* const ws = (unsigned char*)arg_ptr(24); float* const out = (float*)arg_ptr(23); \
    const int tid = opaque_tid(), lane = tid & 63, wave = __builtin_amdgcn_readfirstlane(tid >> 6), gw = vcu * NWAVES + wave; (void)out; (void)lane; (void)gw; (void)ws
#define MOD ((float*)(ws + WS_MOD))
#define ROPE8 ((float*)(ws + WS_ROPE8))
#define ROPE16 ((float*)(ws + WS_ROPE16))
#define MODP ((float*)(ws + WS_MODP))
#define Hb ((bf16*)(ws + WS_H))
#define GAB ((bf16*)(ws + WS_GAB))
#define CQ ((bf16*)(ws + WS_CQ))
#define CKV ((bf16*)(ws + WS_CKV))
#define KRB ((bf16*)(ws + WS_KRB))
#define KRF ((float*)(ws + WS_KRF))
#define KN ((bf16*)(ws + WS_KN))
#define VP ((bf16*)(ws + WS_KN))
#define VV ((bf16*)(ws + WS_V))
#define PO ((bf16*)(ws + WS_PO))
#define SQ ((bf16*)(ws + WS_CQ))
#define SK ((bf16*)(ws + WS_SK))
#define SV ((bf16*)(ws + WS_SV))

    if (IN_PH()) { PH_BEGIN();
        { const float* cvec = ARG_IN(6); const float* cctx = ARG_IN(7); const float* ada_w = ARG_IN(8);
          for (int it = bx; it < 48; it += G) ada_item(it, cvec, cctx, ada_w, MODP, lds, tid, lane, wave); }
        for (int e = bx * 512 + tid; e < 64 * 8 + 64 * 16; e += G * 512) {
            if (e < 512) { const int pos = e >> 3, i = e & 7; const float inv = powf(10000.f, -(float)i / 8.f), a = (float)pos * inv; ROPE8[2 * e] = cosf(a); ROPE8[2 * e + 1] = sinf(a); }
            else { const int f = e - 512, pos = f >> 4, i = f & 15; const float inv = powf(10000.f, -(float)i / 16.f), a = (float)pos * inv; ROPE16[2 * f] = cosf(a); ROPE16[2 * f + 1] = sinf(a); }
        }
        LAS float* scr = (LAS float*)(lds + wave * 16384);
        for (int it = gw; it < CIMLA; it += NGW) if (!(it >= CI1 + CI2 + CI3 && it < CI1 + CI2 + CI3 + CI4)) conv_item(it, 0, ws, scr, lane);
        const u32x4 z = {0u, 0u, 0u, 0u};
        for (int e = bx * 512 + tid; e < 2 * 96 * 128; e += G * 512) { const int i = e / (96 * 128), f = e % (96 * 128);
            *(u32x4*)(ws + (i ? WS_W_MLA1 : WS_W_MLA0) + (size_t)672 * 2048 + (size_t)f * 16) = z; }
    }
    END_PH();

    if (IN_PH()) { PH_BEGIN();
        const float* npre = ARG_IN(10); const float* xin0 = ARG_IN(0); const float* xin1 = ARG_IN(1); const float* adab = ARG_IN(9);
        {
            const float* npost0 = ARG_IN(11);
            for (int it = bx; it < 9; it += G) { const int l = 0, j = it;
                for (int c = tid * 4; c < 1024; c += NWAVES * 64 * 4) { float* cf = MOD + (size_t)(l * 9 + j) * 3072;
                    *(f32x4*)(cf + c) = mod_load(MODP, adab, l, j, 2048 + c) * *(const f32x4*)(npost0 + l * 1024 + c);
                    *(f32x4*)(cf + 1024 + c) = *(const f32x4*)(npre + l * 1024 + c) * (mod_load(MODP, adab, l, j, 1024 + c) + 1.f);
                    *(f32x4*)(cf + 2048 + c) = mod_load(MODP, adab, l, j, c); } }
        }
        {
            LAS float* scr = (LAS float*)(lds + wave * 16384);
            for (int it = gw; it < 2 * CI4; it += NGW) conv_item(CI1 + CI2 + CI3 + (it & (CI4 - 1)), it >= CI4 ? 1 : 0, ws, scr, lane);
        }
        for (int chunk = gw; chunk < R / 12; chunk += NGW) {
            int curm = -1; f32x4 cB[4], cC[4];
#pragma unroll
            for (int j = 0; j < 4; ++j) { cB[j] = (f32x4){0.f, 0.f, 0.f, 0.f}; cC[j] = cB[j]; }
            for (int rr = 0; rr < 12; rr += 2) {
                f32x4 v[2][4];
#pragma unroll
                for (int q = 0; q < 2; ++q) { const int row = chunk * 12 + rr + q; const float* xr = row < RP ? xin0 + (size_t)row * D : xin1 + (size_t)(row - RP) * D;
#pragma unroll
                    for (int j = 0; j < 4; ++j) v[q][j] = *(const f32x4*)(xr + 8 * lane + 512 * (j >> 1) + 4 * (j & 1)); }
#pragma unroll
                for (int q = 0; q < 2; ++q) { const int row = chunk * 12 + rr + q, midx = mod_index(row);
                    if (midx != curm) { curm = midx;
#pragma unroll
                        for (int j = 0; j < 4; ++j) { const int c = 8 * lane + 512 * (j >> 1) + 4 * (j & 1); const f32x4 g = *(const f32x4*)(npre + c), sc = mod_load(MODP, adab, 0, midx, 1024 + c); cB[j] = g * (sc + 1.f); cC[j] = mod_load(MODP, adab, 0, midx, c); } }
                    float ss = 0.f;
#pragma unroll
                    for (int j = 0; j < 4; ++j) ss += v[q][j][0] * v[q][j][0] + v[q][j][1] * v[q][j][1] + v[q][j][2] * v[q][j][2] + v[q][j][3] * v[q][j][3];
                    const float rstd = 1.f / sqrtf(wave_sum(ss) * (1.f / D) + EPS);
#pragma unroll
                    for (int j2 = 0; j2 < 2; ++j2) { const f32x4 ha = v[q][2 * j2] * rstd * cB[2 * j2] + cC[2 * j2], hc = v[q][2 * j2 + 1] * rstd * cB[2 * j2 + 1] + cC[2 * j2 + 1];
                        u32x4 w; w.x = pk2(ha[0], ha[1]); w.y = pk2(ha[2], ha[3]); w.z = pk2(hc[0], hc[1]); w.w = pk2(hc[2], hc[3]); *(u32x4*)(Hb + (size_t)row * D + 8 * lane + 512 * j2) = w; }
                }
            }
        }
    }
    END_PH();

    for (int l = 0; l < NL; ++l) {
        const int i = l >> 1;
        if ((l & 1) == 0) {
#define WM_BASE (ws + (i ? WS_W_MLA1 : WS_W_MLA0))
#define M_WinT ((const bf16*)WM_BASE)
#define M_WuqT ((const bf16*)(WM_BASE + SZ_WIN_MLA))
#define M_WukvT ((const bf16*)(WM_BASE + SZ_WIN_MLA + SZ_WUQ))
#define M_WpT ((const bf16*)(WM_BASE + SZ_WIN_MLA + SZ_WUQ + SZ_WUKV))
#define M_WoT ((const bf16*)(WM_BASE + SZ_WIN_MLA + SZ_WUQ + SZ_WUKV + SZ_WPOOL))
            if (IN_PH()) { PH_BEGIN();
                pg8::Gemm g{Hb, M_WinT, R, 2304, 1024, 1024}; pg8::StaticOrder S; S.init(R, 2304, G, bx);
                pg8::EpiMlaIn E{CQ, CKV, GAB, VP, KRF};
                pg8::gemm_phase<pg8::EpiMlaIn, true>(lds, g, S, E);
                if (l == 0) {
                    const float* cvec = ARG_IN(6); const float* cctx = ARG_IN(7); const float* ada_w = ARG_IN(8);
                    unsigned* qt = (unsigned*)(ws + WS_CTL) + CW_QH + 64; LAS float* scr = (LAS float*)(lds + wave * 16384);
                    constexpr int NCH_SWA = (CISWA + 7) / 8;
                    for (;;) {
                        __syncthreads();
                        if (tid == 0) MISC[0] = __hip_atomic_fetch_add(qt, 1u, __ATOMIC_RELAXED, __HIP_MEMORY_SCOPE_AGENT);
                        __syncthreads();
                        const int item = (int)MISC[0];
                        if (item >= 144 + 2 * NCH_SWA) break;
                        if (item < 144) ada_item(48 + item, cvec, cctx, ada_w, MODP, lds, tid, lane, wave);
                        else { const int c2 = item - 144, inst = c2 >= NCH_SWA ? 1 : 0, r2 = (c2 - inst * NCH_SWA) * 8 + wave; if (r2 < CISWA) conv_item(CIMLA + r2, inst, ws, scr, lane); }
                    }
                }
            }
            END_PH();
            if (IN_PH()) { PH_BEGIN();
                const float* gq = ARG_IN(13) + i * 384; const float* gkv = ARG_IN(14) + i * 256;
                const float* cckv = ARG_IN(2); const float* ckr = ARG_IN(3);
                if (l == 0) {
                    const float* npost0 = ARG_IN(11); const float* npre0 = ARG_IN(10); const float* adab = ARG_IN(9);
                    for (int it = bx; it < 27; it += G) { const int l2 = 1 + it / 9, j = it % 9;
                        for (int c = tid * 4; c < 1024; c += NWAVES * 64 * 4) { float* cf = MOD + (size_t)(l2 * 9 + j) * 3072;
                            *(f32x4*)(cf + c) = mod_load(MODP, adab, l2, j, 2048 + c) * *(const f32x4*)(npost0 + l2 * 1024 + c);
                            *(f32x4*)(cf + 1024 + c) = *(const f32x4*)(npre0 + l2 * 1024 + c) * (mod_load(MODP, adab, l2, j, 1024 + c) + 1.f);
                            *(f32x4*)(cf + 2048 + c) = mod_load(MODP, adab, l2, j, c); } }
                }
                const int half = 1 << (lane >> 4);
                float pm[16];
#pragma unroll
                for (int k = 0; k < 16; ++k) pm[k] = (k - 8 >= -half && k - 8 < half) ? 1.f : 0.f;
                f32x4 gq0 = {0.f, 0.f, 0.f, 0.f}, gq1 = gq0, gk0 = gq0, gk1 = gq0;
                if (lane < 48) { gq0 = *(const f32x4*)(gq + 8 * lane); gq1 = *(const f32x4*)(gq + 8 * lane + 4); }
                if (lane < 32) { gk0 = *(const f32x4*)(gkv + 8 * lane); gk1 = *(const f32x4*)(gkv + 8 * lane + 4); }
                for (int chunk = gw; chunk < R / 12; chunk += NGW) {
                    const int r0 = chunk * 12;
                    const int xl = r0 + 18; const int Bs = xl < RP ? (xl & ~255) : (xl >= R ? R : RP + ((xl - RP) & ~2047)); const bool hasB = Bs > r0 - 8;
                    u32x4 win[27];
#pragma unroll
                    for (int k = 0; k < 27; ++k) { int x = r0 - 8 + k; x = x < 0 ? 0 : (x >= R ? R - 1 : x); win[k] = *(const u32x4*)(VP + (size_t)x * 512 + 8 * lane); }
                    {
#pragma unroll
                        for (int hb = 0; hb < 2; ++hb) {
                            u32x4 wq[6], wk[6]; float kr[6];
#pragma unroll
                            for (int q = 0; q < 6; ++q) { const int row = r0 + 6 * hb + q; const bool prompt = row < RP; const int rk = prompt ? row : RP + ((row - RP) >> 11) * 2304 + ((row - RP) & 2047);
                                wq[q] = (u32x4){0u, 0u, 0u, 0u}; wk[q] = wq[q]; kr[q] = 0.f;
                                if (lane < 48) wq[q] = *(const u32x4*)(CQ + (size_t)row * 384 + 8 * lane);
                                if (lane < 32) { wk[q] = *(const u32x4*)(CKV + (size_t)rk * 256 + 8 * lane); kr[q] = KRF[(size_t)row * 32 + lane]; } }
#pragma unroll
                            for (int q = 0; q < 6; ++q) { const int row = r0 + 6 * hb + q; const bool prompt = row < RP; const int b = prompt ? row >> 8 : (row - RP) >> 11, t = prompt ? row & 255 : (row - RP) & 2047;
                                const int rk = prompt ? row : RP + b * 2304 + t;
                                { const u32x4 w = wq[q]; float v[8] = {bflo(w.x), bfhi(w.x), bflo(w.y), bfhi(w.y), bflo(w.z), bfhi(w.z), bflo(w.w), bfhi(w.w)}; float ss = 0.f;
#pragma unroll
                                  for (int e = 0; e < 8; ++e) ss += v[e] * v[e];
                                  const float rstd = 1.f / sqrtf(wave_sum(ss) * (1.f / 384.f) + EPS);
                                  if (lane < 48) { u32x4 o; o.x = pk2(v[0] * rstd * gq0[0], v[1] * rstd * gq0[1]); o.y = pk2(v[2] * rstd * gq0[2], v[3] * rstd * gq0[3]); o.z = pk2(v[4] * rstd * gq1[0], v[5] * rstd * gq1[1]); o.w = pk2(v[6] * rstd * gq1[2], v[7] * rstd * gq1[3]);
                                      *(u32x4*)(CQ + (size_t)row * 384 + 8 * lane) = o; } }
                                { const u32x4 w = wk[q]; float v[8] = {bflo(w.x), bfhi(w.x), bflo(w.y), bfhi(w.y), bflo(w.z), bfhi(w.z), bflo(w.w), bfhi(w.w)}; float ss = 0.f;
#pragma unroll
                                  for (int e = 0; e < 8; ++e) ss += v[e] * v[e];
                                  const float rstd = 1.f / sqrtf(wave_sum(ss) * (1.f / 256.f) + EPS);
                                  if (lane < 32) { const f32x4 y0 = {v[0] * rstd * gk0[0], v[1] * rstd * gk0[1], v[2] * rstd * gk0[2], v[3] * rstd * gk0[3]}, y1 = {v[4] * rstd * gk1[0], v[5] * rstd * gk1[1], v[6] * rstd * gk1[2], v[7] * rstd * gk1[3]};
                                      u32x4 o; o.x = pk2(y0[0], y0[1]); o.y = pk2(y0[2], y0[3]); o.z = pk2(y1[0], y1[1]); o.w = pk2(y1[2], y1[3]);
                                      *(u32x4*)(CKV + (size_t)rk * 256 + 8 * lane) = o;
                                      if (prompt) { float* st = out + OFF_CKV + ((size_t)(b * 2 + i) * 256 + t) * 256 + 8 * lane; *(f32x4*)st = y0; *(f32x4*)(st + 4) = y1; } } }
                                { const float kv = kr[q];
                                  const float pr = __int_as_float(__builtin_amdgcn_update_dpp(0, __float_as_int(kv), 0x128, 0xf, 0xf, true));
                                  if (lane < 32) { if (prompt) out[OFF_KR + ((size_t)(b * 2 + i) * 256 + t) * 32 + lane] = kv;
                                      const int part = lane >> 4, fi = lane & 7; const bool isx2 = (lane & 8) != 0; const float x1 = isx2 ? pr : kv, x2 = isx2 ? kv : pr;
                                      float o1 = x1, o2 = x2;
                                      if (!prompt) { const int pos = part ? (t & 63) : (t >> 6); const float cs = ROPE8[(pos * 8 + fi) * 2], sn = ROPE8[(pos * 8 + fi) * 2 + 1]; o1 = x1 * cs - x2 * sn; o2 = x1 * sn + x2 * cs; }
                                      KRB[(size_t)rk * 32 + (isx2 ? 16 : 0) + part * 8 + fi] = (bf16)f2bf(isx2 ? o2 : o1); } }
                            }
                            asm volatile("" ::: "memory");
                        }
                    }
#pragma unroll
                    for (int ri = 0; ri < 12; ++ri) {
                        const bool sideR = (r0 + ri) >= Bs;
                        float sA[8]; float cntf = 0.f;
#pragma unroll
                        for (int e = 0; e < 8; ++e) sA[e] = 0.f;
#pragma unroll
                        for (int k = 0; k < 16; ++k) { const int x = r0 + ri + k - 8; const bool valid = !hasB || ((x >= Bs) == sideR); const float m = valid ? pm[k] : 0.f; const u32x4 w = win[ri + k]; cntf += m;
                            sA[0] += bflo(w.x) * m; sA[1] += bfhi(w.x) * m; sA[2] += bflo(w.y) * m; sA[3] += bfhi(w.y) * m;
                            sA[4] += bflo(w.z) * m; sA[5] += bfhi(w.z) * m; sA[6] += bflo(w.w) * m; sA[7] += bfhi(w.w) * m; }
                        const float ic = 1.f / cntf; const u32x4 w = win[ri + 8];
                        bf16* gp = GAB + (size_t)(r0 + ri) * 1024 + 512 + 8 * lane; const u32x4 gg = *(const u32x4*)gp;
                        u32x4 o; o.x = pk2((sA[0] * ic - bflo(w.x)) * bflo(gg.x), (sA[1] * ic - bfhi(w.x)) * bfhi(gg.x)); o.y = pk2((sA[2] * ic - bflo(w.y)) * bflo(gg.y), (sA[3] * ic - bfhi(w.y)) * bfhi(gg.y));
                        o.z = pk2((sA[4] * ic - bflo(w.z)) * bflo(gg.z), (sA[5] * ic - bfhi(w.z)) * bfhi(gg.z)); o.w = pk2((sA[6] * ic - bflo(w.w)) * bflo(gg.w), (sA[7] * ic - bfhi(w.w)) * bfhi(gg.w));
                        *(u32x4*)gp = o;
                    }
                }
                for (int ci = gw; ci < 2048; ci += NGW) {
                    const int b = ci >> 8, p = ci & 255, rk = RP + b * 2304 + 2048 + p;
                    if (lane < 32) { const float* sp = cckv + ((size_t)(b * 2 + i) * 256 + p) * 256 + 8 * lane; const f32x4 y0 = *(const f32x4*)sp, y1 = *(const f32x4*)(sp + 4);
                        u32x4 o; o.x = pk2(y0[0], y0[1]); o.y = pk2(y0[2], y0[3]); o.z = pk2(y1[0], y1[1]); o.w = pk2(y1[2], y1[3]); *(u32x4*)(CKV + (size_t)rk * 256 + 8 * lane) = o; }
                    if (lane < 16) { const int part = lane >> 3, fi = lane & 7; const float* sp = ckr + ((size_t)(b * 2 + i) * 256 + p) * 32 + part * 16 + fi;
                        KRB[(size_t)rk * 32 + lane] = (bf16)f2bf(sp[0]); KRB[(size_t)rk * 32 + 16 + lane] = (bf16)f2bf(sp[8]); }
                }
            }
            END_PH();
            if (IN_PH()) { PH_BEGIN();
                { pg8::Gemm g{CQ, M_WuqT, R, 768, 384, 384}; pg8::StaticOrder S; S.init(R, 768, G, (bx + 64) % G); pg8::EpiQ E{Hb, ROPE8}; pg8::gemm_phase<pg8::EpiQ, true>(lds, g, S, E); }
                { pg8::Gemm g{CKV, M_WukvT, RK, 1024, 256, 256}; pg8::StaticOrder S; S.init(RK, 1024, G, (bx + 160) % G); pg8::EpiBf16 E{KN, 512, 512, (size_t)(WS_V - WS_KN) / 2}; pg8::gemm_phase<pg8::EpiBf16, true>(lds, g, S, E); }
            }
            END_PH();
            if (IN_PH()) { PH_BEGIN();
                struct MlaMk { bf16 *hb, *kn, *vv, *gab, *krb; int wave;
                    __device__ __forceinline__ void operator()(int un, att::Desc& d) const {
                        d.n_b = 0; d.row_b = 0; d.key_b = 0; d.qpos = 0; d.sink2 = 0.f; d.has_sink = 0; d.k1 = krb;
                        int h, qrow, krow;
                        if (un < 512) { const int b = un >> 6, qb = un & 7; h = (un >> 3) & 7; qrow = RP + b * 2048 + qb * 256 + wave * 32; krow = RP + b * 2304; d.n_a = 36; }
                        else { const int v = un - 512, b = v >> 3; h = v & 7; qrow = b * 256 + wave * 32; krow = b * 256; d.n_a = 4; }
                        d.row_a = krow; d.qptr = hb + (size_t)qrow * 768 + h * 96; d.k0 = kn + h * 64; d.v = vv + h * 64; d.optr = gab + (size_t)qrow * 1024 + h * 64; } };
                const MlaMk mk{Hb, KN, VV, GAB, KRB, wave};
                att::attn_phase<0, MlaMk>((LAS char*)lds, mk, vcu, G, 768);
            }
            END_PH();
        } else {
#define WS_BASE (ws + (i ? WS_W_SWA1 : WS_W_SWA0))
#define S_WinT ((const bf16*)WS_BASE)
#define S_WoT ((const bf16*)(WS_BASE + SZ_WIN_SWA))
            if (IN_PH()) { PH_BEGIN();
                const float* ck = ARG_IN(4); const float* cv = ARG_IN(5);
                for (int e = bx * 512 + tid; e < 2 * 2048 * 32; e += G * 512) {
                    const int which = e / (2048 * 32), f = e % (2048 * 32), rowi = f >> 5, ch = f & 31, b = rowi >> 8, p = rowi & 255;
                    const float* s = (which ? cv : ck) + ((size_t)(b * 2 + i) * 256 + p) * 256 + 8 * ch; const f32x4 y0 = *(const f32x4*)s, y1 = *(const f32x4*)(s + 4);
                    u32x4 o; o.x = pk2(y0[0], y0[1]); o.y = pk2(y0[2], y0[3]); o.z = pk2(y1[0], y1[1]); o.w = pk2(y1[2], y1[3]);
                    *(u32x4*)((which ? SV : SK) + (size_t)(RP + b * 2304 + 2048 + p) * 256 + 8 * ch) = o;
                }
                pg8::Gemm g{Hb, S_WinT, R, 2560, 1024, 1024}; pg8::StaticOrder S; S.init(R, 2560, G, bx);
                pg8::EpiSwaIn E{SQ, SK, SV, GAB, out + OFF_K + (size_t)i * 65536, out + OFF_V + (size_t)i * 65536, ROPE16};
                pg8::gemm_phase<pg8::EpiSwaIn, true>(lds, g, S, E);
                if (l == 1) {
                    unsigned* qt = (unsigned*)(ws + WS_CTL) + CW_QH + 80; LAS float* scr = (LAS float*)(lds + wave * 16384);
                    constexpr int NCH_MLA = (CIMLA + 7) / 8;
                    for (;;) {
                        __syncthreads();
                        if (tid == 0) MISC[0] = __hip_atomic_fetch_add(qt, 1u, __ATOMIC_RELAXED, __HIP_MEMORY_SCOPE_AGENT);
                        __syncthreads();
                        const int item = (int)MISC[0];
                        if (item >= NCH_MLA) break;
                        const int r2 = item * 8 + wave; if (r2 < CIMLA && !(r2 >= CI1 + CI2 + CI3 && r2 < CI1 + CI2 + CI3 + CI4)) conv_item(r2, 1, ws, scr, lane);
                    }
                }
            }
            END_PH();
            if (IN_PH()) { PH_BEGIN();
                struct SwaMk { bf16 *sq, *sk, *sv, *gab; const float* sink; int wave, lane;
                    __device__ __forceinline__ void operator()(int un, att::Desc& d) const {
                        d.k1 = nullptr; d.has_sink = 1; d.n_a = 4;
                        int kvh, qrow, q0;
                        if (un < 1024) { const int b = un >> 7, blk = un & 31; kvh = (un >> 5) & 3; q0 = blk * 64; const int kb = RP + b * 2304;
                            qrow = RP + b * 2048 + q0 + (wave & 1) * 32; d.row_a = kb + 2048;
                            const int kfirst = q0 - 128 > 0 ? q0 - 128 : 0, klast = q0 + 128 < 2048 - 64 ? q0 + 128 : 2048 - 64;
                            d.key_b = kfirst; d.row_b = kb + kfirst; d.n_b = (klast - kfirst) / 64 + 1; }
                        else { const int v = un - 1024, b = v >> 4, blk = v & 3; kvh = (v >> 2) & 3; q0 = blk * 64; qrow = b * 256 + q0 + (wave & 1) * 32; d.row_a = b * 256; d.n_b = 0; d.row_b = 0; d.key_b = 0; }
                        const int head = kvh * 4 + (wave >> 1);
                        d.qpos = q0 + (wave & 1) * 32 + (lane & 31); d.sink2 = sink[head] * LOG2E;
                        d.qptr = sq + (size_t)qrow * 1024 + head * 64; d.k0 = sk + kvh * 64; d.v = sv + kvh * 64; d.optr = gab + (size_t)qrow * 1024 + head * 64; } };
                const SwaMk mk{SQ, SK, SV, GAB, ARG_IN(21) + i * 16, wave, lane};
                att::attn_phase<1, SwaMk>((LAS char*)lds, mk, vcu, G, 1536);
            }
            END_PH();
        }
        if (IN_PH()) { PH_BEGIN();
            unsigned* ctlw = (unsigned*)(ws + WS_CTL); unsigned* cnt = ctlw + CW_CNT + l * 2048; unsigned* qh = ctlw + CW_QH + l * 16; unsigned* tmo = ctlw + CW_TMO;
            {
                const bf16* WoT = (l & 1) ? (const bf16*)(ws + (i ? WS_W_SWA1 : WS_W_SWA0) + SZ_WIN_SWA) : (const bf16*)(ws + (i ? WS_W_MLA1 : WS_W_MLA0) + SZ_WIN_MLA + SZ_WUQ + SZ_WUKV + SZ_WPOOL);
                pg8::Gemm g{GAB, WoT, R, 1024, 1024, 1024}; pg8::PanelOrder S{G, vcu, 384}; pg8::EpiOutPub E{Hb, cnt};
                pg8::gemm_phase<pg8::EpiOutPub, true, pg8::PanelOrder>(lds, g, S, E);
            }
            const float* xin0 = ARG_IN(0); const float* xin1 = ARG_IN(1); const bool has_next = l + 1 < NL;
            const int panel = vcu >= 128 ? (vcu - 128) >> 1 : 64 + (vcu >> 2);
            const int rbase = vcu >= 128 ? panel * 256 + ((vcu - 128) & 1) * 128 : panel * 256 + (vcu & 3) * 64;
            const int nrw = vcu >= 128 ? 16 : 8;
#define WAIT_PANEL() do { if (wave == 0) { unsigned sp = 0; \
                while (__hip_atomic_load(cnt + 16 * panel, __ATOMIC_RELAXED, __HIP_MEMORY_SCOPE_AGENT) < 32u) { __builtin_amdgcn_s_sleep(2); \
                    if ((++sp & 1023u) == 0u) { if (__hip_atomic_load(tmo, __ATOMIC_RELAXED, __HIP_MEMORY_SCOPE_AGENT) || sp > (1u << 22)) { __hip_atomic_store(tmo, 1u, __ATOMIC_RELAXED, __HIP_MEMORY_SCOPE_AGENT); break; } } } \
                __builtin_amdgcn_fence(__ATOMIC_ACQUIRE, "agent"); asm volatile("s_waitcnt vmcnt(0)" ::: "memory"); } \
            __syncthreads(); } while (0)
            {
                const int row0 = rbase + wave * nrw, midx = mod_index(row0); const int ln = has_next ? l + 1 : l;
                const float* cf = MOD + (size_t)(l * 9 + midx) * 3072; const float* cfn = MOD + (size_t)(ln * 9 + midx) * 3072;
                f32x4 cA[4], cB[4], cC[4];
#pragma unroll
                for (int k = 0; k < 4; ++k) { const int c = 8 * lane + 512 * (k >> 1) + 4 * (k & 1); cA[k] = *(const f32x4*)(cf + c); cB[k] = *(const f32x4*)(cfn + 1024 + c); cC[k] = *(const f32x4*)(cfn + 2048 + c); }
#define FINAL_ROW(row, xv, ov) do { float ss = 0.f; \
                    _Pragma("unroll") for (int k = 0; k < 4; ++k) ss += ov[k][0] * ov[k][0] + ov[k][1] * ov[k][1] + ov[k][2] * ov[k][2] + ov[k][3] * ov[k][3]; \
                    const float rstd = 1.f / sqrtf(wave_sum(ss) * (1.f / D) + EPS); float s2 = 0.f; \
                    _Pragma("unroll") for (int k = 0; k < 4; ++k) { xv[k] = xv[k] + ov[k] * rstd * cA[k]; s2 += xv[k][0] * xv[k][0] + xv[k][1] * xv[k][1] + xv[k][2] * xv[k][2] + xv[k][3] * xv[k][3]; } \
                    if (has_next) { const float r2 = 1.f / sqrtf(wave_sum(s2) * (1.f / D) + EPS); \
                        _Pragma("unroll") for (int j2 = 0; j2 < 2; ++j2) { const f32x4 xa = xv[2 * j2], xc = xv[2 * j2 + 1]; \
                            u32x4 wx; wx.x = pk2(xa[0], xa[1]); wx.y = pk2(xa[2], xa[3]); wx.z = pk2(xc[0], xc[1]); wx.w = pk2(xc[2], xc[3]); \
                            *(u32x4*)((bf16*)out + (size_t)(row) * 2048 + 8 * lane + 512 * j2) = wx; \
                            const f32x4 ha = xa * r2 * cB[2 * j2] + cC[2 * j2], hc = xc * r2 * cB[2 * j2 + 1] + cC[2 * j2 + 1]; \
                            u32x4 wh; wh.x = pk2(ha[0], ha[1]); wh.y = pk2(ha[2], ha[3]); wh.z = pk2(hc[0], hc[1]); wh.w = pk2(hc[2], hc[3]); \
                            *(u32x4*)(Hb + (size_t)(row) * D + 8 * lane + 512 * j2) = wh; } \
                    } else { _Pragma("unroll") for (int k = 0; k < 4; ++k) *(f32x4*)(out + (size_t)(row) * D + 8 * lane + 512 * (k >> 1) + 4 * (k & 1)) = xv[k]; } } while (0)
#define UNPK(W_, LO_, HI_) do { const u32x4 t_ = (W_); LO_ = (f32x4){bflo(t_.x), bfhi(t_.x), bflo(t_.y), bfhi(t_.y)}; HI_ = (f32x4){bflo(t_.z), bfhi(t_.z), bflo(t_.w), bfhi(t_.w)}; } while (0)
                if (l == 0) {
                    WAIT_PANEL();
                    for (int rr = 0; rr < nrw; rr += 4) {
                        f32x4 xq[4][4]; u32x4 oq[4][2];
#pragma unroll
                        for (int q = 0; q < 4; ++q) { const int row = row0 + rr + q; const float* xr = row < RP ? xin0 + (size_t)row * D : xin1 + (size_t)(row - RP) * D;
#pragma unroll
                            for (int k = 0; k < 4; ++k) xq[q][k] = *(const f32x4*)(xr + 8 * lane + 512 * (k >> 1) + 4 * (k & 1));
#pragma unroll
                            for (int j2 = 0; j2 < 2; ++j2) oq[q][j2] = *(const u32x4*)(Hb + (size_t)row * D + 8 * lane + 512 * j2); }
#pragma unroll
                        for (int q = 0; q < 4; ++q) { f32x4 ov[4]; UNPK(oq[q][0], ov[0], ov[1]); UNPK(oq[q][1], ov[2], ov[3]); FINAL_ROW(row0 + rr + q, xq[q], ov); }
                    }
                } else {
                    u32x4 xw[8][2], ow[8][2];
#pragma unroll
                    for (int q = 0; q < 8; ++q)
#pragma unroll
                        for (int j2 = 0; j2 < 2; ++j2) xw[q][j2] = *(const u32x4*)((const bf16*)out + (size_t)(row0 + q) * 2048 + 8 * lane + 512 * j2);
                    WAIT_PANEL();
                    for (int rr = 0; rr < nrw; rr += 8) {
                        if (rr > 0) {
#pragma unroll
                            for (int q = 0; q < 8; ++q)
#pragma unroll
                                for (int j2 = 0; j2 < 2; ++j2) xw[q][j2] = *(const u32x4*)((const bf16*)out + (size_t)(row0 + rr + q) * 2048 + 8 * lane + 512 * j2);
                        }
#pragma unroll
                        for (int q = 0; q < 8; ++q)
#pragma unroll
                            for (int j2 = 0; j2 < 2; ++j2) ow[q][j2] = *(const u32x4*)(Hb + (size_t)(row0 + rr + q) * D + 8 * lane + 512 * j2);
#pragma unroll
                        for (int q = 0; q < 8; ++q) { f32x4 xv[4], ov[4]; UNPK(xw[q][0], xv[0], xv[1]); UNPK(xw[q][1], xv[2], xv[3]); UNPK(ow[q][0], ov[0], ov[1]); UNPK(ow[q][1], ov[2], ov[3]); FINAL_ROW(row0 + rr + q, xv, ov); }
                    }
                }
#undef FINAL_ROW
#undef UNPK
#undef WAIT_PANEL
            }
        }
        END_PH();
    }
#undef IN_PH
#undef END_PH
}


extern "C" void kernel_launch(void* const* d_in, const int* in_sizes, int n_in, void* d_out, int out_size, void* d_ws, size_t ws_size, hipStream_t stream) {
    static int grid = 0;
    if (grid == 0) {
        if (n_in != 23 || out_size != OUT_TOTAL || ws_size < WS_END) { fprintf(stderr, "kernel_launch: unexpected shapes (n_in %d out %d ws %zu)\n", n_in, out_size, ws_size); grid = -1; return; }
        int dev = 0, cus = 0;
        if (hipGetDevice(&dev) != hipSuccess || hipDeviceGetAttribute(&cus, hipDeviceAttributeMultiprocessorCount, dev) != hipSuccess) { grid = -1; return; }
        if (hipFuncSetAttribute((const void*)fwd_kernel, hipFuncAttributeMaxDynamicSharedMemorySize, LDS_BYTES) != hipSuccess) { fprintf(stderr, "kernel_launch: hipFuncSetAttribute failed\n"); grid = -1; return; }
        int per_cu = 0;
        if (hipOccupancyMaxActiveBlocksPerMultiprocessor(&per_cu, (const void*)fwd_kernel, NWAVES * 64, LDS_BYTES) != hipSuccess || per_cu < 1) { fprintf(stderr, "kernel_launch: occupancy query says %d\n", per_cu); }
        (void)hipGetLastError();
        grid = cus;
    }
    if (grid < 0) return;
    (void)hipMemsetAsync((char*)d_ws + WS_CTL, 0, CTL_ZERO_BYTES, stream);
    Args a{};
    for (int i = 0; i < 23; ++i) a.in[i] = (const float*)d_in[i];
    a.out = (float*)d_out; a.ws = (unsigned char*)d_ws;
#if MK_PER_PHASE
    for (int p = 0; p < N_PHASES; ++p) { a.ph_lo = p; a.ph_hi = p + 1; hipLaunchKernelGGL(fwd_kernel, dim3(grid), dim3(NWAVES * 64), LDS_BYTES, stream, a); }
#else
    a.ph_lo = 0; a.ph_hi = N_PHASES;
    hipLaunchKernelGGL(fwd_kernel, dim3(grid), dim3(NWAVES * 64), LDS_BYTES, stream, a);
#endif
}
```

```cpp
#include <hip/hip_runtime.h>
#include <cstdio>
#include <cstdint>

#ifndef MK_PER_PHASE
#define MK_PER_PHASE 0
#endif

#define GAS __attribute__((address_space(1)))
#define LAS __attribute__((address_space(3)))
typedef unsigned short bf16;
typedef short bf16x8 __attribute__((ext_vector_type(8)));
typedef short s16x4 __attribute__((ext_vector_type(4)));
typedef float f32x4 __attribute__((ext_vector_type(4)));
typedef float f32x2 __attribute__((ext_vector_type(2)));
typedef float f32x16 __attribute__((ext_vector_type(16)));
typedef unsigned u32x4 __attribute__((ext_vector_type(4)));
typedef unsigned u32x2 __attribute__((ext_vector_type(2)));
typedef __bf16 bf16x2_t __attribute__((ext_vector_type(2)));

constexpr int D = 1024, RP = 8192, RS = 16384, R = RP + RS;
constexpr int RK = RP + 8 * 2304;
constexpr int NL = 4;
constexpr float EPS = 1e-6f, LOG2E = 1.4426950408889634f;
constexpr float MLA_SC = 0.10206207261596577f * LOG2E;
constexpr float SWA_SC = 0.125f * LOG2E;
constexpr int OFF_CKV = 25165824, OFF_KR = 29360128, OFF_K = 29884416, OFF_V = 34078720, OUT_TOTAL = 38273024;

constexpr size_t MiB = 1u << 20;
constexpr size_t WS_CTL = 0, CTL_ZERO_BYTES = 128 * 1024;
constexpr int CW_CNT = 8192, CW_QH = 16384, CW_TMO = 17408;
constexpr size_t WS_MOD = 1 * MiB;
constexpr size_t WS_ROPE8 = 1 * MiB + 512 * 1024;
constexpr size_t WS_ROPE16 = WS_ROPE8 + 4096;
constexpr size_t SZ_WIN_MLA = 2304ull * 1024 * 2, SZ_WUQ = 768ull * 384 * 2, SZ_WUKV = 1024ull * 256 * 2, SZ_WPOOL = 512ull * 512 * 2,
                 SZ_WOUT = 1024ull * 1024 * 2, SZ_WIN_SWA = 2560ull * 1024 * 2;
constexpr size_t WS_W = 2 * MiB;
constexpr size_t SZ_W_MLA = SZ_WIN_MLA + SZ_WUQ + SZ_WUKV + SZ_WPOOL + SZ_WOUT, SZ_W_SWA = SZ_WIN_SWA + SZ_WOUT;
constexpr size_t WS_W_MLA0 = WS_W, WS_W_MLA1 = WS_W + SZ_W_MLA, WS_W_SWA0 = WS_W + 2 * SZ_W_MLA, WS_W_SWA1 = WS_W_SWA0 + SZ_W_SWA;
static_assert(WS_W_SWA1 + SZ_W_SWA <= 34 * MiB, "weights");
constexpr size_t WS_H = 34 * MiB;
constexpr size_t WS_GAB = 82 * MiB;
constexpr size_t WS_CQ = 130 * MiB;
constexpr size_t WS_CKV = 148 * MiB;
constexpr size_t WS_KRB = 161 * MiB;
constexpr size_t WS_KRF = 163 * MiB;
constexpr size_t WS_KN = 166 * MiB;
constexpr size_t WS_V = 192 * MiB;
constexpr size_t WS_PO = 218 * MiB;
constexpr size_t WS_SK = 178 * MiB;
constexpr size_t WS_SV = 191 * MiB;
constexpr size_t WS_MODP = 242 * MiB;
constexpr size_t WS_END = 244 * MiB;

__device__ __forceinline__ unsigned f2bf(float f) { unsigned u = __builtin_bit_cast(unsigned, f); return (u + 0x7fffu + ((u >> 16) & 1u)) >> 16; }
__device__ __forceinline__ unsigned pk2(float lo, float hi) { f32x2 v = {lo, hi}; bf16x2_t b = __builtin_convertvector(v, bf16x2_t); return __builtin_bit_cast(unsigned, b); }
__device__ __forceinline__ float bflo(unsigned w) { return __uint_as_float(w << 16); }
__device__ __forceinline__ float bfhi(unsigned w) { return __uint_as_float(w & 0xffff0000u); }
__device__ __forceinline__ float silu_fast(float x) { return x * __builtin_amdgcn_rcpf(1.f + __builtin_amdgcn_exp2f(-x * LOG2E)); }
#define DPP_ADD(v, ctrl) ((v) + __int_as_float(__builtin_amdgcn_update_dpp(0, __float_as_int(v), (ctrl), 0xf, 0xf, true)))
__device__ __forceinline__ float wave_sum(float v) {
    v = DPP_ADD(v, 0xB1); v = DPP_ADD(v, 0x4E); v = DPP_ADD(v, 0x124); v = DPP_ADD(v, 0x128);
    { auto rr = __builtin_amdgcn_permlane16_swap(__float_as_uint(v), __float_as_uint(v), false, false); v = __uint_as_float(rr[0]) + __uint_as_float(rr[1]); }
    { auto rr = __builtin_amdgcn_permlane32_swap(__float_as_uint(v), __float_as_uint(v), false, false); v = __uint_as_float(rr[0]) + __uint_as_float(rr[1]); }
    return v;
}
#define LDS_WAIT() asm volatile("s_waitcnt lgkmcnt(0)" ::: "memory")
__device__ __forceinline__ int opaque_tid() { int t = threadIdx.x; asm volatile("" : "+v"(t)); return t; }

namespace pg8 {
typedef unsigned short bf16_t;
constexpr int BM = 256, BK = 64, HALF = 128, HTB = HALF * BK * 2, STAGE_BYTES = 8 * HTB, NXCD = 8, WGM = 8;
__host__ __device__ __forceinline__ int lds_byte(int r, int c) { const int st = (r >> 4) * 2 + (c >> 5), rr = r & 15, cc = c & 31, ob = rr * 64 + cc * 2; return st * 1024 + (ob ^ (((ob >> 9) & 1) << 5)); }
__host__ __device__ __forceinline__ void stage_rc(int b, int& Rr, int& C) { const int st = b / 1024, sb = b % 1024, swz = sb ^ (((sb >> 9) & 1) << 5); Rr = (st >> 1) * 16 + swz / 64; C = (st & 1) * 32 + (swz % 64) / 2; }
__host__ __device__ __forceinline__ int perm32(int rho) { const int n = rho >> 4, i = rho & 15; return 8 * (i >> 2) + 4 * n + (i & 3); }
struct Unit { int pm, pn; };
struct Gemm { const bf16_t* A; const bf16_t* Bt; int M, N, K, lda; };
struct StaticOrder {
    int nM, nN, nwg, G, c;
    __device__ void init(int M, int N, int G_, int c_) { nM = M / BM; nN = N / BM; nwg = nM * nN; G = G_; c = c_; }
    __device__ bool next(int i, Unit& u) const {
        const long L = (long)i * G + c; if (L >= nwg) return false;
        int wgid = (int)L; { const int q = nwg / NXCD, r = nwg % NXCD, xcd = wgid % NXCD, off = wgid / NXCD; wgid = (xcd < r ? xcd * (q + 1) : r * (q + 1) + (xcd - r) * q) + off; }
        const int nig = WGM * nN, gid = wgid / nig, fm = gid * WGM, gsz = (nM - fm) < WGM ? (nM - fm) : WGM;
        u.pm = fm + ((wgid % nig) % gsz); u.pn = (wgid % nig) / gsz; return true;
    }
};
struct PanelOrder {
    int G, v, nunits;
    __device__ bool next(int i, Unit& u) const { const int L = i * G + v; if (L >= nunits) return false; u.pm = L >> 2; u.pn = L & 3; return true; }
};
template <class Epi, bool ALIGN_EPI, class Sched = StaticOrder>
__device__ __forceinline__ void gemm_phase(LAS unsigned char* lds, const Gemm g, const Sched& S, const Epi& E) {
    const int tid = opaque_tid(), wid = __builtin_amdgcn_readfirstlane(tid >> 6), lane = tid & 63, wr = wid >> 2, wc = wid & 3, fr = lane & 15, fq = lane >> 4;
    const int K = g.K, nt = K / BK, lda = g.lda;
    unsigned voffA[2], voffB[2];
#pragma unroll
    for (int i = 0; i < 2; ++i) { int Rr, C; stage_rc(tid * 16 + i * 8192, Rr, C); const int Rb = Epi::PERM ? ((Rr & ~31) + perm32(Rr & 31)) : Rr;
        voffA[i] = (unsigned)(Rr * lda + C) * 2u; voffB[i] = (unsigned)(Rb * K + C) * 2u; }
    const size_t kstep = (size_t)(BK * 2);
    const size_t hA = (size_t)HALF * lda * 2, hB = (size_t)HALF * K * 2, tA = 2 * hA, tB = 2 * hB;
    const unsigned ldsw = (unsigned)wid * 1024u;
    const int aoff = lds_byte(wr * 64 + fr, fq * 8), boff = lds_byte(wc * 32 + fr, fq * 8);
#define PG8_SA(b, h) (((b) * 2 + (h)) * HTB)
#define PG8_SB(b, h) ((4 + (b) * 2 + (h)) * HTB)
#define PG8_STAGE(bufoff, gbase, voff) do { _Pragma("unroll") for (int _i = 0; _i < 2; ++_i) \
        __builtin_amdgcn_global_load_lds((const unsigned*)((const char*)(gbase) + (voff)[_i]), (LAS unsigned*)(lds + (bufoff) + ldsw + _i * 8192), 16, 0, 0); } while (0)
#define PG8_LDA(dst, b, h) do { _Pragma("unroll") for (int m = 0; m < 4; ++m) _Pragma("unroll") for (int k = 0; k < 2; ++k) dst[m][k] = *(const LAS bf16x8*)(lds + PG8_SA(b, h) + aoff + m * 2048 + k * 1024); } while (0)
#define PG8_LDB(dst, b, h) do { _Pragma("unroll") for (int n = 0; n < 2; ++n) _Pragma("unroll") for (int k = 0; k < 2; ++k) dst[n][k] = *(const LAS bf16x8*)(lds + PG8_SB(b, h) + boff + n * 2048 + k * 1024); } while (0)
#define PG8_MMA(ai, bj, At, Bt) do { __builtin_amdgcn_s_setprio(1); _Pragma("unroll") for (int m = 0; m < 4; ++m) _Pragma("unroll") for (int n = 0; n < 2; ++n) _Pragma("unroll") for (int k = 0; k < 2; ++k) \
        acc[ai][bj][m][n] = __builtin_amdgcn_mfma_f32_16x16x32_bf16(Bt[n][k], At[m][k], acc[ai][bj][m][n], 0, 0, 0); __builtin_amdgcn_s_setprio(0); } while (0)
#define PG8_WAIT_V(n) asm volatile("s_waitcnt vmcnt(" #n ")" ::: "memory")
#define PG8_WAIT_L(n) asm volatile("s_waitcnt lgkmcnt(" #n ")" ::: "memory")
#define PG8_BAR __builtin_amdgcn_s_barrier()
#define PG8_SCHED __builtin_amdgcn_sched_barrier(0)
    Unit cur, nxt; int ui = 0;
    if (!S.next(0, cur)) return;
    f32x4 acc[2][2][4][2];
#pragma unroll
    for (int a = 0; a < 2; ++a)
#pragma unroll
        for (int b = 0; b < 2; ++b)
#pragma unroll
            for (int m = 0; m < 4; ++m)
#pragma unroll
                for (int n = 0; n < 2; ++n) acc[a][b][m][n] = (f32x4){0.f, 0.f, 0.f, 0.f};
    const char* cA = (const char*)g.A + (size_t)cur.pm * tA; const char* cB = (const char*)g.Bt + (size_t)cur.pn * tB;
    PG8_STAGE(PG8_SB(0, 0), cB, voffB); PG8_STAGE(PG8_SB(0, 1), cB + hB, voffB); PG8_STAGE(PG8_SA(0, 0), cA, voffA); PG8_STAGE(PG8_SA(0, 1), cA + hA, voffA);
    if (wr == 1) PG8_BAR;
    PG8_WAIT_V(2); PG8_BAR;
    PG8_STAGE(PG8_SB(1, 0), cB + kstep, voffB); PG8_STAGE(PG8_SA(1, 0), cA + kstep, voffA); PG8_STAGE(PG8_SB(1, 1), cB + hB + kstep, voffB);
    PG8_WAIT_V(6); PG8_BAR;
    for (;;) {
        const bool has_next = S.next(ui + 1, nxt);
        const char* nA = has_next ? (const char*)g.A + (size_t)nxt.pm * tA : cA; const char* nB = has_next ? (const char*)g.Bt + (size_t)nxt.pn * tB : cB;
#pragma nounroll
        for (int t = 0; t < nt; t += 2) {
            const bool last = (t == nt - 2);
            bf16x8 At[4][2], B0[2][2], B1[2][2];
            const char* a1 = cA + (size_t)(t + 1) * kstep;
            const char* a2 = last ? nA : cA + (size_t)(t + 2) * kstep; const char* b2 = last ? nB : cB + (size_t)(t + 2) * kstep;
            const char* a3 = a2 + kstep; const char* b3 = b2 + kstep;
            PG8_LDB(B0, 0, 0); PG8_LDB(B1, 0, 1); PG8_SCHED; PG8_LDA(At, 0, 0); PG8_STAGE(PG8_SA(1, 1), a1 + hA, voffA);
            PG8_WAIT_V(8); PG8_WAIT_L(0); PG8_BAR; PG8_MMA(0, 0, At, B0); PG8_MMA(0, 1, At, B1); PG8_BAR; PG8_SCHED;
            PG8_LDA(At, 0, 1); PG8_STAGE(PG8_SB(0, 0), b2, voffB); PG8_STAGE(PG8_SB(0, 1), b2 + hB, voffB); PG8_STAGE(PG8_SA(0, 0), a2, voffA);
            PG8_WAIT_V(8); PG8_WAIT_L(0); PG8_BAR; PG8_MMA(1, 0, At, B0); PG8_MMA(1, 1, At, B1); PG8_BAR; PG8_SCHED;
            PG8_LDB(B0, 1, 0); PG8_LDB(B1, 1, 1); PG8_SCHED; PG8_LDA(At, 1, 0); PG8_STAGE(PG8_SA(0, 1), a2 + hA, voffA);
            PG8_WAIT_V(8); PG8_WAIT_L(0); PG8_BAR; PG8_MMA(0, 0, At, B0); PG8_MMA(0, 1, At, B1); PG8_BAR; PG8_SCHED;
            PG8_LDA(At, 1, 1); PG8_STAGE(PG8_SB(1, 0), b3, voffB); PG8_STAGE(PG8_SB(1, 1), b3 + hB, voffB); PG8_STAGE(PG8_SA(1, 0), a3, voffA);
            PG8_WAIT_V(8); PG8_WAIT_L(0); PG8_BAR; PG8_MMA(1, 0, At, B0); PG8_MMA(1, 1, At, B1); PG8_BAR; PG8_SCHED;
        }
        if constexpr (ALIGN_EPI) { if (wr == 0) PG8_BAR; }
        E(acc, cur, wr, wc, fr, fq);
        if (!has_next) break;
#pragma unroll
        for (int a = 0; a < 2; ++a)
#pragma unroll
            for (int b = 0; b < 2; ++b)
#pragma unroll
                for (int m = 0; m < 4; ++m)
#pragma unroll
                    for (int n = 0; n < 2; ++n) acc[a][b][m][n] = (f32x4){0.f, 0.f, 0.f, 0.f};
        cur = nxt; cA = nA; cB = nB; ++ui;
        if constexpr (ALIGN_EPI) { if (wr == 1) PG8_BAR; }
    }
    PG8_WAIT_V(0);
    if constexpr (!ALIGN_EPI) { if (wr == 0) PG8_BAR; }
    PG8_BAR;
#undef PG8_SA
#undef PG8_SB
#undef PG8_STAGE
#undef PG8_LDA
#undef PG8_LDB
#undef PG8_MMA
#undef PG8_WAIT_V
#undef PG8_WAIT_L
#undef PG8_BAR
#undef PG8_SCHED
}

__device__ __forceinline__ int rk_base(int pm) { return pm < 32 ? pm * 256 : RP + ((pm - 32) >> 3) * 2304 + ((pm - 32) & 7) * 256; }

struct EpiBf16 {
    static constexpr bool PERM = true;
    bf16* O; int ldc; int split_cols; size_t split_stride;
    __device__ __forceinline__ void operator()(const f32x4 (&acc)[2][2][4][2], const Unit& u, int wr, int wc, int fr, int fq) const {
        const int row0 = u.pm * BM + wr * 64 + fr; int colt = u.pn * BM; bf16* base = O;
        if (split_cols) { const int t = colt / split_cols; base += (size_t)t * split_stride; colt -= t * split_cols; }
        const int col0 = colt + wc * 32 + 8 * fq;
#pragma unroll
        for (int ai = 0; ai < 2; ++ai)
#pragma unroll
            for (int m = 0; m < 4; ++m) { bf16* rowp = base + (size_t)(row0 + ai * HALF + m * 16) * ldc + col0;
#pragma unroll
                for (int bj = 0; bj < 2; ++bj) { const f32x4 v0 = acc[ai][bj][m][0], v1 = acc[ai][bj][m][1];
                    u32x4 w; w.x = pk2(v0[0], v0[1]); w.y = pk2(v0[2], v0[3]); w.z = pk2(v1[0], v1[1]); w.w = pk2(v1[2], v1[3]);
                    *(u32x4*)(rowp + bj * HALF) = w; } }
    }
};
struct EpiOutPub {
    static constexpr bool PERM = true;
    bf16* O; unsigned* cnt;
    __device__ __forceinline__ void operator()(const f32x4 (&acc)[2][2][4][2], const Unit& u, int wr, int wc, int fr, int fq) const {
        const __amdgpu_buffer_rsrc_t rs = __builtin_amdgcn_make_buffer_rsrc((void*)O, (short)0, R * 1024 * 2, 0x00020000);
        const int row0 = u.pm * BM + wr * 64 + fr; const int col0 = u.pn * BM + wc * 32 + 8 * fq;
#pragma unroll
        for (int ai = 0; ai < 2; ++ai)
#pragma unroll
            for (int m = 0; m < 4; ++m) { const int off = ((row0 + ai * HALF + m * 16) * 1024 + col0) * 2;
#pragma unroll
                for (int bj = 0; bj < 2; ++bj) { const f32x4 v0 = acc[ai][bj][m][0], v1 = acc[ai][bj][m][1];
                    u32x4 w; w.x = pk2(v0[0], v0[1]); w.y = pk2(v0[2], v0[3]); w.z = pk2(v1[0], v1[1]); w.w = pk2(v1[2], v1[3]);
                    __builtin_amdgcn_raw_buffer_store_b128(w, rs, off + bj * HALF * 2, 0, 16); } }
        asm volatile("s_waitcnt vmcnt(0)" ::: "memory");
        if ((fr | fq) == 0) __hip_atomic_fetch_add(cnt + 16 * u.pm, 1u, __ATOMIC_RELAXED, __HIP_MEMORY_SCOPE_AGENT);
    }
};
struct EpiPool {
    static constexpr bool PERM = true;
    bf16* GB;
    __device__ __forceinline__ void operator()(const f32x4 (&acc)[2][2][4][2], const Unit& u, int wr, int wc, int fr, int fq) const {
        const int row0 = u.pm * BM + wr * 64 + fr; const int col0 = u.pn * BM + wc * 32 + 8 * fq;
#pragma unroll
        for (int ai = 0; ai < 2; ++ai)
#pragma unroll
            for (int m = 0; m < 4; ++m) { bf16* rowp = GB + (size_t)(row0 + ai * HALF + m * 16) * 1024 + col0;
#pragma unroll
                for (int bj = 0; bj < 2; ++bj) { const f32x4 v0 = acc[ai][bj][m][0], v1 = acc[ai][bj][m][1];
                    const u32x4 gg = *(const u32x4*)(rowp + bj * HALF);
                    u32x4 w;
                    w.x = pk2(v0[0] * silu_fast(bflo(gg.x)), v0[1] * silu_fast(bfhi(gg.x))); w.y = pk2(v0[2] * silu_fast(bflo(gg.y)), v0[3] * silu_fast(bfhi(gg.y)));
                    w.z = pk2(v1[0] * silu_fast(bflo(gg.z)), v1[1] * silu_fast(bfhi(gg.z))); w.w = pk2(v1[2] * silu_fast(bflo(gg.w)), v1[3] * silu_fast(bfhi(gg.w)));
                    *(u32x4*)(rowp + bj * HALF) = w; } }
    }
};
struct EpiMlaIn {
    static constexpr bool PERM = true;
    bf16 *CQ, *CKV, *GAB, *VP; float* KRF;
    __device__ __forceinline__ void operator()(const f32x4 (&acc)[2][2][4][2], const Unit& u, int wr, int wc, int fr, int fq) const {
        const int rt = wr * 64 + fr, grow0 = u.pm * BM, rk0 = rk_base(u.pm), cc = wc * 32 + 8 * fq;
#pragma unroll
        for (int bj = 0; bj < 2; ++bj) {
            const int U = 2 * u.pn + bj;
            if (U == 5) {
                if (wc == 0) {
#pragma unroll
                    for (int ai = 0; ai < 2; ++ai)
#pragma unroll
                        for (int m = 0; m < 4; ++m) { float* p = KRF + (size_t)(grow0 + rt + ai * HALF + m * 16) * 32 + 8 * fq;
                            *(f32x4*)p = acc[ai][bj][m][0]; *(f32x4*)(p + 4) = acc[ai][bj][m][1]; }
                }
                continue;
            }
            bf16* p; int ld, rb = grow0;
            if (U < 3) { p = CQ + 128 * U; ld = 384; }
            else if (U < 5) { p = CKV + 128 * (U - 3); ld = 256; rb = rk0; }
            else if (U < 10) { p = GAB + 128 * (U - 6); ld = 1024; }
            else if (U < 14) { p = VP + 128 * (U - 10); ld = 512; }
            else { p = GAB + 512 + 128 * (U - 14); ld = 1024; }
            p += (size_t)(rb + rt) * ld + cc;
            const bool isgate = (U >= 6 && U < 10) || U >= 14;
#pragma unroll
            for (int ai = 0; ai < 2; ++ai)
#pragma unroll
                for (int m = 0; m < 4; ++m) { f32x4 v0 = acc[ai][bj][m][0], v1 = acc[ai][bj][m][1];
                    if (isgate) { v0 = (f32x4){silu_fast(v0[0]), silu_fast(v0[1]), silu_fast(v0[2]), silu_fast(v0[3])}; v1 = (f32x4){silu_fast(v1[0]), silu_fast(v1[1]), silu_fast(v1[2]), silu_fast(v1[3])}; }
                    u32x4 w; w.x = pk2(v0[0], v0[1]); w.y = pk2(v0[2], v0[3]); w.z = pk2(v1[0], v1[1]); w.w = pk2(v1[2], v1[3]);
                    *(u32x4*)(p + (size_t)(ai * HALF + m * 16) * ld) = w; }
        }
    }
};
__device__ __forceinline__ void rope_perm(f32x4& a, f32x4& b, const float* tb) {
#pragma unroll
    for (int j = 0; j < 4; ++j) { auto rr = __builtin_amdgcn_permlane32_swap(__float_as_uint(a[j]), __float_as_uint(b[j]), false, false); a[j] = __uint_as_float(rr[0]); b[j] = __uint_as_float(rr[1]); }
    const f32x4 c0 = *(const f32x4*)tb, c1 = *(const f32x4*)(tb + 4);
    const f32x4 cs = {c0[0], c0[2], c1[0], c1[2]}, sn = {c0[1], c0[3], c1[1], c1[3]};
    const f32x4 o1 = a * cs - b * sn, o2 = a * sn + b * cs;
    a = o1; b = o2;
#pragma unroll
    for (int j = 0; j < 4; ++j) { auto rr = __builtin_amdgcn_permlane32_swap(__float_as_uint(a[j]), __float_as_uint(b[j]), false, false); a[j] = __uint_as_float(rr[0]); b[j] = __uint_as_float(rr[1]); }
}
struct EpiQ {
    static constexpr bool PERM = true;
    bf16* Q; const float* rope8;
    __device__ __forceinline__ void operator()(const f32x4 (&acc)[2][2][4][2], const Unit& u, int wr, int wc, int fr, int fq) const {
        const int rt = wr * 64 + fr, grow0 = u.pm * BM; const bool sample = u.pm >= 32; const int t0 = ((u.pm - 32) & 7) * 256;
#pragma unroll
        for (int bj = 0; bj < 2; ++bj) {
            const int g32 = 8 * u.pn + 4 * bj + wc; const bool rot = sample && (g32 % 3 == 2);
#pragma unroll
            for (int ai = 0; ai < 2; ++ai)
#pragma unroll
                for (int m = 0; m < 4; ++m) { const int r = rt + ai * HALF + m * 16; f32x4 x1 = acc[ai][bj][m][0], x2 = acc[ai][bj][m][1];
                    if (rot) { const int t = t0 + r, pos = (fq & 1) ? (t & 63) : (t >> 6); rope_perm(x1, x2, rope8 + (pos * 8 + ((fq >> 1) ? 4 : 0)) * 2); }
                    u32x4 w; w.x = pk2(x1[0], x1[1]); w.y = pk2(x1[2], x1[3]); w.z = pk2(x2[0], x2[1]); w.w = pk2(x2[2], x2[3]);
                    *(u32x4*)(Q + (size_t)(grow0 + r) * 768 + 32 * g32 + 8 * fq) = w; }
        }
    }
};
struct EpiSwaIn {
    static constexpr bool PERM = true;
    bf16 *Q, *K, *V, *G; float *stK, *stV; const float* rope16;
    __device__ __forceinline__ void operator()(const f32x4 (&acc)[2][2][4][2], const Unit& u, int wr, int wc, int fr, int fq) const {
        const int rt = wr * 64 + fr, grow0 = u.pm * BM, rk0 = rk_base(u.pm); const bool sample = u.pm >= 32; const int t0 = ((u.pm - 32) & 7) * 256;
        const int pn = u.pn;
#pragma unroll
        for (int bj = 0; bj < 2; ++bj) {
            const int cb = 128 * bj + 32 * wc + 8 * fq;
            const bool rot = sample && pn < 5;
#pragma unroll
            for (int ai = 0; ai < 2; ++ai)
#pragma unroll
                for (int m = 0; m < 4; ++m) { const int r = rt + ai * HALF + m * 16; f32x4 x1 = acc[ai][bj][m][0], x2 = acc[ai][bj][m][1];
                    if (rot) { const int t = t0 + r, pos = (wc & 1) ? (t & 63) : (t >> 6); rope_perm(x1, x2, rope16 + (pos * 16 + 8 * (fq & 1) + ((fq >> 1) ? 4 : 0)) * 2); }
                    bf16* p;
                    if (pn < 4) p = Q + (size_t)(grow0 + r) * 1024 + 256 * pn + cb;
                    else if (pn == 4) p = K + (size_t)(rk0 + r) * 256 + cb;
                    else if (pn == 5) p = V + (size_t)(rk0 + r) * 256 + cb;
                    else p = G + (size_t)(grow0 + r) * 1024 + 256 * (pn - 6) + cb;
                    if (pn >= 6) { x1 = (f32x4){silu_fast(x1[0]), silu_fast(x1[1]), silu_fast(x1[2]), silu_fast(x1[3])}; x2 = (f32x4){silu_fast(x2[0]), silu_fast(x2[1]), silu_fast(x2[2]), silu_fast(x2[3])}; }
                    if (!sample && (pn == 4 || pn == 5)) { float* st = (pn == 4 ? stK : stV) + (size_t)(u.pm * 2 * 256 + r) * 256 + cb; *(f32x4*)st = x1; *(f32x4*)(st + 4) = x2; }
                    u32x4 w; w.x = pk2(x1[0], x1[1]); w.y = pk2(x1[2], x1[3]); w.z = pk2(x2[0], x2[1]); w.w = pk2(x2[2], x2[3]);
                    *(u32x4*)p = w; }
        }
    }
};
}

typedef __attribute__((address_space(4))) const char* kptr_t;
__device__ __forceinline__ const void* arg_ptr(int k) { kptr_t ka = (kptr_t)__builtin_amdgcn_kernarg_segment_ptr(); asm volatile("" : "+s"(ka)); return *(const void* __attribute__((address_space(4)))*)(ka + 8 * k); }
#define ARG_IN(k) ((const float*)arg_ptr(k))
namespace att {
__device__ __forceinline__ int crow(int r, int hi) { return (r & 3) + 8 * (r >> 2) + 4 * hi; }
typedef short v4i16_t __attribute__((ext_vector_type(4)));
__device__ __forceinline__ s16x4 vtr(const LAS char* p) { return __builtin_bit_cast(s16x4, __builtin_amdgcn_ds_read_tr16_b64_v4i16((LAS v4i16_t*)p)); }
__device__ __forceinline__ float xhalf_max(float x) { auto rr = __builtin_amdgcn_permlane32_swap(__float_as_uint(x), __float_as_uint(x), false, false); return __builtin_fmaxf(__uint_as_float(rr[0]), __uint_as_float(rr[1])); }
__device__ __forceinline__ float xhalf_sum(float x) { auto rr = __builtin_amdgcn_permlane32_swap(__float_as_uint(x), __float_as_uint(x), false, false); return __uint_as_float(rr[0]) + __uint_as_float(rr[1]); }
#define SBAR() __builtin_amdgcn_sched_barrier(0)
#define PIN(x) asm volatile("" : "+v"(x))
__device__ __forceinline__ float max3f(float a, float b, float c) { float r; asm("v_max3_f32 %0, %1, %2, %3" : "=v"(r) : "v"(a), "v"(b), "v"(c)); return r; }
__device__ __forceinline__ float max2f(float a, float b) { float r; asm("v_max_f32_e32 %0, %1, %2" : "=v"(r) : "v"(a), "v"(b)); return r; }
struct Desc {
    const bf16* qptr;
    const bf16* k0;
    const bf16* k1;
    const bf16* v;
    int n_a, row_a, n_b, row_b, key_b;
    int qpos; float sink2; int has_sink;
    bf16* optr;
};
constexpr float THR = 8.f;
__device__ __forceinline__ int tile_row(const Desc& d, int t) { return t < d.n_a ? d.row_a + 64 * t : d.row_b + 64 * (t - d.n_a); }
template <int MODE, class MK>
__device__ __forceinline__ void attn_phase(LAS char* lds, const MK& mk, int first, int stride, int nunits) {
    constexpr int DQK = MODE == 0 ? 96 : 64, NCH = DQK / 8, ND0 = DQK / 16, KB = NCH * 1024, VOFF = 3 * KB, NG = 2 * ND0, NHELD = 8, NLATE = NG - NHELD, STG_OFF = VOFF + 2 * 8192;
    static_assert(STG_OFF + 8 * 32 * 272 <= 131072, "attention LDS map");
    constexpr int LDQ = MODE == 0 ? 768 : 1024, LDK0 = MODE == 0 ? 512 : 256, LDV = LDK0, LDO = 1024;
    int un = first; if (un >= nunits) return;
    const int tid = opaque_tid(), lane = tid & 63, r32 = lane & 31, hi = lane >> 5; const int wid = __builtin_amdgcn_readfirstlane(tid >> 6);
    const int kdst = wid * 1024, k1dst = (8 + (wid & 3)) * 1024, vdst = VOFF + wid * 1024;
    const int vlane = ((lane >> 4) & 1) * 32 + (lane & 3) * 8 + (4 * hi + ((lane & 15) >> 2)) * 64;
    const int kfo = hi * 1024 + r32 * 16;
    Desc d; mk(un, d);
#define SRC_K(dd) ((dd).k0 + (size_t)lane * LDK0 + wid * 8)
#define SRC_K1(dd) ((MODE == 0) ? (dd).k1 + (size_t)lane * 32 + (wid & 3) * 8 : (const bf16*)nullptr)
#define SRC_V(dd) ((dd).v + (size_t)(16 * (wid & 3) + (lane >> 2)) * LDV + (wid >> 2) * 32 + (lane & 3) * 8)
    const bf16* ksrc = SRC_K(d); const bf16* k1src = SRC_K1(d); const bf16* vsrc = SRC_V(d);
#define GLDS16(g, l) __builtin_amdgcn_global_load_lds((const unsigned*)(g), (LAS unsigned*)(l), 16, 0, 0)
#define DMAK_(dd, ks_, k1s_, t, soff) do { const size_t _r = (size_t)tile_row(dd, t); GLDS16((ks_) + _r * LDK0, lds + (soff) + kdst); if (MODE == 0 && wid < 4) GLDS16((k1s_) + _r * 32, lds + (soff) + k1dst); } while (0)
#define DMAV_(dd, vs_, t, vslot) do { const size_t _r = (size_t)tile_row(dd, t); GLDS16((vs_) + _r * LDV, lds + (vslot) * 8192 + vdst); } while (0)
#define DMAK(t, soff) DMAK_(d, ksrc, k1src, t, soff)
#define DMAV(t, vslot) DMAV_(d, vsrc, t, vslot)
    int sl_cur = 0, sl_nxt = KB, sl_fre = 2 * KB;
    int vpar = 0;
    DMAK(0, sl_cur); DMAK(1, sl_nxt); DMAV(0, vpar);
    bf16x8 qr[ND0];
#pragma unroll
    for (int d0 = 0; d0 < ND0; ++d0) qr[d0] = *(const bf16x8*)(d.qptr + (size_t)r32 * LDQ + d0 * 16 + hi * 8);
    __syncthreads();
#define ROT() do { const int o_ = sl_cur; sl_cur = sl_nxt; sl_nxt = sl_fre; sl_fre = o_; } while (0)
#define KFADDR(i, soff) (lds + (soff) + kfo + ((i) >> 1) * 2048 + ((i) & 1) * 512)
#define PE(P0, P1, e) ((e) < 16 ? P0[(e) & 15] : P1[(e) & 15])
#define FILL_A(P0, P1, g) do { \
        _Pragma("unroll") for (int e_ = (32 * (g)) / NG; e_ < (32 * ((g) + 1)) / NG; ++e_) sacc += PE(P0, P1, e_); \
        PIN(sacc); \
        _Pragma("unroll") for (int k_ = (16 * (g)) / NG; k_ < (16 * ((g) + 1)) / NG; ++k_) { pw[k_ >> 2][k_ & 3] = pk2(PE(P0, P1, 2 * k_), PE(P0, P1, 2 * k_ + 1)); PIN(pw[k_ >> 2]); } } while (0)
#define QK_PHASE(C0, C1, P0, P1, HAVE_P) do { \
        bf16x8 kl_[NLATE > 0 ? NLATE : 1]; \
        _Pragma("unroll") for (int i_ = 0; i_ < NLATE; ++i_) kl_[i_] = *(const LAS bf16x8*)KFADDR(NHELD + i_, sl_cur); \
        _Pragma("unroll") for (int g_ = 0; g_ < NG; ++g_) { const int d0_ = g_ >> 1; \
            const bf16x8 kk_ = g_ < NHELD ? kf[g_ < NHELD ? g_ : 0] : kl_[g_ >= NHELD ? g_ - NHELD : 0]; \
            if ((g_ & 1) == 0) C0 = __builtin_amdgcn_mfma_f32_32x32x16_bf16(kk_, qr[d0_], d0_ == 0 ? negm : C0, 0, 0, 0); \
            else C1 = __builtin_amdgcn_mfma_f32_32x32x16_bf16(kk_, qr[d0_], d0_ == 0 ? negm : C1, 0, 0, 0); \
            if (HAVE_P) FILL_A(P0, P1, g_); \
            SBAR(); } } while (0)
#define MASKT(C0, C1, t_) do { if (MODE == 1 && (t_) >= d.n_a) { const int key0_ = d.key_b + 64 * ((t_) - d.n_a); \
        if (key0_ - (qb0 + 31) < -128 || key0_ + 63 - qb0 > 128) { const int k0p_ = key0_ - d.qpos; \
            _Pragma("unroll") for (int r = 0; r < 16; ++r) { const int d_ = k0p_ + crow(r, hi); if (d_ > 128 || d_ < -128) C0[r] = -1e30f; if (d_ + 32 > 128 || d_ + 32 < -128) C1[r] = -1e30f; } } } } while (0)
#define DECIDE(C0, C1) do { \
        float a_ = max2f(C0[0], C1[0]), b_ = max2f(C0[1], C1[1]); \
        _Pragma("unroll") for (int r = 2; r < 16; r += 2) { a_ = max3f(a_, C0[r], C1[r]); b_ = max3f(b_, C0[r + 1], C1[r + 1]); } \
        a_ = xhalf_max(max2f(a_, b_)); resc = false; \
        if (__any(a_ > THR)) { const float dl_ = fmaxf(a_, 0.f); mref += dl_; \
            _Pragma("unroll") for (int r = 0; r < 16; ++r) { C0[r] -= dl_; C1[r] -= dl_; } \
            _Pragma("unroll") for (int r = 0; r < 16; ++r) negm[r] = -mref; \
            fsc = __builtin_amdgcn_exp2f(-dl_); lsum *= fsc; resc = true; } } while (0)
#define EXP4(C0, C1, j) do { _Pragma("unroll") for (int e_ = 4 * (j); e_ < 4 * (j) + 4; ++e_) { if (e_ < 16) C0[e_ & 15] = __builtin_amdgcn_exp2f(C0[e_ & 15]); else C1[e_ & 15] = __builtin_amdgcn_exp2f(C1[e_ & 15]); } \
        if (4 * (j) < 16) PIN(C0); else PIN(C1); } while (0)
#define VOFFS(j) ((((j) & 1) * 4096) + (((j) >> 1) * 1024))
#define PV_PHASE(C0, C1, HAVE_C, HAVE_K, tp_) do { \
        const LAS char* vp_ = lds + VOFF + (((tp_) + vpar) & 1) * 8192 + vlane; \
        s16x4 vl_[8], vh_[8]; \
        vl_[0] = vtr(vp_ + VOFFS(0)); vh_[0] = vtr(vp_ + VOFFS(0) + 512); vl_[1] = vtr(vp_ + VOFFS(1)); vh_[1] = vtr(vp_ + VOFFS(1) + 512); \
        _Pragma("unroll") for (int j = 0; j < 8; ++j) { const int ks = j >> 1, dd = j & 1; \
            if (j + 2 < 8) { vl_[j + 2] = vtr(vp_ + VOFFS(j + 2)); vh_[j + 2] = vtr(vp_ + VOFFS(j + 2) + 512); } \
            if (HAVE_K) kf[j] = *(const LAS bf16x8*)KFADDR(j, sl_nxt); \
            const bf16x8 vf_ = {vl_[j][0], vl_[j][1], vl_[j][2], vl_[j][3], vh_[j][0], vh_[j][1], vh_[j][2], vh_[j][3]}; \
            if (dd == 0) o0 = __builtin_amdgcn_mfma_f32_32x32x16_bf16(vf_, __builtin_bit_cast(bf16x8, pw[ks]), o0, 0, 0, 0); \
            else o1 = __builtin_amdgcn_mfma_f32_32x32x16_bf16(vf_, __builtin_bit_cast(bf16x8, pw[ks]), o1, 0, 0, 0); \
            if (HAVE_C) EXP4(C0, C1, j); \
            SBAR(); } } while (0)
#define STEP(C0, C1, P0, P1, t_) do { \
        if ((t_) + 2 < NT) DMAK((t_) + 2, sl_fre); \
        DMAV(t_, ((t_) + vpar) & 1); \
        float sacc = 0.f; \
        QK_PHASE(C0, C1, P0, P1, true); \
        lsum += sacc; \
        MASKT(C0, C1, t_); \
        DECIDE(C0, C1); \
        SBAR(); \
        PV_PHASE(C0, C1, true, true, (t_) - 1); \
        __syncthreads(); \
        ROT(); \
        if (resc) { o0 *= fsc; o1 *= fsc; } } while (0)
    for (;;) {
        const int NT = d.n_a + d.n_b;
        const int qb0 = __builtin_amdgcn_readfirstlane(d.qpos);
        float mref = 0.f, lsum = 0.f, fsc = 1.f; bool resc = false;
        f32x16 o0 = (f32x16){}, o1 = (f32x16){}, negm = (f32x16){};
        f32x16 cA0 = (f32x16){}, cA1 = (f32x16){}, cB0 = (f32x16){}, cB1 = (f32x16){};
        u32x4 pw[4];
#pragma unroll
        for (int i = 0; i < 4; ++i) pw[i] = (u32x4){0u, 0u, 0u, 0u};
        bf16x8 kf[NHELD];
#pragma unroll
        for (int i = 0; i < NHELD; ++i) kf[i] = *(const LAS bf16x8*)KFADDR(i, sl_cur);
        {
            if (2 < NT) DMAK(2, sl_fre);
            float sacc = 0.f; (void)sacc;
            QK_PHASE(cA0, cA1, cA0, cA1, false);
            MASKT(cA0, cA1, 0);
            DECIDE(cA0, cA1);
#pragma unroll
            for (int j = 0; j < 8; ++j) { kf[j] = *(const LAS bf16x8*)KFADDR(j, sl_nxt); EXP4(cA0, cA1, j); SBAR(); }
            __syncthreads();
            ROT();
        }
        int t = 1;
        for (; t + 1 < NT; t += 2) { STEP(cB0, cB1, cA0, cA1, t); STEP(cA0, cA1, cB0, cB1, t + 1); }
        const bool odd_tail = t < NT;
        if (odd_tail) STEP(cB0, cB1, cA0, cA1, t);
        const int un_next = un + stride; const bool has_next = un_next < nunits;
        Desc dn = d;
        const bf16* ksrc_n = ksrc; const bf16* k1src_n = k1src; const bf16* vsrc_n = vsrc;
        u32x4 gpre[4];
#pragma unroll
        for (int i2 = 0; i2 < 4; ++i2) gpre[i2] = *(const u32x4*)(d.optr + (size_t)(i2 * 8 + (lane >> 3)) * LDO + (lane & 7) * 8);
        bf16x8 qn[ND0];
#pragma unroll
        for (int d0 = 0; d0 < ND0; ++d0) qn[d0] = qr[d0];
        if (has_next) {
            mk(un_next, dn);
            ksrc_n = SRC_K(dn); k1src_n = SRC_K1(dn); vsrc_n = SRC_V(dn);
            DMAK_(dn, ksrc_n, k1src_n, 0, sl_cur); DMAK_(dn, ksrc_n, k1src_n, 1, sl_nxt); DMAV_(dn, vsrc_n, 0, (NT + vpar) & 1);
#pragma unroll
            for (int d0 = 0; d0 < ND0; ++d0) qn[d0] = *(const bf16x8*)(dn.qptr + (size_t)r32 * LDQ + d0 * 16 + hi * 8);
        }
        if (odd_tail) {
            float sacc = 0.f;
#pragma unroll
            for (int g = 0; g < NG; ++g) FILL_A(cB0, cB1, g);
            lsum += sacc;
            PV_PHASE(cB0, cB1, false, false, NT - 1);
        } else {
            float sacc = 0.f;
#pragma unroll
            for (int g = 0; g < NG; ++g) FILL_A(cA0, cA1, g);
            lsum += sacc;
            PV_PHASE(cA0, cA1, false, false, NT - 1);
        }
        float lt = xhalf_sum(lsum);
        if (d.has_sink) lt += __builtin_amdgcn_exp2f(d.sink2 - mref);
        const float inv = 1.0f / lt;
        {
            LAS char* stg = lds + STG_OFF + wid * (32 * 272);
#pragma unroll
            for (int d0 = 0; d0 < 2; ++d0)
#pragma unroll
                for (int g = 0; g < 4; ++g) { const f32x16& o = d0 ? o1 : o0;
                    const f32x4 v = {o[4 * g] * inv, o[4 * g + 1] * inv, o[4 * g + 2] * inv, o[4 * g + 3] * inv};
                    *(LAS f32x4*)(stg + r32 * 272 + (32 * d0 + 8 * g + 4 * hi) * 4) = v; }
#pragma unroll
            for (int i2 = 0; i2 < 4; ++i2) { const int row = i2 * 8 + (lane >> 3), ch = lane & 7;
                const f32x4 va = *(const LAS f32x4*)(stg + row * 272 + ch * 32), vb = *(const LAS f32x4*)(stg + row * 272 + ch * 32 + 16);
                const u32x4 gg = gpre[i2];
                u32x4 w;
                w.x = pk2(va[0] * bflo(gg.x), va[1] * bfhi(gg.x)); w.y = pk2(va[2] * bflo(gg.y), va[3] * bfhi(gg.y));
                w.z = pk2(vb[0] * bflo(gg.z), vb[1] * bfhi(gg.z)); w.w = pk2(vb[2] * bflo(gg.w), vb[3] * bfhi(gg.w));
                *(u32x4*)(d.optr + (size_t)row * LDO + ch * 8) = w; }
        }
        __syncthreads();
        if (!has_next) break;
        vpar = (NT + vpar) & 1;
        d = dn; un = un_next; ksrc = ksrc_n; k1src = k1src_n; vsrc = vsrc_n;
#pragma unroll
        for (int d0 = 0; d0 < ND0; ++d0) qr[d0] = qn[d0];
    }
#undef SRC_K
#undef SRC_K1
#undef SRC_V
#undef GLDS16
#undef DMAK_
#undef DMAV_
#undef DMAK
#undef DMAV
#undef ROT
#undef KFADDR
#undef PE
#undef FILL_A
#undef QK_PHASE
#undef MASKT
#undef DECIDE
#undef EXP4
#undef VOFFS
#undef PV_PHASE
#undef STEP
}
#undef SBAR
}

#define XB_TMO      128
#define XB_XCNT(j)  (256  + 64 * (j))
#define XB_XSUB(j)  (1280 + 64 * (j))
#define XB_XGEN(j)  (2304 + 64 * (j))
#define XB_TOP      3328
#define XB_TOPGEN   3392
#define XCD_BAR_WORDS 3456
#define XB_SPIN_CAP (1u << 20)
__device__ __forceinline__ unsigned xb_ld(unsigned* p)              { return __hip_atomic_load(p, __ATOMIC_RELAXED, __HIP_MEMORY_SCOPE_AGENT); }
__device__ __forceinline__ unsigned xb_add(unsigned* p, unsigned v) { return __hip_atomic_fetch_add(p, v, __ATOMIC_RELAXED, __HIP_MEMORY_SCOPE_AGENT); }
__device__ __forceinline__ unsigned xb_xcc_id() { return (unsigned)__builtin_amdgcn_s_getreg((3 << 11) | 20) & 0xFu; }
#define XB_SPIN(cond, bar) do { unsigned _sp = 0; while (cond) { __builtin_amdgcn_s_sleep(1); \
    if ((++_sp & 255u) == 0u) { if (xb_ld(&(bar)[XB_TMO])) break; if (_sp > XB_SPIN_CAP) { atomicAdd(&(bar)[XB_TMO], 1u); break; } } } } while (0)
struct XcdBarrier { unsigned* bar; unsigned x; volatile LAS unsigned* st; };
__device__ __forceinline__ XcdBarrier xcd_barrier_post(unsigned* bar, volatile LAS unsigned* st) {
    XcdBarrier b; b.bar = bar; b.x = xb_xcc_id(); b.st = st;
    if (threadIdx.x == 0) (void)xb_add(&bar[XB_XCNT(b.x)], 1u);
    return b;
}
__device__ __forceinline__ void xcd_barrier_complete(unsigned* bar, unsigned x, unsigned& nloc, unsigned& nx) {
    const unsigned G = gridDim.x * gridDim.y * gridDim.z;
    unsigned sum, cnt, mine, sp = 0u;
    for (;;) {
        sum = 0u; cnt = 0u; mine = 0u;
#pragma unroll
        for (unsigned j = 0; j < 16; ++j) { const unsigned c = xb_ld(&bar[XB_XCNT(j)]); sum += c; cnt += (c > 0u) ? 1u : 0u; mine = (j == x) ? c : mine; }
        if (sum == G) break;
        __builtin_amdgcn_s_sleep(1);
        if ((++sp & 255u) == 0u) { if (xb_ld(&bar[XB_TMO])) break; if (sp > XB_SPIN_CAP) { atomicAdd(&bar[XB_TMO], 1u); break; } }
    }
    nloc = mine > 0u ? mine : 1u; nx = cnt > 0u ? cnt : 1u;
}
__device__ __forceinline__ void xcd_barrier(const XcdBarrier& b0) {
    asm volatile("s_waitcnt vmcnt(0)" ::: "memory");
    __syncthreads();
    if (threadIdx.x == 0) {
        XcdBarrier b = b0; b.x = xb_xcc_id();
        unsigned* bar = b.bar; asm volatile("" : "+s"(bar));
        __builtin_amdgcn_s_waitcnt(0);
        unsigned nloc = b.st[0], nx = b.st[1];
        if (nloc == 0u) { xcd_barrier_complete(bar, b.x, nloc, nx); b.st[0] = nloc; b.st[1] = nx; }
        const unsigned old = xb_add(&bar[XB_XSUB(b.x)], 1u);
        const unsigned gen = old / nloc;
        if (old + 1u == (gen + 1u) * nloc) {
            __builtin_amdgcn_fence(__ATOMIC_RELEASE, "agent");
            asm volatile("s_waitcnt vmcnt(0)" ::: "memory");
            const unsigned og = xb_add(&bar[XB_TOP], 1u);
            const unsigned tg = og / nx;
            if (og + 1u == (tg + 1u) * nx) xb_add(&bar[XB_TOPGEN], 1u);
            else XB_SPIN(xb_ld(&bar[XB_TOPGEN]) == tg, bar);
            __builtin_amdgcn_fence(__ATOMIC_ACQUIRE, "agent");
            xb_add(&bar[XB_XGEN(b.x)], 1u);
            asm volatile("s_waitcnt vmcnt(0)" ::: "memory");
        } else {
            XB_SPIN(xb_ld(&bar[XB_XGEN(b.x)]) == gen, bar);
            __builtin_amdgcn_fence(__ATOMIC_ACQUIRE, "agent");
            asm volatile("s_waitcnt vmcnt(0)" ::: "memory");
        }
    }
    __syncthreads();
}

struct Args { const float* in[23]; float* out; unsigned char* ws; int ph_lo, ph_hi; };
constexpr int NWAVES = 8;
constexpr int N_PHASES = 2 + 5 + 3 + 5 + 3;
constexpr int RING_BYTES = 131072, MISC_OFF = RING_BYTES + 320, LDS_BYTES = 147456;

struct TMap { int kind, row_off, col_off, ldw; const float* nscale; float scale; };
__device__ __forceinline__ void tmap(const TMap& tm, int n, int& drow, float& sc) {
    drow = n + tm.row_off; sc = tm.scale;
    switch (tm.kind) {
        case 1: if (n >= 672) drow += 96; break;
        case 2: { const int e = n % 96; if (e >= 64) { const int d = e - 64; const int p = (d & 7) | ((d & 8) << 1) | ((d & 16) >> 1); drow = n - e + 64 + p; } } break;
        case 3: { const int h = n >> 7, e = n & 127; drow = (e < 64) ? h * 64 + e : 512 + h * 64 + (e - 64); } break;
        case 4: sc = tm.nscale[n]; break;
        case 5: if (n >= 1024) sc = 1.f; break;
        default: break;
    }
}
__device__ __forceinline__ void transpose_item(const float* W, int K, int N, bf16* WT, const TMap& tm, LAS float* scr, int item, int lane) {
    const int nblk = N / 32, kb = item / nblk, nb = item % nblk, k0 = 64 * kb, n0 = 32 * nb;
    f32x4 wv[8];
#pragma unroll
    for (int i = 0; i < 8; ++i) wv[i] = *(const f32x4*)(W + (size_t)(k0 + 8 * i + (lane >> 3)) * N + n0 + 4 * (lane & 7));
#pragma unroll
    for (int i = 0; i < 8; ++i) { LAS float* d = scr + (8 * i + (lane >> 3)) * 33 + 4 * (lane & 7); d[0] = wv[i][0]; d[1] = wv[i][1]; d[2] = wv[i][2]; d[3] = wv[i][3]; }
    LDS_WAIT(); asm volatile("" ::: "memory");
    const int c = lane & 7;
#pragma unroll
    for (int j = 0; j < 4; ++j) { const int n = (lane >> 3) + 8 * j; const LAS float* s = scr + (8 * c) * 33 + n;
        int drow; float sc; tmap(tm, n0 + n, drow, sc);
        u32x4 o; o.x = pk2(s[0 * 33] * sc, s[1 * 33] * sc); o.y = pk2(s[2 * 33] * sc, s[3 * 33] * sc); o.z = pk2(s[4 * 33] * sc, s[5 * 33] * sc); o.w = pk2(s[6 * 33] * sc, s[7 * 33] * sc);
        *(u32x4*)(WT + (size_t)drow * tm.ldw + tm.col_off + k0 + 8 * c) = o; }
    LDS_WAIT(); asm volatile("" ::: "memory");
}

__device__ __forceinline__ f32x4 mod_load(const float* MODPp, const float* ada_b, int l, int midx, int off) {
    f32x4 s = *(const f32x4*)(ada_b + l * 3072 + off);
#pragma unroll
    for (int kq = 0; kq < 4; ++kq) s += *(const f32x4*)(MODPp + ((size_t)((kq * 4 + l) * 9 + midx)) * 3072 + off);
    return s;
}
__device__ __forceinline__ void ada_item(int it, const float* cvec, const float* cctx, const float* ada_w, float* modp, LAS unsigned char* lds, int tid, int lane, int wave) {
    LAS float* red = (LAS float*)lds;
    const int l = it / 48, rem = it % 48, cc = rem >> 2, kq = rem & 3, k0 = kq * 256 + wave * 32;
    float sv[9];
#pragma unroll
    for (int j = 0; j < 9; ++j) { const float c = (j < 8) ? cvec[j * 1024 + k0 + (lane & 31)] : cctx[k0 + (lane & 31)]; sv[j] = c / (1.f + expf(-c)); }
    f32x4 acc[9];
#pragma unroll
    for (int j = 0; j < 9; ++j) acc[j] = (f32x4){0.f, 0.f, 0.f, 0.f};
    const float* wp = ada_w + ((size_t)l * 1024 + k0) * 3072 + cc * 256 + 4 * lane;
    f32x4 wv[32];
#pragma unroll
    for (int kk = 0; kk < 32; ++kk) wv[kk] = *(const f32x4*)(wp + (size_t)kk * 3072);
    asm volatile("" ::: "memory");
#pragma unroll
    for (int kk = 0; kk < 32; ++kk) {
#pragma unroll
        for (int j = 0; j < 9; ++j) { const float sc = __int_as_float(__builtin_amdgcn_readlane(__float_as_int(sv[j]), kk)); acc[j] += wv[kk] * sc; }
    }
#pragma unroll
    for (int j = 0; j < 9; ++j) *(LAS f32x4*)(red + (wave * 9 + j) * 256 + 4 * lane) = acc[j];
    __syncthreads();
    for (int idx = tid; idx < 9 * 256; idx += NWAVES * 64) { const int j = idx >> 8, col = idx & 255; float sm = 0.f;
#pragma unroll
        for (int w = 0; w < 8; ++w) sm += red[(w * 9 + j) * 256 + col];
        modp[((size_t)((kq * 4 + l) * 9 + j)) * 3072 + cc * 256 + col] = sm; }
    __syncthreads();
}
constexpr int CI1 = 1104, CI2 = 144, CI3 = 128, CI4 = 1024, CI5 = 512, CI6 = 1280, CI7 = 512, CIMLA = CI1 + CI2 + CI3 + CI4 + CI5, CISWA = CI6 + CI7;
__device__ __forceinline__ void conv_item(int r, int i, unsigned char* ws, LAS float* scr, int lane) {
    unsigned char* wm = ws + (i ? WS_W_MLA1 : WS_W_MLA0); unsigned char* wsw = ws + (i ? WS_W_SWA1 : WS_W_SWA0);
    if (r < CI1) { const int nb = r % 69; if (nb >= 37 && nb < 53) return;
        TMap tm{1, 0, 0, 1024, nullptr, 1.f}; transpose_item(ARG_IN(12) + (size_t)i * 1024 * 2208, 1024, 2208, (bf16*)wm, tm, scr, r, lane); return; } r -= CI1;
    if (r < CI2) { TMap tm{2, 0, 0, 384, nullptr, MLA_SC}; transpose_item(ARG_IN(15) + (size_t)i * 384 * 768, 384, 768, (bf16*)(wm + SZ_WIN_MLA), tm, scr, r, lane); return; } r -= CI2;
    if (r < CI3) { TMap tm{3, 0, 0, 256, nullptr, 1.f}; transpose_item(ARG_IN(16) + (size_t)i * 256 * 1024, 256, 1024, (bf16*)(wm + SZ_WIN_MLA + SZ_WUQ), tm, scr, r, lane); return; } r -= CI3;
    if (r < CI4) {
        const int g = r >> 8, kb = (r >> 4) & 15, eb = r & 15, k = kb * 64 + lane;
        const float* wi = ARG_IN(12) + (size_t)i * 1024 * 2208 + (size_t)k * 2208 + 1184 + g * 128;
        const float* wp = ARG_IN(17) + ((size_t)i * 4 + g) * 128 * 128 + eb * 8; const float* sp = ARG_IN(18) + i * 512 + g * 128 + eb * 8;
#pragma unroll
        for (int q = 0; q < 4; ++q) { const int c = 32 * q + (lane >> 1); *(LAS f32x4*)(scr + c * 8 + 4 * (lane & 1)) = *(const f32x4*)(wp + (size_t)c * 128 + 4 * (lane & 1)); }
        LDS_WAIT(); asm volatile("" ::: "memory");
        float acc[8];
#pragma unroll
        for (int e = 0; e < 8; ++e) acc[e] = 0.f;
#pragma nounroll
        for (int hc = 0; hc < 2; ++hc) {
            f32x4 arow[16];
#pragma unroll
            for (int q = 0; q < 16; ++q) arow[q] = *(const f32x4*)(wi + 64 * hc + 4 * q);
            const LAS float* sw = scr + 64 * hc * 8;
#pragma unroll
            for (int q = 0; q < 16; ++q) {
#pragma unroll
                for (int cc = 0; cc < 4; ++cc) { const float a = arow[q][cc];
                    const f32x4 w0 = *(const LAS f32x4*)(sw + (4 * q + cc) * 8), w1 = *(const LAS f32x4*)(sw + (4 * q + cc) * 8 + 4);
                    acc[0] += a * w0[0]; acc[1] += a * w0[1]; acc[2] += a * w0[2]; acc[3] += a * w0[3]; acc[4] += a * w1[0]; acc[5] += a * w1[1]; acc[6] += a * w1[2]; acc[7] += a * w1[3]; } }
        }
        bf16* dst = (bf16*)wm + (size_t)(1280 + g * 128 + eb * 8) * 1024 + k;
#pragma unroll
        for (int e = 0; e < 8; ++e) dst[(size_t)e * 1024] = (bf16)f2bf(acc[e] * sp[e]);
        LDS_WAIT(); asm volatile("" ::: "memory");
        return; } r -= CI4;
    if (r < CI5) { TMap tm{0, 0, 0, 1024, nullptr, 1.f}; transpose_item(ARG_IN(19) + (size_t)i * 1024 * 1024, 1024, 1024, (bf16*)(wm + SZ_WIN_MLA + SZ_WUQ + SZ_WUKV + SZ_WPOOL), tm, scr, r, lane); return; } r -= CI5;
    if (r < CI6) { TMap tm{5, 0, 0, 1024, nullptr, SWA_SC}; transpose_item(ARG_IN(20) + (size_t)i * 1024 * 2560, 1024, 2560, (bf16*)wsw, tm, scr, r, lane); return; } r -= CI6;
    { TMap tm{0, 0, 0, 1024, nullptr, 1.f}; transpose_item(ARG_IN(22) + (size_t)i * 1024 * 1024, 1024, 1024, (bf16*)(wsw + SZ_WIN_SWA), tm, scr, r, lane); }
}
__device__ __forceinline__ int mod_index(int row) { return row < RP ? 8 : ((row - RP) >> 11); }

__global__ void __launch_bounds__(NWAVES * 64, 2) fwd_kernel(Args args) {
    extern __shared__ __attribute__((aligned(16))) unsigned char lds_raw[];
    LAS unsigned char* lds = (LAS unsigned char*)lds_raw;
    volatile LAS unsigned* MISC = (volatile LAS unsigned*)(lds + MISC_OFF);
    const int G = gridDim.x; const int bx = blockIdx.x; const int vcu = (G % 8 == 0) ? (bx % 8) * (G / 8) + bx / 8 : bx;
    const int NGW = G * NWAVES;
    { const int tid0 = threadIdx.x; for (int u = tid0; u < (LDS_BYTES - RING_BYTES) / 4; u += NWAVES * 64) ((LAS unsigned*)(lds + RING_BYTES))[u] = 0u; }
    __syncthreads();
    XcdBarrier bar; bar.bar = (unsigned*)((unsigned char*)arg_ptr(24) + WS_CTL) + 1024; bar.x = 0; bar.st = nullptr;
    if (!MK_PER_PHASE) bar = xcd_barrier_post(bar.bar, MISC + 8);
    const int lo = MK_PER_PHASE ? args.ph_lo : 0, hi = MK_PER_PHASE ? args.ph_hi : N_PHASES;
    int pid = 0;
#define IN_PH() (lo <= pid && pid < hi)
#define END_PH() do { if (!MK_PER_PHASE && lo <= pid && pid + 1 < hi) xcd_barrier(bar); ++pid; } while (0)
#define PH_BEGIN() unsigned char* const ws = (unsigned char*)arg_ptr(24); float* const out = (float*)arg_ptr(23); \
    const int tid = opaque_tid(), lane = tid & 63, wave = __builtin_amdgcn_readfirstlane(tid >> 6), gw = vcu * NWAVES + wave; (void)out; (void)lane; (void)gw; (void)ws
#define MOD ((float*)(ws + WS_MOD))
#define ROPE8 ((float*)(ws + WS_ROPE8))
#define ROPE16 ((float*)(ws + WS_ROPE16))
#define MODP ((float*)(ws + WS_MODP))
#define Hb ((bf16*)(ws + WS_H))
#define GAB ((bf16*)(ws + WS_GAB))
#define CQ ((bf16*)(ws + WS_CQ))
#define CKV ((bf16*)(ws + WS_CKV))
#define KRB ((bf16*)(ws + WS_KRB))
#define KRF ((float*)(ws + WS_KRF))
#define KN ((bf16*)(ws + WS_KN))
#define VP ((bf16*)(ws + WS_KN))
#define VV ((bf16*)(ws + WS_V))
#define PO ((bf16*)(ws + WS_PO))
#define SQ ((bf16*)(ws + WS_CQ))
#define SK ((bf16*)(ws + WS_SK))
#define SV ((bf16*)(ws + WS_SV))

    if (IN_PH()) { PH_BEGIN();
        { const float* cvec = ARG_IN(6); const float* cctx = ARG_IN(7); const float* ada_w = ARG_IN(8);
          for (int it = bx; it < 48; it += G) ada_item(it, cvec, cctx, ada_w, MODP, lds, tid, lane, wave); }
        for (int e = bx * 512 + tid; e < 64 * 8 + 64 * 16; e += G * 512) {
            if (e < 512) { const int pos = e >> 3, i = e & 7; const float inv = powf(10000.f, -(float)i / 8.f), a = (float)pos * inv; ROPE8[2 * e] = cosf(a); ROPE8[2 * e + 1] = sinf(a); }
            else { const int f = e - 512, pos = f >> 4, i = f & 15; const float inv = powf(10000.f, -(float)i / 16.f), a = (float)pos * inv; ROPE16[2 * f] = cosf(a); ROPE16[2 * f + 1] = sinf(a); }
        }
        LAS float* scr = (LAS float*)(lds + wave * 16384);
        for (int it = gw; it < CIMLA; it += NGW) if (!(it >= CI1 + CI2 + CI3 && it < CI1 + CI2 + CI3 + CI4)) conv_item(it, 0, ws, scr, lane);
        const u32x4 z = {0u, 0u, 0u, 0u};
        for (int e = bx * 512 + tid; e < 2 * 96 * 128; e += G * 512) { const int i = e / (96 * 128), f = e % (96 * 128);
            *(u32x4*)(ws + (i ? WS_W_MLA1 : WS_W_MLA0) + (size_t)672 * 2048 + (size_t)f * 16) = z; }
    }
    END_PH();

    if (IN_PH()) { PH_BEGIN();
        const float* npre = ARG_IN(10); const float* xin0 = ARG_IN(0); const float* xin1 = ARG_IN(1); const float* adab = ARG_IN(9);
        {
            const float* npost0 = ARG_IN(11);
            for (int it = bx; it < 9; it += G) { const int l = 0, j = it;
                for (int c = tid * 4; c < 1024; c += NWAVES * 64 * 4) { float* cf = MOD + (size_t)(l * 9 + j) * 3072;
                    *(f32x4*)(cf + c) = mod_load(MODP, adab, l, j, 2048 + c) * *(const f32x4*)(npost0 + l * 1024 + c);
                    *(f32x4*)(cf + 1024 + c) = *(const f32x4*)(npre + l * 1024 + c) * (mod_load(MODP, adab, l, j, 1024 + c) + 1.f);
                    *(f32x4*)(cf + 2048 + c) = mod_load(MODP, adab, l, j, c); } }
        }
        {
            LAS float* scr = (LAS float*)(lds + wave * 16384);
            for (int it = gw; it < 2 * CI4; it += NGW) conv_item(CI1 + CI2 + CI3 + (it & (CI4 - 1)), it >= CI4 ? 1 : 0, ws, scr, lane);
        }
        for (int chunk = gw; chunk < R / 12; chunk += NGW) {
            int curm = -1; f32x4 cB[4], cC[4];
#pragma unroll
            for (int j = 0; j < 4; ++j) { cB[j] = (f32x4){0.f, 0.f, 0.f, 0.f}; cC[j] = cB[j]; }
            for (int rr = 0; rr < 12; rr += 2) {
                f32x4 v[2][4];
#pragma unroll
                for (int q = 0; q < 2; ++q) { const int row = chunk * 12 + rr + q; const float* xr = row < RP ? xin0 + (size_t)row * D : xin1 + (size_t)(row - RP) * D;
#pragma unroll
                    for (int j = 0; j < 4; ++j) v[q][j] = *(const f32x4*)(xr + 8 * lane + 512 * (j >> 1) + 4 * (j & 1)); }
#pragma unroll
                for (int q = 0; q < 2; ++q) { const int row = chunk * 12 + rr + q, midx = mod_index(row);
                    if (midx != curm) { curm = midx;
#pragma unroll
                        for (int j = 0; j < 4; ++j) { const int c = 8 * lane + 512 * (j >> 1) + 4 * (j & 1); const f32x4 g = *(const f32x4*)(npre + c), sc = mod_load(MODP, adab, 0, midx, 1024 + c); cB[j] = g * (sc + 1.f); cC[j] = mod_load(MODP, adab, 0, midx, c); } }
                    float ss = 0.f;
#pragma unroll
                    for (int j = 0; j < 4; ++j) ss += v[q][j][0] * v[q][j][0] + v[q][j][1] * v[q][j][1] + v[q][j][2] * v[q][j][2] + v[q][j][3] * v[q][j][3];
                    const float rstd = 1.f / sqrtf(wave_sum(ss) * (1.f / D) + EPS);
#pragma unroll
                    for (int j2 = 0; j2 < 2; ++j2) { const f32x4 ha = v[q][2 * j2] * rstd * cB[2 * j2] + cC[2 * j2], hc = v[q][2 * j2 + 1] * rstd * cB[2 * j2 + 1] + cC[2 * j2 + 1];
                        u32x4 w; w.x = pk2(ha[0], ha[1]); w.y = pk2(ha[2], ha[3]); w.z = pk2(hc[0], hc[1]); w.w = pk2(hc[2], hc[3]); *(u32x4*)(Hb + (size_t)row * D + 8 * lane + 512 * j2) = w; }
                }
            }
        }
    }
    END_PH();

    for (int l = 0; l < NL; ++l) {
        const int i = l >> 1;
        if ((l & 1) == 0) {
#define WM_BASE (ws + (i ? WS_W_MLA1 : WS_W_MLA0))
#define M_WinT ((const bf16*)WM_BASE)
#define M_WuqT ((const bf16*)(WM_BASE + SZ_WIN_MLA))
#define M_WukvT ((const bf16*)(WM_BASE + SZ_WIN_MLA + SZ_WUQ))
#define M_WpT ((const bf16*)(WM_BASE + SZ_WIN_MLA + SZ_WUQ + SZ_WUKV))
#define M_WoT ((const bf16*)(WM_BASE + SZ_WIN_MLA + SZ_WUQ + SZ_WUKV + SZ_WPOOL))
            if (IN_PH()) { PH_BEGIN();
                pg8::Gemm g{Hb, M_WinT, R, 2304, 1024, 1024}; pg8::StaticOrder S; S.init(R, 2304, G, bx);
                pg8::EpiMlaIn E{CQ, CKV, GAB, VP, KRF};
                pg8::gemm_phase<pg8::EpiMlaIn, true>(lds, g, S, E);
                if (l == 0) {
                    const float* cvec = ARG_IN(6); const float* cctx = ARG_IN(7); const float* ada_w = ARG_IN(8);
                    unsigned* qt = (unsigned*)(ws + WS_CTL) + CW_QH + 64; LAS float* scr = (LAS float*)(lds + wave * 16384);
                    constexpr int NCH_SWA = (CISWA + 7) / 8;
                    for (;;) {
                        __syncthreads();
                        if (tid == 0) MISC[0] = __hip_atomic_fetch_add(qt, 1u, __ATOMIC_RELAXED, __HIP_MEMORY_SCOPE_AGENT);
                        __syncthreads();
                        const int item = (int)MISC[0];
                        if (item >= 144 + 2 * NCH_SWA) break;
                        if (item < 144) ada_item(48 + item, cvec, cctx, ada_w, MODP, lds, tid, lane, wave);
                        else { const int c2 = item - 144, inst = c2 >= NCH_SWA ? 1 : 0, r2 = (c2 - inst * NCH_SWA) * 8 + wave; if (r2 < CISWA) conv_item(CIMLA + r2, inst, ws, scr, lane); }
                    }
                }
            }
            END_PH();
            if (IN_PH()) { PH_BEGIN();
                const float* gq = ARG_IN(13) + i * 384; const float* gkv = ARG_IN(14) + i * 256;
                const float* cckv = ARG_IN(2); const float* ckr = ARG_IN(3);
                if (l == 0) {
                    const float* npost0 = ARG_IN(11); const float* npre0 = ARG_IN(10); const float* adab = ARG_IN(9);
                    for (int it = bx; it < 27; it += G) { const int l2 = 1 + it / 9, j = it % 9;
                        for (int c = tid * 4; c < 1024; c += NWAVES * 64 * 4) { float* cf = MOD + (size_t)(l2 * 9 + j) * 3072;
                            *(f32x4*)(cf + c) = mod_load(MODP, adab, l2, j, 2048 + c) * *(const f32x4*)(npost0 + l2 * 1024 + c);
                            *(f32x4*)(cf + 1024 + c) = *(const f32x4*)(npre0 + l2 * 1024 + c) * (mod_load(MODP, adab, l2, j, 1024 + c) + 1.f);
                            *(f32x4*)(cf + 2048 + c) = mod_load(MODP, adab, l2, j, c); } }
                }
                const int half = 1 << (lane >> 4);
                float pm[16];
#pragma unroll
                for (int k = 0; k < 16; ++k) pm[k] = (k - 8 >= -half && k - 8 < half) ? 1.f : 0.f;
                f32x4 gq0 = {0.f, 0.f, 0.f, 0.f}, gq1 = gq0, gk0 = gq0, gk1 = gq0;
                if (lane < 48) { gq0 = *(const f32x4*)(gq + 8 * lane); gq1 = *(const f32x4*)(gq + 8 * lane + 4); }
                if (lane < 32) { gk0 = *(const f32x4*)(gkv + 8 * lane); gk1 = *(const f32x4*)(gkv + 8 * lane + 4); }
                for (int chunk = gw; chunk < R / 12; chunk += NGW) {
                    const int r0 = chunk * 12;
                    const int xl = r0 + 18; const int Bs = xl < RP ? (xl & ~255) : (xl >= R ? R : RP + ((xl - RP) & ~2047)); const bool hasB = Bs > r0 - 8;
                    u32x4 win[27];
#pragma unroll
                    for (int k = 0; k < 27; ++k) { int x = r0 - 8 + k; x = x < 0 ? 0 : (x >= R ? R - 1 : x); win[k] = *(const u32x4*)(VP + (size_t)x * 512 + 8 * lane); }
                    {
#pragma unroll
                        for (int hb = 0; hb < 2; ++hb) {
                            u32x4 wq[6], wk[6]; float kr[6];
#pragma unroll
                            for (int q = 0; q < 6; ++q) { const int row = r0 + 6 * hb + q; const bool prompt = row < RP; const int rk = prompt ? row : RP + ((row - RP) >> 11) * 2304 + ((row - RP) & 2047);
                                wq[q] = (u32x4){0u, 0u, 0u, 0u}; wk[q] = wq[q]; kr[q] = 0.f;
                                if (lane < 48) wq[q] = *(const u32x4*)(CQ + (size_t)row * 384 + 8 * lane);
                                if (lane < 32) { wk[q] = *(const u32x4*)(CKV + (size_t)rk * 256 + 8 * lane); kr[q] = KRF[(size_t)row * 32 + lane]; } }
#pragma unroll
                            for (int q = 0; q < 6; ++q) { const int row = r0 + 6 * hb + q; const bool prompt = row < RP; const int b = prompt ? row >> 8 : (row - RP) >> 11, t = prompt ? row & 255 : (row - RP) & 2047;
                                const int rk = prompt ? row : RP + b * 2304 + t;
                                { const u32x4 w = wq[q]; float v[8] = {bflo(w.x), bfhi(w.x), bflo(w.y), bfhi(w.y), bflo(w.z), bfhi(w.z), bflo(w.w), bfhi(w.w)}; float ss = 0.f;
#pragma unroll
                                  for (int e = 0; e < 8; ++e) ss += v[e] * v[e];
                                  const float rstd = 1.f / sqrtf(wave_sum(ss) * (1.f / 384.f) + EPS);
                                  if (lane < 48) { u32x4 o; o.x = pk2(v[0] * rstd * gq0[0], v[1] * rstd * gq0[1]); o.y = pk2(v[2] * rstd * gq0[2], v[3] * rstd * gq0[3]); o.z = pk2(v[4] * rstd * gq1[0], v[5] * rstd * gq1[1]); o.w = pk2(v[6] * rstd * gq1[2], v[7] * rstd * gq1[3]);
                                      *(u32x4*)(CQ + (size_t)row * 384 + 8 * lane) = o; } }
                                { const u32x4 w = wk[q]; float v[8] = {bflo(w.x), bfhi(w.x), bflo(w.y), bfhi(w.y), bflo(w.z), bfhi(w.z), bflo(w.w), bfhi(w.w)}; float ss = 0.f;
#pragma unroll
                                  for (int e = 0; e < 8; ++e) ss += v[e] * v[e];
                                  const float rstd = 1.f / sqrtf(wave_sum(ss) * (1.f / 256.f) + EPS);
                                  if (lane < 32) { const f32x4 y0 = {v[0] * rstd * gk0[0], v[1] * rstd * gk0[1], v[2] * rstd * gk0[2], v[3] * rstd * gk0[3]}, y1 = {v[4] * rstd * gk1[0], v[5] * rstd * gk1[1], v[6] * rstd * gk1[2], v[7] * rstd * gk1[3]};
                                      u32x4 o; o.x = pk2(y0[0], y0[1]); o.y = pk2(y0[2], y0[3]); o.z = pk2(y1[0], y1[1]); o.w = pk2(y1[2], y1[3]);
                                      *(u32x4*)(CKV + (size_t)rk * 256 + 8 * lane) = o;
                                      if (prompt) { float* st = out + OFF_CKV + ((size_t)(b * 2 + i) * 256 + t) * 256 + 8 * lane; *(f32x4*)st = y0; *(f32x4*)(st + 4) = y1; } } }
                                { const float kv = kr[q];
                                  const float pr = __int_as_float(__builtin_amdgcn_update_dpp(0, __float_as_int(kv), 0x128, 0xf, 0xf, true));
                                  if (lane < 32) { if (prompt) out[OFF_KR + ((size_t)(b * 2 + i) * 256 + t) * 32 + lane] = kv;
                                      const int part = lane >> 4, fi = lane & 7; const bool isx2 = (lane & 8) != 0; const float x1 = isx2 ? pr : kv, x2 = isx2 ? kv : pr;
                                      float o1 = x1, o2 = x2;
                                      if (!prompt) { const int pos = part ? (t & 63) : (t >> 6); const float cs = ROPE8[(pos * 8 + fi) * 2], sn = ROPE8[(pos * 8 + fi) * 2 + 1]; o1 = x1 * cs - x2 * sn; o2 = x1 * sn + x2 * cs; }
                                      KRB[(size_t)rk * 32 + (isx2 ? 16 : 0) + part * 8 + fi] = (bf16)f2bf(isx2 ? o2 : o1); } }
                            }
                            asm volatile("" ::: "memory");
                        }
                    }
#pragma unroll
                    for (int ri = 0; ri < 12; ++ri) {
                        const bool sideR = (r0 + ri) >= Bs;
                        float sA[8]; float cntf = 0.f;
#pragma unroll
                        for (int e = 0; e < 8; ++e) sA[e] = 0.f;
#pragma unroll
                        for (int k = 0; k < 16; ++k) { const int x = r0 + ri + k - 8; const bool valid = !hasB || ((x >= Bs) == sideR); const float m = valid ? pm[k] : 0.f; const u32x4 w = win[ri + k]; cntf += m;
                            sA[0] += bflo(w.x) * m; sA[1] += bfhi(w.x) * m; sA[2] += bflo(w.y) * m; sA[3] += bfhi(w.y) * m;
                            sA[4] += bflo(w.z) * m; sA[5] += bfhi(w.z) * m; sA[6] += bflo(w.w) * m; sA[7] += bfhi(w.w) * m; }
                        const float ic = 1.f / cntf; const u32x4 w = win[ri + 8];
                        bf16* gp = GAB + (size_t)(r0 + ri) * 1024 + 512 + 8 * lane; const u32x4 gg = *(const u32x4*)gp;
                        u32x4 o; o.x = pk2((sA[0] * ic - bflo(w.x)) * bflo(gg.x), (sA[1] * ic - bfhi(w.x)) * bfhi(gg.x)); o.y = pk2((sA[2] * ic - bflo(w.y)) * bflo(gg.y), (sA[3] * ic - bfhi(w.y)) * bfhi(gg.y));
                        o.z = pk2((sA[4] * ic - bflo(w.z)) * bflo(gg.z), (sA[5] * ic - bfhi(w.z)) * bfhi(gg.z)); o.w = pk2((sA[6] * ic - bflo(w.w)) * bflo(gg.w), (sA[7] * ic - bfhi(w.w)) * bfhi(gg.w));
                        *(u32x4*)gp = o;
                    }
                }
                for (int ci = gw; ci < 2048; ci += NGW) {
                    const int b = ci >> 8, p = ci & 255, rk = RP + b * 2304 + 2048 + p;
                    if (lane < 32) { const float* sp = cckv + ((size_t)(b * 2 + i) * 256 + p) * 256 + 8 * lane; const f32x4 y0 = *(const f32x4*)sp, y1 = *(const f32x4*)(sp + 4);
                        u32x4 o; o.x = pk2(y0[0], y0[1]); o.y = pk2(y0[2], y0[3]); o.z = pk2(y1[0], y1[1]); o.w = pk2(y1[2], y1[3]); *(u32x4*)(CKV + (size_t)rk * 256 + 8 * lane) = o; }
                    if (lane < 16) { const int part = lane >> 3, fi = lane & 7; const float* sp = ckr + ((size_t)(b * 2 + i) * 256 + p) * 32 + part * 16 + fi;
                        KRB[(size_t)rk * 32 + lane] = (bf16)f2bf(sp[0]); KRB[(size_t)rk * 32 + 16 + lane] = (bf16)f2bf(sp[8]); }
                }
            }
            END_PH();
            if (IN_PH()) { PH_BEGIN();
                { pg8::Gemm g{CQ, M_WuqT, R, 768, 384, 384}; pg8::StaticOrder S; S.init(R, 768, G, bx); pg8::EpiQ E{Hb, ROPE8}; pg8::gemm_phase<pg8::EpiQ, true>(lds, g, S, E); }
                if (bx >= 32) { pg8::Gemm g{CKV, M_WukvT, RK, 1024, 256, 256}; pg8::StaticOrder S; S.init(RK, 1024, G - 32, bx - 32); pg8::EpiBf16 E{KN, 512, 512, (size_t)(WS_V - WS_KN) / 2}; pg8::gemm_phase<pg8::EpiBf16, true>(lds, g, S, E); }
            }
            END_PH();
            if (IN_PH()) { PH_BEGIN();
                struct MlaMk { bf16 *hb, *kn, *vv, *gab, *krb; int wave;
                    __device__ __forceinline__ void operator()(int un, att::Desc& d) const {
                        d.n_b = 0; d.row_b = 0; d.key_b = 0; d.qpos = 0; d.sink2 = 0.f; d.has_sink = 0; d.k1 = krb;
                        int h, qrow, krow;
                        if (un < 512) { const int b = un >> 6, qb = un & 7; h = (un >> 3) & 7; qrow = RP + b * 2048 + qb * 256 + wave * 32; krow = RP + b * 2304; d.n_a = 36; }
                        else { const int v = un - 512, b = v >> 3; h = v & 7; qrow = b * 256 + wave * 32; krow = b * 256; d.n_a = 4; }
                        d.row_a = krow; d.qptr = hb + (size_t)qrow * 768 + h * 96; d.k0 = kn + h * 64; d.v = vv + h * 64; d.optr = gab + (size_t)qrow * 1024 + h * 64; } };
                const MlaMk mk{Hb, KN, VV, GAB, KRB, wave};
                att::attn_phase<0, MlaMk>((LAS char*)lds, mk, vcu, G, 768);
            }
            END_PH();
        } else {
#define WS_BASE (ws + (i ? WS_W_SWA1 : WS_W_SWA0))
#define S_WinT ((const bf16*)WS_BASE)
#define S_WoT ((const bf16*)(WS_BASE + SZ_WIN_SWA))
            if (IN_PH()) { PH_BEGIN();
                const float* ck = ARG_IN(4); const float* cv = ARG_IN(5);
                for (int e = bx * 512 + tid; e < 2 * 2048 * 32; e += G * 512) {
                    const int which = e / (2048 * 32), f = e % (2048 * 32), rowi = f >> 5, ch = f & 31, b = rowi >> 8, p = rowi & 255;
                    const float* s = (which ? cv : ck) + ((size_t)(b * 2 + i) * 256 + p) * 256 + 8 * ch; const f32x4 y0 = *(const f32x4*)s, y1 = *(const f32x4*)(s + 4);
                    u32x4 o; o.x = pk2(y0[0], y0[1]); o.y = pk2(y0[2], y0[3]); o.z = pk2(y1[0], y1[1]); o.w = pk2(y1[2], y1[3]);
                    *(u32x4*)((which ? SV : SK) + (size_t)(RP + b * 2304 + 2048 + p) * 256 + 8 * ch) = o;
                }
                pg8::Gemm g{Hb, S_WinT, R, 2560, 1024, 1024}; pg8::StaticOrder S; S.init(R, 2560, G, bx);
                pg8::EpiSwaIn E{SQ, SK, SV, GAB, out + OFF_K + (size_t)i * 65536, out + OFF_V + (size_t)i * 65536, ROPE16};
                pg8::gemm_phase<pg8::EpiSwaIn, true>(lds, g, S, E);
                if (l == 1) {
                    unsigned* qt = (unsigned*)(ws + WS_CTL) + CW_QH + 80; LAS float* scr = (LAS float*)(lds + wave * 16384);
                    constexpr int NCH_MLA = (CIMLA + 7) / 8;
                    for (;;) {
                        __syncthreads();
                        if (tid == 0) MISC[0] = __hip_atomic_fetch_add(qt, 1u, __ATOMIC_RELAXED, __HIP_MEMORY_SCOPE_AGENT);
                        __syncthreads();
                        const int item = (int)MISC[0];
                        if (item >= NCH_MLA) break;
                        const int r2 = item * 8 + wave; if (r2 < CIMLA && !(r2 >= CI1 + CI2 + CI3 && r2 < CI1 + CI2 + CI3 + CI4)) conv_item(r2, 1, ws, scr, lane);
                    }
                }
            }
            END_PH();
            if (IN_PH()) { PH_BEGIN();
                struct SwaMk { bf16 *sq, *sk, *sv, *gab; const float* sink; int wave, lane;
                    __device__ __forceinline__ void operator()(int un, att::Desc& d) const {
                        d.k1 = nullptr; d.has_sink = 1; d.n_a = 4;
                        int kvh, qrow, q0;
                        if (un < 1024) { const int b = un >> 7, blk = un & 31; kvh = (un >> 5) & 3; q0 = blk * 64; const int kb = RP + b * 2304;
                            qrow = RP + b * 2048 + q0 + (wave & 1) * 32; d.row_a = kb + 2048;
                            const int kfirst = q0 - 128 > 0 ? q0 - 128 : 0, klast = q0 + 128 < 2048 - 64 ? q0 + 128 : 2048 - 64;
                            d.key_b = kfirst; d.row_b = kb + kfirst; d.n_b = (klast - kfirst) / 64 + 1; }
                        else { const int v = un - 1024, b = v >> 4, blk = v & 3; kvh = (v >> 2) & 3; q0 = blk * 64; qrow = b * 256 + q0 + (wave & 1) * 32; d.row_a = b * 256; d.n_b = 0; d.row_b = 0; d.key_b = 0; }
                        const int head = kvh * 4 + (wave >> 1);
                        d.qpos = q0 + (wave & 1) * 32 + (lane & 31); d.sink2 = sink[head] * LOG2E;
                        d.qptr = sq + (size_t)qrow * 1024 + head * 64; d.k0 = sk + kvh * 64; d.v = sv + kvh * 64; d.optr = gab + (size_t)qrow * 1024 + head * 64; } };
                const SwaMk mk{SQ, SK, SV, GAB, ARG_IN(21) + i * 16, wave, lane};
                att::attn_phase<1, SwaMk>((LAS char*)lds, mk, vcu, G, 1536);
            }
            END_PH();
        }
        if (IN_PH()) { PH_BEGIN();
            unsigned* ctlw = (unsigned*)(ws + WS_CTL); unsigned* cnt = ctlw + CW_CNT + l * 2048; unsigned* qh = ctlw + CW_QH + l * 16; unsigned* tmo = ctlw + CW_TMO;
            {
                const bf16* WoT = (l & 1) ? (const bf16*)(ws + (i ? WS_W_SWA1 : WS_W_SWA0) + SZ_WIN_SWA) : (const bf16*)(ws + (i ? WS_W_MLA1 : WS_W_MLA0) + SZ_WIN_MLA + SZ_WUQ + SZ_WUKV + SZ_WPOOL);
                pg8::Gemm g{GAB, WoT, R, 1024, 1024, 1024}; pg8::PanelOrder S{G, vcu, 384}; pg8::EpiOutPub E{Hb, cnt};
                pg8::gemm_phase<pg8::EpiOutPub, true, pg8::PanelOrder>(lds, g, S, E);
            }
            const float* xin0 = ARG_IN(0); const float* xin1 = ARG_IN(1); const bool has_next = l + 1 < NL;
            const int panel = vcu >= 128 ? (vcu - 128) >> 1 : 64 + (vcu >> 2);
            const int rbase = vcu >= 128 ? panel * 256 + ((vcu - 128) & 1) * 128 : panel * 256 + (vcu & 3) * 64;
            const int nrw = vcu >= 128 ? 16 : 8;
#define WAIT_PANEL() do { if (wave == 0) { unsigned sp = 0; \
                while (__hip_atomic_load(cnt + 16 * panel, __ATOMIC_RELAXED, __HIP_MEMORY_SCOPE_AGENT) < 32u) { __builtin_amdgcn_s_sleep(2); \
                    if ((++sp & 1023u) == 0u) { if (__hip_atomic_load(tmo, __ATOMIC_RELAXED, __HIP_MEMORY_SCOPE_AGENT) || sp > (1u << 22)) { __hip_atomic_store(tmo, 1u, __ATOMIC_RELAXED, __HIP_MEMORY_SCOPE_AGENT); break; } } } \
                __builtin_amdgcn_fence(__ATOMIC_ACQUIRE, "agent"); asm volatile("s_waitcnt vmcnt(0)" ::: "memory"); } \
            __syncthreads(); } while (0)
            {
                const int row0 = rbase + wave * nrw, midx = mod_index(row0); const int ln = has_next ? l + 1 : l;
                const float* cf = MOD + (size_t)(l * 9 + midx) * 3072; const float* cfn = MOD + (size_t)(ln * 9 + midx) * 3072;
                f32x4 cA[4], cB[4], cC[4];
#pragma unroll
                for (int k = 0; k < 4; ++k) { const int c = 8 * lane + 512 * (k >> 1) + 4 * (k & 1); cA[k] = *(const f32x4*)(cf + c); cB[k] = *(const f32x4*)(cfn + 1024 + c); cC[k] = *(const f32x4*)(cfn + 2048 + c); }
#define FINAL_ROW(row, xv, ov) do { float ss = 0.f; \
                    _Pragma("unroll") for (int k = 0; k < 4; ++k) ss += ov[k][0] * ov[k][0] + ov[k][1] * ov[k][1] + ov[k][2] * ov[k][2] + ov[k][3] * ov[k][3]; \
                    const float rstd = 1.f / sqrtf(wave_sum(ss) * (1.f / D) + EPS); float s2 = 0.f; \
                    _Pragma("unroll") for (int k = 0; k < 4; ++k) { xv[k] = xv[k] + ov[k] * rstd * cA[k]; s2 += xv[k][0] * xv[k][0] + xv[k][1] * xv[k][1] + xv[k][2] * xv[k][2] + xv[k][3] * xv[k][3]; } \
                    if (has_next) { const float r2 = 1.f / sqrtf(wave_sum(s2) * (1.f / D) + EPS); \
                        _Pragma("unroll") for (int j2 = 0; j2 < 2; ++j2) { const f32x4 xa = xv[2 * j2], xc = xv[2 * j2 + 1]; \
                            u32x4 wx; wx.x = pk2(xa[0], xa[1]); wx.y = pk2(xa[2], xa[3]); wx.z = pk2(xc[0], xc[1]); wx.w = pk2(xc[2], xc[3]); \
                            *(u32x4*)((bf16*)out + (size_t)(row) * 2048 + 8 * lane + 512 * j2) = wx; \
                            const f32x4 ha = xa * r2 * cB[2 * j2] + cC[2 * j2], hc = xc * r2 * cB[2 * j2 + 1] + cC[2 * j2 + 1]; \
                            u32x4 wh; wh.x = pk2(ha[0], ha[1]); wh.y = pk2(ha[2], ha[3]); wh.z = pk2(hc[0], hc[1]); wh.w = pk2(hc[2], hc[3]); \
                            *(u32x4*)(Hb + (size_t)(row) * D + 8 * lane + 512 * j2) = wh; } \
                    } else { _Pragma("unroll") for (int k = 0; k < 4; ++k) *(f32x4*)(out + (size_t)(row) * D + 8 * lane + 512 * (k >> 1) + 4 * (k & 1)) = xv[k]; } } while (0)
#define UNPK(W_, LO_, HI_) do { const u32x4 t_ = (W_); LO_ = (f32x4){bflo(t_.x), bfhi(t_.x), bflo(t_.y), bfhi(t_.y)}; HI_ = (f32x4){bflo(t_.z), bfhi(t_.z), bflo(t_.w), bfhi(t_.w)}; } while (0)
                if (l == 0) {
                    WAIT_PANEL();
                    for (int rr = 0; rr < nrw; rr += 4) {
                        f32x4 xq[4][4]; u32x4 oq[4][2];
#pragma unroll
                        for (int q = 0; q < 4; ++q) { const int row = row0 + rr + q; const float* xr = row < RP ? xin0 + (size_t)row * D : xin1 + (size_t)(row - RP) * D;
#pragma unroll
                            for (int k = 0; k < 4; ++k) xq[q][k] = *(const f32x4*)(xr + 8 * lane + 512 * (k >> 1) + 4 * (k & 1));
#pragma unroll
                            for (int j2 = 0; j2 < 2; ++j2) oq[q][j2] = *(const u32x4*)(Hb + (size_t)row * D + 8 * lane + 512 * j2); }
#pragma unroll
                        for (int q = 0; q < 4; ++q) { f32x4 ov[4]; UNPK(oq[q][0], ov[0], ov[1]); UNPK(oq[q][1], ov[2], ov[3]); FINAL_ROW(row0 + rr + q, xq[q], ov); }
                    }
                } else {
                    u32x4 xw[8][2], ow[8][2];
#pragma unroll
                    for (int q = 0; q < 8; ++q)
#pragma unroll
                        for (int j2 = 0; j2 < 2; ++j2) xw[q][j2] = *(const u32x4*)((const bf16*)out + (size_t)(row0 + q) * 2048 + 8 * lane + 512 * j2);
                    WAIT_PANEL();
                    for (int rr = 0; rr < nrw; rr += 8) {
                        if (rr > 0) {
#pragma unroll
                            for (int q = 0; q < 8; ++q)
#pragma unroll
                                for (int j2 = 0; j2 < 2; ++j2) xw[q][j2] = *(const u32x4*)((const bf16*)out + (size_t)(row0 + rr + q) * 2048 + 8 * lane + 512 * j2);
                        }
#pragma unroll
                        for (int q = 0; q < 8; ++q)
#pragma unroll
                            for (int j2 = 0; j2 < 2; ++j2) ow[q][j2] = *(const u32x4*)(Hb + (size_t)(row0 + rr + q) * D + 8 * lane + 512 * j2);
#pragma unroll
                        for (int q = 0; q < 8; ++q) { f32x4 xv[4], ov[4]; UNPK(xw[q][0], xv[0], xv[1]); UNPK(xw[q][1], xv[2], xv[3]); UNPK(ow[q][0], ov[0], ov[1]); UNPK(ow[q][1], ov[2], ov[3]); FINAL_ROW(row0 + rr + q, xv, ov); }
                    }
                }
#undef FINAL_ROW
#undef UNPK
#undef WAIT_PANEL
            }
        }
        END_PH();
    }
#undef IN_PH
#undef END_PH
}


extern "C" void kernel_launch(void* const* d_in, const int* in_sizes, int n_in, void* d_out, int out_size, void* d_ws, size_t ws_size, hipStream_t stream) {
    static int grid = 0;
    if (grid == 0) {
        if (n_in != 23 || out_size != OUT_TOTAL || ws_size < WS_END) { fprintf(stderr, "kernel_launch: unexpected shapes (n_in %d out %d ws %zu)\n", n_in, out_size, ws_size); grid = -1; return; }
        int dev = 0, cus = 0;
        if (hipGetDevice(&dev) != hipSuccess || hipDeviceGetAttribute(&cus, hipDeviceAttributeMultiprocessorCount, dev) != hipSuccess) { grid = -1; return; }
        if (hipFuncSetAttribute((const void*)fwd_kernel, hipFuncAttributeMaxDynamicSharedMemorySize, LDS_BYTES) != hipSuccess) { fprintf(stderr, "kernel_launch: hipFuncSetAttribute failed\n"); grid = -1; return; }
        int per_cu = 0;
        if (hipOccupancyMaxActiveBlocksPerMultiprocessor(&per_cu, (const void*)fwd_kernel, NWAVES * 64, LDS_BYTES) != hipSuccess || per_cu < 1) { fprintf(stderr, "kernel_launch: occupancy query says %d\n", per_cu); }
        (void)hipGetLastError();
        grid = cus;
    }
    if (grid < 0) return;
    (void)hipMemsetAsync((char*)d_ws + WS_CTL, 0, CTL_ZERO_BYTES, stream);
    Args a{};
    for (int i = 0; i < 23; ++i) a.in[i] = (const float*)d_in[i];
    a.out = (float*)d_out; a.ws = (unsigned char*)d_ws;
#if MK_PER_PHASE
    for (int p = 0; p < N_PHASES; ++p) { a.ph_lo = p; a.ph_hi = p + 1; hipLaunchKernelGGL(fwd_kernel, dim3(grid), dim3(NWAVES * 64), LDS_BYTES, stream, a); }
#else
    a.ph_lo = 0; a.ph_hi = N_PHASES;
    hipLaunchKernelGGL(fwd_kernel, dim3(grid), dim3(NWAVES * 64), LDS_BYTES, stream, a);
#endif
}
```

```cpp
#include <hip/hip_runtime.h>
#pragma clang diagnostic ignored "-Winline-asm"
#include <cstdio>
#include <cstdint>

#ifndef MK_PER_PHASE
#define MK_PER_PHASE 0
#endif

#define GAS __attribute__((address_space(1)))
#define LAS __attribute__((address_space(3)))
typedef unsigned short bf16;
typedef short bf16x8 __attribute__((ext_vector_type(8)));
typedef short s16x4 __attribute__((ext_vector_type(4)));
typedef float f32x4 __attribute__((ext_vector_type(4)));
typedef float f32x2 __attribute__((ext_vector_type(2)));
typedef float f32x16 __attribute__((ext_vector_type(16)));
typedef unsigned u32x4 __attribute__((ext_vector_type(4)));
typedef unsigned u32x2 __attribute__((ext_vector_type(2)));
typedef __bf16 bf16x2_t __attribute__((ext_vector_type(2)));

constexpr int D = 1024, RP = 8192, RS = 16384, R = RP + RS;
constexpr int RK = RP + 8 * 2304;
constexpr int NL = 4;
constexpr float EPS = 1e-6f, LOG2E = 1.4426950408889634f;
constexpr float MLA_SC = 0.10206207261596577f * LOG2E;
constexpr float SWA_SC = 0.125f * LOG2E;
constexpr int OFF_CKV = 25165824, OFF_KR = 29360128, OFF_K = 29884416, OFF_V = 34078720, OUT_TOTAL = 38273024;

constexpr size_t MiB = 1u << 20;
constexpr size_t WS_CTL = 0, CTL_ZERO_BYTES = 128 * 1024;
constexpr int CW_CNT = 8192, CW_QH = 16384, CW_TMO = 17408;
constexpr size_t WS_MOD = 1 * MiB;
constexpr size_t WS_ROPE8 = 1 * MiB + 512 * 1024;
constexpr size_t WS_ROPE16 = WS_ROPE8 + 4096;
constexpr size_t SZ_WIN_MLA = 2304ull * 1024 * 2, SZ_WUQ = 768ull * 384 * 2, SZ_WUKV = 1024ull * 256 * 2, SZ_WPOOL = 512ull * 512 * 2,
                 SZ_WOUT = 1024ull * 1024 * 2, SZ_WIN_SWA = 2560ull * 1024 * 2;
constexpr size_t WS_W = 2 * MiB;
constexpr size_t SZ_W_MLA = SZ_WIN_MLA + SZ_WUQ + SZ_WUKV + SZ_WPOOL + SZ_WOUT, SZ_W_SWA = SZ_WIN_SWA + SZ_WOUT;
constexpr size_t WS_W_MLA0 = WS_W, WS_W_MLA1 = WS_W + SZ_W_MLA, WS_W_SWA0 = WS_W + 2 * SZ_W_MLA, WS_W_SWA1 = WS_W_SWA0 + SZ_W_SWA;
static_assert(WS_W_SWA1 + SZ_W_SWA <= 34 * MiB, "weights");
constexpr size_t WS_H = 34 * MiB;
constexpr size_t WS_GAB = 82 * MiB;
constexpr size_t WS_CQ = 130 * MiB;
constexpr size_t WS_CKV = 148 * MiB;
constexpr size_t WS_KRB = 161 * MiB;
constexpr size_t WS_KRF = 163 * MiB;
constexpr size_t WS_KN = 166 * MiB;
constexpr size_t WS_V = 192 * MiB;
constexpr size_t WS_PO = 218 * MiB;
constexpr size_t WS_SK = 178 * MiB;
constexpr size_t WS_SV = 191 * MiB;
constexpr size_t WS_MODP = 242 * MiB;
constexpr size_t WS_END = 244 * MiB;

__device__ __forceinline__ unsigned f2bf(float f) { unsigned u = __builtin_bit_cast(unsigned, f); return (u + 0x7fffu + ((u >> 16) & 1u)) >> 16; }
__device__ __forceinline__ unsigned pk2(float lo, float hi) { f32x2 v = {lo, hi}; bf16x2_t b = __builtin_convertvector(v, bf16x2_t); return __builtin_bit_cast(unsigned, b); }
__device__ __forceinline__ float bflo(unsigned w) { return __uint_as_float(w << 16); }
__device__ __forceinline__ float bfhi(unsigned w) { return __uint_as_float(w & 0xffff0000u); }
__device__ __forceinline__ float silu_fast(float x) { return x * __builtin_amdgcn_rcpf(1.f + __builtin_amdgcn_exp2f(-x * LOG2E)); }
#define DPP_ADD(v, ctrl) ((v) + __int_as_float(__builtin_amdgcn_update_dpp(0, __float_as_int(v), (ctrl), 0xf, 0xf, true)))
__device__ __forceinline__ float wave_sum(float v) {
    v = DPP_ADD(v, 0xB1); v = DPP_ADD(v, 0x4E); v = DPP_ADD(v, 0x124); v = DPP_ADD(v, 0x128);
    { auto rr = __builtin_amdgcn_permlane16_swap(__float_as_uint(v), __float_as_uint(v), false, false); v = __uint_as_float(rr[0]) + __uint_as_float(rr[1]); }
    { auto rr = __builtin_amdgcn_permlane32_swap(__float_as_uint(v), __float_as_uint(v), false, false); v = __uint_as_float(rr[0]) + __uint_as_float(rr[1]); }
    return v;
}
#define LDS_WAIT() asm volatile("s_waitcnt lgkmcnt(0)" ::: "memory")
__device__ __forceinline__ int opaque_tid() { int t = threadIdx.x; asm volatile("" : "+v"(t)); return t; }

namespace pg8 {
typedef unsigned short bf16_t;
constexpr int BM = 256, BK = 64, HALF = 128, HTB = HALF * BK * 2, STAGE_BYTES = 8 * HTB, NXCD = 8, WGM = 8;
__host__ __device__ __forceinline__ int lds_byte(int r, int c) { const int st = (r >> 4) * 2 + (c >> 5), rr = r & 15, cc = c & 31, ob = rr * 64 + cc * 2; return st * 1024 + (ob ^ (((ob >> 9) & 1) << 5)); }
__host__ __device__ __forceinline__ void stage_rc(int b, int& Rr, int& C) { const int st = b / 1024, sb = b % 1024, swz = sb ^ (((sb >> 9) & 1) << 5); Rr = (st >> 1) * 16 + swz / 64; C = (st & 1) * 32 + (swz % 64) / 2; }
__host__ __device__ __forceinline__ int perm32(int rho) { const int n = rho >> 4, i = rho & 15; return 8 * (i >> 2) + 4 * n + (i & 3); }
struct Unit { int pm, pn; };
struct Gemm { const bf16_t* A; const bf16_t* Bt; int M, N, K, lda; };
struct StaticOrder {
    int nM, nN, nwg, G, c;
    __device__ void init(int M, int N, int G_, int c_) { nM = M / BM; nN = N / BM; nwg = nM * nN; G = G_; c = c_; }
    __device__ bool next(int i, Unit& u) const {
        const long L = (long)i * G + c; if (L >= nwg) return false;
        int wgid = (int)L; { const int q = nwg / NXCD, r = nwg % NXCD, xcd = wgid % NXCD, off = wgid / NXCD; wgid = (xcd < r ? xcd * (q + 1) : r * (q + 1) + (xcd - r) * q) + off; }
        const int nig = WGM * nN, gid = wgid / nig, fm = gid * WGM, gsz = (nM - fm) < WGM ? (nM - fm) : WGM;
        u.pm = fm + ((wgid % nig) % gsz); u.pn = (wgid % nig) / gsz; return true;
    }
};
struct PanelOrder {
    int G, v, nunits;
    __device__ bool next(int i, Unit& u) const { const int L = i * G + v; if (L >= nunits) return false; u.pm = L >> 2; u.pn = L & 3; return true; }
};
template <class Epi, bool ALIGN_EPI, class Sched = StaticOrder>
__device__ __forceinline__ void gemm_phase(LAS unsigned char* lds, const Gemm g, const Sched& S, const Epi& E) {
    const int tid = opaque_tid(), wid = __builtin_amdgcn_readfirstlane(tid >> 6), lane = tid & 63, wr = wid >> 2, wc = wid & 3, fr = lane & 15, fq = lane >> 4;
    const int K = g.K, nt = K / BK, lda = g.lda;
    unsigned voffA[2], voffB[2];
#pragma unroll
    for (int i = 0; i < 2; ++i) { int Rr, C; stage_rc(tid * 16 + i * 8192, Rr, C); const int Rb = Epi::PERM ? ((Rr & ~31) + perm32(Rr & 31)) : Rr;
        voffA[i] = (unsigned)(Rr * lda + C) * 2u; voffB[i] = (unsigned)(Rb * K + C) * 2u; }
    const size_t kstep = (size_t)(BK * 2);
    const size_t hA = (size_t)HALF * lda * 2, hB = (size_t)HALF * K * 2, tA = 2 * hA, tB = 2 * hB;
    const unsigned ldsw = (unsigned)wid * 1024u;
    const int aoff = lds_byte(wr * 64 + fr, fq * 8), boff = lds_byte(wc * 32 + fr, fq * 8);
#define PG8_SA(b, h) (((b) * 2 + (h)) * HTB)
#define PG8_SB(b, h) ((4 + (b) * 2 + (h)) * HTB)
#define PG8_STAGE(bufoff, gbase, voff) do { _Pragma("unroll") for (int _i = 0; _i < 2; ++_i) \
        __builtin_amdgcn_global_load_lds((const unsigned*)((const char*)(gbase) + (voff)[_i]), (LAS unsigned*)(lds + (bufoff) + ldsw + _i * 8192), 16, 0, 0); } while (0)
#define PG8_LDA(dst, b, h) do { _Pragma("unroll") for (int m = 0; m < 4; ++m) _Pragma("unroll") for (int k = 0; k < 2; ++k) dst[m][k] = *(const LAS bf16x8*)(lds + PG8_SA(b, h) + aoff + m * 2048 + k * 1024); } while (0)
#define PG8_LDB(dst, b, h) do { _Pragma("unroll") for (int n = 0; n < 2; ++n) _Pragma("unroll") for (int k = 0; k < 2; ++k) dst[n][k] = *(const LAS bf16x8*)(lds + PG8_SB(b, h) + boff + n * 2048 + k * 1024); } while (0)
#define PG8_MMA(ai, bj, At, Bt) do { __builtin_amdgcn_s_setprio(1); _Pragma("unroll") for (int m = 0; m < 4; ++m) _Pragma("unroll") for (int n = 0; n < 2; ++n) _Pragma("unroll") for (int k = 0; k < 2; ++k) \
        acc[ai][bj][m][n] = __builtin_amdgcn_mfma_f32_16x16x32_bf16(Bt[n][k], At[m][k], acc[ai][bj][m][n], 0, 0, 0); __builtin_amdgcn_s_setprio(0); } while (0)
#define PG8_WAIT_V(n) asm volatile("s_waitcnt vmcnt(" #n ")" ::: "memory")
#define PG8_WAIT_L(n) asm volatile("s_waitcnt lgkmcnt(" #n ")" ::: "memory")
#define PG8_BAR __builtin_amdgcn_s_barrier()
#define PG8_SCHED __builtin_amdgcn_sched_barrier(0)
    Unit cur, nxt; int ui = 0;
    if (!S.next(0, cur)) return;
    f32x4 acc[2][2][4][2];
#pragma unroll
    for (int a = 0; a < 2; ++a)
#pragma unroll
        for (int b = 0; b < 2; ++b)
#pragma unroll
            for (int m = 0; m < 4; ++m)
#pragma unroll
                for (int n = 0; n < 2; ++n) acc[a][b][m][n] = (f32x4){0.f, 0.f, 0.f, 0.f};
    const char* cA = (const char*)g.A + (size_t)cur.pm * tA; const char* cB = (const char*)g.Bt + (size_t)cur.pn * tB;
    PG8_STAGE(PG8_SB(0, 0), cB, voffB); PG8_STAGE(PG8_SB(0, 1), cB + hB, voffB); PG8_STAGE(PG8_SA(0, 0), cA, voffA); PG8_STAGE(PG8_SA(0, 1), cA + hA, voffA);
    if (wr == 1) PG8_BAR;
    PG8_WAIT_V(2); PG8_BAR;
    PG8_STAGE(PG8_SB(1, 0), cB + kstep, voffB); PG8_STAGE(PG8_SA(1, 0), cA + kstep, voffA); PG8_STAGE(PG8_SB(1, 1), cB + hB + kstep, voffB);
    PG8_WAIT_V(6); PG8_BAR;
    for (;;) {
        const bool has_next = S.next(ui + 1, nxt);
        const char* nA = has_next ? (const char*)g.A + (size_t)nxt.pm * tA : cA; const char* nB = has_next ? (const char*)g.Bt + (size_t)nxt.pn * tB : cB;
#pragma nounroll
        for (int t = 0; t < nt; t += 2) {
            const bool last = (t == nt - 2);
            bf16x8 At[4][2], B0[2][2], B1[2][2];
            const char* a1 = cA + (size_t)(t + 1) * kstep;
            const char* a2 = last ? nA : cA + (size_t)(t + 2) * kstep; const char* b2 = last ? nB : cB + (size_t)(t + 2) * kstep;
            const char* a3 = a2 + kstep; const char* b3 = b2 + kstep;
            PG8_LDB(B0, 0, 0); PG8_LDB(B1, 0, 1); PG8_SCHED; PG8_LDA(At, 0, 0); PG8_STAGE(PG8_SA(1, 1), a1 + hA, voffA);
            PG8_WAIT_V(8); PG8_WAIT_L(0); PG8_BAR; PG8_MMA(0, 0, At, B0); PG8_MMA(0, 1, At, B1); PG8_BAR; PG8_SCHED;
            PG8_LDA(At, 0, 1); PG8_STAGE(PG8_SB(0, 0), b2, voffB); PG8_STAGE(PG8_SB(0, 1), b2 + hB, voffB); PG8_STAGE(PG8_SA(0, 0), a2, voffA);
            PG8_WAIT_V(8); PG8_WAIT_L(0); PG8_BAR; PG8_MMA(1, 0, At, B0); PG8_MMA(1, 1, At, B1); PG8_BAR; PG8_SCHED;
            PG8_LDB(B0, 1, 0); PG8_LDB(B1, 1, 1); PG8_SCHED; PG8_LDA(At, 1, 0); PG8_STAGE(PG8_SA(0, 1), a2 + hA, voffA);
            PG8_WAIT_V(8); PG8_WAIT_L(0); PG8_BAR; PG8_MMA(0, 0, At, B0); PG8_MMA(0, 1, At, B1); PG8_BAR; PG8_SCHED;
            PG8_LDA(At, 1, 1); PG8_STAGE(PG8_SB(1, 0), b3, voffB); PG8_STAGE(PG8_SB(1, 1), b3 + hB, voffB); PG8_STAGE(PG8_SA(1, 0), a3, voffA);
            PG8_WAIT_V(8); PG8_WAIT_L(0); PG8_BAR; PG8_MMA(1, 0, At, B0); PG8_MMA(1, 1, At, B1); PG8_BAR; PG8_SCHED;
        }
        if constexpr (ALIGN_EPI) { if (wr == 0) PG8_BAR; }
        E(acc, cur, wr, wc, fr, fq);
        if (!has_next) break;
#pragma unroll
        for (int a = 0; a < 2; ++a)
#pragma unroll
            for (int b = 0; b < 2; ++b)
#pragma unroll
                for (int m = 0; m < 4; ++m)
#pragma unroll
                    for (int n = 0; n < 2; ++n) acc[a][b][m][n] = (f32x4){0.f, 0.f, 0.f, 0.f};
        cur = nxt; cA = nA; cB = nB; ++ui;
        if constexpr (ALIGN_EPI) { if (wr == 1) PG8_BAR; }
    }
    PG8_WAIT_V(0);
    if constexpr (!ALIGN_EPI) { if (wr == 0) PG8_BAR; }
    PG8_BAR;
#undef PG8_SA
#undef PG8_SB
#undef PG8_STAGE
#undef PG8_LDA
#undef PG8_LDB
#undef PG8_MMA
#undef PG8_WAIT_V
#undef PG8_WAIT_L
#undef PG8_BAR
#undef PG8_SCHED
}

__device__ __forceinline__ int rk_base(int pm) { return pm < 32 ? pm * 256 : RP + ((pm - 32) >> 3) * 2304 + ((pm - 32) & 7) * 256; }

struct EpiBf16 {
    static constexpr bool PERM = true;
    bf16* O; int ldc; int split_cols; size_t split_stride;
    __device__ __forceinline__ void operator()(const f32x4 (&acc)[2][2][4][2], const Unit& u, int wr, int wc, int fr, int fq) const {
        const int row0 = u.pm * BM + wr * 64 + fr; int colt = u.pn * BM; bf16* base = O;
        if (split_cols) { const int t = colt / split_cols; base += (size_t)t * split_stride; colt -= t * split_cols; }
        const int col0 = colt + wc * 32 + 8 * fq;
#pragma unroll
        for (int ai = 0; ai < 2; ++ai)
#pragma unroll
            for (int m = 0; m < 4; ++m) { bf16* rowp = base + (size_t)(row0 + ai * HALF + m * 16) * ldc + col0;
#pragma unroll
                for (int bj = 0; bj < 2; ++bj) { const f32x4 v0 = acc[ai][bj][m][0], v1 = acc[ai][bj][m][1];
                    u32x4 w; w.x = pk2(v0[0], v0[1]); w.y = pk2(v0[2], v0[3]); w.z = pk2(v1[0], v1[1]); w.w = pk2(v1[2], v1[3]);
                    *(u32x4*)(rowp + bj * HALF) = w; } }
    }
};
struct EpiOutPub {
    static constexpr bool PERM = true;
    bf16* O; unsigned* cnt;
    __device__ __forceinline__ void operator()(const f32x4 (&acc)[2][2][4][2], const Unit& u, int wr, int wc, int fr, int fq) const {
        const __amdgpu_buffer_rsrc_t rs = __builtin_amdgcn_make_buffer_rsrc((void*)O, (short)0, R * 1024 * 2, 0x00020000);
        const int row0 = u.pm * BM + wr * 64 + fr; const int col0 = u.pn * BM + wc * 32 + 8 * fq;
#pragma unroll
        for (int ai = 0; ai < 2; ++ai)
#pragma unroll
            for (int m = 0; m < 4; ++m) { const int off = ((row0 + ai * HALF + m * 16) * 1024 + col0) * 2;
#pragma unroll
                for (int bj = 0; bj < 2; ++bj) { const f32x4 v0 = acc[ai][bj][m][0], v1 = acc[ai][bj][m][1];
                    u32x4 w; w.x = pk2(v0[0], v0[1]); w.y = pk2(v0[2], v0[3]); w.z = pk2(v1[0], v1[1]); w.w = pk2(v1[2], v1[3]);
                    __builtin_amdgcn_raw_buffer_store_b128(w, rs, off + bj * HALF * 2, 0, 16); } }
        asm volatile("s_waitcnt vmcnt(0)" ::: "memory");
        if ((fr | fq) == 0) __hip_atomic_fetch_add(cnt + 16 * u.pm, 1u, __ATOMIC_RELAXED, __HIP_MEMORY_SCOPE_AGENT);
    }
};
struct EpiPool {
    static constexpr bool PERM = true;
    bf16* GB;
    __device__ __forceinline__ void operator()(const f32x4 (&acc)[2][2][4][2], const Unit& u, int wr, int wc, int fr, int fq) const {
        const int row0 = u.pm * BM + wr * 64 + fr; const int col0 = u.pn * BM + wc * 32 + 8 * fq;
#pragma unroll
        for (int ai = 0; ai < 2; ++ai)
#pragma unroll
            for (int m = 0; m < 4; ++m) { bf16* rowp = GB + (size_t)(row0 + ai * HALF + m * 16) * 1024 + col0;
#pragma unroll
                for (int bj = 0; bj < 2; ++bj) { const f32x4 v0 = acc[ai][bj][m][0], v1 = acc[ai][bj][m][1];
                    const u32x4 gg = *(const u32x4*)(rowp + bj * HALF);
                    u32x4 w;
                    w.x = pk2(v0[0] * silu_fast(bflo(gg.x)), v0[1] * silu_fast(bfhi(gg.x))); w.y = pk2(v0[2] * silu_fast(bflo(gg.y)), v0[3] * silu_fast(bfhi(gg.y)));
                    w.z = pk2(v1[0] * silu_fast(bflo(gg.z)), v1[1] * silu_fast(bfhi(gg.z))); w.w = pk2(v1[2] * silu_fast(bflo(gg.w)), v1[3] * silu_fast(bfhi(gg.w)));
                    *(u32x4*)(rowp + bj * HALF) = w; } }
    }
};
struct EpiMlaIn {
    static constexpr bool PERM = true;
    bf16 *CQ, *CKV, *GAB, *VP; float* KRF;
    __device__ __forceinline__ void operator()(const f32x4 (&acc)[2][2][4][2], const Unit& u, int wr, int wc, int fr, int fq) const {
        const int rt = wr * 64 + fr, grow0 = u.pm * BM, rk0 = rk_base(u.pm), cc = wc * 32 + 8 * fq;
#pragma unroll
        for (int bj = 0; bj < 2; ++bj) {
            const int U = 2 * u.pn + bj;
            if (U == 5) {
                if (wc == 0) {
#pragma unroll
                    for (int ai = 0; ai < 2; ++ai)
#pragma unroll
                        for (int m = 0; m < 4; ++m) { float* p = KRF + (size_t)(grow0 + rt + ai * HALF + m * 16) * 32 + 8 * fq;
                            *(f32x4*)p = acc[ai][bj][m][0]; *(f32x4*)(p + 4) = acc[ai][bj][m][1]; }
                }
                continue;
            }
            bf16* p; int ld, rb = grow0;
            if (U < 3) { p = CQ + 128 * U; ld = 384; }
            else if (U < 5) { p = CKV + 128 * (U - 3); ld = 256; rb = rk0; }
            else if (U < 10) { p = GAB + 128 * (U - 6); ld = 1024; }
            else if (U < 14) { p = VP + 128 * (U - 10); ld = 512; }
            else { p = GAB + 512 + 128 * (U - 14); ld = 1024; }
            p += (size_t)(rb + rt) * ld + cc;
            const bool isgate = (U >= 6 && U < 10) || U >= 14;
#pragma unroll
            for (int ai = 0; ai < 2; ++ai)
#pragma unroll
                for (int m = 0; m < 4; ++m) { f32x4 v0 = acc[ai][bj][m][0], v1 = acc[ai][bj][m][1];
                    if (isgate) { v0 = (f32x4){silu_fast(v0[0]), silu_fast(v0[1]), silu_fast(v0[2]), silu_fast(v0[3])}; v1 = (f32x4){silu_fast(v1[0]), silu_fast(v1[1]), silu_fast(v1[2]), silu_fast(v1[3])}; }
                    u32x4 w; w.x = pk2(v0[0], v0[1]); w.y = pk2(v0[2], v0[3]); w.z = pk2(v1[0], v1[1]); w.w = pk2(v1[2], v1[3]);
                    *(u32x4*)(p + (size_t)(ai * HALF + m * 16) * ld) = w; }
        }
    }
};
__device__ __forceinline__ void rope_perm(f32x4& a, f32x4& b, const float* tb) {
#pragma unroll
    for (int j = 0; j < 4; ++j) { auto rr = __builtin_amdgcn_permlane32_swap(__float_as_uint(a[j]), __float_as_uint(b[j]), false, false); a[j] = __uint_as_float(rr[0]); b[j] = __uint_as_float(rr[1]); }
    const f32x4 c0 = *(const f32x4*)tb, c1 = *(const f32x4*)(tb + 4);
    const f32x4 cs = {c0[0], c0[2], c1[0], c1[2]}, sn = {c0[1], c0[3], c1[1], c1[3]};
    const f32x4 o1 = a * cs - b * sn, o2 = a * sn + b * cs;
    a = o1; b = o2;
#pragma unroll
    for (int j = 0; j < 4; ++j) { auto rr = __builtin_amdgcn_permlane32_swap(__float_as_uint(a[j]), __float_as_uint(b[j]), false, false); a[j] = __uint_as_float(rr[0]); b[j] = __uint_as_float(rr[1]); }
}
struct EpiQ {
    static constexpr bool PERM = true;
    bf16* Q; const float* rope8;
    __device__ __forceinline__ void operator()(const f32x4 (&acc)[2][2][4][2], const Unit& u, int wr, int wc, int fr, int fq) const {
        const int rt = wr * 64 + fr, grow0 = u.pm * BM; const bool sample = u.pm >= 32; const int t0 = ((u.pm - 32) & 7) * 256;
#pragma unroll
        for (int bj = 0; bj < 2; ++bj) {
            const int g32 = 8 * u.pn + 4 * bj + wc; const bool rot = sample && (g32 % 3 == 2);
#pragma unroll
            for (int ai = 0; ai < 2; ++ai)
#pragma unroll
                for (int m = 0; m < 4; ++m) { const int r = rt + ai * HALF + m * 16; f32x4 x1 = acc[ai][bj][m][0], x2 = acc[ai][bj][m][1];
                    if (rot) { const int t = t0 + r, pos = (fq & 1) ? (t & 63) : (t >> 6); rope_perm(x1, x2, rope8 + (pos * 8 + ((fq >> 1) ? 4 : 0)) * 2); }
                    u32x4 w; w.x = pk2(x1[0], x1[1]); w.y = pk2(x1[2], x1[3]); w.z = pk2(x2[0], x2[1]); w.w = pk2(x2[2], x2[3]);
                    *(u32x4*)(Q + (size_t)(grow0 + r) * 768 + 32 * g32 + 8 * fq) = w; }
        }
    }
};
struct EpiSwaIn {
    static constexpr bool PERM = true;
    bf16 *Q, *K, *V, *G; float *stK, *stV; const float* rope16;
    __device__ __forceinline__ void operator()(const f32x4 (&acc)[2][2][4][2], const Unit& u, int wr, int wc, int fr, int fq) const {
        const int rt = wr * 64 + fr, grow0 = u.pm * BM, rk0 = rk_base(u.pm); const bool sample = u.pm >= 32; const int t0 = ((u.pm - 32) & 7) * 256;
        const int pn = u.pn;
#pragma unroll
        for (int bj = 0; bj < 2; ++bj) {
            const int cb = 128 * bj + 32 * wc + 8 * fq;
            const bool rot = sample && pn < 5;
#pragma unroll
            for (int ai = 0; ai < 2; ++ai)
#pragma unroll
                for (int m = 0; m < 4; ++m) { const int r = rt + ai * HALF + m * 16; f32x4 x1 = acc[ai][bj][m][0], x2 = acc[ai][bj][m][1];
                    if (rot) { const int t = t0 + r, pos = (wc & 1) ? (t & 63) : (t >> 6); rope_perm(x1, x2, rope16 + (pos * 16 + 8 * (fq & 1) + ((fq >> 1) ? 4 : 0)) * 2); }
                    bf16* p;
                    if (pn < 4) p = Q + (size_t)(grow0 + r) * 1024 + 256 * pn + cb;
                    else if (pn == 4) p = K + (size_t)(rk0 + r) * 256 + cb;
                    else if (pn == 5) p = V + (size_t)(rk0 + r) * 256 + cb;
                    else p = G + (size_t)(grow0 + r) * 1024 + 256 * (pn - 6) + cb;
                    if (pn >= 6) { x1 = (f32x4){silu_fast(x1[0]), silu_fast(x1[1]), silu_fast(x1[2]), silu_fast(x1[3])}; x2 = (f32x4){silu_fast(x2[0]), silu_fast(x2[1]), silu_fast(x2[2]), silu_fast(x2[3])}; }
                    if (!sample && (pn == 4 || pn == 5)) { float* st = (pn == 4 ? stK : stV) + (size_t)(u.pm * 2 * 256 + r) * 256 + cb; *(f32x4*)st = x1; *(f32x4*)(st + 4) = x2; }
                    u32x4 w; w.x = pk2(x1[0], x1[1]); w.y = pk2(x1[2], x1[3]); w.z = pk2(x2[0], x2[1]); w.w = pk2(x2[2], x2[3]);
                    *(u32x4*)p = w; }
        }
    }
};
}

typedef __attribute__((address_space(4))) const char* kptr_t;
__device__ __forceinline__ const void* arg_ptr(int k) { kptr_t ka = (kptr_t)__builtin_amdgcn_kernarg_segment_ptr(); asm volatile("" : "+s"(ka)); return *(const void* __attribute__((address_space(4)))*)(ka + 8 * k); }
#define ARG_IN(k) ((const float*)arg_ptr(k))
namespace att {
__device__ __forceinline__ int crow(int r, int hi) { return (r & 3) + 8 * (r >> 2) + 4 * hi; }
typedef short v4i16_t __attribute__((ext_vector_type(4)));
__device__ __forceinline__ s16x4 vtr(const LAS char* p) { return __builtin_bit_cast(s16x4, __builtin_amdgcn_ds_read_tr16_b64_v4i16((LAS v4i16_t*)p)); }
__device__ __forceinline__ float xhalf_max(float x) { auto rr = __builtin_amdgcn_permlane32_swap(__float_as_uint(x), __float_as_uint(x), false, false); return __builtin_fmaxf(__uint_as_float(rr[0]), __uint_as_float(rr[1])); }
__device__ __forceinline__ float xhalf_sum(float x) { auto rr = __builtin_amdgcn_permlane32_swap(__float_as_uint(x), __float_as_uint(x), false, false); return __uint_as_float(rr[0]) + __uint_as_float(rr[1]); }
#define SBAR() __builtin_amdgcn_sched_barrier(0)
#define PIN(x) asm volatile("" : "+v"(x))
__device__ __forceinline__ float max3f(float a, float b, float c) { float r; asm("v_max3_f32 %0, %1, %2, %3" : "=v"(r) : "v"(a), "v"(b), "v"(c)); return r; }
__device__ __forceinline__ float max2f(float a, float b) { float r; asm("v_max_f32_e32 %0, %1, %2" : "=v"(r) : "v"(a), "v"(b)); return r; }
struct Desc {
    const bf16* qptr;
    const bf16* k0;
    const bf16* k1;
    const bf16* v;
    int n_a, row_a, n_b, row_b, key_b;
    int qpos; float sink2; int has_sink;
    bf16* optr;
};
constexpr float THR = 8.f;
__device__ __forceinline__ int tile_row(const Desc& d, int t) { return t < d.n_a ? d.row_a + 64 * t : d.row_b + 64 * (t - d.n_a); }
template <int MODE, class MK>
__device__ __forceinline__ void attn_phase(LAS char* lds, const MK& mk, int first, int stride, int nunits) {
    constexpr int DQK = MODE == 0 ? 96 : 64, NCH = DQK / 8, ND0 = DQK / 16, KB = NCH * 1024, VOFF = 3 * KB, NG = 2 * ND0, NHELD = 8, NLATE = NG - NHELD, STG_OFF = VOFF + 2 * 8192;
    static_assert(STG_OFF + 8 * 32 * 272 <= 131072, "attention LDS map");
    constexpr int LDQ = MODE == 0 ? 768 : 1024, LDK0 = MODE == 0 ? 512 : 256, LDV = LDK0, LDO = 1024;
    int un = first; if (un >= nunits) return;
    const int tid = opaque_tid(), lane = tid & 63, r32 = lane & 31, hi = lane >> 5; const int wid = __builtin_amdgcn_readfirstlane(tid >> 6);
    const int kdst = wid * 1024, k1dst = (8 + (wid & 3)) * 1024, vdst = VOFF + wid * 1024;
    const int vlane = ((lane >> 4) & 1) * 32 + (lane & 3) * 8 + (4 * hi + ((lane & 15) >> 2)) * 64;
    const int kfo = hi * 1024 + r32 * 16;
    Desc d; mk(un, d);
    const unsigned kvo = (unsigned)(lane * LDK0 + wid * 8) * 2u, k1vo = (unsigned)(lane * 32 + (wid & 3) * 8) * 2u;
    const unsigned vvo = (unsigned)((16 * (wid & 3) + (lane >> 2)) * LDV + (wid >> 2) * 32 + (lane & 3) * 8) * 2u;
#define GLDS16(vo, sb, l) asm volatile("s_mov_b32 m0, %2\n\ts_nop 0\n\tglobal_load_lds_dwordx4 %0, %1" :: "v"(vo), "s"(sb), "s"((unsigned)(size_t)(l)) : "memory", "m0")
#define DMA_DRAIN() asm volatile("s_waitcnt vmcnt(0)" ::: "memory")
#define DMAK_(dd, t, soff) do { const size_t _r = (size_t)tile_row(dd, t); GLDS16(kvo, (dd).k0 + _r * LDK0, lds + (soff) + kdst); if (MODE == 0 && wid < 4) GLDS16(k1vo, (dd).k1 + _r * 32, lds + (soff) + k1dst); } while (0)
#define DMAV_(dd, t, vslot) do { const size_t _r = (size_t)tile_row(dd, t); GLDS16(vvo, (dd).v + _r * LDV, lds + (vslot) * 8192 + vdst); } while (0)
#define DMAK(t, soff) DMAK_(d, t, soff)
#define DMAV(t, vslot) DMAV_(d, t, vslot)
    int sl_cur = 0, sl_nxt = KB, sl_fre = 2 * KB;
    int vpar = 0;
    DMAK(0, sl_cur); DMAK(1, sl_nxt); DMAV(0, vpar);
    bf16x8 qr[ND0];
#pragma unroll
    for (int d0 = 0; d0 < ND0; ++d0) qr[d0] = *(const bf16x8*)(d.qptr + (size_t)r32 * LDQ + d0 * 16 + hi * 8);
    DMA_DRAIN(); __syncthreads();
#define ROT() do { const int o_ = sl_cur; sl_cur = sl_nxt; sl_nxt = sl_fre; sl_fre = o_; } while (0)
#define KFADDR(i, soff) (lds + (soff) + kfo + ((i) >> 1) * 2048 + ((i) & 1) * 512)
#define PE(P0, P1, e) ((e) < 16 ? P0[(e) & 15] : P1[(e) & 15])
#define FILL_A(P0, P1, g) do { \
        _Pragma("unroll") for (int e_ = (32 * (g)) / NG; e_ < (32 * ((g) + 1)) / NG; ++e_) sacc += PE(P0, P1, e_); \
        _Pragma("unroll") for (int k_ = (16 * (g)) / NG; k_ < (16 * ((g) + 1)) / NG; ++k_) { pw[k_ >> 2][k_ & 3] = pk2(PE(P0, P1, 2 * k_), PE(P0, P1, 2 * k_ + 1)); } } while (0)
#define QK_PHASE(C0, C1, P0, P1, HAVE_P) do { \
        bf16x8 kl_[NLATE > 0 ? NLATE : 1]; \
        _Pragma("unroll") for (int i_ = 0; i_ < NLATE; ++i_) kl_[i_] = *(const LAS bf16x8*)KFADDR(NHELD + i_, sl_cur); \
        _Pragma("unroll") for (int g_ = 0; g_ < NG; ++g_) { const int d0_ = g_ >> 1; \
            const bf16x8 kk_ = g_ < NHELD ? kf[g_ < NHELD ? g_ : 0] : kl_[g_ >= NHELD ? g_ - NHELD : 0]; \
            if ((g_ & 1) == 0) C0 = __builtin_amdgcn_mfma_f32_32x32x16_bf16(kk_, qr[d0_], d0_ == 0 ? negm : C0, 0, 0, 0); \
            else C1 = __builtin_amdgcn_mfma_f32_32x32x16_bf16(kk_, qr[d0_], d0_ == 0 ? negm : C1, 0, 0, 0); \
            if (g_ < NHELD) kf[g_ < NHELD ? g_ : 0] = *(const LAS bf16x8*)KFADDR(g_, sl_nxt); \
            if (HAVE_P) FILL_A(P0, P1, g_); \
            SBAR(); } } while (0)
#define MASKT(C0, C1, t_) do { if (MODE == 1 && (t_) >= d.n_a) { const int key0_ = d.key_b + 64 * ((t_) - d.n_a); \
        if (key0_ - (qb0 + 31) < -128 || key0_ + 63 - qb0 > 128) { const int k0p_ = key0_ - d.qpos; \
            _Pragma("unroll") for (int r = 0; r < 16; ++r) { const int d_ = k0p_ + crow(r, hi); if (d_ > 128 || d_ < -128) C0[r] = -1e30f; if (d_ + 32 > 128 || d_ + 32 < -128) C1[r] = -1e30f; } } } } while (0)
#define DECIDE(C0, C1) do { \
        float a_ = max2f(C0[0], C1[0]), b_ = max2f(C0[1], C1[1]); \
        _Pragma("unroll") for (int r = 2; r < 16; r += 2) { a_ = max3f(a_, C0[r], C1[r]); b_ = max3f(b_, C0[r + 1], C1[r + 1]); } \
        a_ = xhalf_max(max2f(a_, b_)); resc = false; \
        if (__any(a_ > THR)) { const float dl_ = fmaxf(a_, 0.f); mref += dl_; \
            _Pragma("unroll") for (int r = 0; r < 16; ++r) { C0[r] -= dl_; C1[r] -= dl_; } \
            _Pragma("unroll") for (int r = 0; r < 16; ++r) negm[r] = -mref; \
            fsc = __builtin_amdgcn_exp2f(-dl_); lsum *= fsc; resc = true; } } while (0)
#define EXP4(C0, C1, j) do { _Pragma("unroll") for (int e_ = 4 * (j); e_ < 4 * (j) + 4; ++e_) { if (e_ < 16) C0[e_ & 15] = __builtin_amdgcn_exp2f(C0[e_ & 15]); else C1[e_ & 15] = __builtin_amdgcn_exp2f(C1[e_ & 15]); } \
        if (4 * (j) < 16) PIN(C0); else PIN(C1); } while (0)
#define VOFFS(j) ((((j) & 1) * 4096) + (((j) >> 1) * 1024))
#define PV_PHASE(C0, C1, HAVE_C, HAVE_K, tp_) do { \
        const LAS char* vp_ = lds + VOFF + (((tp_) + vpar) & 1) * 8192 + vlane; \
        s16x4 vl_[8], vh_[8]; \
        vl_[0] = vtr(vp_ + VOFFS(0)); vh_[0] = vtr(vp_ + VOFFS(0) + 512); vl_[1] = vtr(vp_ + VOFFS(1)); vh_[1] = vtr(vp_ + VOFFS(1) + 512); \
        _Pragma("unroll") for (int j = 0; j < 8; ++j) { const int ks = j >> 1, dd = j & 1; \
            if (j + 2 < 8) { vl_[j + 2] = vtr(vp_ + VOFFS(j + 2)); vh_[j + 2] = vtr(vp_ + VOFFS(j + 2) + 512); } \
            const bf16x8 vf_ = {vl_[j][0], vl_[j][1], vl_[j][2], vl_[j][3], vh_[j][0], vh_[j][1], vh_[j][2], vh_[j][3]}; \
            if (dd == 0) o0 = __builtin_amdgcn_mfma_f32_32x32x16_bf16(vf_, __builtin_bit_cast(bf16x8, pw[ks]), o0, 0, 0, 0); \
            else o1 = __builtin_amdgcn_mfma_f32_32x32x16_bf16(vf_, __builtin_bit_cast(bf16x8, pw[ks]), o1, 0, 0, 0); \
            if (HAVE_C) EXP4(C0, C1, j); \
            SBAR(); } } while (0)
#define STEP(C0, C1, P0, P1, t_) do { \
        if ((t_) + 2 < NT) DMAK((t_) + 2, sl_fre); \
        DMAV(t_, ((t_) + vpar) & 1); \
        float sacc = 0.f; \
        QK_PHASE(C0, C1, P0, P1, true); \
        lsum += sacc; \
        MASKT(C0, C1, t_); \
        DECIDE(C0, C1); \
        SBAR(); \
        PV_PHASE(C0, C1, true, true, (t_) - 1); \
        DMA_DRAIN(); __syncthreads(); \
        ROT(); \
        if (resc) { o0 *= fsc; o1 *= fsc; } } while (0)
    for (;;) {
        const int NT = d.n_a + d.n_b;
        const int qb0 = __builtin_amdgcn_readfirstlane(d.qpos);
        float mref = 0.f, lsum = 0.f, fsc = 1.f; bool resc = false;
        f32x16 o0 = (f32x16){}, o1 = (f32x16){}, negm = (f32x16){};
        f32x16 cA0 = (f32x16){}, cA1 = (f32x16){}, cB0 = (f32x16){}, cB1 = (f32x16){};
        u32x4 pw[4];
#pragma unroll
        for (int i = 0; i < 4; ++i) pw[i] = (u32x4){0u, 0u, 0u, 0u};
        bf16x8 kf[NHELD];
#pragma unroll
        for (int i = 0; i < NHELD; ++i) kf[i] = *(const LAS bf16x8*)KFADDR(i, sl_cur);
        {
            if (2 < NT) DMAK(2, sl_fre);
            float sacc = 0.f; (void)sacc;
            QK_PHASE(cA0, cA1, cA0, cA1, false);
            MASKT(cA0, cA1, 0);
            DECIDE(cA0, cA1);
#pragma unroll
            for (int j = 0; j < 8; ++j) { EXP4(cA0, cA1, j); SBAR(); }
            DMA_DRAIN(); __syncthreads();
            ROT();
        }
        int t = 1;
        for (; t + 1 < NT; t += 2) { STEP(cB0, cB1, cA0, cA1, t); STEP(cA0, cA1, cB0, cB1, t + 1); }
        const bool odd_tail = t < NT;
        if (odd_tail) STEP(cB0, cB1, cA0, cA1, t);
        const int un_next = un + stride; const bool has_next = un_next < nunits;
        Desc dn = d;
        u32x4 gpre[4];
#pragma unroll
        for (int i2 = 0; i2 < 4; ++i2) gpre[i2] = *(const u32x4*)(d.optr + (size_t)(i2 * 8 + (lane >> 3)) * LDO + (lane & 7) * 8);
        bf16x8 qn[ND0];
#pragma unroll
        for (int d0 = 0; d0 < ND0; ++d0) qn[d0] = qr[d0];
        if (has_next) {
            mk(un_next, dn);
            DMAK_(dn, 0, sl_cur); DMAK_(dn, 1, sl_nxt); DMAV_(dn, 0, (NT + vpar) & 1);
#pragma unroll
            for (int d0 = 0; d0 < ND0; ++d0) qn[d0] = *(const bf16x8*)(dn.qptr + (size_t)r32 * LDQ + d0 * 16 + hi * 8);
        }
        if (odd_tail) {
            float sacc = 0.f;
#pragma unroll
            for (int g = 0; g < NG; ++g) FILL_A(cB0, cB1, g);
            lsum += sacc;
            PV_PHASE(cB0, cB1, false, false, NT - 1);
        } else {
            float sacc = 0.f;
#pragma unroll
            for (int g = 0; g < NG; ++g) FILL_A(cA0, cA1, g);
            lsum += sacc;
            PV_PHASE(cA0, cA1, false, false, NT - 1);
        }
        float lt = xhalf_sum(lsum);
        if (d.has_sink) lt += __builtin_amdgcn_exp2f(d.sink2 - mref);
        const float inv = 1.0f / lt;
        {
            LAS char* stg = lds + STG_OFF + wid * (32 * 272);
#pragma unroll
            for (int d0 = 0; d0 < 2; ++d0)
#pragma unroll
                for (int g = 0; g < 4; ++g) { const f32x16& o = d0 ? o1 : o0;
                    const f32x4 v = {o[4 * g] * inv, o[4 * g + 1] * inv, o[4 * g + 2] * inv, o[4 * g + 3] * inv};
                    *(LAS f32x4*)(stg + r32 * 272 + (32 * d0 + 8 * g + 4 * hi) * 4) = v; }
#pragma unroll
            for (int i2 = 0; i2 < 4; ++i2) { const int row = i2 * 8 + (lane >> 3), ch = lane & 7;
                const f32x4 va = *(const LAS f32x4*)(stg + row * 272 + ch * 32), vb = *(const LAS f32x4*)(stg + row * 272 + ch * 32 + 16);
                const u32x4 gg = gpre[i2];
                u32x4 w;
                w.x = pk2(va[0] * bflo(gg.x), va[1] * bfhi(gg.x)); w.y = pk2(va[2] * bflo(gg.y), va[3] * bfhi(gg.y));
                w.z = pk2(vb[0] * bflo(gg.z), vb[1] * bfhi(gg.z)); w.w = pk2(vb[2] * bflo(gg.w), vb[3] * bfhi(gg.w));
                *(u32x4*)(d.optr + (size_t)row * LDO + ch * 8) = w; }
        }
        DMA_DRAIN(); __syncthreads();
        if (!has_next) break;
        vpar = (NT + vpar) & 1;
        d = dn; un = un_next;
#pragma unroll
        for (int d0 = 0; d0 < ND0; ++d0) qr[d0] = qn[d0];
    }
#undef GLDS16
#undef DMA_DRAIN
#undef DMAK_
#undef DMAV_
#undef DMAK
#undef DMAV
#undef ROT
#undef KFADDR
#undef PE
#undef FILL_A
#undef QK_PHASE
#undef MASKT
#undef DECIDE
#undef EXP4
#undef VOFFS
#undef PV_PHASE
#undef STEP
}
#undef SBAR
}

#define XB_TMO      128
#define XB_XCNT(j)  (256  + 64 * (j))
#define XB_XSUB(j)  (1280 + 64 * (j))
#define XB_XGEN(j)  (2304 + 64 * (j))
#define XB_TOP      3328
#define XB_TOPGEN   3392
#define XCD_BAR_WORDS 3456
#define XB_SPIN_CAP (1u << 20)
__device__ __forceinline__ unsigned xb_ld(unsigned* p)              { return __hip_atomic_load(p, __ATOMIC_RELAXED, __HIP_MEMORY_SCOPE_AGENT); }
__device__ __forceinline__ unsigned xb_add(unsigned* p, unsigned v) { return __hip_atomic_fetch_add(p, v, __ATOMIC_RELAXED, __HIP_MEMORY_SCOPE_AGENT); }
__device__ __forceinline__ unsigned xb_xcc_id() { return (unsigned)__builtin_amdgcn_s_getreg((3 << 11) | 20) & 0xFu; }
#define XB_SPIN(cond, bar) do { unsigned _sp = 0; while (cond) { __builtin_amdgcn_s_sleep(1); \
    if ((++_sp & 255u) == 0u) { if (xb_ld(&(bar)[XB_TMO])) break; if (_sp > XB_SPIN_CAP) { atomicAdd(&(bar)[XB_TMO], 1u); break; } } } } while (0)
struct XcdBarrier { unsigned* bar; unsigned x; volatile LAS unsigned* st; };
__device__ __forceinline__ XcdBarrier xcd_barrier_post(unsigned* bar, volatile LAS unsigned* st) {
    XcdBarrier b; b.bar = bar; b.x = xb_xcc_id(); b.st = st;
    if (threadIdx.x == 0) (void)xb_add(&bar[XB_XCNT(b.x)], 1u);
    return b;
}
__device__ __forceinline__ void xcd_barrier_complete(unsigned* bar, unsigned x, unsigned& nloc, unsigned& nx) {
    const unsigned G = gridDim.x * gridDim.y * gridDim.z;
    unsigned sum, cnt, mine, sp = 0u;
    for (;;) {
        sum = 0u; cnt = 0u; mine = 0u;
#pragma unroll
        for (unsigned j = 0; j < 16; ++j) { const unsigned c = xb_ld(&bar[XB_XCNT(j)]); sum += c; cnt += (c > 0u) ? 1u : 0u; mine = (j == x) ? c : mine; }
        if (sum == G) break;
        __builtin_amdgcn_s_sleep(1);
        if ((++sp & 255u) == 0u) { if (xb_ld(&bar[XB_TMO])) break; if (sp > XB_SPIN_CAP) { atomicAdd(&bar[XB_TMO], 1u); break; } }
    }
    nloc = mine > 0u ? mine : 1u; nx = cnt > 0u ? cnt : 1u;
}
__device__ __forceinline__ void xcd_barrier(const XcdBarrier& b0) {
    asm volatile("s_waitcnt vmcnt(0)" ::: "memory");
    __syncthreads();
    if (threadIdx.x == 0) {
        XcdBarrier b = b0; b.x = xb_xcc_id();
        unsigned* bar = b.bar; asm volatile("" : "+s"(bar));
        __builtin_amdgcn_s_waitcnt(0);
        unsigned nloc = b.st[0], nx = b.st[1];
        if (nloc == 0u) { xcd_barrier_complete(bar, b.x, nloc, nx); b.st[0] = nloc; b.st[1] = nx; }
        const unsigned old = xb_add(&bar[XB_XSUB(b.x)], 1u);
        const unsigned gen = old / nloc;
        if (old + 1u == (gen + 1u) * nloc) {
            __builtin_amdgcn_fence(__ATOMIC_RELEASE, "agent");
            asm volatile("s_waitcnt vmcnt(0)" ::: "memory");
            const unsigned og = xb_add(&bar[XB_TOP], 1u);
            const unsigned tg = og / nx;
            if (og + 1u == (tg + 1u) * nx) xb_add(&bar[XB_TOPGEN], 1u);
            else XB_SPIN(xb_ld(&bar[XB_TOPGEN]) == tg, bar);
            __builtin_amdgcn_fence(__ATOMIC_ACQUIRE, "agent");
            xb_add(&bar[XB_XGEN(b.x)], 1u);
            asm volatile("s_waitcnt vmcnt(0)" ::: "memory");
        } else {
            XB_SPIN(xb_ld(&bar[XB_XGEN(b.x)]) == gen, bar);
            __builtin_amdgcn_fence(__ATOMIC_ACQUIRE, "agent");
            asm volatile("s_waitcnt vmcnt(0)" ::: "memory");
        }
    }
    __syncthreads();
}

struct Args { const float* in[23]; float* out; unsigned char* ws; int ph_lo, ph_hi; };
constexpr int NWAVES = 8;
constexpr int N_PHASES = 2 + 5 + 3 + 5 + 3;
constexpr int RING_BYTES = 131072, MISC_OFF = RING_BYTES + 320, LDS_BYTES = 147456;

struct TMap { int kind, row_off, col_off, ldw; const float* nscale; float scale; };
__device__ __forceinline__ void tmap(const TMap& tm, int n, int& drow, float& sc) {
    drow = n + tm.row_off; sc = tm.scale;
    switch (tm.kind) {
        case 1: if (n >= 672) drow += 96; break;
        case 2: { const int e = n % 96; if (e >= 64) { const int d = e - 64; const int p = (d & 7) | ((d & 8) << 1) | ((d & 16) >> 1); drow = n - e + 64 + p; } } break;
        case 3: { const int h = n >> 7, e = n & 127; drow = (e < 64) ? h * 64 + e : 512 + h * 64 + (e - 64); } break;
        case 4: sc = tm.nscale[n]; break;
        case 5: if (n >= 1024) sc = 1.f; break;
        default: break;
    }
}
__device__ __forceinline__ void transpose_item(const float* W, int K, int N, bf16* WT, const TMap& tm, LAS float* scr, int item, int lane) {
    const int nblk = N / 32, kb = item / nblk, nb = item % nblk, k0 = 64 * kb, n0 = 32 * nb;
    f32x4 wv[8];
#pragma unroll
    for (int i = 0; i < 8; ++i) wv[i] = *(const f32x4*)(W + (size_t)(k0 + 8 * i + (lane >> 3)) * N + n0 + 4 * (lane & 7));
#pragma unroll
    for (int i = 0; i < 8; ++i) { LAS float* d = scr + (8 * i + (lane >> 3)) * 33 + 4 * (lane & 7); d[0] = wv[i][0]; d[1] = wv[i][1]; d[2] = wv[i][2]; d[3] = wv[i][3]; }
    LDS_WAIT(); asm volatile("" ::: "memory");
    const int c = lane & 7;
#pragma unroll
    for (int j = 0; j < 4; ++j) { const int n = (lane >> 3) + 8 * j; const LAS float* s = scr + (8 * c) * 33 + n;
        int drow; float sc; tmap(tm, n0 + n, drow, sc);
        u32x4 o; o.x = pk2(s[0 * 33] * sc, s[1 * 33] * sc); o.y = pk2(s[2 * 33] * sc, s[3 * 33] * sc); o.z = pk2(s[4 * 33] * sc, s[5 * 33] * sc); o.w = pk2(s[6 * 33] * sc, s[7 * 33] * sc);
        *(u32x4*)(WT + (size_t)drow * tm.ldw + tm.col_off + k0 + 8 * c) = o; }
    LDS_WAIT(); asm volatile("" ::: "memory");
}

__device__ __forceinline__ f32x4 mod_load(const float* MODPp, const float* ada_b, int l, int midx, int off) {
    f32x4 s = *(const f32x4*)(ada_b + l * 3072 + off);
#pragma unroll
    for (int kq = 0; kq < 4; ++kq) s += *(const f32x4*)(MODPp + ((size_t)((kq * 4 + l) * 9 + midx)) * 3072 + off);
    return s;
}
__device__ __forceinline__ void ada_item(int it, const float* cvec, const float* cctx, const float* ada_w, float* modp, LAS unsigned char* lds, int tid, int lane, int wave) {
    LAS float* red = (LAS float*)lds;
    const int l = it / 48, rem = it % 48, cc = rem >> 2, kq = rem & 3, k0 = kq * 256 + wave * 32;
    float sv[9];
#pragma unroll
    for (int j = 0; j < 9; ++j) { const float c = (j < 8) ? cvec[j * 1024 + k0 + (lane & 31)] : cctx[k0 + (lane & 31)]; sv[j] = c / (1.f + expf(-c)); }
    f32x4 acc[9];
#pragma unroll
    for (int j = 0; j < 9; ++j) acc[j] = (f32x4){0.f, 0.f, 0.f, 0.f};
    const float* wp = ada_w + ((size_t)l * 1024 + k0) * 3072 + cc * 256 + 4 * lane;
    f32x4 wv[32];
#pragma unroll
    for (int kk = 0; kk < 32; ++kk) wv[kk] = *(const f32x4*)(wp + (size_t)kk * 3072);
    asm volatile("" ::: "memory");
#pragma unroll
    for (int kk = 0; kk < 32; ++kk) {
#pragma unroll
        for (int j = 0; j < 9; ++j) { const float sc = __int_as_float(__builtin_amdgcn_readlane(__float_as_int(sv[j]), kk)); acc[j] += wv[kk] * sc; }
    }
#pragma unroll
    for (int j = 0; j < 9; ++j) *(LAS f32x4*)(red + (wave * 9 + j) * 256 + 4 * lane) = acc[j];
    __syncthreads();
    for (int idx = tid; idx < 9 * 256; idx += NWAVES * 64) { const int j = idx >> 8, col = idx & 255; float sm = 0.f;
#pragma unroll
        for (int w = 0; w < 8; ++w) sm += red[(w * 9 + j) * 256 + col];
        modp[((size_t)((kq * 4 + l) * 9 + j)) * 3072 + cc * 256 + col] = sm; }
    __syncthreads();
}
constexpr int CI1 = 1104, CI2 = 144, CI3 = 128, CI4 = 1024, CI5 = 512, CI6 = 1280, CI7 = 512, CIMLA = CI1 + CI2 + CI3 + CI4 + CI5, CISWA = CI6 + CI7;
__device__ __forceinline__ void conv_item(int r, int i, unsigned char* ws, LAS float* scr, int lane) {
    unsigned char* wm = ws + (i ? WS_W_MLA1 : WS_W_MLA0); unsigned char* wsw = ws + (i ? WS_W_SWA1 : WS_W_SWA0);
    if (r < CI1) { const int nb = r % 69; if (nb >= 37 && nb < 53) return;
        TMap tm{1, 0, 0, 1024, nullptr, 1.f}; transpose_item(ARG_IN(12) + (size_t)i * 1024 * 2208, 1024, 2208, (bf16*)wm, tm, scr, r, lane); return; } r -= CI1;
    if (r < CI2) { TMap tm{2, 0, 0, 384, nullptr, MLA_SC}; transpose_item(ARG_IN(15) + (size_t)i * 384 * 768, 384, 768, (bf16*)(wm + SZ_WIN_MLA), tm, scr, r, lane); return; } r -= CI2;
    if (r < CI3) { TMap tm{3, 0, 0, 256, nullptr, 1.f}; transpose_item(ARG_IN(16) + (size_t)i * 256 * 1024, 256, 1024, (bf16*)(wm + SZ_WIN_MLA + SZ_WUQ), tm, scr, r, lane); return; } r -= CI3;
    if (r < CI4) {
        const int g = r >> 8, kb = (r >> 4) & 15, eb = r & 15, k = kb * 64 + lane;
        const float* wi = ARG_IN(12) + (size_t)i * 1024 * 2208 + (size_t)k * 2208 + 1184 + g * 128;
        const float* wp = ARG_IN(17) + ((size_t)i * 4 + g) * 128 * 128 + eb * 8; const float* sp = ARG_IN(18) + i * 512 + g * 128 + eb * 8;
#pragma unroll
        for (int q = 0; q < 4; ++q) { const int c = 32 * q + (lane >> 1); *(LAS f32x4*)(scr + c * 8 + 4 * (lane & 1)) = *(const f32x4*)(wp + (size_t)c * 128 + 4 * (lane & 1)); }
        LDS_WAIT(); asm volatile("" ::: "memory");
        float acc[8];
#pragma unroll
        for (int e = 0; e < 8; ++e) acc[e] = 0.f;
#pragma nounroll
        for (int hc = 0; hc < 2; ++hc) {
            f32x4 arow[16];
#pragma unroll
            for (int q = 0; q < 16; ++q) arow[q] = *(const f32x4*)(wi + 64 * hc + 4 * q);
            const LAS float* sw = scr + 64 * hc * 8;
#pragma unroll
            for (int q = 0; q < 16; ++q) {
#pragma unroll
                for (int cc = 0; cc < 4; ++cc) { const float a = arow[q][cc];
                    const f32x4 w0 = *(const LAS f32x4*)(sw + (4 * q + cc) * 8), w1 = *(const LAS f32x4*)(sw + (4 * q + cc) * 8 + 4);
                    acc[0] += a * w0[0]; acc[1] += a * w0[1]; acc[2] += a * w0[2]; acc[3] += a * w0[3]; acc[4] += a * w1[0]; acc[5] += a * w1[1]; acc[6] += a * w1[2]; acc[7] += a * w1[3]; } }
        }
        bf16* dst = (bf16*)wm + (size_t)(1280 + g * 128 + eb * 8) * 1024 + k;
#pragma unroll
        for (int e = 0; e < 8; ++e) dst[(size_t)e * 1024] = (bf16)f2bf(acc[e] * sp[e]);
        LDS_WAIT(); asm volatile("" ::: "memory");
        return; } r -= CI4;
    if (r < CI5) { TMap tm{0, 0, 0, 1024, nullptr, 1.f}; transpose_item(ARG_IN(19) + (size_t)i * 1024 * 1024, 1024, 1024, (bf16*)(wm + SZ_WIN_MLA + SZ_WUQ + SZ_WUKV + SZ_WPOOL), tm, scr, r, lane); return; } r -= CI5;
    if (r < CI6) { TMap tm{5, 0, 0, 1024, nullptr, SWA_SC}; transpose_item(ARG_IN(20) + (size_t)i * 1024 * 2560, 1024, 2560, (bf16*)wsw, tm, scr, r, lane); return; } r -= CI6;
    { TMap tm{0, 0, 0, 1024, nullptr, 1.f}; transpose_item(ARG_IN(22) + (size_t)i * 1024 * 1024, 1024, 1024, (bf16*)(wsw + SZ_WIN_SWA), tm, scr, r, lane); }
}
__device__ __forceinline__ int mod_index(int row) { return row < RP ? 8 : ((row - RP) >> 11); }

__global__ void __launch_bounds__(NWAVES * 64, 2) fwd_kernel(Args args) {
    extern __shared__ __attribute__((aligned(16))) unsigned char lds_raw[];
    LAS unsigned char* lds = (LAS unsigned char*)lds_raw;
    volatile LAS unsigned* MISC = (volatile LAS unsigned*)(lds + MISC_OFF);
    const int G = gridDim.x; const int bx = blockIdx.x; const int vcu = (G % 8 == 0) ? (bx % 8) * (G / 8) + bx / 8 : bx;
    const int NGW = G * NWAVES;
    { const int tid0 = threadIdx.x; for (int u = tid0; u < (LDS_BYTES - RING_BYTES) / 4; u += NWAVES * 64) ((LAS unsigned*)(lds + RING_BYTES))[u] = 0u; }
    __syncthreads();
    XcdBarrier bar; bar.bar = (unsigned*)((unsigned char*)arg_ptr(24) + WS_CTL) + 1024; bar.x = 0; bar.st = nullptr;
    if (!MK_PER_PHASE) bar = xcd_barrier_post(bar.bar, MISC + 8);
    const int lo = MK_PER_PHASE ? args.ph_lo : 0, hi = MK_PER_PHASE ? args.ph_hi : N_PHASES;
    int pid = 0;
#define IN_PH() (lo <= pid && pid < hi)
#define END_PH() do { if (!MK_PER_PHASE && lo <= pid && pid + 1 < hi) xcd_barrier(bar); ++pid; } while (0)
#define PH_BEGIN() unsigned char* const ws = (unsigned char*)arg_ptr(24); float* const out = (float*)arg_ptr(23); \
    const int tid = opaque_tid(), lane = tid & 63, wave = __builtin_amdgcn_readfirstlane(tid >> 6), gw = vcu * NWAVES + wave; (void)out; (void)lane; (void)gw; (void)ws
#define MOD ((float*)(ws + WS_MOD))
#define ROPE8 ((float*)(ws + WS_ROPE8))
#define ROPE16 ((float*)(ws + WS_ROPE16))
#define MODP ((float*)(ws + WS_MODP))
#define Hb ((bf16*)(ws + WS_H))
#define GAB ((bf16*)(ws + WS_GAB))
#define CQ ((bf16*)(ws + WS_CQ))
#define CKV ((bf16*)(ws + WS_CKV))
#define KRB ((bf16*)(ws + WS_KRB))
#define KRF ((float*)(ws + WS_KRF))
#define KN ((bf16*)(ws + WS_KN))
#define VP ((bf16*)(ws + WS_KN))
#define VV ((bf16*)(ws + WS_V))
#define PO ((bf16*)(ws + WS_PO))
#define SQ ((bf16*)(ws + WS_CQ))
#define SK ((bf16*)(ws + WS_SK))
#define SV ((bf16*)(ws + WS_SV))

    if (IN_PH()) { PH_BEGIN();
        { const float* cvec = ARG_IN(6); const float* cctx = ARG_IN(7); const float* ada_w = ARG_IN(8);
          for (int it = bx; it < 48; it += G) ada_item(it, cvec, cctx, ada_w, MODP, lds, tid, lane, wave); }
        for (int e = bx * 512 + tid; e < 64 * 8 + 64 * 16; e += G * 512) {
            if (e < 512) { const int pos = e >> 3, i = e & 7; const float inv = powf(10000.f, -(float)i / 8.f), a = (float)pos * inv; ROPE8[2 * e] = cosf(a); ROPE8[2 * e + 1] = sinf(a); }
            else { const int f = e - 512, pos = f >> 4, i = f & 15; const float inv = powf(10000.f, -(float)i / 16.f), a = (float)pos * inv; ROPE16[2 * f] = cosf(a); ROPE16[2 * f + 1] = sinf(a); }
        }
        LAS float* scr = (LAS float*)(lds + wave * 16384);
        for (int it = gw; it < CIMLA; it += NGW) if (!(it >= CI1 + CI2 + CI3 && it < CI1 + CI2 + CI3 + CI4)) conv_item(it, 0, ws, scr, lane);
        const u32x4 z = {0u, 0u, 0u, 0u};
        for (int e = bx * 512 + tid; e < 2 * 96 * 128; e += G * 512) { const int i = e / (96 * 128), f = e % (96 * 128);
            *(u32x4*)(ws + (i ? WS_W_MLA1 : WS_W_MLA0) + (size_t)672 * 2048 + (size_t)f * 16) = z; }
    }
    END_PH();

    if (IN_PH()) { PH_BEGIN();
        const float* npre = ARG_IN(10); const float* xin0 = ARG_IN(0); const float* xin1 = ARG_IN(1); const float* adab = ARG_IN(9);
        {
            const float* npost0 = ARG_IN(11);
            for (int it = bx; it < 9; it += G) { const int l = 0, j = it;
                for (int c = tid * 4; c < 1024; c += NWAVES * 64 * 4) { float* cf = MOD + (size_t)(l * 9 + j) * 3072;
                    *(f32x4*)(cf + c) = mod_load(MODP, adab, l, j, 2048 + c) * *(const f32x4*)(npost0 + l * 1024 + c);
                    *(f32x4*)(cf + 1024 + c) = *(const f32x4*)(npre + l * 1024 + c) * (mod_load(MODP, adab, l, j, 1024 + c) + 1.f);
                    *(f32x4*)(cf + 2048 + c) = mod_load(MODP, adab, l, j, c); } }
        }
        {
            LAS float* scr = (LAS float*)(lds + wave * 16384);
            for (int it = gw; it < 2 * CI4; it += NGW) conv_item(CI1 + CI2 + CI3 + (it & (CI4 - 1)), it >= CI4 ? 1 : 0, ws, scr, lane);
        }
        for (int chunk = gw; chunk < R / 12; chunk += NGW) {
            int curm = -1; f32x4 cB[4], cC[4];
#pragma unroll
            for (int j = 0; j < 4; ++j) { cB[j] = (f32x4){0.f, 0.f, 0.f, 0.f}; cC[j] = cB[j]; }
            for (int rr = 0; rr < 12; rr += 2) {
                f32x4 v[2][4];
#pragma unroll
                for (int q = 0; q < 2; ++q) { const int row = chunk * 12 + rr + q; const float* xr = row < RP ? xin0 + (size_t)row * D : xin1 + (size_t)(row - RP) * D;
#pragma unroll
                    for (int j = 0; j < 4; ++j) v[q][j] = *(const f32x4*)(xr + 8 * lane + 512 * (j >> 1) + 4 * (j & 1)); }
#pragma unroll
                for (int q = 0; q < 2; ++q) { const int row = chunk * 12 + rr + q, midx = mod_index(row);
                    if (midx != curm) { curm = midx;
#pragma unroll
                        for (int j = 0; j < 4; ++j) { const int c = 8 * lane + 512 * (j >> 1) + 4 * (j & 1); const f32x4 g = *(const f32x4*)(npre + c), sc = mod_load(MODP, adab, 0, midx, 1024 + c); cB[j] = g * (sc + 1.f); cC[j] = mod_load(MODP, adab, 0, midx, c); } }
                    float ss = 0.f;
#pragma unroll
                    for (int j = 0; j < 4; ++j) ss += v[q][j][0] * v[q][j][0] + v[q][j][1] * v[q][j][1] + v[q][j][2] * v[q][j][2] + v[q][j][3] * v[q][j][3];
                    const float rstd = 1.f / sqrtf(wave_sum(ss) * (1.f / D) + EPS);
#pragma unroll
                    for (int j2 = 0; j2 < 2; ++j2) { const f32x4 ha = v[q][2 * j2] * rstd * cB[2 * j2] + cC[2 * j2], hc = v[q][2 * j2 + 1] * rstd * cB[2 * j2 + 1] + cC[2 * j2 + 1];
                        u32x4 w; w.x = pk2(ha[0], ha[1]); w.y = pk2(ha[2], ha[3]); w.z = pk2(hc[0], hc[1]); w.w = pk2(hc[2], hc[3]); *(u32x4*)(Hb + (size_t)row * D + 8 * lane + 512 * j2) = w; }
                }
            }
        }
    }
    END_PH();

    for (int l = 0; l < NL; ++l) {
        const int i = l >> 1;
        if ((l & 1) == 0) {
#define WM_BASE (ws + (i ? WS_W_MLA1 : WS_W_MLA0))
#define M_WinT ((const bf16*)WM_BASE)
#define M_WuqT ((const bf16*)(WM_BASE + SZ_WIN_MLA))
#define M_WukvT ((const bf16*)(WM_BASE + SZ_WIN_MLA + SZ_WUQ))
#define M_WpT ((const bf16*)(WM_BASE + SZ_WIN_MLA + SZ_WUQ + SZ_WUKV))
#define M_WoT ((const bf16*)(WM_BASE + SZ_WIN_MLA + SZ_WUQ + SZ_WUKV + SZ_WPOOL))
            if (IN_PH()) { PH_BEGIN();
                pg8::Gemm g{Hb, M_WinT, R, 2304, 1024, 1024}; pg8::StaticOrder S; S.init(R, 2304, G, bx);
                pg8::EpiMlaIn E{CQ, CKV, GAB, VP, KRF};
                pg8::gemm_phase<pg8::EpiMlaIn, true>(lds, g, S, E);
                if (l == 0) {
                    const float* cvec = ARG_IN(6); const float* cctx = ARG_IN(7); const float* ada_w = ARG_IN(8);
                    unsigned* qt = (unsigned*)(ws + WS_CTL) + CW_QH + 64; LAS float* scr = (LAS float*)(lds + wave * 16384);
                    constexpr int NCH_SWA = (CISWA + 7) / 8;
                    for (;;) {
                        __syncthreads();
                        if (tid == 0) MISC[0] = __hip_atomic_fetch_add(qt, 1u, __ATOMIC_RELAXED, __HIP_MEMORY_SCOPE_AGENT);
                        __syncthreads();
                        const int item = (int)MISC[0];
                        if (item >= 144 + 2 * NCH_SWA) break;
                        if (item < 144) ada_item(48 + item, cvec, cctx, ada_w, MODP, lds, tid, lane, wave);
                        else { const int c2 = item - 144, inst = c2 >= NCH_SWA ? 1 : 0, r2 = (c2 - inst * NCH_SWA) * 8 + wave; if (r2 < CISWA) conv_item(CIMLA + r2, inst, ws, scr, lane); }
                    }
                }
            }
            END_PH();
            if (IN_PH()) { PH_BEGIN();
                const float* gq = ARG_IN(13) + i * 384; const float* gkv = ARG_IN(14) + i * 256;
                const float* cckv = ARG_IN(2); const float* ckr = ARG_IN(3);
                if (l == 0) {
                    const float* npost0 = ARG_IN(11); const float* npre0 = ARG_IN(10); const float* adab = ARG_IN(9);
                    for (int it = bx; it < 27; it += G) { const int l2 = 1 + it / 9, j = it % 9;
                        for (int c = tid * 4; c < 1024; c += NWAVES * 64 * 4) { float* cf = MOD + (size_t)(l2 * 9 + j) * 3072;
                            *(f32x4*)(cf + c) = mod_load(MODP, adab, l2, j, 2048 + c) * *(const f32x4*)(npost0 + l2 * 1024 + c);
                            *(f32x4*)(cf + 1024 + c) = *(const f32x4*)(npre0 + l2 * 1024 + c) * (mod_load(MODP, adab, l2, j, 1024 + c) + 1.f);
                            *(f32x4*)(cf + 2048 + c) = mod_load(MODP, adab, l2, j, c); } }
                }
                const int half = 1 << (lane >> 4);
                float pm[16];
#pragma unroll
                for (int k = 0; k < 16; ++k) pm[k] = (k - 8 >= -half && k - 8 < half) ? 1.f : 0.f;
                f32x4 gq0 = {0.f, 0.f, 0.f, 0.f}, gq1 = gq0, gk0 = gq0, gk1 = gq0;
                if (lane < 48) { gq0 = *(const f32x4*)(gq + 8 * lane); gq1 = *(const f32x4*)(gq + 8 * lane + 4); }
                if (lane < 32) { gk0 = *(const f32x4*)(gkv + 8 * lane); gk1 = *(const f32x4*)(gkv + 8 * lane + 4); }
                for (int chunk = gw; chunk < R / 12; chunk += NGW) {
                    const int r0 = chunk * 12;
                    const int xl = r0 + 18; const int Bs = xl < RP ? (xl & ~255) : (xl >= R ? R : RP + ((xl - RP) & ~2047)); const bool hasB = Bs > r0 - 8;
                    u32x4 win[27];
#pragma unroll
                    for (int k = 0; k < 27; ++k) { int x = r0 - 8 + k; x = x < 0 ? 0 : (x >= R ? R - 1 : x); win[k] = *(const u32x4*)(VP + (size_t)x * 512 + 8 * lane); }
                    {
#pragma unroll
                        for (int hb = 0; hb < 2; ++hb) {
                            u32x4 wq[6], wk[6]; float kr[6];
#pragma unroll
                            for (int q = 0; q < 6; ++q) { const int row = r0 + 6 * hb + q; const bool prompt = row < RP; const int rk = prompt ? row : RP + ((row - RP) >> 11) * 2304 + ((row - RP) & 2047);
                                wq[q] = (u32x4){0u, 0u, 0u, 0u}; wk[q] = wq[q]; kr[q] = 0.f;
                                if (lane < 48) wq[q] = *(const u32x4*)(CQ + (size_t)row * 384 + 8 * lane);
                                if (lane < 32) { wk[q] = *(const u32x4*)(CKV + (size_t)rk * 256 + 8 * lane); kr[q] = KRF[(size_t)row * 32 + lane]; } }
#pragma unroll
                            for (int q = 0; q < 6; ++q) { const int row = r0 + 6 * hb + q; const bool prompt = row < RP; const int b = prompt ? row >> 8 : (row - RP) >> 11, t = prompt ? row & 255 : (row - RP) & 2047;
                                const int rk = prompt ? row : RP + b * 2304 + t;
                                { const u32x4 w = wq[q]; float v[8] = {bflo(w.x), bfhi(w.x), bflo(w.y), bfhi(w.y), bflo(w.z), bfhi(w.z), bflo(w.w), bfhi(w.w)}; float ss = 0.f;
#pragma unroll
                                  for (int e = 0; e < 8; ++e) ss += v[e] * v[e];
                                  const float rstd = 1.f / sqrtf(wave_sum(ss) * (1.f / 384.f) + EPS);
                                  if (lane < 48) { u32x4 o; o.x = pk2(v[0] * rstd * gq0[0], v[1] * rstd * gq0[1]); o.y = pk2(v[2] * rstd * gq0[2], v[3] * rstd * gq0[3]); o.z = pk2(v[4] * rstd * gq1[0], v[5] * rstd * gq1[1]); o.w = pk2(v[6] * rstd * gq1[2], v[7] * rstd * gq1[3]);
                                      *(u32x4*)(CQ + (size_t)row * 384 + 8 * lane) = o; } }
                                { const u32x4 w = wk[q]; float v[8] = {bflo(w.x), bfhi(w.x), bflo(w.y), bfhi(w.y), bflo(w.z), bfhi(w.z), bflo(w.w), bfhi(w.w)}; float ss = 0.f;
#pragma unroll
                                  for (int e = 0; e < 8; ++e) ss += v[e] * v[e];
                                  const float rstd = 1.f / sqrtf(wave_sum(ss) * (1.f / 256.f) + EPS);
                                  if (lane < 32) { const f32x4 y0 = {v[0] * rstd * gk0[0], v[1] * rstd * gk0[1], v[2] * rstd * gk0[2], v[3] * rstd * gk0[3]}, y1 = {v[4] * rstd * gk1[0], v[5] * rstd * gk1[1], v[6] * rstd * gk1[2], v[7] * rstd * gk1[3]};
                                      u32x4 o; o.x = pk2(y0[0], y0[1]); o.y = pk2(y0[2], y0[3]); o.z = pk2(y1[0], y1[1]); o.w = pk2(y1[2], y1[3]);
                                      *(u32x4*)(CKV + (size_t)rk * 256 + 8 * lane) = o;
                                      if (prompt) { float* st = out + OFF_CKV + ((size_t)(b * 2 + i) * 256 + t) * 256 + 8 * lane; *(f32x4*)st = y0; *(f32x4*)(st + 4) = y1; } } }
                                { const float kv = kr[q];
                                  const float pr = __int_as_float(__builtin_amdgcn_update_dpp(0, __float_as_int(kv), 0x128, 0xf, 0xf, true));
                                  if (lane < 32) { if (prompt) out[OFF_KR + ((size_t)(b * 2 + i) * 256 + t) * 32 + lane] = kv;
                                      const int part = lane >> 4, fi = lane & 7; const bool isx2 = (lane & 8) != 0; const float x1 = isx2 ? pr : kv, x2 = isx2 ? kv : pr;
                                      float o1 = x1, o2 = x2;
                                      if (!prompt) { const int pos = part ? (t & 63) : (t >> 6); const float cs = ROPE8[(pos * 8 + fi) * 2], sn = ROPE8[(pos * 8 + fi) * 2 + 1]; o1 = x1 * cs - x2 * sn; o2 = x1 * sn + x2 * cs; }
                                      KRB[(size_t)rk * 32 + (isx2 ? 16 : 0) + part * 8 + fi] = (bf16)f2bf(isx2 ? o2 : o1); } }
                            }
                            asm volatile("" ::: "memory");
                        }
                    }
#pragma unroll
                    for (int ri = 0; ri < 12; ++ri) {
                        const bool sideR = (r0 + ri) >= Bs;
                        float sA[8]; float cntf = 0.f;
#pragma unroll
                        for (int e = 0; e < 8; ++e) sA[e] = 0.f;
#pragma unroll
                        for (int k = 0; k < 16; ++k) { const int x = r0 + ri + k - 8; const bool valid = !hasB || ((x >= Bs) == sideR); const float m = valid ? pm[k] : 0.f; const u32x4 w = win[ri + k]; cntf += m;
                            sA[0] += bflo(w.x) * m; sA[1] += bfhi(w.x) * m; sA[2] += bflo(w.y) * m; sA[3] += bfhi(w.y) * m;
                            sA[4] += bflo(w.z) * m; sA[5] += bfhi(w.z) * m; sA[6] += bflo(w.w) * m; sA[7] += bfhi(w.w) * m; }
                        const float ic = 1.f / cntf; const u32x4 w = win[ri + 8];
                        bf16* gp = GAB + (size_t)(r0 + ri) * 1024 + 512 + 8 * lane; const u32x4 gg = *(const u32x4*)gp;
                        u32x4 o; o.x = pk2((sA[0] * ic - bflo(w.x)) * bflo(gg.x), (sA[1] * ic - bfhi(w.x)) * bfhi(gg.x)); o.y = pk2((sA[2] * ic - bflo(w.y)) * bflo(gg.y), (sA[3] * ic - bfhi(w.y)) * bfhi(gg.y));
                        o.z = pk2((sA[4] * ic - bflo(w.z)) * bflo(gg.z), (sA[5] * ic - bfhi(w.z)) * bfhi(gg.z)); o.w = pk2((sA[6] * ic - bflo(w.w)) * bflo(gg.w), (sA[7] * ic - bfhi(w.w)) * bfhi(gg.w));
                        *(u32x4*)gp = o;
                    }
                }
                for (int ci = gw; ci < 2048; ci += NGW) {
                    const int b = ci >> 8, p = ci & 255, rk = RP + b * 2304 + 2048 + p;
                    if (lane < 32) { const float* sp = cckv + ((size_t)(b * 2 + i) * 256 + p) * 256 + 8 * lane; const f32x4 y0 = *(const f32x4*)sp, y1 = *(const f32x4*)(sp + 4);
                        u32x4 o; o.x = pk2(y0[0], y0[1]); o.y = pk2(y0[2], y0[3]); o.z = pk2(y1[0], y1[1]); o.w = pk2(y1[2], y1[3]); *(u32x4*)(CKV + (size_t)rk * 256 + 8 * lane) = o; }
                    if (lane < 16) { const int part = lane >> 3, fi = lane & 7; const float* sp = ckr + ((size_t)(b * 2 + i) * 256 + p) * 32 + part * 16 + fi;
                        KRB[(size_t)rk * 32 + lane] = (bf16)f2bf(sp[0]); KRB[(size_t)rk * 32 + 16 + lane] = (bf16)f2bf(sp[8]); }
                }
            }
            END_PH();
            if (IN_PH()) { PH_BEGIN();
                { pg8::Gemm g{CQ, M_WuqT, R, 768, 384, 384}; pg8::StaticOrder S; S.init(R, 768, G, bx); pg8::EpiQ E{Hb, ROPE8}; pg8::gemm_phase<pg8::EpiQ, true>(lds, g, S, E); }
                if (bx >= 32) { pg8::Gemm g{CKV, M_WukvT, RK, 1024, 256, 256}; pg8::StaticOrder S; S.init(RK, 1024, G - 32, bx - 32); pg8::EpiBf16 E{KN, 512, 512, (size_t)(WS_V - WS_KN) / 2}; pg8::gemm_phase<pg8::EpiBf16, true>(lds, g, S, E); }
            }
            END_PH();
            if (IN_PH()) { PH_BEGIN();
                struct MlaMk { bf16 *hb, *kn, *vv, *gab, *krb; int wave;
                    __device__ __forceinline__ void operator()(int un, att::Desc& d) const {
                        d.n_b = 0; d.row_b = 0; d.key_b = 0; d.qpos = 0; d.sink2 = 0.f; d.has_sink = 0; d.k1 = krb;
                        int h, qrow, krow;
                        if (un < 512) { const int b = un >> 6, qb = un & 7; h = (un >> 3) & 7; qrow = RP + b * 2048 + qb * 256 + wave * 32; krow = RP + b * 2304; d.n_a = 36; }
                        else { const int v = un - 512, b = v >> 3; h = v & 7; qrow = b * 256 + wave * 32; krow = b * 256; d.n_a = 4; }
                        d.row_a = krow; d.qptr = hb + (size_t)qrow * 768 + h * 96; d.k0 = kn + h * 64; d.v = vv + h * 64; d.optr = gab + (size_t)qrow * 1024 + h * 64; } };
                const MlaMk mk{Hb, KN, VV, GAB, KRB, wave};
                att::attn_phase<0, MlaMk>((LAS char*)lds, mk, vcu, G, 768);
            }
            END_PH();
        } else {
#define WS_BASE (ws + (i ? WS_W_SWA1 : WS_W_SWA0))
#define S_WinT ((const bf16*)WS_BASE)
#define S_WoT ((const bf16*)(WS_BASE + SZ_WIN_SWA))
            if (IN_PH()) { PH_BEGIN();
                const float* ck = ARG_IN(4); const float* cv = ARG_IN(5);
                for (int e = bx * 512 + tid; e < 2 * 2048 * 32; e += G * 512) {
                    const int which = e / (2048 * 32), f = e % (2048 * 32), rowi = f >> 5, ch = f & 31, b = rowi >> 8, p = rowi & 255;
                    const float* s = (which ? cv : ck) + ((size_t)(b * 2 + i) * 256 + p) * 256 + 8 * ch; const f32x4 y0 = *(const f32x4*)s, y1 = *(const f32x4*)(s + 4);
                    u32x4 o; o.x = pk2(y0[0], y0[1]); o.y = pk2(y0[2], y0[3]); o.z = pk2(y1[0], y1[1]); o.w = pk2(y1[2], y1[3]);
                    *(u32x4*)((which ? SV : SK) + (size_t)(RP + b * 2304 + 2048 + p) * 256 + 8 * ch) = o;
                }
                pg8::Gemm g{Hb, S_WinT, R, 2560, 1024, 1024}; pg8::StaticOrder S; S.init(R, 2560, G, bx);
                pg8::EpiSwaIn E{SQ, SK, SV, GAB, out + OFF_K + (size_t)i * 65536, out + OFF_V + (size_t)i * 65536, ROPE16};
                pg8::gemm_phase<pg8::EpiSwaIn, true>(lds, g, S, E);
                if (l == 1) {
                    unsigned* qt = (unsigned*)(ws + WS_CTL) + CW_QH + 80; LAS float* scr = (LAS float*)(lds + wave * 16384);
                    constexpr int NCH_MLA = (CIMLA + 7) / 8;
                    for (;;) {
                        __syncthreads();
                        if (tid == 0) MISC[0] = __hip_atomic_fetch_add(qt, 1u, __ATOMIC_RELAXED, __HIP_MEMORY_SCOPE_AGENT);
                        __syncthreads();
                        const int item = (int)MISC[0];
                        if (item >= NCH_MLA) break;
                        const int r2 = item * 8 + wave; if (r2 < CIMLA && !(r2 >= CI1 + CI2 + CI3 && r2 < CI1 + CI2 + CI3 + CI4)) conv_item(r2, 1, ws, scr, lane);
                    }
                }
            }
            END_PH();
            if (IN_PH()) { PH_BEGIN();
                struct SwaMk { bf16 *sq, *sk, *sv, *gab; const float* sink; int wave, lane;
                    __device__ __forceinline__ void operator()(int un, att::Desc& d) const {
                        d.k1 = nullptr; d.has_sink = 1; d.n_a = 4;
                        int kvh, qrow, q0;
                        if (un < 1024) { const int b = un >> 7, blk = un & 31; kvh = (un >> 5) & 3; q0 = blk * 64; const int kb = RP + b * 2304;
                            qrow = RP + b * 2048 + q0 + (wave & 1) * 32; d.row_a = kb + 2048;
                            const int kfirst = q0 - 128 > 0 ? q0 - 128 : 0, klast = q0 + 128 < 2048 - 64 ? q0 + 128 : 2048 - 64;
                            d.key_b = kfirst; d.row_b = kb + kfirst; d.n_b = (klast - kfirst) / 64 + 1; }
                        else { const int v = un - 1024, b = v >> 4, blk = v & 3; kvh = (v >> 2) & 3; q0 = blk * 64; qrow = b * 256 + q0 + (wave & 1) * 32; d.row_a = b * 256; d.n_b = 0; d.row_b = 0; d.key_b = 0; }
                        const int head = kvh * 4 + (wave >> 1);
                        d.qpos = q0 + (wave & 1) * 32 + (lane & 31); d.sink2 = sink[head] * LOG2E;
                        d.qptr = sq + (size_t)qrow * 1024 + head * 64; d.k0 = sk + kvh * 64; d.v = sv + kvh * 64; d.optr = gab + (size_t)qrow * 1024 + head * 64; } };
                const SwaMk mk{SQ, SK, SV, GAB, ARG_IN(21) + i * 16, wave, lane};
                att::attn_phase<1, SwaMk>((LAS char*)lds, mk, vcu, G, 1536);
            }
            END_PH();
        }
        if (IN_PH()) { PH_BEGIN();
            unsigned* ctlw = (unsigned*)(ws + WS_CTL); unsigned* cnt = ctlw + CW_CNT + l * 2048; unsigned* qh = ctlw + CW_QH + l * 16; unsigned* tmo = ctlw + CW_TMO;
            {
                const bf16* WoT = (l & 1) ? (const bf16*)(ws + (i ? WS_W_SWA1 : WS_W_SWA0) + SZ_WIN_SWA) : (const bf16*)(ws + (i ? WS_W_MLA1 : WS_W_MLA0) + SZ_WIN_MLA + SZ_WUQ + SZ_WUKV + SZ_WPOOL);
                pg8::Gemm g{GAB, WoT, R, 1024, 1024, 1024}; pg8::PanelOrder S{G, vcu, 384}; pg8::EpiOutPub E{Hb, cnt};
                pg8::gemm_phase<pg8::EpiOutPub, true, pg8::PanelOrder>(lds, g, S, E);
            }
            const float* xin0 = ARG_IN(0); const float* xin1 = ARG_IN(1); const bool has_next = l + 1 < NL;
            const int panel = vcu >= 128 ? (vcu - 128) >> 1 : 64 + (vcu >> 2);
            const int rbase = vcu >= 128 ? panel * 256 + ((vcu - 128) & 1) * 128 : panel * 256 + (vcu & 3) * 64;
            const int nrw = vcu >= 128 ? 16 : 8;
#define WAIT_PANEL() do { if (wave == 0) { unsigned sp = 0; \
                while (__hip_atomic_load(cnt + 16 * panel, __ATOMIC_RELAXED, __HIP_MEMORY_SCOPE_AGENT) < 32u) { __builtin_amdgcn_s_sleep(2); \
                    if ((++sp & 1023u) == 0u) { if (__hip_atomic_load(tmo, __ATOMIC_RELAXED, __HIP_MEMORY_SCOPE_AGENT) || sp > (1u << 22)) { __hip_atomic_store(tmo, 1u, __ATOMIC_RELAXED, __HIP_MEMORY_SCOPE_AGENT); break; } } } \
                __builtin_amdgcn_fence(__ATOMIC_ACQUIRE, "agent"); asm volatile("s_waitcnt vmcnt(0)" ::: "memory"); } \
            __syncthreads(); } while (0)
            {
                const int row0 = rbase + wave * nrw, midx = mod_index(row0); const int ln = has_next ? l + 1 : l;
                const float* cf = MOD + (size_t)(l * 9 + midx) * 3072; const float* cfn = MOD + (size_t)(ln * 9 + midx) * 3072;
                f32x4 cA[4], cB[4], cC[4];
#pragma unroll
                for (int k = 0; k < 4; ++k) { const int c = 8 * lane + 512 * (k >> 1) + 4 * (k & 1); cA[k] = *(const f32x4*)(cf + c); cB[k] = *(const f32x4*)(cfn + 1024 + c); cC[k] = *(const f32x4*)(cfn + 2048 + c); }
#define FINAL_ROW(row, xv, ov) do { float ss = 0.f; \
                    _Pragma("unroll") for (int k = 0; k < 4; ++k) ss += ov[k][0] * ov[k][0] + ov[k][1] * ov[k][1] + ov[k][2] * ov[k][2] + ov[k][3] * ov[k][3]; \
                    const float rstd = 1.f / sqrtf(wave_sum(ss) * (1.f / D) + EPS); float s2 = 0.f; \
                    _Pragma("unroll") for (int k = 0; k < 4; ++k) { xv[k] = xv[k] + ov[k] * rstd * cA[k]; s2 += xv[k][0] * xv[k][0] + xv[k][1] * xv[k][1] + xv[k][2] * xv[k][2] + xv[k][3] * xv[k][3]; } \
                    if (has_next) { const float r2 = 1.f / sqrtf(wave_sum(s2) * (1.f / D) + EPS); \
                        _Pragma("unroll") for (int j2 = 0; j2 < 2; ++j2) { const f32x4 xa = xv[2 * j2], xc = xv[2 * j2 + 1]; \
                            u32x4 wx; wx.x = pk2(xa[0], xa[1]); wx.y = pk2(xa[2], xa[3]); wx.z = pk2(xc[0], xc[1]); wx.w = pk2(xc[2], xc[3]); \
                            *(u32x4*)((bf16*)out + (size_t)(row) * 2048 + 8 * lane + 512 * j2) = wx; \
                            const f32x4 ha = xa * r2 * cB[2 * j2] + cC[2 * j2], hc = xc * r2 * cB[2 * j2 + 1] + cC[2 * j2 + 1]; \
                            u32x4 wh; wh.x = pk2(ha[0], ha[1]); wh.y = pk2(ha[2], ha[3]); wh.z = pk2(hc[0], hc[1]); wh.w = pk2(hc[2], hc[3]); \
                            *(u32x4*)(Hb + (size_t)(row) * D + 8 * lane + 512 * j2) = wh; } \
                    } else { _Pragma("unroll") for (int k = 0; k < 4; ++k) *(f32x4*)(out + (size_t)(row) * D + 8 * lane + 512 * (k >> 1) + 4 * (k & 1)) = xv[k]; } } while (0)
#define UNPK(W_, LO_, HI_) do { const u32x4 t_ = (W_); LO_ = (f32x4){bflo(t_.x), bfhi(t_.x), bflo(t_.y), bfhi(t_.y)}; HI_ = (f32x4){bflo(t_.z), bfhi(t_.z), bflo(t_.w), bfhi(t_.w)}; } while (0)
                if (l == 0) {
                    WAIT_PANEL();
                    for (int rr = 0; rr < nrw; rr += 4) {
                        f32x4 xq[4][4]; u32x4 oq[4][2];
#pragma unroll
                        for (int q = 0; q < 4; ++q) { const int row = row0 + rr + q; const float* xr = row < RP ? xin0 + (size_t)row * D : xin1 + (size_t)(row - RP) * D;
#pragma unroll
                            for (int k = 0; k < 4; ++k) xq[q][k] = *(const f32x4*)(xr + 8 * lane + 512 * (k >> 1) + 4 * (k & 1));
#pragma unroll
                            for (int j2 = 0; j2 < 2; ++j2) oq[q][j2] = *(const u32x4*)(Hb + (size_t)row * D + 8 * lane + 512 * j2); }
#pragma unroll
                        for (int q = 0; q < 4; ++q) { f32x4 ov[4]; UNPK(oq[q][0], ov[0], ov[1]); UNPK(oq[q][1], ov[2], ov[3]); FINAL_ROW(row0 + rr + q, xq[q], ov); }
                    }
                } else {
                    u32x4 xw[8][2], ow[8][2];
#pragma unroll
                    for (int q = 0; q < 8; ++q)
#pragma unroll
                        for (int j2 = 0; j2 < 2; ++j2) xw[q][j2] = *(const u32x4*)((const bf16*)out + (size_t)(row0 + q) * 2048 + 8 * lane + 512 * j2);
                    WAIT_PANEL();
                    for (int rr = 0; rr < nrw; rr += 8) {
                        if (rr > 0) {
#pragma unroll
                            for (int q = 0; q < 8; ++q)
#pragma unroll
                                for (int j2 = 0; j2 < 2; ++j2) xw[q][j2] = *(const u32x4*)((const bf16*)out + (size_t)(row0 + rr + q) * 2048 + 8 * lane + 512 * j2);
                        }
#pragma unroll
                        for (int q = 0; q < 8; ++q)
#pragma unroll
                            for (int j2 = 0; j2 < 2; ++j2) ow[q][j2] = *(const u32x4*)(Hb + (size_t)(row0 + rr + q) * D + 8 * lane + 512 * j2);
#pragma unroll
                        for (int q = 0; q < 8; ++q) { f32x4 xv[4], ov[4]; UNPK(xw[q][0], xv[0], xv[1]); UNPK(xw[q][1], xv[2], xv[3]); UNPK(ow[q][0], ov[0], ov[1]); UNPK(ow[q][1], ov[2], ov[3]); FINAL_ROW(row0 + rr + q, xv, ov); }
                    }
                }
#undef FINAL_ROW
#undef UNPK
#undef WAIT_PANEL
            }
        }
        END_PH();
    }
#undef IN_PH
#undef END_PH
}


extern "C" void kernel_launch(void* const* d_in, const int* in_sizes, int n_in, void* d_out, int out_size, void* d_ws, size_t ws_size, hipStream_t stream) {
    static int grid = 0;
    if (grid == 0) {
        if (n_in != 23 || out_size != OUT_TOTAL || ws_size < WS_END) { fprintf(stderr, "kernel_launch: unexpected shapes (n_in %d out %d ws %zu)\n", n_in, out_size, ws_size); grid = -1; return; }
        int dev = 0, cus = 0;
        if (hipGetDevice(&dev) != hipSuccess || hipDeviceGetAttribute(&cus, hipDeviceAttributeMultiprocessorCount, dev) != hipSuccess) { grid = -1; return; }
        if (hipFuncSetAttribute((const void*)fwd_kernel, hipFuncAttributeMaxDynamicSharedMemorySize, LDS_BYTES) != hipSuccess) { fprintf(stderr, "kernel_launch: hipFuncSetAttribute failed\n"); grid = -1; return; }
        int per_cu = 0;
        if (hipOccupancyMaxActiveBlocksPerMultiprocessor(&per_cu, (const void*)fwd_kernel, NWAVES * 64, LDS_BYTES) != hipSuccess || per_cu < 1) { fprintf(stderr, "kernel_launch: occupancy query says %d\n", per_cu); }
        (void)hipGetLastError();
        grid = cus;
    }
    if (grid < 0) return;
    (void)hipMemsetAsync((char*)d_ws + WS_CTL, 0, CTL_ZERO_BYTES, stream);
    Args a{};
    for (int i = 0; i < 23; ++i) a.in[i] = (const float*)d_in[i];
    a.out = (float*)d_out; a.ws = (unsigned char*)d_ws;
#if MK_PER_PHASE
    for (int p = 0; p < N_PHASES; ++p) { a.ph_lo = p; a.ph_hi = p + 1; hipLaunchKernelGGL(fwd_kernel, dim3(grid), dim3(NWAVES * 64), LDS_BYTES, stream, a); }
#else
    a.ph_lo = 0; a.ph_hi = N_PHASES;
    hipLaunchKernelGGL(fwd_kernel, dim3(grid), dim3(NWAVES * 64), LDS_BYTES, stream, a);
#endif
}
```

```cpp
#include <hip/hip_runtime.h>
#pragma clang diagnostic ignored "-Winline-asm"
#include <cstdio>
#include <cstdint>

#ifndef MK_PER_PHASE
#define MK_PER_PHASE 0
#endif

#define GAS __attribute__((address_space(1)))
#define LAS __attribute__((address_space(3)))
typedef unsigned short bf16;
typedef short bf16x8 __attribute__((ext_vector_type(8)));
typedef short s16x4 __attribute__((ext_vector_type(4)));
typedef float f32x4 __attribute__((ext_vector_type(4)));
typedef float f32x2 __attribute__((ext_vector_type(2)));
typedef float f32x16 __attribute__((ext_vector_type(16)));
typedef unsigned u32x4 __attribute__((ext_vector_type(4)));
typedef unsigned u32x2 __attribute__((ext_vector_type(2)));
typedef __bf16 bf16x2_t __attribute__((ext_vector_type(2)));

constexpr int D = 1024, RP = 8192, RS = 16384, R = RP + RS;
constexpr int RK = RP + 8 * 2304;
constexpr int NL = 4;
constexpr float EPS = 1e-6f, LOG2E = 1.4426950408889634f;
constexpr float MLA_SC = 0.10206207261596577f * LOG2E;
constexpr float SWA_SC = 0.125f * LOG2E;
constexpr int OFF_CKV = 25165824, OFF_KR = 29360128, OFF_K = 29884416, OFF_V = 34078720, OUT_TOTAL = 38273024;

constexpr size_t MiB = 1u << 20;
constexpr size_t WS_CTL = 0, CTL_ZERO_BYTES = 128 * 1024;
constexpr int CW_CNT = 8192, CW_QH = 16384, CW_TMO = 17408, CW_ADA = 17424;
constexpr size_t WS_MOD = 1 * MiB;
constexpr size_t WS_ROPE8 = 1 * MiB + 512 * 1024;
constexpr size_t WS_ROPE16 = WS_ROPE8 + 4096;
constexpr size_t SZ_WIN_MLA = 2304ull * 1024 * 2, SZ_WUQ = 768ull * 384 * 2, SZ_WUKV = 1024ull * 256 * 2, SZ_WPOOL = 512ull * 512 * 2,
                 SZ_WOUT = 1024ull * 1024 * 2, SZ_WIN_SWA = 2560ull * 1024 * 2;
constexpr size_t WS_W = 2 * MiB;
constexpr size_t SZ_W_MLA = SZ_WIN_MLA + SZ_WUQ + SZ_WUKV + SZ_WPOOL + SZ_WOUT, SZ_W_SWA = SZ_WIN_SWA + SZ_WOUT;
constexpr size_t WS_W_MLA0 = WS_W, WS_W_MLA1 = WS_W + SZ_W_MLA, WS_W_SWA0 = WS_W + 2 * SZ_W_MLA, WS_W_SWA1 = WS_W_SWA0 + SZ_W_SWA;
static_assert(WS_W_SWA1 + SZ_W_SWA <= 34 * MiB, "weights");
constexpr size_t WS_H = 34 * MiB;
constexpr size_t WS_GAB = 82 * MiB;
constexpr size_t WS_CQ = 130 * MiB;
constexpr size_t WS_CKV = 148 * MiB;
constexpr size_t WS_KRB = 161 * MiB;
constexpr size_t WS_KRF = 163 * MiB;
constexpr size_t WS_KN = 166 * MiB;
constexpr size_t WS_V = 192 * MiB;
constexpr size_t WS_PO = 218 * MiB;
constexpr size_t WS_SK = 178 * MiB;
constexpr size_t WS_SV = 191 * MiB;
constexpr size_t WS_MODP = 242 * MiB;
constexpr size_t WS_END = 244 * MiB;

__device__ __forceinline__ unsigned f2bf(float f) { unsigned u = __builtin_bit_cast(unsigned, f); return (u + 0x7fffu + ((u >> 16) & 1u)) >> 16; }
__device__ __forceinline__ unsigned pk2(float lo, float hi) { f32x2 v = {lo, hi}; bf16x2_t b = __builtin_convertvector(v, bf16x2_t); return __builtin_bit_cast(unsigned, b); }
__device__ __forceinline__ float bflo(unsigned w) { return __uint_as_float(w << 16); }
__device__ __forceinline__ float bfhi(unsigned w) { return __uint_as_float(w & 0xffff0000u); }
__device__ __forceinline__ float silu_fast(float x) { return x * __builtin_amdgcn_rcpf(1.f + __builtin_amdgcn_exp2f(-x * LOG2E)); }
#define DPP_ADD(v, ctrl) ((v) + __int_as_float(__builtin_amdgcn_update_dpp(0, __float_as_int(v), (ctrl), 0xf, 0xf, true)))
__device__ __forceinline__ float wave_sum(float v) {
    v = DPP_ADD(v, 0xB1); v = DPP_ADD(v, 0x4E); v = DPP_ADD(v, 0x124); v = DPP_ADD(v, 0x128);
    { auto rr = __builtin_amdgcn_permlane16_swap(__float_as_uint(v), __float_as_uint(v), false, false); v = __uint_as_float(rr[0]) + __uint_as_float(rr[1]); }
    { auto rr = __builtin_amdgcn_permlane32_swap(__float_as_uint(v), __float_as_uint(v), false, false); v = __uint_as_float(rr[0]) + __uint_as_float(rr[1]); }
    return v;
}
#define LDS_WAIT() asm volatile("s_waitcnt lgkmcnt(0)" ::: "memory")
__device__ __forceinline__ int opaque_tid() { int t = threadIdx.x; asm volatile("" : "+v"(t)); return t; }

namespace pg8 {
typedef unsigned short bf16_t;
constexpr int BM = 256, BK = 64, HALF = 128, HTB = HALF * BK * 2, STAGE_BYTES = 8 * HTB, NXCD = 8, WGM = 8;
__host__ __device__ __forceinline__ int lds_byte(int r, int c) { const int st = (r >> 4) * 2 + (c >> 5), rr = r & 15, cc = c & 31, ob = rr * 64 + cc * 2; return st * 1024 + (ob ^ (((ob >> 9) & 1) << 5)); }
__host__ __device__ __forceinline__ void stage_rc(int b, int& Rr, int& C) { const int st = b / 1024, sb = b % 1024, swz = sb ^ (((sb >> 9) & 1) << 5); Rr = (st >> 1) * 16 + swz / 64; C = (st & 1) * 32 + (swz % 64) / 2; }
__host__ __device__ __forceinline__ int perm32(int rho) { const int n = rho >> 4, i = rho & 15; return 8 * (i >> 2) + 4 * n + (i & 3); }
struct Unit { int pm, pn; };
struct Gemm { const bf16_t* A; const bf16_t* Bt; int M, N, K, lda; };
struct StaticOrder {
    int nM, nN, nwg, G, c;
    __device__ void init(int M, int N, int G_, int c_) { nM = M / BM; nN = N / BM; nwg = nM * nN; G = G_; c = c_; }
    __device__ bool next(int i, Unit& u) const {
        const long L = (long)i * G + c; if (L >= nwg) return false;
        int wgid = (int)L; { const int q = nwg / NXCD, r = nwg % NXCD, xcd = wgid % NXCD, off = wgid / NXCD; wgid = (xcd < r ? xcd * (q + 1) : r * (q + 1) + (xcd - r) * q) + off; }
        const int nig = WGM * nN, gid = wgid / nig, fm = gid * WGM, gsz = (nM - fm) < WGM ? (nM - fm) : WGM;
        u.pm = fm + ((wgid % nig) % gsz); u.pn = (wgid % nig) / gsz; return true;
    }
};
struct PanelOrder {
    int G, v, nunits;
    __device__ bool next(int i, Unit& u) const { const int L = i * G + v; if (L >= nunits) return false; u.pm = L >> 2; u.pn = L & 3; return true; }
};
template <class Epi, bool ALIGN_EPI, class Sched = StaticOrder>
__device__ __forceinline__ void gemm_phase(LAS unsigned char* lds, const Gemm g, const Sched& S, const Epi& E) {
    const int tid = opaque_tid(), wid = __builtin_amdgcn_readfirstlane(tid >> 6), lane = tid & 63, wr = wid >> 2, wc = wid & 3, fr = lane & 15, fq = lane >> 4;
    const int K = g.K, nt = K / BK, lda = g.lda;
    unsigned voffA[2], voffB[2];
#pragma unroll
    for (int i = 0; i < 2; ++i) { int Rr, C; stage_rc(tid * 16 + i * 8192, Rr, C); const int Rb = Epi::PERM ? ((Rr & ~31) + perm32(Rr & 31)) : Rr;
        voffA[i] = (unsigned)(Rr * lda + C) * 2u; voffB[i] = (unsigned)(Rb * K + C) * 2u; }
    const size_t kstep = (size_t)(BK * 2);
    const size_t hA = (size_t)HALF * lda * 2, hB = (size_t)HALF * K * 2, tA = 2 * hA, tB = 2 * hB;
    const unsigned ldsw = (unsigned)wid * 1024u;
    const int aoff = lds_byte(wr * 64 + fr, fq * 8), boff = lds_byte(wc * 32 + fr, fq * 8);
#define PG8_SA(b, h) (((b) * 2 + (h)) * HTB)
#define PG8_SB(b, h) ((4 + (b) * 2 + (h)) * HTB)
#define PG8_STAGE(bufoff, gbase, voff) do { _Pragma("unroll") for (int _i = 0; _i < 2; ++_i) \
        __builtin_amdgcn_global_load_lds((const unsigned*)((const char*)(gbase) + (voff)[_i]), (LAS unsigned*)(lds + (bufoff) + ldsw + _i * 8192), 16, 0, 0); } while (0)
#define PG8_LDA(dst, b, h) do { _Pragma("unroll") for (int m = 0; m < 4; ++m) _Pragma("unroll") for (int k = 0; k < 2; ++k) dst[m][k] = *(const LAS bf16x8*)(lds + PG8_SA(b, h) + aoff + m * 2048 + k * 1024); } while (0)
#define PG8_LDB(dst, b, h) do { _Pragma("unroll") for (int n = 0; n < 2; ++n) _Pragma("unroll") for (int k = 0; k < 2; ++k) dst[n][k] = *(const LAS bf16x8*)(lds + PG8_SB(b, h) + boff + n * 2048 + k * 1024); } while (0)
#define PG8_MMA(ai, bj, At, Bt) do { __builtin_amdgcn_s_setprio(1); _Pragma("unroll") for (int m = 0; m < 4; ++m) _Pragma("unroll") for (int n = 0; n < 2; ++n) _Pragma("unroll") for (int k = 0; k < 2; ++k) \
        acc[ai][bj][m][n] = __builtin_amdgcn_mfma_f32_16x16x32_bf16(Bt[n][k], At[m][k], acc[ai][bj][m][n], 0, 0, 0); __builtin_amdgcn_s_setprio(0); } while (0)
#define PG8_WAIT_V(n) asm volatile("s_waitcnt vmcnt(" #n ")" ::: "memory")
#define PG8_WAIT_L(n) asm volatile("s_waitcnt lgkmcnt(" #n ")" ::: "memory")
#define PG8_BAR __builtin_amdgcn_s_barrier()
#define PG8_SCHED __builtin_amdgcn_sched_barrier(0)
    Unit cur, nxt; int ui = 0;
    if (!S.next(0, cur)) return;
    f32x4 acc[2][2][4][2];
#pragma unroll
    for (int a = 0; a < 2; ++a)
#pragma unroll
        for (int b = 0; b < 2; ++b)
#pragma unroll
            for (int m = 0; m < 4; ++m)
#pragma unroll
                for (int n = 0; n < 2; ++n) acc[a][b][m][n] = (f32x4){0.f, 0.f, 0.f, 0.f};
    const char* cA = (const char*)g.A + (size_t)cur.pm * tA; const char* cB = (const char*)g.Bt + (size_t)cur.pn * tB;
    PG8_STAGE(PG8_SB(0, 0), cB, voffB); PG8_STAGE(PG8_SB(0, 1), cB + hB, voffB); PG8_STAGE(PG8_SA(0, 0), cA, voffA); PG8_STAGE(PG8_SA(0, 1), cA + hA, voffA);
    if (wr == 1) PG8_BAR;
    PG8_WAIT_V(2); PG8_BAR;
    PG8_STAGE(PG8_SB(1, 0), cB + kstep, voffB); PG8_STAGE(PG8_SA(1, 0), cA + kstep, voffA); PG8_STAGE(PG8_SB(1, 1), cB + hB + kstep, voffB);
    PG8_WAIT_V(6); PG8_BAR;
    for (;;) {
        const bool has_next = S.next(ui + 1, nxt);
        const char* nA = has_next ? (const char*)g.A + (size_t)nxt.pm * tA : cA; const char* nB = has_next ? (const char*)g.Bt + (size_t)nxt.pn * tB : cB;
#pragma nounroll
        for (int t = 0; t < nt; t += 2) {
            const bool last = (t == nt - 2);
            bf16x8 At[4][2], B0[2][2], B1[2][2];
            const char* a1 = cA + (size_t)(t + 1) * kstep;
            const char* a2 = last ? nA : cA + (size_t)(t + 2) * kstep; const char* b2 = last ? nB : cB + (size_t)(t + 2) * kstep;
            const char* a3 = a2 + kstep; const char* b3 = b2 + kstep;
            PG8_LDB(B0, 0, 0); PG8_LDB(B1, 0, 1); PG8_SCHED; PG8_LDA(At, 0, 0); PG8_STAGE(PG8_SA(1, 1), a1 + hA, voffA);
            PG8_WAIT_V(8); PG8_WAIT_L(0); PG8_BAR; PG8_MMA(0, 0, At, B0); PG8_MMA(0, 1, At, B1); PG8_BAR; PG8_SCHED;
            PG8_LDA(At, 0, 1); PG8_STAGE(PG8_SB(0, 0), b2, voffB); PG8_STAGE(PG8_SB(0, 1), b2 + hB, voffB); PG8_STAGE(PG8_SA(0, 0), a2, voffA);
            PG8_WAIT_V(8); PG8_WAIT_L(0); PG8_BAR; PG8_MMA(1, 0, At, B0); PG8_MMA(1, 1, At, B1); PG8_BAR; PG8_SCHED;
            PG8_LDB(B0, 1, 0); PG8_LDB(B1, 1, 1); PG8_SCHED; PG8_LDA(At, 1, 0); PG8_STAGE(PG8_SA(0, 1), a2 + hA, voffA);
            PG8_WAIT_V(8); PG8_WAIT_L(0); PG8_BAR; PG8_MMA(0, 0, At, B0); PG8_MMA(0, 1, At, B1); PG8_BAR; PG8_SCHED;
            PG8_LDA(At, 1, 1); PG8_STAGE(PG8_SB(1, 0), b3, voffB); PG8_STAGE(PG8_SB(1, 1), b3 + hB, voffB); PG8_STAGE(PG8_SA(1, 0), a3, voffA);
            PG8_WAIT_V(8); PG8_WAIT_L(0); PG8_BAR; PG8_MMA(1, 0, At, B0); PG8_MMA(1, 1, At, B1); PG8_BAR; PG8_SCHED;
        }
        if constexpr (ALIGN_EPI) { if (wr == 0) PG8_BAR; }
        E(acc, cur, wr, wc, fr, fq);
        if (!has_next) break;
#pragma unroll
        for (int a = 0; a < 2; ++a)
#pragma unroll
            for (int b = 0; b < 2; ++b)
#pragma unroll
                for (int m = 0; m < 4; ++m)
#pragma unroll
                    for (int n = 0; n < 2; ++n) acc[a][b][m][n] = (f32x4){0.f, 0.f, 0.f, 0.f};
        cur = nxt; cA = nA; cB = nB; ++ui;
        if constexpr (ALIGN_EPI) { if (wr == 1) PG8_BAR; }
    }
    PG8_WAIT_V(0);
    if constexpr (!ALIGN_EPI) { if (wr == 0) PG8_BAR; }
    PG8_BAR;
#undef PG8_SA
#undef PG8_SB
#undef PG8_STAGE
#undef PG8_LDA
#undef PG8_LDB
#undef PG8_MMA
#undef PG8_WAIT_V
#undef PG8_WAIT_L
#undef PG8_BAR
#undef PG8_SCHED
}

__device__ __forceinline__ int rk_base(int pm) { return pm < 32 ? pm * 256 : RP + ((pm - 32) >> 3) * 2304 + ((pm - 32) & 7) * 256; }

struct EpiBf16 {
    static constexpr bool PERM = true;
    bf16* O; int ldc; int split_cols; size_t split_stride;
    __device__ __forceinline__ void operator()(const f32x4 (&acc)[2][2][4][2], const Unit& u, int wr, int wc, int fr, int fq) const {
        const int row0 = u.pm * BM + wr * 64 + fr; int colt = u.pn * BM; bf16* base = O;
        if (split_cols) { const int t = colt / split_cols; base += (size_t)t * split_stride; colt -= t * split_cols; }
        const int col0 = colt + wc * 32 + 8 * fq;
#pragma unroll
        for (int ai = 0; ai < 2; ++ai)
#pragma unroll
            for (int m = 0; m < 4; ++m) { bf16* rowp = base + (size_t)(row0 + ai * HALF + m * 16) * ldc + col0;
#pragma unroll
                for (int bj = 0; bj < 2; ++bj) { const f32x4 v0 = acc[ai][bj][m][0], v1 = acc[ai][bj][m][1];
                    u32x4 w; w.x = pk2(v0[0], v0[1]); w.y = pk2(v0[2], v0[3]); w.z = pk2(v1[0], v1[1]); w.w = pk2(v1[2], v1[3]);
                    *(u32x4*)(rowp + bj * HALF) = w; } }
    }
};
struct EpiOutPub {
    static constexpr bool PERM = true;
    bf16* O; unsigned* cnt;
    __device__ __forceinline__ void operator()(const f32x4 (&acc)[2][2][4][2], const Unit& u, int wr, int wc, int fr, int fq) const {
        const __amdgpu_buffer_rsrc_t rs = __builtin_amdgcn_make_buffer_rsrc((void*)O, (short)0, R * 1024 * 2, 0x00020000);
        const int row0 = u.pm * BM + wr * 64 + fr; const int col0 = u.pn * BM + wc * 32 + 8 * fq;
#pragma unroll
        for (int ai = 0; ai < 2; ++ai)
#pragma unroll
            for (int m = 0; m < 4; ++m) { const int off = ((row0 + ai * HALF + m * 16) * 1024 + col0) * 2;
#pragma unroll
                for (int bj = 0; bj < 2; ++bj) { const f32x4 v0 = acc[ai][bj][m][0], v1 = acc[ai][bj][m][1];
                    u32x4 w; w.x = pk2(v0[0], v0[1]); w.y = pk2(v0[2], v0[3]); w.z = pk2(v1[0], v1[1]); w.w = pk2(v1[2], v1[3]);
                    __builtin_amdgcn_raw_buffer_store_b128(w, rs, off + bj * HALF * 2, 0, 16); } }
        asm volatile("s_waitcnt vmcnt(0)" ::: "memory");
        if ((fr | fq) == 0) __hip_atomic_fetch_add(cnt + 16 * u.pm, 1u, __ATOMIC_RELAXED, __HIP_MEMORY_SCOPE_AGENT);
    }
};
struct EpiPool {
    static constexpr bool PERM = true;
    bf16* GB;
    __device__ __forceinline__ void operator()(const f32x4 (&acc)[2][2][4][2], const Unit& u, int wr, int wc, int fr, int fq) const {
        const int row0 = u.pm * BM + wr * 64 + fr; const int col0 = u.pn * BM + wc * 32 + 8 * fq;
#pragma unroll
        for (int ai = 0; ai < 2; ++ai)
#pragma unroll
            for (int m = 0; m < 4; ++m) { bf16* rowp = GB + (size_t)(row0 + ai * HALF + m * 16) * 1024 + col0;
#pragma unroll
                for (int bj = 0; bj < 2; ++bj) { const f32x4 v0 = acc[ai][bj][m][0], v1 = acc[ai][bj][m][1];
                    const u32x4 gg = *(const u32x4*)(rowp + bj * HALF);
                    u32x4 w;
                    w.x = pk2(v0[0] * silu_fast(bflo(gg.x)), v0[1] * silu_fast(bfhi(gg.x))); w.y = pk2(v0[2] * silu_fast(bflo(gg.y)), v0[3] * silu_fast(bfhi(gg.y)));
                    w.z = pk2(v1[0] * silu_fast(bflo(gg.z)), v1[1] * silu_fast(bfhi(gg.z))); w.w = pk2(v1[2] * silu_fast(bflo(gg.w)), v1[3] * silu_fast(bfhi(gg.w)));
                    *(u32x4*)(rowp + bj * HALF) = w; } }
    }
};
struct EpiMlaIn {
    static constexpr bool PERM = true;
    bf16 *CQ, *CKV, *GAB, *VP; float* KRF;
    __device__ __forceinline__ void operator()(const f32x4 (&acc)[2][2][4][2], const Unit& u, int wr, int wc, int fr, int fq) const {
        const int rt = wr * 64 + fr, grow0 = u.pm * BM, rk0 = rk_base(u.pm), cc = wc * 32 + 8 * fq;
#pragma unroll
        for (int bj = 0; bj < 2; ++bj) {
            const int U = 2 * u.pn + bj;
            if (U == 5) {
                if (wc == 0) {
#pragma unroll
                    for (int ai = 0; ai < 2; ++ai)
#pragma unroll
                        for (int m = 0; m < 4; ++m) { float* p = KRF + (size_t)(grow0 + rt + ai * HALF + m * 16) * 32 + 8 * fq;
                            *(f32x4*)p = acc[ai][bj][m][0]; *(f32x4*)(p + 4) = acc[ai][bj][m][1]; }
                }
                continue;
            }
            bf16* p; int ld, rb = grow0;
            if (U < 3) { p = CQ + 128 * U; ld = 384; }
            else if (U < 5) { p = CKV + 128 * (U - 3); ld = 256; rb = rk0; }
            else if (U < 10) { p = GAB + 128 * (U - 6); ld = 1024; }
            else if (U < 14) { p = VP + 128 * (U - 10); ld = 512; }
            else { p = GAB + 512 + 128 * (U - 14); ld = 1024; }
            p += (size_t)(rb + rt) * ld + cc;
            const bool isgate = (U >= 6 && U < 10) || U >= 14;
#pragma unroll
            for (int ai = 0; ai < 2; ++ai)
#pragma unroll
                for (int m = 0; m < 4; ++m) { f32x4 v0 = acc[ai][bj][m][0], v1 = acc[ai][bj][m][1];
                    if (isgate) { v0 = (f32x4){silu_fast(v0[0]), silu_fast(v0[1]), silu_fast(v0[2]), silu_fast(v0[3])}; v1 = (f32x4){silu_fast(v1[0]), silu_fast(v1[1]), silu_fast(v1[2]), silu_fast(v1[3])}; }
                    u32x4 w; w.x = pk2(v0[0], v0[1]); w.y = pk2(v0[2], v0[3]); w.z = pk2(v1[0], v1[1]); w.w = pk2(v1[2], v1[3]);
                    *(u32x4*)(p + (size_t)(ai * HALF + m * 16) * ld) = w; }
        }
    }
};
__device__ __forceinline__ void rope_perm(f32x4& a, f32x4& b, const float* tb) {
#pragma unroll
    for (int j = 0; j < 4; ++j) { auto rr = __builtin_amdgcn_permlane32_swap(__float_as_uint(a[j]), __float_as_uint(b[j]), false, false); a[j] = __uint_as_float(rr[0]); b[j] = __uint_as_float(rr[1]); }
    const f32x4 c0 = *(const f32x4*)tb, c1 = *(const f32x4*)(tb + 4);
    const f32x4 cs = {c0[0], c0[2], c1[0], c1[2]}, sn = {c0[1], c0[3], c1[1], c1[3]};
    const f32x4 o1 = a * cs - b * sn, o2 = a * sn + b * cs;
    a = o1; b = o2;
#pragma unroll
    for (int j = 0; j < 4; ++j) { auto rr = __builtin_amdgcn_permlane32_swap(__float_as_uint(a[j]), __float_as_uint(b[j]), false, false); a[j] = __uint_as_float(rr[0]); b[j] = __uint_as_float(rr[1]); }
}
struct EpiQ {
    static constexpr bool PERM = true;
    bf16* Q; const float* rope8;
    __device__ __forceinline__ void operator()(const f32x4 (&acc)[2][2][4][2], const Unit& u, int wr, int wc, int fr, int fq) const {
        const int rt = wr * 64 + fr, grow0 = u.pm * BM; const bool sample = u.pm >= 32; const int t0 = ((u.pm - 32) & 7) * 256;
#pragma unroll
        for (int bj = 0; bj < 2; ++bj) {
            const int g32 = 8 * u.pn + 4 * bj + wc; const bool rot = sample && (g32 % 3 == 2);
#pragma unroll
            for (int ai = 0; ai < 2; ++ai)
#pragma unroll
                for (int m = 0; m < 4; ++m) { const int r = rt + ai * HALF + m * 16; f32x4 x1 = acc[ai][bj][m][0], x2 = acc[ai][bj][m][1];
                    if (rot) { const int t = t0 + r, pos = (fq & 1) ? (t & 63) : (t >> 6); rope_perm(x1, x2, rope8 + (pos * 8 + ((fq >> 1) ? 4 : 0)) * 2); }
                    u32x4 w; w.x = pk2(x1[0], x1[1]); w.y = pk2(x1[2], x1[3]); w.z = pk2(x2[0], x2[1]); w.w = pk2(x2[2], x2[3]);
                    *(u32x4*)(Q + (size_t)(grow0 + r) * 768 + 32 * g32 + 8 * fq) = w; }
        }
    }
};
struct EpiSwaIn {
    static constexpr bool PERM = true;
    bf16 *Q, *K, *V, *G; float *stK, *stV; const float* rope16;
    __device__ __forceinline__ void operator()(const f32x4 (&acc)[2][2][4][2], const Unit& u, int wr, int wc, int fr, int fq) const {
        const int rt = wr * 64 + fr, grow0 = u.pm * BM, rk0 = rk_base(u.pm); const bool sample = u.pm >= 32; const int t0 = ((u.pm - 32) & 7) * 256;
        const int pn = u.pn;
#pragma unroll
        for (int bj = 0; bj < 2; ++bj) {
            const int cb = 128 * bj + 32 * wc + 8 * fq;
            const bool rot = sample && pn < 5;
#pragma unroll
            for (int ai = 0; ai < 2; ++ai)
#pragma unroll
                for (int m = 0; m < 4; ++m) { const int r = rt + ai * HALF + m * 16; f32x4 x1 = acc[ai][bj][m][0], x2 = acc[ai][bj][m][1];
                    if (rot) { const int t = t0 + r, pos = (wc & 1) ? (t & 63) : (t >> 6); rope_perm(x1, x2, rope16 + (pos * 16 + 8 * (fq & 1) + ((fq >> 1) ? 4 : 0)) * 2); }
                    bf16* p;
                    if (pn < 4) p = Q + (size_t)(grow0 + r) * 1024 + 256 * pn + cb;
                    else if (pn == 4) p = K + (size_t)(rk0 + r) * 256 + cb;
                    else if (pn == 5) p = V + (size_t)(rk0 + r) * 256 + cb;
                    else p = G + (size_t)(grow0 + r) * 1024 + 256 * (pn - 6) + cb;
                    if (pn >= 6) { x1 = (f32x4){silu_fast(x1[0]), silu_fast(x1[1]), silu_fast(x1[2]), silu_fast(x1[3])}; x2 = (f32x4){silu_fast(x2[0]), silu_fast(x2[1]), silu_fast(x2[2]), silu_fast(x2[3])}; }
                    if (!sample && (pn == 4 || pn == 5)) { float* st = (pn == 4 ? stK : stV) + (size_t)(u.pm * 2 * 256 + r) * 256 + cb; *(f32x4*)st = x1; *(f32x4*)(st + 4) = x2; }
                    u32x4 w; w.x = pk2(x1[0], x1[1]); w.y = pk2(x1[2], x1[3]); w.z = pk2(x2[0], x2[1]); w.w = pk2(x2[2], x2[3]);
                    *(u32x4*)p = w; }
        }
    }
};
}

typedef __attribute__((address_space(4))) const char* kptr_t;
__device__ __forceinline__ const void* arg_ptr(int k) { kptr_t ka = (kptr_t)__builtin_amdgcn_kernarg_segment_ptr(); asm volatile("" : "+s"(ka)); return *(const void* __attribute__((address_space(4)))*)(ka + 8 * k); }
#define ARG_IN(k) ((const float*)arg_ptr(k))
namespace att {
__device__ __forceinline__ int crow(int r, int hi) { return (r & 3) + 8 * (r >> 2) + 4 * hi; }
typedef short v4i16_t __attribute__((ext_vector_type(4)));
__device__ __forceinline__ s16x4 vtr(const LAS char* p) { return __builtin_bit_cast(s16x4, __builtin_amdgcn_ds_read_tr16_b64_v4i16((LAS v4i16_t*)p)); }
__device__ __forceinline__ float xhalf_max(float x) { auto rr = __builtin_amdgcn_permlane32_swap(__float_as_uint(x), __float_as_uint(x), false, false); return __builtin_fmaxf(__uint_as_float(rr[0]), __uint_as_float(rr[1])); }
__device__ __forceinline__ float xhalf_sum(float x) { auto rr = __builtin_amdgcn_permlane32_swap(__float_as_uint(x), __float_as_uint(x), false, false); return __uint_as_float(rr[0]) + __uint_as_float(rr[1]); }
#define SBAR() __builtin_amdgcn_sched_barrier(0)
#define PIN(x) asm volatile("" : "+v"(x))
__device__ __forceinline__ float max3f(float a, float b, float c) { float r; asm("v_max3_f32 %0, %1, %2, %3" : "=v"(r) : "v"(a), "v"(b), "v"(c)); return r; }
__device__ __forceinline__ float max2f(float a, float b) { float r; asm("v_max_f32_e32 %0, %1, %2" : "=v"(r) : "v"(a), "v"(b)); return r; }
struct Desc {
    const bf16* qptr;
    const bf16* k0;
    const bf16* k1;
    const bf16* v;
    int n_a, row_a, n_b, row_b, key_b;
    int qpos; float sink2; int has_sink;
    bf16* optr;
};
constexpr float THR = 8.f;
__device__ __forceinline__ int tile_row(const Desc& d, int t) { return t < d.n_a ? d.row_a + 64 * t : d.row_b + 64 * (t - d.n_a); }
template <int MODE, class MK>
__device__ __forceinline__ void attn_phase(LAS char* lds, const MK& mk, int first, int stride, int nunits) {
    constexpr int DQK = MODE == 0 ? 96 : 64, NCH = DQK / 8, ND0 = DQK / 16, KB = NCH * 1024, VOFF = 3 * KB, NG = 2 * ND0, NHELD = 8, NLATE = NG - NHELD, STG_OFF = VOFF + 2 * 8192;
    static_assert(STG_OFF + 8 * 32 * 272 <= 131072, "attention LDS map");
    constexpr int LDQ = MODE == 0 ? 768 : 1024, LDK0 = MODE == 0 ? 512 : 256, LDV = LDK0, LDO = 1024;
    int un = first; if (un >= nunits) return;
    const int tid = opaque_tid(), lane = tid & 63, r32 = lane & 31, hi = lane >> 5; const int wid = __builtin_amdgcn_readfirstlane(tid >> 6);
    const int kdst = wid * 1024, k1dst = (8 + (wid & 3)) * 1024, vdst = VOFF + wid * 1024;
    const int vlane = ((lane >> 4) & 1) * 32 + (lane & 3) * 8 + (4 * hi + ((lane & 15) >> 2)) * 64;
    const int kfo = hi * 1024 + r32 * 16;
    Desc d; mk(un, d);
    const unsigned kvo = (unsigned)(lane * LDK0 + wid * 8) * 2u, k1vo = (unsigned)(lane * 32 + (wid & 3) * 8) * 2u;
    const unsigned vvo = (unsigned)((16 * (wid & 3) + (lane >> 2)) * LDV + (wid >> 2) * 32 + (lane & 3) * 8) * 2u;
#define GLDS16(vo, sb, l) asm volatile("s_mov_b32 m0, %2\n\ts_nop 0\n\tglobal_load_lds_dwordx4 %0, %1" :: "v"(vo), "s"(sb), "s"((unsigned)(size_t)(l)) : "memory", "m0")
#define DMA_DRAIN() asm volatile("s_waitcnt vmcnt(0)" ::: "memory")
#define DMAK_(dd, t, soff) do { const size_t _r = (size_t)tile_row(dd, t); GLDS16(kvo, (dd).k0 + _r * LDK0, lds + (soff) + kdst); if (MODE == 0 && wid < 4) GLDS16(k1vo, (dd).k1 + _r * 32, lds + (soff) + k1dst); } while (0)
#define DMAV_(dd, t, vslot) do { const size_t _r = (size_t)tile_row(dd, t); GLDS16(vvo, (dd).v + _r * LDV, lds + (vslot) * 8192 + vdst); } while (0)
#define DMAK(t, soff) DMAK_(d, t, soff)
#define DMAV(t, vslot) DMAV_(d, t, vslot)
    int sl_cur = 0, sl_nxt = KB, sl_fre = 2 * KB;
    int vpar = 0;
    DMAK(0, sl_cur); DMAK(1, sl_nxt); DMAV(0, vpar);
    bf16x8 qr[ND0];
#pragma unroll
    for (int d0 = 0; d0 < ND0; ++d0) qr[d0] = *(const bf16x8*)(d.qptr + (size_t)r32 * LDQ + d0 * 16 + hi * 8);
    DMA_DRAIN(); __syncthreads();
#define ROT() do { const int o_ = sl_cur; sl_cur = sl_nxt; sl_nxt = sl_fre; sl_fre = o_; } while (0)
#define KFADDR(i, soff) (lds + (soff) + kfo + ((i) >> 1) * 2048 + ((i) & 1) * 512)
#define PE(P0, P1, e) ((e) < 16 ? P0[(e) & 15] : P1[(e) & 15])
#define FILL_A(P0, P1, g) do { \
        _Pragma("unroll") for (int e_ = (32 * (g)) / NG; e_ < (32 * ((g) + 1)) / NG; ++e_) sacc += PE(P0, P1, e_); \
        _Pragma("unroll") for (int k_ = (16 * (g)) / NG; k_ < (16 * ((g) + 1)) / NG; ++k_) { pw[k_ >> 2][k_ & 3] = pk2(PE(P0, P1, 2 * k_), PE(P0, P1, 2 * k_ + 1)); } } while (0)
#define QK_PHASE(C0, C1, P0, P1, HAVE_P) do { \
        bf16x8 kl_[NLATE > 0 ? NLATE : 1]; \
        _Pragma("unroll") for (int i_ = 0; i_ < NLATE; ++i_) kl_[i_] = *(const LAS bf16x8*)KFADDR(NHELD + i_, sl_cur); \
        _Pragma("unroll") for (int g_ = 0; g_ < NG; ++g_) { const int d0_ = g_ >> 1; \
            const bf16x8 kk_ = g_ < NHELD ? kf[g_ < NHELD ? g_ : 0] : kl_[g_ >= NHELD ? g_ - NHELD : 0]; \
            if ((g_ & 1) == 0) C0 = __builtin_amdgcn_mfma_f32_32x32x16_bf16(kk_, qr[d0_], d0_ == 0 ? negm : C0, 0, 0, 0); \
            else C1 = __builtin_amdgcn_mfma_f32_32x32x16_bf16(kk_, qr[d0_], d0_ == 0 ? negm : C1, 0, 0, 0); \
            if (g_ < NHELD) kf[g_ < NHELD ? g_ : 0] = *(const LAS bf16x8*)KFADDR(g_, sl_nxt); \
            if (HAVE_P) FILL_A(P0, P1, g_); \
            SBAR(); } } while (0)
#define MASKT(C0, C1, t_) do { if (MODE == 1 && (t_) >= d.n_a) { const int key0_ = d.key_b + 64 * ((t_) - d.n_a); \
        if (key0_ - (qb0 + 31) < -128 || key0_ + 63 - qb0 > 128) { const int k0p_ = key0_ - d.qpos; \
            _Pragma("unroll") for (int r = 0; r < 16; ++r) { const int d_ = k0p_ + crow(r, hi); if (d_ > 128 || d_ < -128) C0[r] = -1e30f; if (d_ + 32 > 128 || d_ + 32 < -128) C1[r] = -1e30f; } } } } while (0)
#define DECIDE(C0, C1) do { \
        float a_ = max2f(C0[0], C1[0]), b_ = max2f(C0[1], C1[1]); \
        _Pragma("unroll") for (int r = 2; r < 16; r += 2) { a_ = max3f(a_, C0[r], C1[r]); b_ = max3f(b_, C0[r + 1], C1[r + 1]); } \
        a_ = xhalf_max(max2f(a_, b_)); resc = false; \
        if (__any(a_ > THR)) { const float dl_ = fmaxf(a_, 0.f); mref += dl_; \
            _Pragma("unroll") for (int r = 0; r < 16; ++r) { C0[r] -= dl_; C1[r] -= dl_; } \
            _Pragma("unroll") for (int r = 0; r < 16; ++r) negm[r] = -mref; \
            fsc = __builtin_amdgcn_exp2f(-dl_); lsum *= fsc; resc = true; } } while (0)
#define EXP4(C0, C1, j) do { _Pragma("unroll") for (int e_ = 4 * (j); e_ < 4 * (j) + 4; ++e_) { if (e_ < 16) C0[e_ & 15] = __builtin_amdgcn_exp2f(C0[e_ & 15]); else C1[e_ & 15] = __builtin_amdgcn_exp2f(C1[e_ & 15]); } \
        if (4 * (j) < 16) PIN(C0); else PIN(C1); } while (0)
#define VOFFS(j) ((((j) & 1) * 4096) + (((j) >> 1) * 1024))
#define PV_PHASE(C0, C1, HAVE_C, HAVE_K, tp_) do { \
        const LAS char* vp_ = lds + VOFF + (((tp_) + vpar) & 1) * 8192 + vlane; \
        s16x4 vl_[8], vh_[8]; \
        vl_[0] = vtr(vp_ + VOFFS(0)); vh_[0] = vtr(vp_ + VOFFS(0) + 512); vl_[1] = vtr(vp_ + VOFFS(1)); vh_[1] = vtr(vp_ + VOFFS(1) + 512); \
        _Pragma("unroll") for (int j = 0; j < 8; ++j) { const int ks = j >> 1, dd = j & 1; \
            if (j + 2 < 8) { vl_[j + 2] = vtr(vp_ + VOFFS(j + 2)); vh_[j + 2] = vtr(vp_ + VOFFS(j + 2) + 512); } \
            const bf16x8 vf_ = {vl_[j][0], vl_[j][1], vl_[j][2], vl_[j][3], vh_[j][0], vh_[j][1], vh_[j][2], vh_[j][3]}; \
            if (dd == 0) o0 = __builtin_amdgcn_mfma_f32_32x32x16_bf16(vf_, __builtin_bit_cast(bf16x8, pw[ks]), o0, 0, 0, 0); \
            else o1 = __builtin_amdgcn_mfma_f32_32x32x16_bf16(vf_, __builtin_bit_cast(bf16x8, pw[ks]), o1, 0, 0, 0); \
            if (HAVE_C) EXP4(C0, C1, j); \
            SBAR(); } } while (0)
#define STEP(C0, C1, P0, P1, t_) do { \
        if ((t_) + 2 < NT) DMAK((t_) + 2, sl_fre); \
        DMAV(t_, ((t_) + vpar) & 1); \
        float sacc = 0.f; \
        QK_PHASE(C0, C1, P0, P1, true); \
        lsum += sacc; \
        MASKT(C0, C1, t_); \
        DECIDE(C0, C1); \
        SBAR(); \
        PV_PHASE(C0, C1, true, true, (t_) - 1); \
        DMA_DRAIN(); __syncthreads(); \
        ROT(); \
        if (resc) { o0 *= fsc; o1 *= fsc; } } while (0)
    for (;;) {
        const int NT = d.n_a + d.n_b;
        const int qb0 = __builtin_amdgcn_readfirstlane(d.qpos);
        float mref = 0.f, lsum = 0.f, fsc = 1.f; bool resc = false;
        f32x16 o0 = (f32x16){}, o1 = (f32x16){}, negm = (f32x16){};
        f32x16 cA0 = (f32x16){}, cA1 = (f32x16){}, cB0 = (f32x16){}, cB1 = (f32x16){};
        u32x4 pw[4];
#pragma unroll
        for (int i = 0; i < 4; ++i) pw[i] = (u32x4){0u, 0u, 0u, 0u};
        bf16x8 kf[NHELD];
#pragma unroll
        for (int i = 0; i < NHELD; ++i) kf[i] = *(const LAS bf16x8*)KFADDR(i, sl_cur);
        {
            if (2 < NT) DMAK(2, sl_fre);
            float sacc = 0.f; (void)sacc;
            QK_PHASE(cA0, cA1, cA0, cA1, false);
            MASKT(cA0, cA1, 0);
            DECIDE(cA0, cA1);
#pragma unroll
            for (int j = 0; j < 8; ++j) { EXP4(cA0, cA1, j); SBAR(); }
            DMA_DRAIN(); __syncthreads();
            ROT();
        }
        int t = 1;
        for (; t + 1 < NT; t += 2) { STEP(cB0, cB1, cA0, cA1, t); STEP(cA0, cA1, cB0, cB1, t + 1); }
        const bool odd_tail = t < NT;
        if (odd_tail) STEP(cB0, cB1, cA0, cA1, t);
        const int un_next = un + stride; const bool has_next = un_next < nunits;
        Desc dn = d;
        u32x4 gpre[4];
#pragma unroll
        for (int i2 = 0; i2 < 4; ++i2) gpre[i2] = *(const u32x4*)(d.optr + (size_t)(i2 * 8 + (lane >> 3)) * LDO + (lane & 7) * 8);
        bf16x8 qn[ND0];
#pragma unroll
        for (int d0 = 0; d0 < ND0; ++d0) qn[d0] = qr[d0];
        if (has_next) {
            mk(un_next, dn);
            DMAK_(dn, 0, sl_cur); DMAK_(dn, 1, sl_nxt); DMAV_(dn, 0, (NT + vpar) & 1);
#pragma unroll
            for (int d0 = 0; d0 < ND0; ++d0) qn[d0] = *(const bf16x8*)(dn.qptr + (size_t)r32 * LDQ + d0 * 16 + hi * 8);
        }
        if (odd_tail) {
            float sacc = 0.f;
#pragma unroll
            for (int g = 0; g < NG; ++g) FILL_A(cB0, cB1, g);
            lsum += sacc;
            PV_PHASE(cB0, cB1, false, false, NT - 1);
        } else {
            float sacc = 0.f;
#pragma unroll
            for (int g = 0; g < NG; ++g) FILL_A(cA0, cA1, g);
            lsum += sacc;
            PV_PHASE(cA0, cA1, false, false, NT - 1);
        }
        float lt = xhalf_sum(lsum);
        if (d.has_sink) lt += __builtin_amdgcn_exp2f(d.sink2 - mref);
        const float inv = 1.0f / lt;
        {
            LAS char* stg = lds + STG_OFF + wid * (32 * 272);
#pragma unroll
            for (int d0 = 0; d0 < 2; ++d0)
#pragma unroll
                for (int g = 0; g < 4; ++g) { const f32x16& o = d0 ? o1 : o0;
                    const f32x4 v = {o[4 * g] * inv, o[4 * g + 1] * inv, o[4 * g + 2] * inv, o[4 * g + 3] * inv};
                    *(LAS f32x4*)(stg + r32 * 272 + (32 * d0 + 8 * g + 4 * hi) * 4) = v; }
#pragma unroll
            for (int i2 = 0; i2 < 4; ++i2) { const int row = i2 * 8 + (lane >> 3), ch = lane & 7;
                const f32x4 va = *(const LAS f32x4*)(stg + row * 272 + ch * 32), vb = *(const LAS f32x4*)(stg + row * 272 + ch * 32 + 16);
                const u32x4 gg = gpre[i2];
                u32x4 w;
                w.x = pk2(va[0] * bflo(gg.x), va[1] * bfhi(gg.x)); w.y = pk2(va[2] * bflo(gg.y), va[3] * bfhi(gg.y));
                w.z = pk2(vb[0] * bflo(gg.z), vb[1] * bfhi(gg.z)); w.w = pk2(vb[2] * bflo(gg.w), vb[3] * bfhi(gg.w));
                *(u32x4*)(d.optr + (size_t)row * LDO + ch * 8) = w; }
        }
        DMA_DRAIN(); __syncthreads();
        if (!has_next) break;
        vpar = (NT + vpar) & 1;
        d = dn; un = un_next;
#pragma unroll
        for (int d0 = 0; d0 < ND0; ++d0) qr[d0] = qn[d0];
    }
#undef GLDS16
#undef DMA_DRAIN
#undef DMAK_
#undef DMAV_
#undef DMAK
#undef DMAV
#undef ROT
#undef KFADDR
#undef PE
#undef FILL_A
#undef QK_PHASE
#undef MASKT
#undef DECIDE
#undef EXP4
#undef VOFFS
#undef PV_PHASE
#undef STEP
}
#undef SBAR
}

#define XB_TMO      128
#define XB_XCNT(j)  (256  + 64 * (j))
#define XB_XSUB(j)  (1280 + 64 * (j))
#define XB_XGEN(j)  (2304 + 64 * (j))
#define XB_TOP      3328
#define XB_TOPGEN   3392
#define XCD_BAR_WORDS 3456
#define XB_SPIN_CAP (1u << 20)
__device__ __forceinline__ unsigned xb_ld(unsigned* p)              { return __hip_atomic_load(p, __ATOMIC_RELAXED, __HIP_MEMORY_SCOPE_AGENT); }
__device__ __forceinline__ unsigned xb_add(unsigned* p, unsigned v) { return __hip_atomic_fetch_add(p, v, __ATOMIC_RELAXED, __HIP_MEMORY_SCOPE_AGENT); }
__device__ __forceinline__ unsigned xb_xcc_id() { return (unsigned)__builtin_amdgcn_s_getreg((3 << 11) | 20) & 0xFu; }
#define XB_SPIN(cond, bar) do { unsigned _sp = 0; while (cond) { __builtin_amdgcn_s_sleep(1); \
    if ((++_sp & 255u) == 0u) { if (xb_ld(&(bar)[XB_TMO])) break; if (_sp > XB_SPIN_CAP) { atomicAdd(&(bar)[XB_TMO], 1u); break; } } } } while (0)
struct XcdBarrier { unsigned* bar; unsigned x; volatile LAS unsigned* st; };
__device__ __forceinline__ XcdBarrier xcd_barrier_post(unsigned* bar, volatile LAS unsigned* st) {
    XcdBarrier b; b.bar = bar; b.x = xb_xcc_id(); b.st = st;
    if (threadIdx.x == 0) (void)xb_add(&bar[XB_XCNT(b.x)], 1u);
    return b;
}
__device__ __forceinline__ void xcd_barrier_complete(unsigned* bar, unsigned x, unsigned& nloc, unsigned& nx) {
    const unsigned G = gridDim.x * gridDim.y * gridDim.z;
    unsigned sum, cnt, mine, sp = 0u;
    for (;;) {
        sum = 0u; cnt = 0u; mine = 0u;
#pragma unroll
        for (unsigned j = 0; j < 16; ++j) { const unsigned c = xb_ld(&bar[XB_XCNT(j)]); sum += c; cnt += (c > 0u) ? 1u : 0u; mine = (j == x) ? c : mine; }
        if (sum == G) break;
        __builtin_amdgcn_s_sleep(1);
        if ((++sp & 255u) == 0u) { if (xb_ld(&bar[XB_TMO])) break; if (sp > XB_SPIN_CAP) { atomicAdd(&bar[XB_TMO], 1u); break; } }
    }
    nloc = mine > 0u ? mine : 1u; nx = cnt > 0u ? cnt : 1u;
}
__device__ __forceinline__ void xcd_barrier(const XcdBarrier& b0) {
    asm volatile("s_waitcnt vmcnt(0)" ::: "memory");
    __syncthreads();
    if (threadIdx.x == 0) {
        XcdBarrier b = b0; b.x = xb_xcc_id();
        unsigned* bar = b.bar; asm volatile("" : "+s"(bar));
        __builtin_amdgcn_s_waitcnt(0);
        unsigned nloc = b.st[0], nx = b.st[1];
        if (nloc == 0u) { xcd_barrier_complete(bar, b.x, nloc, nx); b.st[0] = nloc; b.st[1] = nx; }
        const unsigned old = xb_add(&bar[XB_XSUB(b.x)], 1u);
        const unsigned gen = old / nloc;
        if (old + 1u == (gen + 1u) * nloc) {
            __builtin_amdgcn_fence(__ATOMIC_RELEASE, "agent");
            asm volatile("s_waitcnt vmcnt(0)" ::: "memory");
            const unsigned og = xb_add(&bar[XB_TOP], 1u);
            const unsigned tg = og / nx;
            if (og + 1u == (tg + 1u) * nx) xb_add(&bar[XB_TOPGEN], 1u);
            else XB_SPIN(xb_ld(&bar[XB_TOPGEN]) == tg, bar);
            __builtin_amdgcn_fence(__ATOMIC_ACQUIRE, "agent");
            xb_add(&bar[XB_XGEN(b.x)], 1u);
            asm volatile("s_waitcnt vmcnt(0)" ::: "memory");
        } else {
            XB_SPIN(xb_ld(&bar[XB_XGEN(b.x)]) == gen, bar);
            __builtin_amdgcn_fence(__ATOMIC_ACQUIRE, "agent");
            asm volatile("s_waitcnt vmcnt(0)" ::: "memory");
        }
    }
    __syncthreads();
}

struct Args { const float* in[23]; float* out; unsigned char* ws; int ph_lo, ph_hi; };
constexpr int NWAVES = 8;
constexpr int N_PHASES = 1 + 5 + 3 + 5 + 3;
constexpr int RING_BYTES = 131072, MISC_OFF = RING_BYTES + 320, LDS_BYTES = 147456;

struct TMap { int kind, row_off, col_off, ldw; const float* nscale; float scale; };
__device__ __forceinline__ void tmap(const TMap& tm, int n, int& drow, float& sc) {
    drow = n + tm.row_off; sc = tm.scale;
    switch (tm.kind) {
        case 1: if (n >= 672) drow += 96; break;
        case 2: { const int e = n % 96; if (e >= 64) { const int d = e - 64; const int p = (d & 7) | ((d & 8) << 1) | ((d & 16) >> 1); drow = n - e + 64 + p; } } break;
        case 3: { const int h = n >> 7, e = n & 127; drow = (e < 64) ? h * 64 + e : 512 + h * 64 + (e - 64); } break;
        case 4: sc = tm.nscale[n]; break;
        case 5: if (n >= 1024) sc = 1.f; break;
        default: break;
    }
}
__device__ __forceinline__ void transpose_item(const float* W, int K, int N, bf16* WT, const TMap& tm, LAS float* scr, int item, int lane) {
    const int nblk = N / 32, kb = item / nblk, nb = item % nblk, k0 = 64 * kb, n0 = 32 * nb;
    f32x4 wv[8];
#pragma unroll
    for (int i = 0; i < 8; ++i) wv[i] = *(const f32x4*)(W + (size_t)(k0 + 8 * i + (lane >> 3)) * N + n0 + 4 * (lane & 7));
#pragma unroll
    for (int i = 0; i < 8; ++i) { LAS float* d = scr + (8 * i + (lane >> 3)) * 33 + 4 * (lane & 7); d[0] = wv[i][0]; d[1] = wv[i][1]; d[2] = wv[i][2]; d[3] = wv[i][3]; }
    LDS_WAIT(); asm volatile("" ::: "memory");
    const int c = lane & 7;
#pragma unroll
    for (int j = 0; j < 4; ++j) { const int n = (lane >> 3) + 8 * j; const LAS float* s = scr + (8 * c) * 33 + n;
        int drow; float sc; tmap(tm, n0 + n, drow, sc);
        u32x4 o; o.x = pk2(s[0 * 33] * sc, s[1 * 33] * sc); o.y = pk2(s[2 * 33] * sc, s[3 * 33] * sc); o.z = pk2(s[4 * 33] * sc, s[5 * 33] * sc); o.w = pk2(s[6 * 33] * sc, s[7 * 33] * sc);
        *(u32x4*)(WT + (size_t)drow * tm.ldw + tm.col_off + k0 + 8 * c) = o; }
    LDS_WAIT(); asm volatile("" ::: "memory");
}

__device__ __forceinline__ f32x4 mod_load(const float* MODPp, const float* ada_b, int l, int midx, int off) {
    f32x4 s = *(const f32x4*)(ada_b + l * 3072 + off);
#pragma unroll
    for (int kq = 0; kq < 4; ++kq) s += *(const f32x4*)(MODPp + ((size_t)((kq * 4 + l) * 9 + midx)) * 3072 + off);
    return s;
}
__device__ __forceinline__ void ada_item(int it, const float* cvec, const float* cctx, const float* ada_w, float* modp, LAS unsigned char* lds, int tid, int lane, int wave) {
    LAS float* red = (LAS float*)lds;
    const int l = it / 48, rem = it % 48, cc = rem >> 2, kq = rem & 3, k0 = kq * 256 + wave * 32;
    float sv[9];
#pragma unroll
    for (int j = 0; j < 9; ++j) { const float c = (j < 8) ? cvec[j * 1024 + k0 + (lane & 31)] : cctx[k0 + (lane & 31)]; sv[j] = c / (1.f + expf(-c)); }
    f32x4 acc[9];
#pragma unroll
    for (int j = 0; j < 9; ++j) acc[j] = (f32x4){0.f, 0.f, 0.f, 0.f};
    const float* wp = ada_w + ((size_t)l * 1024 + k0) * 3072 + cc * 256 + 4 * lane;
    f32x4 wv[32];
#pragma unroll
    for (int kk = 0; kk < 32; ++kk) wv[kk] = *(const f32x4*)(wp + (size_t)kk * 3072);
    asm volatile("" ::: "memory");
#pragma unroll
    for (int kk = 0; kk < 32; ++kk) {
#pragma unroll
        for (int j = 0; j < 9; ++j) { const float sc = __int_as_float(__builtin_amdgcn_readlane(__float_as_int(sv[j]), kk)); acc[j] += wv[kk] * sc; }
    }
#pragma unroll
    for (int j = 0; j < 9; ++j) *(LAS f32x4*)(red + (wave * 9 + j) * 256 + 4 * lane) = acc[j];
    __syncthreads();
    for (int idx = tid; idx < 9 * 256; idx += NWAVES * 64) { const int j = idx >> 8, col = idx & 255; float sm = 0.f;
#pragma unroll
        for (int w = 0; w < 8; ++w) sm += red[(w * 9 + j) * 256 + col];
        modp[((size_t)((kq * 4 + l) * 9 + j)) * 3072 + cc * 256 + col] = sm; }
    __syncthreads();
}
constexpr int CI1 = 1104, CI2 = 144, CI3 = 128, CI4 = 1024, CI5 = 512, CI6 = 1280, CI7 = 512, CIMLA = CI1 + CI2 + CI3 + CI4 + CI5, CISWA = CI6 + CI7;
__device__ __forceinline__ void conv_item(int r, int i, unsigned char* ws, LAS float* scr, int lane) {
    unsigned char* wm = ws + (i ? WS_W_MLA1 : WS_W_MLA0); unsigned char* wsw = ws + (i ? WS_W_SWA1 : WS_W_SWA0);
    if (r < CI1) { const int nb = r % 69; if (nb >= 37 && nb < 53) return;
        TMap tm{1, 0, 0, 1024, nullptr, 1.f}; transpose_item(ARG_IN(12) + (size_t)i * 1024 * 2208, 1024, 2208, (bf16*)wm, tm, scr, r, lane); return; } r -= CI1;
    if (r < CI2) { TMap tm{2, 0, 0, 384, nullptr, MLA_SC}; transpose_item(ARG_IN(15) + (size_t)i * 384 * 768, 384, 768, (bf16*)(wm + SZ_WIN_MLA), tm, scr, r, lane); return; } r -= CI2;
    if (r < CI3) { TMap tm{3, 0, 0, 256, nullptr, 1.f}; transpose_item(ARG_IN(16) + (size_t)i * 256 * 1024, 256, 1024, (bf16*)(wm + SZ_WIN_MLA + SZ_WUQ), tm, scr, r, lane); return; } r -= CI3;
    if (r < CI4) {
        const int g = r >> 8, kb = (r >> 4) & 15, eb = r & 15, k = kb * 64 + lane;
        const float* wi = ARG_IN(12) + (size_t)i * 1024 * 2208 + (size_t)k * 2208 + 1184 + g * 128;
        const float* wp = ARG_IN(17) + ((size_t)i * 4 + g) * 128 * 128 + eb * 8; const float* sp = ARG_IN(18) + i * 512 + g * 128 + eb * 8;
#pragma unroll
        for (int q = 0; q < 4; ++q) { const int c = 32 * q + (lane >> 1); *(LAS f32x4*)(scr + c * 8 + 4 * (lane & 1)) = *(const f32x4*)(wp + (size_t)c * 128 + 4 * (lane & 1)); }
        LDS_WAIT(); asm volatile("" ::: "memory");
        float acc[8];
#pragma unroll
        for (int e = 0; e < 8; ++e) acc[e] = 0.f;
#pragma nounroll
        for (int hc = 0; hc < 2; ++hc) {
            f32x4 arow[16];
#pragma unroll
            for (int q = 0; q < 16; ++q) arow[q] = *(const f32x4*)(wi + 64 * hc + 4 * q);
            const LAS float* sw = scr + 64 * hc * 8;
#pragma unroll
            for (int q = 0; q < 16; ++q) {
#pragma unroll
                for (int cc = 0; cc < 4; ++cc) { const float a = arow[q][cc];
                    const f32x4 w0 = *(const LAS f32x4*)(sw + (4 * q + cc) * 8), w1 = *(const LAS f32x4*)(sw + (4 * q + cc) * 8 + 4);
                    acc[0] += a * w0[0]; acc[1] += a * w0[1]; acc[2] += a * w0[2]; acc[3] += a * w0[3]; acc[4] += a * w1[0]; acc[5] += a * w1[1]; acc[6] += a * w1[2]; acc[7] += a * w1[3]; } }
        }
        bf16* dst = (bf16*)wm + (size_t)(1280 + g * 128 + eb * 8) * 1024 + k;
#pragma unroll
        for (int e = 0; e < 8; ++e) dst[(size_t)e * 1024] = (bf16)f2bf(acc[e] * sp[e]);
        LDS_WAIT(); asm volatile("" ::: "memory");
        return; } r -= CI4;
    if (r < CI5) { TMap tm{0, 0, 0, 1024, nullptr, 1.f}; transpose_item(ARG_IN(19) + (size_t)i * 1024 * 1024, 1024, 1024, (bf16*)(wm + SZ_WIN_MLA + SZ_WUQ + SZ_WUKV + SZ_WPOOL), tm, scr, r, lane); return; } r -= CI5;
    if (r < CI6) { TMap tm{5, 0, 0, 1024, nullptr, SWA_SC}; transpose_item(ARG_IN(20) + (size_t)i * 1024 * 2560, 1024, 2560, (bf16*)wsw, tm, scr, r, lane); return; } r -= CI6;
    { TMap tm{0, 0, 0, 1024, nullptr, 1.f}; transpose_item(ARG_IN(22) + (size_t)i * 1024 * 1024, 1024, 1024, (bf16*)(wsw + SZ_WIN_SWA), tm, scr, r, lane); }
}
__device__ __forceinline__ int mod_index(int row) { return row < RP ? 8 : ((row - RP) >> 11); }

__global__ void __launch_bounds__(NWAVES * 64, 2) fwd_kernel(Args args) {
    extern __shared__ __attribute__((aligned(16))) unsigned char lds_raw[];
    LAS unsigned char* lds = (LAS unsigned char*)lds_raw;
    volatile LAS unsigned* MISC = (volatile LAS unsigned*)(lds + MISC_OFF);
    const int G = gridDim.x; const int bx = blockIdx.x; const int vcu = (G % 8 == 0) ? (bx % 8) * (G / 8) + bx / 8 : bx;
    const int NGW = G * NWAVES;
    { const int tid0 = threadIdx.x; for (int u = tid0; u < (LDS_BYTES - RING_BYTES) / 4; u += NWAVES * 64) ((LAS unsigned*)(lds + RING_BYTES))[u] = 0u; }
    __syncthreads();
    XcdBarrier bar; bar.bar = (unsigned*)((unsigned char*)arg_ptr(24) + WS_CTL) + 1024; bar.x = 0; bar.st = nullptr;
    if (!MK_PER_PHASE) bar = xcd_barrier_post(bar.bar, MISC + 8);
    const int lo = MK_PER_PHASE ? args.ph_lo : 0, hi = MK_PER_PHASE ? args.ph_hi : N_PHASES;
    int pid = 0;
#define IN_PH() (lo <= pid && pid < hi)
#define END_PH() do { if (!MK_PER_PHASE && lo <= pid && pid + 1 < hi) xcd_barrier(bar); ++pid; } while (0)
#define PH_BEGIN() unsigned char* const ws = (unsigned char*)arg_ptr(24); float* const out = (float*)arg_ptr(23); \
    const int tid = opaque_tid(), lane = tid & 63, wave = __builtin_amdgcn_readfirstlane(tid >> 6), gw = vcu * NWAVES + wave; (void)out; (void)lane; (void)gw; (void)ws
#define MOD ((float*)(ws + WS_MOD))
#define ROPE8 ((float*)(ws + WS_ROPE8))
#define ROPE16 ((float*)(ws + WS_ROPE16))
#define MODP ((float*)(ws + WS_MODP))
#define Hb ((bf16*)(ws + WS_H))
#define GAB ((bf16*)(ws + WS_GAB))
#define CQ ((bf16*)(ws + WS_CQ))
#define CKV ((bf16*)(ws + WS_CKV))
#define KRB ((bf16*)(ws + WS_KRB))
#define KRF ((float*)(ws + WS_KRF))
#define KN ((bf16*)(ws + WS_KN))
#define VP ((bf16*)(ws + WS_KN))
#define VV ((bf16*)(ws + WS_V))
#define PO ((bf16*)(ws + WS_PO))
#define SQ ((bf16*)(ws + WS_CQ))
#define SK ((bf16*)(ws + WS_SK))
#define SV ((bf16*)(ws + WS_SV))

    if (IN_PH()) { PH_BEGIN();
        { const float* cvec = ARG_IN(6); const float* cctx = ARG_IN(7); const float* ada_w = ARG_IN(8);
          int nad = 0;
          for (int it = bx; it < 48; it += G) { ada_item(it, cvec, cctx, ada_w, MODP, lds, tid, lane, wave); ++nad; }
          if (nad) {
              __builtin_amdgcn_fence(__ATOMIC_RELEASE, "agent"); asm volatile("s_waitcnt vmcnt(0)" ::: "memory"); __syncthreads();
              if (tid == 0) __hip_atomic_fetch_add((unsigned*)(ws + WS_CTL) + CW_ADA, (unsigned)nad, __ATOMIC_RELEASE, __HIP_MEMORY_SCOPE_AGENT); } }
        for (int e = bx * 512 + tid; e < 64 * 8 + 64 * 16; e += G * 512) {
            if (e < 512) { const int pos = e >> 3, i = e & 7; const float inv = powf(10000.f, -(float)i / 8.f), a = (float)pos * inv; ROPE8[2 * e] = cosf(a); ROPE8[2 * e + 1] = sinf(a); }
            else { const int f = e - 512, pos = f >> 4, i = f & 15; const float inv = powf(10000.f, -(float)i / 16.f), a = (float)pos * inv; ROPE16[2 * f] = cosf(a); ROPE16[2 * f + 1] = sinf(a); }
        }
        LAS float* scr = (LAS float*)(lds + wave * 16384);
        for (int it = gw; it < CIMLA; it += NGW) if (!(it >= CI1 + CI2 + CI3 && it < CI1 + CI2 + CI3 + CI4)) conv_item(it, 0, ws, scr, lane);
        const u32x4 z = {0u, 0u, 0u, 0u};
        for (int e = bx * 512 + tid; e < 2 * 96 * 128; e += G * 512) { const int i = e / (96 * 128), f = e % (96 * 128);
            *(u32x4*)(ws + (i ? WS_W_MLA1 : WS_W_MLA0) + (size_t)672 * 2048 + (size_t)f * 16) = z; }
        const float* npre = ARG_IN(10); const float* xin0 = ARG_IN(0); const float* xin1 = ARG_IN(1); const float* adab = ARG_IN(9);
        {
            LAS float* scr = (LAS float*)(lds + wave * 16384);
            for (int it = gw; it < 2 * CI4; it += NGW) conv_item(CI1 + CI2 + CI3 + (it & (CI4 - 1)), it >= CI4 ? 1 : 0, ws, scr, lane);
        }
        {
            if (wave == 0) { unsigned sp = 0; unsigned* ctlw = (unsigned*)(ws + WS_CTL);
                while (__hip_atomic_load(ctlw + CW_ADA, __ATOMIC_RELAXED, __HIP_MEMORY_SCOPE_AGENT) < 48u) { __builtin_amdgcn_s_sleep(2);
                    if ((++sp & 1023u) == 0u) { if (__hip_atomic_load(ctlw + CW_TMO, __ATOMIC_RELAXED, __HIP_MEMORY_SCOPE_AGENT) || sp > (1u << 22)) { __hip_atomic_store(ctlw + CW_TMO, 1u, __ATOMIC_RELAXED, __HIP_MEMORY_SCOPE_AGENT); break; } } }
                __builtin_amdgcn_fence(__ATOMIC_ACQUIRE, "agent"); asm volatile("s_waitcnt vmcnt(0)" ::: "memory"); }
            __syncthreads();
        }
        {
            const float* npost0 = ARG_IN(11);
            for (int it = bx; it < 9; it += G) { const int l = 0, j = it;
                for (int c = tid * 4; c < 1024; c += NWAVES * 64 * 4) { float* cf = MOD + (size_t)(l * 9 + j) * 3072;
                    *(f32x4*)(cf + c) = mod_load(MODP, adab, l, j, 2048 + c) * *(const f32x4*)(npost0 + l * 1024 + c);
                    *(f32x4*)(cf + 1024 + c) = *(const f32x4*)(npre + l * 1024 + c) * (mod_load(MODP, adab, l, j, 1024 + c) + 1.f);
                    *(f32x4*)(cf + 2048 + c) = mod_load(MODP, adab, l, j, c); } }
        }
        for (int chunk = gw; chunk < R / 12; chunk += NGW) {
            int curm = -1; f32x4 cB[4], cC[4];
#pragma unroll
            for (int j = 0; j < 4; ++j) { cB[j] = (f32x4){0.f, 0.f, 0.f, 0.f}; cC[j] = cB[j]; }
            for (int rr = 0; rr < 12; rr += 2) {
                f32x4 v[2][4];
#pragma unroll
                for (int q = 0; q < 2; ++q) { const int row = chunk * 12 + rr + q; const float* xr = row < RP ? xin0 + (size_t)row * D : xin1 + (size_t)(row - RP) * D;
#pragma unroll
                    for (int j = 0; j < 4; ++j) v[q][j] = *(const f32x4*)(xr + 8 * lane + 512 * (j >> 1) + 4 * (j & 1)); }
#pragma unroll
                for (int q = 0; q < 2; ++q) { const int row = chunk * 12 + rr + q, midx = mod_index(row);
                    if (midx != curm) { curm = midx;
#pragma unroll
                        for (int j = 0; j < 4; ++j) { const int c = 8 * lane + 512 * (j >> 1) + 4 * (j & 1); const f32x4 g = *(const f32x4*)(npre + c), sc = mod_load(MODP, adab, 0, midx, 1024 + c); cB[j] = g * (sc + 1.f); cC[j] = mod_load(MODP, adab, 0, midx, c); } }
                    float ss = 0.f;
#pragma unroll
                    for (int j = 0; j < 4; ++j) ss += v[q][j][0] * v[q][j][0] + v[q][j][1] * v[q][j][1] + v[q][j][2] * v[q][j][2] + v[q][j][3] * v[q][j][3];
                    const float rstd = 1.f / sqrtf(wave_sum(ss) * (1.f / D) + EPS);
#pragma unroll
                    for (int j2 = 0; j2 < 2; ++j2) { const f32x4 ha = v[q][2 * j2] * rstd * cB[2 * j2] + cC[2 * j2], hc = v[q][2 * j2 + 1] * rstd * cB[2 * j2 + 1] + cC[2 * j2 + 1];
                        u32x4 w; w.x = pk2(ha[0], ha[1]); w.y = pk2(ha[2], ha[3]); w.z = pk2(hc[0], hc[1]); w.w = pk2(hc[2], hc[3]); *(u32x4*)(Hb + (size_t)row * D + 8 * lane + 512 * j2) = w; }
                }
            }
        }
    }
    END_PH();

    for (int l = 0; l < NL; ++l) {
        const int i = l >> 1;
        if ((l & 1) == 0) {
#define WM_BASE (ws + (i ? WS_W_MLA1 : WS_W_MLA0))
#define M_WinT ((const bf16*)WM_BASE)
#define M_WuqT ((const bf16*)(WM_BASE + SZ_WIN_MLA))
#define M_WukvT ((const bf16*)(WM_BASE + SZ_WIN_MLA + SZ_WUQ))
#define M_WpT ((const bf16*)(WM_BASE + SZ_WIN_MLA + SZ_WUQ + SZ_WUKV))
#define M_WoT ((const bf16*)(WM_BASE + SZ_WIN_MLA + SZ_WUQ + SZ_WUKV + SZ_WPOOL))
            if (IN_PH()) { PH_BEGIN();
                pg8::Gemm g{Hb, M_WinT, R, 2304, 1024, 1024}; pg8::StaticOrder S; S.init(R, 2304, G, bx);
                pg8::EpiMlaIn E{CQ, CKV, GAB, VP, KRF};
                pg8::gemm_phase<pg8::EpiMlaIn, true>(lds, g, S, E);
                if (l == 0) {
                    const float* cvec = ARG_IN(6); const float* cctx = ARG_IN(7); const float* ada_w = ARG_IN(8);
                    unsigned* qt = (unsigned*)(ws + WS_CTL) + CW_QH + 64; LAS float* scr = (LAS float*)(lds + wave * 16384);
                    constexpr int NCH_SWA = (CISWA + 7) / 8;
                    for (;;) {
                        __syncthreads();
                        if (tid == 0) MISC[0] = __hip_atomic_fetch_add(qt, 1u, __ATOMIC_RELAXED, __HIP_MEMORY_SCOPE_AGENT);
                        __syncthreads();
                        const int item = (int)MISC[0];
                        if (item >= 144 + 2 * NCH_SWA) break;
                        if (item < 144) ada_item(48 + item, cvec, cctx, ada_w, MODP, lds, tid, lane, wave);
                        else { const int c2 = item - 144, inst = c2 >= NCH_SWA ? 1 : 0, r2 = (c2 - inst * NCH_SWA) * 8 + wave; if (r2 < CISWA) conv_item(CIMLA + r2, inst, ws, scr, lane); }
                    }
                }
            }
            END_PH();
            if (IN_PH()) { PH_BEGIN();
                const float* gq = ARG_IN(13) + i * 384; const float* gkv = ARG_IN(14) + i * 256;
                const float* cckv = ARG_IN(2); const float* ckr = ARG_IN(3);
                if (l == 0) {
                    const float* npost0 = ARG_IN(11); const float* npre0 = ARG_IN(10); const float* adab = ARG_IN(9);
                    for (int it = bx; it < 27; it += G) { const int l2 = 1 + it / 9, j = it % 9;
                        for (int c = tid * 4; c < 1024; c += NWAVES * 64 * 4) { float* cf = MOD + (size_t)(l2 * 9 + j) * 3072;
                            *(f32x4*)(cf + c) = mod_load(MODP, adab, l2, j, 2048 + c) * *(const f32x4*)(npost0 + l2 * 1024 + c);
                            *(f32x4*)(cf + 1024 + c) = *(const f32x4*)(npre0 + l2 * 1024 + c) * (mod_load(MODP, adab, l2, j, 1024 + c) + 1.f);
                            *(f32x4*)(cf + 2048 + c) = mod_load(MODP, adab, l2, j, c); } }
                }
                const int half = 1 << (lane >> 4);
                float pm[16];
#pragma unroll
                for (int k = 0; k < 16; ++k) pm[k] = (k - 8 >= -half && k - 8 < half) ? 1.f : 0.f;
                f32x4 gq0 = {0.f, 0.f, 0.f, 0.f}, gq1 = gq0, gk0 = gq0, gk1 = gq0;
                if (lane < 48) { gq0 = *(const f32x4*)(gq + 8 * lane); gq1 = *(const f32x4*)(gq + 8 * lane + 4); }
                if (lane < 32) { gk0 = *(const f32x4*)(gkv + 8 * lane); gk1 = *(const f32x4*)(gkv + 8 * lane + 4); }
                for (int chunk = gw; chunk < R / 12; chunk += NGW) {
                    const int r0 = chunk * 12;
                    const int xl = r0 + 18; const int Bs = xl < RP ? (xl & ~255) : (xl >= R ? R : RP + ((xl - RP) & ~2047)); const bool hasB = Bs > r0 - 8;
                    u32x4 win[27];
#pragma unroll
                    for (int k = 0; k < 27; ++k) { int x = r0 - 8 + k; x = x < 0 ? 0 : (x >= R ? R - 1 : x); win[k] = *(const u32x4*)(VP + (size_t)x * 512 + 8 * lane); }
                    {
#pragma unroll
                        for (int hb = 0; hb < 2; ++hb) {
                            u32x4 wq[6], wk[6]; float kr[6];
#pragma unroll
                            for (int q = 0; q < 6; ++q) { const int row = r0 + 6 * hb + q; const bool prompt = row < RP; const int rk = prompt ? row : RP + ((row - RP) >> 11) * 2304 + ((row - RP) & 2047);
                                wq[q] = (u32x4){0u, 0u, 0u, 0u}; wk[q] = wq[q]; kr[q] = 0.f;
                                if (lane < 48) wq[q] = *(const u32x4*)(CQ + (size_t)row * 384 + 8 * lane);
                                if (lane < 32) { wk[q] = *(const u32x4*)(CKV + (size_t)rk * 256 + 8 * lane); kr[q] = KRF[(size_t)row * 32 + lane]; } }
#pragma unroll
                            for (int q = 0; q < 6; ++q) { const int row = r0 + 6 * hb + q; const bool prompt = row < RP; const int b = prompt ? row >> 8 : (row - RP) >> 11, t = prompt ? row & 255 : (row - RP) & 2047;
                                const int rk = prompt ? row : RP + b * 2304 + t;
                                { const u32x4 w = wq[q]; float v[8] = {bflo(w.x), bfhi(w.x), bflo(w.y), bfhi(w.y), bflo(w.z), bfhi(w.z), bflo(w.w), bfhi(w.w)}; float ss = 0.f;
#pragma unroll
                                  for (int e = 0; e < 8; ++e) ss += v[e] * v[e];
                                  const float rstd = 1.f / sqrtf(wave_sum(ss) * (1.f / 384.f) + EPS);
                                  if (lane < 48) { u32x4 o; o.x = pk2(v[0] * rstd * gq0[0], v[1] * rstd * gq0[1]); o.y = pk2(v[2] * rstd * gq0[2], v[3] * rstd * gq0[3]); o.z = pk2(v[4] * rstd * gq1[0], v[5] * rstd * gq1[1]); o.w = pk2(v[6] * rstd * gq1[2], v[7] * rstd * gq1[3]);
                                      *(u32x4*)(CQ + (size_t)row * 384 + 8 * lane) = o; } }
                                { const u32x4 w = wk[q]; float v[8] = {bflo(w.x), bfhi(w.x), bflo(w.y), bfhi(w.y), bflo(w.z), bfhi(w.z), bflo(w.w), bfhi(w.w)}; float ss = 0.f;
#pragma unroll
                                  for (int e = 0; e < 8; ++e) ss += v[e] * v[e];
                                  const float rstd = 1.f / sqrtf(wave_sum(ss) * (1.f / 256.f) + EPS);
                                  if (lane < 32) { const f32x4 y0 = {v[0] * rstd * gk0[0], v[1] * rstd * gk0[1], v[2] * rstd * gk0[2], v[3] * rstd * gk0[3]}, y1 = {v[4] * rstd * gk1[0], v[5] * rstd * gk1[1], v[6] * rstd * gk1[2], v[7] * rstd * gk1[3]};
                                      u32x4 o; o.x = pk2(y0[0], y0[1]); o.y = pk2(y0[2], y0[3]); o.z = pk2(y1[0], y1[1]); o.w = pk2(y1[2], y1[3]);
                                      *(u32x4*)(CKV + (size_t)rk * 256 + 8 * lane) = o;
                                      if (prompt) { float* st = out + OFF_CKV + ((size_t)(b * 2 + i) * 256 + t) * 256 + 8 * lane; *(f32x4*)st = y0; *(f32x4*)(st + 4) = y1; } } }
                                { const float kv = kr[q];
                                  const float pr = __int_as_float(__builtin_amdgcn_update_dpp(0, __float_as_int(kv), 0x128, 0xf, 0xf, true));
                                  if (lane < 32) { if (prompt) out[OFF_KR + ((size_t)(b * 2 + i) * 256 + t) * 32 + lane] = kv;
                                      const int part = lane >> 4, fi = lane & 7; const bool isx2 = (lane & 8) != 0; const float x1 = isx2 ? pr : kv, x2 = isx2 ? kv : pr;
                                      float o1 = x1, o2 = x2;
                                      if (!prompt) { const int pos = part ? (t & 63) : (t >> 6); const float cs = ROPE8[(pos * 8 + fi) * 2], sn = ROPE8[(pos * 8 + fi) * 2 + 1]; o1 = x1 * cs - x2 * sn; o2 = x1 * sn + x2 * cs; }
                                      KRB[(size_t)rk * 32 + (isx2 ? 16 : 0) + part * 8 + fi] = (bf16)f2bf(isx2 ? o2 : o1); } }
                            }
                            asm volatile("" ::: "memory");
                        }
                    }
#pragma unroll
                    for (int ri = 0; ri < 12; ++ri) {
                        const bool sideR = (r0 + ri) >= Bs;
                        float sA[8]; float cntf = 0.f;
#pragma unroll
                        for (int e = 0; e < 8; ++e) sA[e] = 0.f;
#pragma unroll
                        for (int k = 0; k < 16; ++k) { const int x = r0 + ri + k - 8; const bool valid = !hasB || ((x >= Bs) == sideR); const float m = valid ? pm[k] : 0.f; const u32x4 w = win[ri + k]; cntf += m;
                            sA[0] += bflo(w.x) * m; sA[1] += bfhi(w.x) * m; sA[2] += bflo(w.y) * m; sA[3] += bfhi(w.y) * m;
                            sA[4] += bflo(w.z) * m; sA[5] += bfhi(w.z) * m; sA[6] += bflo(w.w) * m; sA[7] += bfhi(w.w) * m; }
                        const float ic = 1.f / cntf; const u32x4 w = win[ri + 8];
                        bf16* gp = GAB + (size_t)(r0 + ri) * 1024 + 512 + 8 * lane; const u32x4 gg = *(const u32x4*)gp;
                        u32x4 o; o.x = pk2((sA[0] * ic - bflo(w.x)) * bflo(gg.x), (sA[1] * ic - bfhi(w.x)) * bfhi(gg.x)); o.y = pk2((sA[2] * ic - bflo(w.y)) * bflo(gg.y), (sA[3] * ic - bfhi(w.y)) * bfhi(gg.y));
                        o.z = pk2((sA[4] * ic - bflo(w.z)) * bflo(gg.z), (sA[5] * ic - bfhi(w.z)) * bfhi(gg.z)); o.w = pk2((sA[6] * ic - bflo(w.w)) * bflo(gg.w), (sA[7] * ic - bfhi(w.w)) * bfhi(gg.w));
                        *(u32x4*)gp = o;
                    }
                }
                for (int ci = gw; ci < 2048; ci += NGW) {
                    const int b = ci >> 8, p = ci & 255, rk = RP + b * 2304 + 2048 + p;
                    if (lane < 32) { const float* sp = cckv + ((size_t)(b * 2 + i) * 256 + p) * 256 + 8 * lane; const f32x4 y0 = *(const f32x4*)sp, y1 = *(const f32x4*)(sp + 4);
                        u32x4 o; o.x = pk2(y0[0], y0[1]); o.y = pk2(y0[2], y0[3]); o.z = pk2(y1[0], y1[1]); o.w = pk2(y1[2], y1[3]); *(u32x4*)(CKV + (size_t)rk * 256 + 8 * lane) = o; }
                    if (lane < 16) { const int part = lane >> 3, fi = lane & 7; const float* sp = ckr + ((size_t)(b * 2 + i) * 256 + p) * 32 + part * 16 + fi;
                        KRB[(size_t)rk * 32 + lane] = (bf16)f2bf(sp[0]); KRB[(size_t)rk * 32 + 16 + lane] = (bf16)f2bf(sp[8]); }
                }
            }
            END_PH();
            if (IN_PH()) { PH_BEGIN();
                { pg8::Gemm g{CQ, M_WuqT, R, 768, 384, 384}; pg8::StaticOrder S; S.init(R, 768, G, bx); pg8::EpiQ E{Hb, ROPE8}; pg8::gemm_phase<pg8::EpiQ, true>(lds, g, S, E); }
                if (bx >= 32) { pg8::Gemm g{CKV, M_WukvT, RK, 1024, 256, 256}; pg8::StaticOrder S; S.init(RK, 1024, G - 32, bx - 32); pg8::EpiBf16 E{KN, 512, 512, (size_t)(WS_V - WS_KN) / 2}; pg8::gemm_phase<pg8::EpiBf16, true>(lds, g, S, E); }
            }
            END_PH();
            if (IN_PH()) { PH_BEGIN();
                struct MlaMk { bf16 *hb, *kn, *vv, *gab, *krb; int wave;
                    __device__ __forceinline__ void operator()(int un, att::Desc& d) const {
                        d.n_b = 0; d.row_b = 0; d.key_b = 0; d.qpos = 0; d.sink2 = 0.f; d.has_sink = 0; d.k1 = krb;
                        int h, qrow, krow;
                        if (un < 512) { const int b = un >> 6, qb = un & 7; h = (un >> 3) & 7; qrow = RP + b * 2048 + qb * 256 + wave * 32; krow = RP + b * 2304; d.n_a = 36; }
                        else { const int v = un - 512, b = v >> 3; h = v & 7; qrow = b * 256 + wave * 32; krow = b * 256; d.n_a = 4; }
                        d.row_a = krow; d.qptr = hb + (size_t)qrow * 768 + h * 96; d.k0 = kn + h * 64; d.v = vv + h * 64; d.optr = gab + (size_t)qrow * 1024 + h * 64; } };
                const MlaMk mk{Hb, KN, VV, GAB, KRB, wave};
                att::attn_phase<0, MlaMk>((LAS char*)lds, mk, vcu, G, 768);
            }
            END_PH();
        } else {
#define WS_BASE (ws + (i ? WS_W_SWA1 : WS_W_SWA0))
#define S_WinT ((const bf16*)WS_BASE)
#define S_WoT ((const bf16*)(WS_BASE + SZ_WIN_SWA))
            if (IN_PH()) { PH_BEGIN();
                const float* ck = ARG_IN(4); const float* cv = ARG_IN(5);
                for (int e = bx * 512 + tid; e < 2 * 2048 * 32; e += G * 512) {
                    const int which = e / (2048 * 32), f = e % (2048 * 32), rowi = f >> 5, ch = f & 31, b = rowi >> 8, p = rowi & 255;
                    const float* s = (which ? cv : ck) + ((size_t)(b * 2 + i) * 256 + p) * 256 + 8 * ch; const f32x4 y0 = *(const f32x4*)s, y1 = *(const f32x4*)(s + 4);
                    u32x4 o; o.x = pk2(y0[0], y0[1]); o.y = pk2(y0[2], y0[3]); o.z = pk2(y1[0], y1[1]); o.w = pk2(y1[2], y1[3]);
                    *(u32x4*)((which ? SV : SK) + (size_t)(RP + b * 2304 + 2048 + p) * 256 + 8 * ch) = o;
                }
                pg8::Gemm g{Hb, S_WinT, R, 2560, 1024, 1024}; pg8::StaticOrder S; S.init(R, 2560, G, bx);
                pg8::EpiSwaIn E{SQ, SK, SV, GAB, out + OFF_K + (size_t)i * 65536, out + OFF_V + (size_t)i * 65536, ROPE16};
                pg8::gemm_phase<pg8::EpiSwaIn, true>(lds, g, S, E);
                if (l == 1) {
                    unsigned* qt = (unsigned*)(ws + WS_CTL) + CW_QH + 80; LAS float* scr = (LAS float*)(lds + wave * 16384);
                    constexpr int NCH_MLA = (CIMLA + 7) / 8;
                    for (;;) {
                        __syncthreads();
                        if (tid == 0) MISC[0] = __hip_atomic_fetch_add(qt, 1u, __ATOMIC_RELAXED, __HIP_MEMORY_SCOPE_AGENT);
                        __syncthreads();
                        const int item = (int)MISC[0];
                        if (item >= NCH_MLA) break;
                        const int r2 = item * 8 + wave; if (r2 < CIMLA && !(r2 >= CI1 + CI2 + CI3 && r2 < CI1 + CI2 + CI3 + CI4)) conv_item(r2, 1, ws, scr, lane);
                    }
                }
            }
            END_PH();
            if (IN_PH()) { PH_BEGIN();
                struct SwaMk { bf16 *sq, *sk, *sv, *gab; const float* sink; int wave, lane;
                    __device__ __forceinline__ void operator()(int un, att::Desc& d) const {
                        d.k1 = nullptr; d.has_sink = 1; d.n_a = 4;
                        int kvh, qrow, q0;
                        if (un < 1024) { const int b = un >> 7, blk = un & 31; kvh = (un >> 5) & 3; q0 = blk * 64; const int kb = RP + b * 2304;
                            qrow = RP + b * 2048 + q0 + (wave & 1) * 32; d.row_a = kb + 2048;
                            const int kfirst = q0 - 128 > 0 ? q0 - 128 : 0, klast = q0 + 128 < 2048 - 64 ? q0 + 128 : 2048 - 64;
                            d.key_b = kfirst; d.row_b = kb + kfirst; d.n_b = (klast - kfirst) / 64 + 1; }
                        else { const int v = un - 1024, b = v >> 4, blk = v & 3; kvh = (v >> 2) & 3; q0 = blk * 64; qrow = b * 256 + q0 + (wave & 1) * 32; d.row_a = b * 256; d.n_b = 0; d.row_b = 0; d.key_b = 0; }
                        const int head = kvh * 4 + (wave >> 1);
                        d.qpos = q0 + (wave & 1) * 32 + (lane & 31); d.sink2 = sink[head] * LOG2E;
                        d.qptr = sq + (size_t)qrow * 1024 + head * 64; d.k0 = sk + kvh * 64; d.v = sv + kvh * 64; d.optr = gab + (size_t)qrow * 1024 + head * 64; } };
                const SwaMk mk{SQ, SK, SV, GAB, ARG_IN(21) + i * 16, wave, lane};
                att::attn_phase<1, SwaMk>((LAS char*)lds, mk, vcu, G, 1536);
            }
            END_PH();
        }
        if (IN_PH()) { PH_BEGIN();
            unsigned* ctlw = (unsigned*)(ws + WS_CTL); unsigned* cnt = ctlw + CW_CNT + l * 2048; unsigned* qh = ctlw + CW_QH + l * 16; unsigned* tmo = ctlw + CW_TMO;
            {
                const bf16* WoT = (l & 1) ? (const bf16*)(ws + (i ? WS_W_SWA1 : WS_W_SWA0) + SZ_WIN_SWA) : (const bf16*)(ws + (i ? WS_W_MLA1 : WS_W_MLA0) + SZ_WIN_MLA + SZ_WUQ + SZ_WUKV + SZ_WPOOL);
                pg8::Gemm g{GAB, WoT, R, 1024, 1024, 1024}; pg8::PanelOrder S{G, vcu, 384}; pg8::EpiOutPub E{Hb, cnt};
                pg8::gemm_phase<pg8::EpiOutPub, true, pg8::PanelOrder>(lds, g, S, E);
            }
            const float* xin0 = ARG_IN(0); const float* xin1 = ARG_IN(1); const bool has_next = l + 1 < NL;
            const int panel = vcu >= 128 ? (vcu - 128) >> 1 : 64 + (vcu >> 2);
            const int rbase = vcu >= 128 ? panel * 256 + ((vcu - 128) & 1) * 128 : panel * 256 + (vcu & 3) * 64;
            const int nrw = vcu >= 128 ? 16 : 8;
#define WAIT_PANEL() do { if (wave == 0) { unsigned sp = 0; \
                while (__hip_atomic_load(cnt + 16 * panel, __ATOMIC_RELAXED, __HIP_MEMORY_SCOPE_AGENT) < 32u) { __builtin_amdgcn_s_sleep(2); \
                    if ((++sp & 1023u) == 0u) { if (__hip_atomic_load(tmo, __ATOMIC_RELAXED, __HIP_MEMORY_SCOPE_AGENT) || sp > (1u << 22)) { __hip_atomic_store(tmo, 1u, __ATOMIC_RELAXED, __HIP_MEMORY_SCOPE_AGENT); break; } } } \
                __builtin_amdgcn_fence(__ATOMIC_ACQUIRE, "agent"); asm volatile("s_waitcnt vmcnt(0)" ::: "memory"); } \
            __syncthreads(); } while (0)
            {
                const int row0 = rbase + wave * nrw, midx = mod_index(row0); const int ln = has_next ? l + 1 : l;
                const float* cf = MOD + (size_t)(l * 9 + midx) * 3072; const float* cfn = MOD + (size_t)(ln * 9 + midx) * 3072;
                f32x4 cA[4], cB[4], cC[4];
#pragma unroll
                for (int k = 0; k < 4; ++k) { const int c = 8 * lane + 512 * (k >> 1) + 4 * (k & 1); cA[k] = *(const f32x4*)(cf + c); cB[k] = *(const f32x4*)(cfn + 1024 + c); cC[k] = *(const f32x4*)(cfn + 2048 + c); }
#define FINAL_ROW(row, xv, ov) do { float ss = 0.f; \
                    _Pragma("unroll") for (int k = 0; k < 4; ++k) ss += ov[k][0] * ov[k][0] + ov[k][1] * ov[k][1] + ov[k][2] * ov[k][2] + ov[k][3] * ov[k][3]; \
                    const float rstd = 1.f / sqrtf(wave_sum(ss) * (1.f / D) + EPS); float s2 = 0.f; \
                    _Pragma("unroll") for (int k = 0; k < 4; ++k) { xv[k] = xv[k] + ov[k] * rstd * cA[k]; s2 += xv[k][0] * xv[k][0] + xv[k][1] * xv[k][1] + xv[k][2] * xv[k][2] + xv[k][3] * xv[k][3]; } \
                    if (has_next) { const float r2 = 1.f / sqrtf(wave_sum(s2) * (1.f / D) + EPS); \
                        _Pragma("unroll") for (int j2 = 0; j2 < 2; ++j2) { const f32x4 xa = xv[2 * j2], xc = xv[2 * j2 + 1]; \
                            u32x4 wx; wx.x = pk2(xa[0], xa[1]); wx.y = pk2(xa[2], xa[3]); wx.z = pk2(xc[0], xc[1]); wx.w = pk2(xc[2], xc[3]); \
                            *(u32x4*)((bf16*)out + (size_t)(row) * 2048 + 8 * lane + 512 * j2) = wx; \
                            const f32x4 ha = xa * r2 * cB[2 * j2] + cC[2 * j2], hc = xc * r2 * cB[2 * j2 + 1] + cC[2 * j2 + 1]; \
                            u32x4 wh; wh.x = pk2(ha[0], ha[1]); wh.y = pk2(ha[2], ha[3]); wh.z = pk2(hc[0], hc[1]); wh.w = pk2(hc[2], hc[3]); \
                            *(u32x4*)(Hb + (size_t)(row) * D + 8 * lane + 512 * j2) = wh; } \
                    } else { _Pragma("unroll") for (int k = 0; k < 4; ++k) *(f32x4*)(out + (size_t)(row) * D + 8 * lane + 512 * (k >> 1) + 4 * (k & 1)) = xv[k]; } } while (0)
#define UNPK(W_, LO_, HI_) do { const u32x4 t_ = (W_); LO_ = (f32x4){bflo(t_.x), bfhi(t_.x), bflo(t_.y), bfhi(t_.y)}; HI_ = (f32x4){bflo(t_.z), bfhi(t_.z), bflo(t_.w), bfhi(t_.w)}; } while (0)
                if (l == 0) {
                    WAIT_PANEL();
                    for (int rr = 0; rr < nrw; rr += 4) {
                        f32x4 xq[4][4]; u32x4 oq[4][2];
#pragma unroll
                        for (int q = 0; q < 4; ++q) { const int row = row0 + rr + q; const float* xr = row < RP ? xin0 + (size_t)row * D : xin1 + (size_t)(row - RP) * D;
#pragma unroll
                            for (int k = 0; k < 4; ++k) xq[q][k] = *(const f32x4*)(xr + 8 * lane + 512 * (k >> 1) + 4 * (k & 1));
#pragma unroll
                            for (int j2 = 0; j2 < 2; ++j2) oq[q][j2] = *(const u32x4*)(Hb + (size_t)row * D + 8 * lane + 512 * j2); }
#pragma unroll
                        for (int q = 0; q < 4; ++q) { f32x4 ov[4]; UNPK(oq[q][0], ov[0], ov[1]); UNPK(oq[q][1], ov[2], ov[3]); FINAL_ROW(row0 + rr + q, xq[q], ov); }
                    }
                } else {
                    u32x4 xw[8][2], ow[8][2];
#pragma unroll
                    for (int q = 0; q < 8; ++q)
#pragma unroll
                        for (int j2 = 0; j2 < 2; ++j2) xw[q][j2] = *(const u32x4*)((const bf16*)out + (size_t)(row0 + q) * 2048 + 8 * lane + 512 * j2);
                    WAIT_PANEL();
                    for (int rr = 0; rr < nrw; rr += 8) {
                        if (rr > 0) {
#pragma unroll
                            for (int q = 0; q < 8; ++q)
#pragma unroll
                                for (int j2 = 0; j2 < 2; ++j2) xw[q][j2] = *(const u32x4*)((const bf16*)out + (size_t)(row0 + rr + q) * 2048 + 8 * lane + 512 * j2);
                        }
#pragma unroll
                        for (int q = 0; q < 8; ++q)
#pragma unroll
                            for (int j2 = 0; j2 < 2; ++j2) ow[q][j2] = *(const u32x4*)(Hb + (size_t)(row0 + rr + q) * D + 8 * lane + 512 * j2);
#pragma unroll
                        for (int q = 0; q < 8; ++q) { f32x4 xv[4], ov[4]; UNPK(xw[q][0], xv[0], xv[1]); UNPK(xw[q][1], xv[2], xv[3]); UNPK(ow[q][0], ov[0], ov[1]); UNPK(ow[q][1], ov[2], ov[3]); FINAL_ROW(row0 + rr + q, xv, ov); }
                    }
                }
#undef FINAL_ROW
#undef UNPK
#undef WAIT_PANEL
            }
        }
        END_PH();
    }
#undef IN_PH
#undef END_PH
}


extern "C" void kernel_launch(void* const* d_in, const int* in_sizes, int n_in, void* d_out, int out_size, void* d_ws, size_t ws_size, hipStream_t stream) {
    static int grid = 0;
    if (grid == 0) {
        if (n_in != 23 || out_size != OUT_TOTAL || ws_size < WS_END) { fprintf(stderr, "kernel_launch: unexpected shapes (n_in %d out %d ws %zu)\n", n_in, out_size, ws_size); grid = -1; return; }
        int dev = 0, cus = 0;
        if (hipGetDevice(&dev) != hipSuccess || hipDeviceGetAttribute(&cus, hipDeviceAttributeMultiprocessorCount, dev) != hipSuccess) { grid = -1; return; }
        if (hipFuncSetAttribute((const void*)fwd_kernel, hipFuncAttributeMaxDynamicSharedMemorySize, LDS_BYTES) != hipSuccess) { fprintf(stderr, "kernel_launch: hipFuncSetAttribute failed\n"); grid = -1; return; }
        int per_cu = 0;
        if (hipOccupancyMaxActiveBlocksPerMultiprocessor(&per_cu, (const void*)fwd_kernel, NWAVES * 64, LDS_BYTES) != hipSuccess || per_cu < 1) { fprintf(stderr, "kernel_launch: occupancy query says %d\n", per_cu); }
        (void)hipGetLastError();
        grid = cus;
    }
    if (grid < 0) return;
    (void)hipMemsetAsync((char*)d_ws + WS_CTL, 0, CTL_ZERO_BYTES, stream);
    Args a{};
    for (int i = 0; i < 23; ++i) a.in[i] = (const float*)d_in[i];
    a.out = (float*)d_out; a.ws = (unsigned char*)d_ws;
#if MK_PER_PHASE
    for (int p = 0; p < N_PHASES; ++p) { a.ph_lo = p; a.ph_hi = p + 1; hipLaunchKernelGGL(fwd_kernel, dim3(grid), dim3(NWAVES * 64), LDS_BYTES, stream, a); }
#else
    a.ph_lo = 0; a.ph_hi = N_PHASES;
    hipLaunchKernelGGL(fwd_kernel, dim3(grid), dim3(NWAVES * 64), LDS_BYTES, stream, a);
#endif
}
```

```cpp
#include <hip/hip_runtime.h>
#pragma clang diagnostic ignored "-Winline-asm"
#include <cstdio>
#include <cstdint>

#ifndef MK_PER_PHASE
#define MK_PER_PHASE 0
#endif

#define GAS __attribute__((address_space(1)))
#define LAS __attribute__((address_space(3)))
typedef unsigned short bf16;
typedef short bf16x8 __attribute__((ext_vector_type(8)));
typedef short s16x4 __attribute__((ext_vector_type(4)));
typedef float f32x4 __attribute__((ext_vector_type(4)));
typedef float f32x2 __attribute__((ext_vector_type(2)));
typedef float f32x16 __attribute__((ext_vector_type(16)));
typedef unsigned u32x4 __attribute__((ext_vector_type(4)));
typedef unsigned u32x2 __attribute__((ext_vector_type(2)));
typedef __bf16 bf16x2_t __attribute__((ext_vector_type(2)));

constexpr int D = 1024, RP = 8192, RS = 16384, R = RP + RS;
constexpr int RK = RP + 8 * 2304;
constexpr int NL = 4;
constexpr float EPS = 1e-6f, LOG2E = 1.4426950408889634f;
constexpr float MLA_SC = 0.10206207261596577f * LOG2E;
constexpr float SWA_SC = 0.125f * LOG2E;
constexpr int OFF_CKV = 25165824, OFF_KR = 29360128, OFF_K = 29884416, OFF_V = 34078720, OUT_TOTAL = 38273024;

constexpr size_t MiB = 1u << 20;
constexpr size_t WS_CTL = 0, CTL_ZERO_BYTES = 128 * 1024;
constexpr int CW_CNT = 8192, CW_QH = 16384, CW_TMO = 17408, CW_ADA = 17424, CW_ACNT = 18432;
constexpr size_t WS_MOD = 1 * MiB;
constexpr size_t WS_ROPE8 = 1 * MiB + 512 * 1024;
constexpr size_t WS_ROPE16 = WS_ROPE8 + 4096;
constexpr size_t SZ_WIN_MLA = 2304ull * 1024 * 2, SZ_WUQ = 768ull * 384 * 2, SZ_WUKV = 1024ull * 256 * 2, SZ_WPOOL = 512ull * 512 * 2,
                 SZ_WOUT = 1024ull * 1024 * 2, SZ_WIN_SWA = 2560ull * 1024 * 2;
constexpr size_t WS_W = 2 * MiB;
constexpr size_t SZ_W_MLA = SZ_WIN_MLA + SZ_WUQ + SZ_WUKV + SZ_WPOOL + SZ_WOUT, SZ_W_SWA = SZ_WIN_SWA + SZ_WOUT;
constexpr size_t WS_W_MLA0 = WS_W, WS_W_MLA1 = WS_W + SZ_W_MLA, WS_W_SWA0 = WS_W + 2 * SZ_W_MLA, WS_W_SWA1 = WS_W_SWA0 + SZ_W_SWA;
static_assert(WS_W_SWA1 + SZ_W_SWA <= 34 * MiB, "weights");
constexpr size_t WS_H = 34 * MiB;
constexpr size_t WS_GAB = 82 * MiB;
constexpr size_t WS_CQ = 130 * MiB;
constexpr size_t WS_CKV = 148 * MiB;
constexpr size_t WS_KRB = 161 * MiB;
constexpr size_t WS_KRF = 163 * MiB;
constexpr size_t WS_KN = 166 * MiB;
constexpr size_t WS_V = 192 * MiB;
constexpr size_t WS_PO = 218 * MiB;
constexpr size_t WS_SK = 178 * MiB;
constexpr size_t WS_SV = 191 * MiB;
constexpr size_t WS_MODP = 254 * MiB;
constexpr size_t WS_END = 256 * MiB;

__device__ __forceinline__ unsigned f2bf(float f) { unsigned u = __builtin_bit_cast(unsigned, f); return (u + 0x7fffu + ((u >> 16) & 1u)) >> 16; }
__device__ __forceinline__ unsigned pk2(float lo, float hi) { f32x2 v = {lo, hi}; bf16x2_t b = __builtin_convertvector(v, bf16x2_t); return __builtin_bit_cast(unsigned, b); }
__device__ __forceinline__ float bflo(unsigned w) { return __uint_as_float(w << 16); }
__device__ __forceinline__ float bfhi(unsigned w) { return __uint_as_float(w & 0xffff0000u); }
__device__ __forceinline__ float silu_fast(float x) { return x * __builtin_amdgcn_rcpf(1.f + __builtin_amdgcn_exp2f(-x * LOG2E)); }
#define DPP_ADD(v, ctrl) ((v) + __int_as_float(__builtin_amdgcn_update_dpp(0, __float_as_int(v), (ctrl), 0xf, 0xf, true)))
__device__ __forceinline__ float wave_sum(float v) {
    v = DPP_ADD(v, 0xB1); v = DPP_ADD(v, 0x4E); v = DPP_ADD(v, 0x124); v = DPP_ADD(v, 0x128);
    { auto rr = __builtin_amdgcn_permlane16_swap(__float_as_uint(v), __float_as_uint(v), false, false); v = __uint_as_float(rr[0]) + __uint_as_float(rr[1]); }
    { auto rr = __builtin_amdgcn_permlane32_swap(__float_as_uint(v), __float_as_uint(v), false, false); v = __uint_as_float(rr[0]) + __uint_as_float(rr[1]); }
    return v;
}
#define LDS_WAIT() asm volatile("s_waitcnt lgkmcnt(0)" ::: "memory")
__device__ __forceinline__ int opaque_tid() { int t = threadIdx.x; asm volatile("" : "+v"(t)); return t; }

namespace pg8 {
typedef unsigned short bf16_t;
constexpr int BM = 256, BK = 64, HALF = 128, HTB = HALF * BK * 2, STAGE_BYTES = 8 * HTB, NXCD = 8, WGM = 8;
__host__ __device__ __forceinline__ int lds_byte(int r, int c) { const int st = (r >> 4) * 2 + (c >> 5), rr = r & 15, cc = c & 31, ob = rr * 64 + cc * 2; return st * 1024 + (ob ^ (((ob >> 9) & 1) << 5)); }
__host__ __device__ __forceinline__ void stage_rc(int b, int& Rr, int& C) { const int st = b / 1024, sb = b % 1024, swz = sb ^ (((sb >> 9) & 1) << 5); Rr = (st >> 1) * 16 + swz / 64; C = (st & 1) * 32 + (swz % 64) / 2; }
__host__ __device__ __forceinline__ int perm32(int rho) { const int n = rho >> 4, i = rho & 15; return 8 * (i >> 2) + 4 * n + (i & 3); }
struct Unit { int pm, pn; };
struct Gemm { const bf16_t* A; const bf16_t* Bt; int M, N, K, lda; };
struct StaticOrder {
    int nM, nN, nwg, G, c;
    __device__ void init(int M, int N, int G_, int c_) { nM = M / BM; nN = N / BM; nwg = nM * nN; G = G_; c = c_; }
    __device__ bool next(int i, Unit& u) const {
        const long L = (long)i * G + c; if (L >= nwg) return false;
        int wgid = (int)L; { const int q = nwg / NXCD, r = nwg % NXCD, xcd = wgid % NXCD, off = wgid / NXCD; wgid = (xcd < r ? xcd * (q + 1) : r * (q + 1) + (xcd - r) * q) + off; }
        const int nig = WGM * nN, gid = wgid / nig, fm = gid * WGM, gsz = (nM - fm) < WGM ? (nM - fm) : WGM;
        u.pm = fm + ((wgid % nig) % gsz); u.pn = (wgid % nig) / gsz; return true;
    }
};
struct SkipOrder { StaticOrder s; int skip;
    __device__ bool next(int i, Unit& u) const { if (!s.next(i, u)) return false; if (skip >= 0 && u.pn >= skip) ++u.pn; return true; } };
struct OneTile { int pm, pn;
    __device__ bool next(int i, Unit& u) const { if (i > 0) return false; u.pm = pm; u.pn = pn; return true; } };
struct PanelOrder {
    int G, v, nunits;
    __device__ bool next(int i, Unit& u) const { const int L = i * G + v; if (L >= nunits) return false; u.pm = L >> 2; u.pn = L & 3; return true; }
};
template <class Epi, bool ALIGN_EPI, class Sched = StaticOrder>
__device__ __forceinline__ void gemm_phase(LAS unsigned char* lds, const Gemm g, const Sched& S, const Epi& E) {
    const int tid = opaque_tid(), wid = __builtin_amdgcn_readfirstlane(tid >> 6), lane = tid & 63, wr = wid >> 2, wc = wid & 3, fr = lane & 15, fq = lane >> 4;
    const int K = g.K, nt = K / BK, lda = g.lda;
    unsigned voffA[2], voffB[2];
#pragma unroll
    for (int i = 0; i < 2; ++i) { int Rr, C; stage_rc(tid * 16 + i * 8192, Rr, C); const int Rb = Epi::PERM ? ((Rr & ~31) + perm32(Rr & 31)) : Rr;
        voffA[i] = (unsigned)(Rr * lda + C) * 2u; voffB[i] = (unsigned)(Rb * K + C) * 2u; }
    const size_t kstep = (size_t)(BK * 2);
    const size_t hA = (size_t)HALF * lda * 2, hB = (size_t)HALF * K * 2, tA = 2 * hA, tB = 2 * hB;
    const unsigned ldsw = (unsigned)wid * 1024u;
    const int aoff = lds_byte(wr * 64 + fr, fq * 8), boff = lds_byte(wc * 32 + fr, fq * 8);
#define PG8_SA(b, h) (((b) * 2 + (h)) * HTB)
#define PG8_SB(b, h) ((4 + (b) * 2 + (h)) * HTB)
#define PG8_STAGE(bufoff, gbase, voff) do { _Pragma("unroll") for (int _i = 0; _i < 2; ++_i) \
        __builtin_amdgcn_global_load_lds((const unsigned*)((const char*)(gbase) + (voff)[_i]), (LAS unsigned*)(lds + (bufoff) + ldsw + _i * 8192), 16, 0, 0); } while (0)
#define PG8_LDA(dst, b, h) do { _Pragma("unroll") for (int m = 0; m < 4; ++m) _Pragma("unroll") for (int k = 0; k < 2; ++k) dst[m][k] = *(const LAS bf16x8*)(lds + PG8_SA(b, h) + aoff + m * 2048 + k * 1024); } while (0)
#define PG8_LDB(dst, b, h) do { _Pragma("unroll") for (int n = 0; n < 2; ++n) _Pragma("unroll") for (int k = 0; k < 2; ++k) dst[n][k] = *(const LAS bf16x8*)(lds + PG8_SB(b, h) + boff + n * 2048 + k * 1024); } while (0)
#define PG8_MMA(ai, bj, At, Bt) do { __builtin_amdgcn_s_setprio(1); _Pragma("unroll") for (int m = 0; m < 4; ++m) _Pragma("unroll") for (int n = 0; n < 2; ++n) _Pragma("unroll") for (int k = 0; k < 2; ++k) \
        acc[ai][bj][m][n] = __builtin_amdgcn_mfma_f32_16x16x32_bf16(Bt[n][k], At[m][k], acc[ai][bj][m][n], 0, 0, 0); __builtin_amdgcn_s_setprio(0); } while (0)
#define PG8_WAIT_V(n) asm volatile("s_waitcnt vmcnt(" #n ")" ::: "memory")
#define PG8_WAIT_L(n) asm volatile("s_waitcnt lgkmcnt(" #n ")" ::: "memory")
#define PG8_BAR __builtin_amdgcn_s_barrier()
#define PG8_SCHED __builtin_amdgcn_sched_barrier(0)
    Unit cur, nxt; int ui = 0;
    if (!S.next(0, cur)) return;
    f32x4 acc[2][2][4][2];
#pragma unroll
    for (int a = 0; a < 2; ++a)
#pragma unroll
        for (int b = 0; b < 2; ++b)
#pragma unroll
            for (int m = 0; m < 4; ++m)
#pragma unroll
                for (int n = 0; n < 2; ++n) acc[a][b][m][n] = (f32x4){0.f, 0.f, 0.f, 0.f};
    const char* cA = (const char*)g.A + (size_t)cur.pm * tA; const char* cB = (const char*)g.Bt + (size_t)cur.pn * tB;
    PG8_STAGE(PG8_SB(0, 0), cB, voffB); PG8_STAGE(PG8_SB(0, 1), cB + hB, voffB); PG8_STAGE(PG8_SA(0, 0), cA, voffA); PG8_STAGE(PG8_SA(0, 1), cA + hA, voffA);
    if (wr == 1) PG8_BAR;
    PG8_WAIT_V(2); PG8_BAR;
    PG8_STAGE(PG8_SB(1, 0), cB + kstep, voffB); PG8_STAGE(PG8_SA(1, 0), cA + kstep, voffA); PG8_STAGE(PG8_SB(1, 1), cB + hB + kstep, voffB);
    PG8_WAIT_V(6); PG8_BAR;
    for (;;) {
        const bool has_next = S.next(ui + 1, nxt);
        const char* nA = has_next ? (const char*)g.A + (size_t)nxt.pm * tA : cA; const char* nB = has_next ? (const char*)g.Bt + (size_t)nxt.pn * tB : cB;
#pragma nounroll
        for (int t = 0; t < nt; t += 2) {
            const bool last = (t == nt - 2);
            bf16x8 At[4][2], B0[2][2], B1[2][2];
            const char* a1 = cA + (size_t)(t + 1) * kstep;
            const char* a2 = last ? nA : cA + (size_t)(t + 2) * kstep; const char* b2 = last ? nB : cB + (size_t)(t + 2) * kstep;
            const char* a3 = a2 + kstep; const char* b3 = b2 + kstep;
            PG8_LDB(B0, 0, 0); PG8_LDB(B1, 0, 1); PG8_SCHED; PG8_LDA(At, 0, 0); PG8_STAGE(PG8_SA(1, 1), a1 + hA, voffA);
            PG8_WAIT_V(8); PG8_WAIT_L(0); PG8_BAR; PG8_MMA(0, 0, At, B0); PG8_MMA(0, 1, At, B1); PG8_BAR; PG8_SCHED;
            PG8_LDA(At, 0, 1); PG8_STAGE(PG8_SB(0, 0), b2, voffB); PG8_STAGE(PG8_SB(0, 1), b2 + hB, voffB); PG8_STAGE(PG8_SA(0, 0), a2, voffA);
            PG8_WAIT_V(8); PG8_WAIT_L(0); PG8_BAR; PG8_MMA(1, 0, At, B0); PG8_MMA(1, 1, At, B1); PG8_BAR; PG8_SCHED;
            PG8_LDB(B0, 1, 0); PG8_LDB(B1, 1, 1); PG8_SCHED; PG8_LDA(At, 1, 0); PG8_STAGE(PG8_SA(0, 1), a2 + hA, voffA);
            PG8_WAIT_V(8); PG8_WAIT_L(0); PG8_BAR; PG8_MMA(0, 0, At, B0); PG8_MMA(0, 1, At, B1); PG8_BAR; PG8_SCHED;
            PG8_LDA(At, 1, 1); PG8_STAGE(PG8_SB(1, 0), b3, voffB); PG8_STAGE(PG8_SB(1, 1), b3 + hB, voffB); PG8_STAGE(PG8_SA(1, 0), a3, voffA);
            PG8_WAIT_V(8); PG8_WAIT_L(0); PG8_BAR; PG8_MMA(1, 0, At, B0); PG8_MMA(1, 1, At, B1); PG8_BAR; PG8_SCHED;
        }
        if constexpr (ALIGN_EPI) { if (wr == 0) PG8_BAR; }
        E(acc, cur, wr, wc, fr, fq);
        if (!has_next) break;
#pragma unroll
        for (int a = 0; a < 2; ++a)
#pragma unroll
            for (int b = 0; b < 2; ++b)
#pragma unroll
                for (int m = 0; m < 4; ++m)
#pragma unroll
                    for (int n = 0; n < 2; ++n) acc[a][b][m][n] = (f32x4){0.f, 0.f, 0.f, 0.f};
        cur = nxt; cA = nA; cB = nB; ++ui;
        if constexpr (ALIGN_EPI) { if (wr == 1) PG8_BAR; }
    }
    PG8_WAIT_V(0);
    if constexpr (!ALIGN_EPI) { if (wr == 0) PG8_BAR; }
    PG8_BAR;
#undef PG8_SA
#undef PG8_SB
#undef PG8_STAGE
#undef PG8_LDA
#undef PG8_LDB
#undef PG8_MMA
#undef PG8_WAIT_V
#undef PG8_WAIT_L
#undef PG8_BAR
#undef PG8_SCHED
}

__device__ __forceinline__ int rk_base(int pm) { return pm < 32 ? pm * 256 : RP + ((pm - 32) >> 3) * 2304 + ((pm - 32) & 7) * 256; }

struct EpiBf16 {
    static constexpr bool PERM = true;
    bf16* O; int ldc; int split_cols; size_t split_stride;
    __device__ __forceinline__ void operator()(const f32x4 (&acc)[2][2][4][2], const Unit& u, int wr, int wc, int fr, int fq) const {
        const int row0 = u.pm * BM + wr * 64 + fr; int colt = u.pn * BM; bf16* base = O;
        if (split_cols) { const int t = colt / split_cols; base += (size_t)t * split_stride; colt -= t * split_cols; }
        const int col0 = colt + wc * 32 + 8 * fq;
#pragma unroll
        for (int ai = 0; ai < 2; ++ai)
#pragma unroll
            for (int m = 0; m < 4; ++m) { bf16* rowp = base + (size_t)(row0 + ai * HALF + m * 16) * ldc + col0;
#pragma unroll
                for (int bj = 0; bj < 2; ++bj) { const f32x4 v0 = acc[ai][bj][m][0], v1 = acc[ai][bj][m][1];
                    u32x4 w; w.x = pk2(v0[0], v0[1]); w.y = pk2(v0[2], v0[3]); w.z = pk2(v1[0], v1[1]); w.w = pk2(v1[2], v1[3]);
                    *(u32x4*)(rowp + bj * HALF) = w; } }
    }
};
struct EpiOutPub {
    static constexpr bool PERM = true;
    bf16* O; unsigned* cnt;
    __device__ __forceinline__ void operator()(const f32x4 (&acc)[2][2][4][2], const Unit& u, int wr, int wc, int fr, int fq) const {
        const __amdgpu_buffer_rsrc_t rs = __builtin_amdgcn_make_buffer_rsrc((void*)O, (short)0, R * 1024 * 2, 0x00020000);
        const int row0 = u.pm * BM + wr * 64 + fr; const int col0 = u.pn * BM + wc * 32 + 8 * fq;
#pragma unroll
        for (int ai = 0; ai < 2; ++ai)
#pragma unroll
            for (int m = 0; m < 4; ++m) { const int off = ((row0 + ai * HALF + m * 16) * 1024 + col0) * 2;
#pragma unroll
                for (int bj = 0; bj < 2; ++bj) { const f32x4 v0 = acc[ai][bj][m][0], v1 = acc[ai][bj][m][1];
                    u32x4 w; w.x = pk2(v0[0], v0[1]); w.y = pk2(v0[2], v0[3]); w.z = pk2(v1[0], v1[1]); w.w = pk2(v1[2], v1[3]);
                    __builtin_amdgcn_raw_buffer_store_b128(w, rs, off + bj * HALF * 2, 0, 16); } }
        asm volatile("s_waitcnt vmcnt(0)" ::: "memory");
        if ((fr | fq) == 0) __hip_atomic_fetch_add(cnt + 16 * u.pm, 1u, __ATOMIC_RELAXED, __HIP_MEMORY_SCOPE_AGENT);
    }
};
struct EpiPool {
    static constexpr bool PERM = true;
    bf16* GB;
    __device__ __forceinline__ void operator()(const f32x4 (&acc)[2][2][4][2], const Unit& u, int wr, int wc, int fr, int fq) const {
        const int row0 = u.pm * BM + wr * 64 + fr; const int col0 = u.pn * BM + wc * 32 + 8 * fq;
#pragma unroll
        for (int ai = 0; ai < 2; ++ai)
#pragma unroll
            for (int m = 0; m < 4; ++m) { bf16* rowp = GB + (size_t)(row0 + ai * HALF + m * 16) * 1024 + col0;
#pragma unroll
                for (int bj = 0; bj < 2; ++bj) { const f32x4 v0 = acc[ai][bj][m][0], v1 = acc[ai][bj][m][1];
                    const u32x4 gg = *(const u32x4*)(rowp + bj * HALF);
                    u32x4 w;
                    w.x = pk2(v0[0] * silu_fast(bflo(gg.x)), v0[1] * silu_fast(bfhi(gg.x))); w.y = pk2(v0[2] * silu_fast(bflo(gg.y)), v0[3] * silu_fast(bfhi(gg.y)));
                    w.z = pk2(v1[0] * silu_fast(bflo(gg.z)), v1[1] * silu_fast(bfhi(gg.z))); w.w = pk2(v1[2] * silu_fast(bflo(gg.w)), v1[3] * silu_fast(bfhi(gg.w)));
                    *(u32x4*)(rowp + bj * HALF) = w; } }
    }
};
struct EpiMlaIn {
    static constexpr bool PERM = true;
    bf16 *CQ, *CKV, *GAB, *VP; float* KRF;
    __device__ __forceinline__ void operator()(const f32x4 (&acc)[2][2][4][2], const Unit& u, int wr, int wc, int fr, int fq) const {
        const int rt = wr * 64 + fr, grow0 = u.pm * BM, rk0 = rk_base(u.pm), cc = wc * 32 + 8 * fq;
#pragma unroll
        for (int bj = 0; bj < 2; ++bj) {
            const int U = 2 * u.pn + bj;
            if (U == 5) {
                if (wc == 0) {
#pragma unroll
                    for (int ai = 0; ai < 2; ++ai)
#pragma unroll
                        for (int m = 0; m < 4; ++m) { float* p = KRF + (size_t)(grow0 + rt + ai * HALF + m * 16) * 32 + 8 * fq;
                            *(f32x4*)p = acc[ai][bj][m][0]; *(f32x4*)(p + 4) = acc[ai][bj][m][1]; }
                }
                continue;
            }
            bf16* p; int ld, rb = grow0;
            if (U < 3) { p = CQ + 128 * U; ld = 384; }
            else if (U < 5) { p = CKV + 128 * (U - 3); ld = 256; rb = rk0; }
            else if (U < 10) { p = GAB + 128 * (U - 6); ld = 1024; }
            else if (U < 14) { p = VP + 128 * (U - 10); ld = 512; }
            else { p = GAB + 512 + 128 * (U - 14); ld = 1024; }
            p += (size_t)(rb + rt) * ld + cc;
            const bool isgate = (U >= 6 && U < 10) || U >= 14;
#pragma unroll
            for (int ai = 0; ai < 2; ++ai)
#pragma unroll
                for (int m = 0; m < 4; ++m) { f32x4 v0 = acc[ai][bj][m][0], v1 = acc[ai][bj][m][1];
                    if (isgate) { v0 = (f32x4){silu_fast(v0[0]), silu_fast(v0[1]), silu_fast(v0[2]), silu_fast(v0[3])}; v1 = (f32x4){silu_fast(v1[0]), silu_fast(v1[1]), silu_fast(v1[2]), silu_fast(v1[3])}; }
                    u32x4 w; w.x = pk2(v0[0], v0[1]); w.y = pk2(v0[2], v0[3]); w.z = pk2(v1[0], v1[1]); w.w = pk2(v1[2], v1[3]);
                    *(u32x4*)(p + (size_t)(ai * HALF + m * 16) * ld) = w; }
        }
    }
};
__device__ __forceinline__ void rope_perm(f32x4& a, f32x4& b, const float* tb) {
#pragma unroll
    for (int j = 0; j < 4; ++j) { auto rr = __builtin_amdgcn_permlane32_swap(__float_as_uint(a[j]), __float_as_uint(b[j]), false, false); a[j] = __uint_as_float(rr[0]); b[j] = __uint_as_float(rr[1]); }
    const f32x4 c0 = *(const f32x4*)tb, c1 = *(const f32x4*)(tb + 4);
    const f32x4 cs = {c0[0], c0[2], c1[0], c1[2]}, sn = {c0[1], c0[3], c1[1], c1[3]};
    const f32x4 o1 = a * cs - b * sn, o2 = a * sn + b * cs;
    a = o1; b = o2;
#pragma unroll
    for (int j = 0; j < 4; ++j) { auto rr = __builtin_amdgcn_permlane32_swap(__float_as_uint(a[j]), __float_as_uint(b[j]), false, false); a[j] = __uint_as_float(rr[0]); b[j] = __uint_as_float(rr[1]); }
}
struct EpiQ {
    static constexpr bool PERM = true;
    bf16* Q; const float* rope8;
    __device__ __forceinline__ void operator()(const f32x4 (&acc)[2][2][4][2], const Unit& u, int wr, int wc, int fr, int fq) const {
        const int rt = wr * 64 + fr, grow0 = u.pm * BM; const bool sample = u.pm >= 32; const int t0 = ((u.pm - 32) & 7) * 256;
#pragma unroll
        for (int bj = 0; bj < 2; ++bj) {
            const int g32 = 8 * u.pn + 4 * bj + wc; const bool rot = sample && (g32 % 3 == 2);
#pragma unroll
            for (int ai = 0; ai < 2; ++ai)
#pragma unroll
                for (int m = 0; m < 4; ++m) { const int r = rt + ai * HALF + m * 16; f32x4 x1 = acc[ai][bj][m][0], x2 = acc[ai][bj][m][1];
                    if (rot) { const int t = t0 + r, pos = (fq & 1) ? (t & 63) : (t >> 6); rope_perm(x1, x2, rope8 + (pos * 8 + ((fq >> 1) ? 4 : 0)) * 2); }
                    u32x4 w; w.x = pk2(x1[0], x1[1]); w.y = pk2(x1[2], x1[3]); w.z = pk2(x2[0], x2[1]); w.w = pk2(x2[2], x2[3]);
                    *(u32x4*)(Q + (size_t)(grow0 + r) * 768 + 32 * g32 + 8 * fq) = w; }
        }
    }
};
struct EpiSwaIn {
    static constexpr bool PERM = true;
    bf16 *Q, *K, *V, *G; float *stK, *stV; const float* rope16;
    __device__ __forceinline__ void operator()(const f32x4 (&acc)[2][2][4][2], const Unit& u, int wr, int wc, int fr, int fq) const {
        const int rt = wr * 64 + fr, grow0 = u.pm * BM, rk0 = rk_base(u.pm); const bool sample = u.pm >= 32; const int t0 = ((u.pm - 32) & 7) * 256;
        const int pn = u.pn;
#pragma unroll
        for (int bj = 0; bj < 2; ++bj) {
            const int cb = 128 * bj + 32 * wc + 8 * fq;
            const bool rot = sample && pn < 5;
#pragma unroll
            for (int ai = 0; ai < 2; ++ai)
#pragma unroll
                for (int m = 0; m < 4; ++m) { const int r = rt + ai * HALF + m * 16; f32x4 x1 = acc[ai][bj][m][0], x2 = acc[ai][bj][m][1];
                    if (rot) { const int t = t0 + r, pos = (wc & 1) ? (t & 63) : (t >> 6); rope_perm(x1, x2, rope16 + (pos * 16 + 8 * (fq & 1) + ((fq >> 1) ? 4 : 0)) * 2); }
                    bf16* p;
                    if (pn < 4) p = Q + (size_t)(grow0 + r) * 1024 + 256 * pn + cb;
                    else if (pn == 4) p = K + (size_t)(rk0 + r) * 256 + cb;
                    else if (pn == 5) p = V + (size_t)(rk0 + r) * 256 + cb;
                    else p = G + (size_t)(grow0 + r) * 1024 + 256 * (pn - 6) + cb;
                    if (pn >= 6) { x1 = (f32x4){silu_fast(x1[0]), silu_fast(x1[1]), silu_fast(x1[2]), silu_fast(x1[3])}; x2 = (f32x4){silu_fast(x2[0]), silu_fast(x2[1]), silu_fast(x2[2]), silu_fast(x2[3])}; }
                    if (!sample && (pn == 4 || pn == 5)) { float* st = (pn == 4 ? stK : stV) + (size_t)(u.pm * 2 * 256 + r) * 256 + cb; *(f32x4*)st = x1; *(f32x4*)(st + 4) = x2; }
                    u32x4 w; w.x = pk2(x1[0], x1[1]); w.y = pk2(x1[2], x1[3]); w.z = pk2(x2[0], x2[1]); w.w = pk2(x2[2], x2[3]);
                    *(u32x4*)p = w; }
        }
    }
};
}

typedef __attribute__((address_space(4))) const char* kptr_t;
__device__ __forceinline__ const void* arg_ptr(int k) { kptr_t ka = (kptr_t)__builtin_amdgcn_kernarg_segment_ptr(); asm volatile("" : "+s"(ka)); return *(const void* __attribute__((address_space(4)))*)(ka + 8 * k); }
#define ARG_IN(k) ((const float*)arg_ptr(k))
namespace att {
__device__ __forceinline__ int crow(int r, int hi) { return (r & 3) + 8 * (r >> 2) + 4 * hi; }
typedef short v4i16_t __attribute__((ext_vector_type(4)));
__device__ __forceinline__ s16x4 vtr(const LAS char* p) { return __builtin_bit_cast(s16x4, __builtin_amdgcn_ds_read_tr16_b64_v4i16((LAS v4i16_t*)p)); }
__device__ __forceinline__ float xhalf_max(float x) { auto rr = __builtin_amdgcn_permlane32_swap(__float_as_uint(x), __float_as_uint(x), false, false); return __builtin_fmaxf(__uint_as_float(rr[0]), __uint_as_float(rr[1])); }
__device__ __forceinline__ float xhalf_sum(float x) { auto rr = __builtin_amdgcn_permlane32_swap(__float_as_uint(x), __float_as_uint(x), false, false); return __uint_as_float(rr[0]) + __uint_as_float(rr[1]); }
#define SBAR() __builtin_amdgcn_sched_barrier(0)
#define PIN(x) asm volatile("" : "+v"(x))
__device__ __forceinline__ float max3f(float a, float b, float c) { float r; asm("v_max3_f32 %0, %1, %2, %3" : "=v"(r) : "v"(a), "v"(b), "v"(c)); return r; }
__device__ __forceinline__ float max2f(float a, float b) { float r; asm("v_max_f32_e32 %0, %1, %2" : "=v"(r) : "v"(a), "v"(b)); return r; }
struct Desc {
    const bf16* qptr;
    const bf16* k0;
    const bf16* k1;
    const bf16* v;
    int n_a, row_a, n_b, row_b, key_b;
    int qpos; float sink2; int has_sink; int panel;
    bf16* optr;
};
constexpr float THR = 8.f;
__device__ __forceinline__ int tile_row(const Desc& d, int t) { return t < d.n_a ? d.row_a + 64 * t : d.row_b + 64 * (t - d.n_a); }
template <int MODE, class MK, bool ADAPT>
__device__ __forceinline__ unsigned attn_phase(LAS char* lds, const MK& mk, int first, int stride, int nunits, unsigned* acnt, volatile LAS unsigned* flag) {
    constexpr int DQK = MODE == 0 ? 96 : 64, NCH = DQK / 8, ND0 = DQK / 16, KB = NCH * 1024, VOFF = 3 * KB, NG = 2 * ND0, NHELD = 8, NLATE = NG - NHELD, STG_OFF = VOFF + 2 * 8192;
    static_assert(STG_OFF + 8 * 32 * 272 <= 131072, "attention LDS map");
    constexpr int LDQ = MODE == 0 ? 768 : 1024, LDK0 = MODE == 0 ? 512 : 256, LDV = LDK0, LDO = 1024;
    int un = first; if (un >= nunits) return 0u;
    unsigned failbits = 0u; int uidx = 0;
    const int tid = opaque_tid(), lane = tid & 63, r32 = lane & 31, hi = lane >> 5; const int wid = __builtin_amdgcn_readfirstlane(tid >> 6);
    const int kdst = wid * 1024, k1dst = (8 + (wid & 3)) * 1024, vdst = VOFF + wid * 1024;
    const int vlane = ((lane >> 4) & 1) * 32 + (lane & 3) * 8 + (4 * hi + ((lane & 15) >> 2)) * 64;
    const int kfo = hi * 1024 + r32 * 16;
    Desc d; mk(un, d);
    const unsigned kvo = (unsigned)(lane * LDK0 + wid * 8) * 2u, k1vo = (unsigned)(lane * 32 + (wid & 3) * 8) * 2u;
    const unsigned vvo = (unsigned)((16 * (wid & 3) + (lane >> 2)) * LDV + (wid >> 2) * 32 + (lane & 3) * 8) * 2u;
#define GLDS16(vo, sb, l) asm volatile("s_mov_b32 m0, %2\n\ts_nop 0\n\tglobal_load_lds_dwordx4 %0, %1" :: "v"(vo), "s"(sb), "s"((unsigned)(size_t)(l)) : "memory", "m0")
#define DMA_DRAIN() asm volatile("s_waitcnt vmcnt(0)" ::: "memory")
#define DMAK_(dd, t, soff) do { const size_t _r = (size_t)tile_row(dd, t); GLDS16(kvo, (dd).k0 + _r * LDK0, lds + (soff) + kdst); if (MODE == 0 && wid < 4) GLDS16(k1vo, (dd).k1 + _r * 32, lds + (soff) + k1dst); } while (0)
#define DMAV_(dd, t, vslot) do { const size_t _r = (size_t)tile_row(dd, t); GLDS16(vvo, (dd).v + _r * LDV, lds + (vslot) * 8192 + vdst); } while (0)
#define DMAK(t, soff) DMAK_(d, t, soff)
#define DMAV(t, vslot) DMAV_(d, t, vslot)
    int sl_cur = 0, sl_nxt = KB, sl_fre = 2 * KB;
    int vpar = 0;
    DMAK(0, sl_cur); DMAK(1, sl_nxt); DMAV(0, vpar);
    bf16x8 qr[ND0];
#pragma unroll
    for (int d0 = 0; d0 < ND0; ++d0) qr[d0] = *(const bf16x8*)(d.qptr + (size_t)r32 * LDQ + d0 * 16 + hi * 8);
    DMA_DRAIN(); __syncthreads();
#define ROT() do { const int o_ = sl_cur; sl_cur = sl_nxt; sl_nxt = sl_fre; sl_fre = o_; } while (0)
#define KFADDR(i, soff) (lds + (soff) + kfo + ((i) >> 1) * 2048 + ((i) & 1) * 512)
#define PE(P0, P1, e) ((e) < 16 ? P0[(e) & 15] : P1[(e) & 15])
#define FILL_A(P0, P1, g) do { \
        _Pragma("unroll") for (int e_ = (32 * (g)) / NG; e_ < (32 * ((g) + 1)) / NG; ++e_) sacc += PE(P0, P1, e_); \
        _Pragma("unroll") for (int k_ = (16 * (g)) / NG; k_ < (16 * ((g) + 1)) / NG; ++k_) { pw[k_ >> 2][k_ & 3] = pk2(PE(P0, P1, 2 * k_), PE(P0, P1, 2 * k_ + 1)); } } while (0)
#define QK_PHASE(C0, C1, P0, P1, HAVE_P) do { \
        bf16x8 kl_[NLATE > 0 ? NLATE : 1]; \
        _Pragma("unroll") for (int i_ = 0; i_ < NLATE; ++i_) kl_[i_] = *(const LAS bf16x8*)KFADDR(NHELD + i_, sl_cur); \
        _Pragma("unroll") for (int g_ = 0; g_ < NG; ++g_) { const int d0_ = g_ >> 1; \
            const bf16x8 kk_ = g_ < NHELD ? kf[g_ < NHELD ? g_ : 0] : kl_[g_ >= NHELD ? g_ - NHELD : 0]; \
            if ((g_ & 1) == 0) C0 = __builtin_amdgcn_mfma_f32_32x32x16_bf16(kk_, qr[d0_], d0_ == 0 ? (ADAPT ? negm : (f32x16){}) : C0, 0, 0, 0); \
            else C1 = __builtin_amdgcn_mfma_f32_32x32x16_bf16(kk_, qr[d0_], d0_ == 0 ? (ADAPT ? negm : (f32x16){}) : C1, 0, 0, 0); \
            if (g_ < NHELD) kf[g_ < NHELD ? g_ : 0] = *(const LAS bf16x8*)KFADDR(g_, sl_nxt); \
            if (HAVE_P) FILL_A(P0, P1, g_); \
            SBAR(); } } while (0)
#define MASKT(C0, C1, t_) do { if (MODE == 1 && (t_) >= d.n_a) { const int key0_ = d.key_b + 64 * ((t_) - d.n_a); \
        if (key0_ - (qb0 + 31) < -128 || key0_ + 63 - qb0 > 128) { const int k0p_ = key0_ - d.qpos; \
            _Pragma("unroll") for (int r = 0; r < 16; ++r) { const int d_ = k0p_ + crow(r, hi); if (d_ > 128 || d_ < -128) C0[r] = -1e30f; if (d_ + 32 > 128 || d_ + 32 < -128) C1[r] = -1e30f; } } } } while (0)
#define DECIDE(C0, C1) do { \
        float a_ = max2f(C0[0], C1[0]), b_ = max2f(C0[1], C1[1]); \
        _Pragma("unroll") for (int r = 2; r < 16; r += 2) { a_ = max3f(a_, C0[r], C1[r]); b_ = max3f(b_, C0[r + 1], C1[r + 1]); } \
        a_ = xhalf_max(max2f(a_, b_)); resc = false; \
        if (__any(a_ > THR)) { const float dl_ = fmaxf(a_, 0.f); mref += dl_; \
            _Pragma("unroll") for (int r = 0; r < 16; ++r) { C0[r] -= dl_; C1[r] -= dl_; } \
            _Pragma("unroll") for (int r = 0; r < 16; ++r) negm[r] = -mref; \
            fsc = __builtin_amdgcn_exp2f(-dl_); lsum *= fsc; resc = true; } } while (0)
#define EXP4(C0, C1, j) do { _Pragma("unroll") for (int e_ = 4 * (j); e_ < 4 * (j) + 4; ++e_) { if (e_ < 16) C0[e_ & 15] = __builtin_amdgcn_exp2f(C0[e_ & 15]); else C1[e_ & 15] = __builtin_amdgcn_exp2f(C1[e_ & 15]); } \
        if (4 * (j) < 16) PIN(C0); else PIN(C1); } while (0)
#define VOFFS(j) ((((j) & 1) * 4096) + (((j) >> 1) * 1024))
#define PV_PHASE(C0, C1, HAVE_C, HAVE_K, tp_) do { \
        const LAS char* vp_ = lds + VOFF + (((tp_) + vpar) & 1) * 8192 + vlane; \
        s16x4 vl_[8], vh_[8]; \
        vl_[0] = vtr(vp_ + VOFFS(0)); vh_[0] = vtr(vp_ + VOFFS(0) + 512); vl_[1] = vtr(vp_ + VOFFS(1)); vh_[1] = vtr(vp_ + VOFFS(1) + 512); \
        _Pragma("unroll") for (int j = 0; j < 8; ++j) { const int ks = j >> 1, dd = j & 1; \
            if (j + 2 < 8) { vl_[j + 2] = vtr(vp_ + VOFFS(j + 2)); vh_[j + 2] = vtr(vp_ + VOFFS(j + 2) + 512); } \
            const bf16x8 vf_ = {vl_[j][0], vl_[j][1], vl_[j][2], vl_[j][3], vh_[j][0], vh_[j][1], vh_[j][2], vh_[j][3]}; \
            if (dd == 0) o0 = __builtin_amdgcn_mfma_f32_32x32x16_bf16(vf_, __builtin_bit_cast(bf16x8, pw[ks]), o0, 0, 0, 0); \
            else o1 = __builtin_amdgcn_mfma_f32_32x32x16_bf16(vf_, __builtin_bit_cast(bf16x8, pw[ks]), o1, 0, 0, 0); \
            if (HAVE_C) EXP4(C0, C1, j); \
            SBAR(); } } while (0)
#define STEP(C0, C1, P0, P1, t_) do { \
        if ((t_) + 2 < NT) DMAK((t_) + 2, sl_fre); \
        DMAV(t_, ((t_) + vpar) & 1); \
        float sacc = 0.f; \
        QK_PHASE(C0, C1, P0, P1, true); \
        lsum += sacc; \
        MASKT(C0, C1, t_); \
        if (ADAPT) DECIDE(C0, C1); \
        SBAR(); \
        PV_PHASE(C0, C1, true, true, (t_) - 1); \
        DMA_DRAIN(); __syncthreads(); \
        ROT(); \
        if (resc) { o0 *= fsc; o1 *= fsc; } } while (0)
    for (;;) {
        const int NT = d.n_a + d.n_b;
        const int qb0 = __builtin_amdgcn_readfirstlane(d.qpos);
        float mref = 0.f, lsum = 0.f, fsc = 1.f; bool resc = false;
        f32x16 o0 = (f32x16){}, o1 = (f32x16){}, negm = (f32x16){};
        f32x16 cA0 = (f32x16){}, cA1 = (f32x16){}, cB0 = (f32x16){}, cB1 = (f32x16){};
        u32x4 pw[4];
#pragma unroll
        for (int i = 0; i < 4; ++i) pw[i] = (u32x4){0u, 0u, 0u, 0u};
        bf16x8 kf[NHELD];
#pragma unroll
        for (int i = 0; i < NHELD; ++i) kf[i] = *(const LAS bf16x8*)KFADDR(i, sl_cur);
        {
            if (2 < NT) DMAK(2, sl_fre);
            float sacc = 0.f; (void)sacc;
            QK_PHASE(cA0, cA1, cA0, cA1, false);
            MASKT(cA0, cA1, 0);
            if (ADAPT) DECIDE(cA0, cA1);
#pragma unroll
            for (int j = 0; j < 8; ++j) { EXP4(cA0, cA1, j); SBAR(); }
            DMA_DRAIN(); __syncthreads();
            ROT();
        }
        int t = 1;
        for (; t + 1 < NT; t += 2) { STEP(cB0, cB1, cA0, cA1, t); STEP(cA0, cA1, cB0, cB1, t + 1); }
        const bool odd_tail = t < NT;
        if (odd_tail) STEP(cB0, cB1, cA0, cA1, t);
        const int un_next = un + stride; const bool has_next = un_next < nunits;
        Desc dn = d;
        u32x4 gpre[4];
#pragma unroll
        for (int i2 = 0; i2 < 4; ++i2) gpre[i2] = *(const u32x4*)(d.optr + (size_t)(i2 * 8 + (lane >> 3)) * LDO + (lane & 7) * 8);
        bf16x8 qn[ND0];
#pragma unroll
        for (int d0 = 0; d0 < ND0; ++d0) qn[d0] = qr[d0];
        if (has_next) {
            mk(un_next, dn);
            DMAK_(dn, 0, sl_cur); DMAK_(dn, 1, sl_nxt); DMAV_(dn, 0, (NT + vpar) & 1);
#pragma unroll
            for (int d0 = 0; d0 < ND0; ++d0) qn[d0] = *(const bf16x8*)(dn.qptr + (size_t)r32 * LDQ + d0 * 16 + hi * 8);
        }
        if (odd_tail) {
            float sacc = 0.f;
#pragma unroll
            for (int g = 0; g < NG; ++g) FILL_A(cB0, cB1, g);
            lsum += sacc;
            PV_PHASE(cB0, cB1, false, false, NT - 1);
        } else {
            float sacc = 0.f;
#pragma unroll
            for (int g = 0; g < NG; ++g) FILL_A(cA0, cA1, g);
            lsum += sacc;
            PV_PHASE(cA0, cA1, false, false, NT - 1);
        }
        float lt = xhalf_sum(lsum);
        if (d.has_sink) lt += __builtin_amdgcn_exp2f(d.sink2 - mref);
        const float inv = 1.0f / lt;
        bool fail = false;
        if (!ADAPT) {
            const bool bad = !(lt > 8.7e-19f && lt < 1.2e30f);
            if (__any(bad) && lane == 0) flag[0] = 1u;
            __syncthreads();
            fail = flag[0] != 0u;
            if (fail) failbits |= 1u << uidx;
        }
        if (!fail) {
            LAS char* stg = lds + STG_OFF + wid * (32 * 272);
            const __amdgpu_buffer_rsrc_t ors = __builtin_amdgcn_make_buffer_rsrc((void*)d.optr, (short)0, 32 * LDO * 2, 0x00020000);
#pragma unroll
            for (int d0 = 0; d0 < 2; ++d0)
#pragma unroll
                for (int g = 0; g < 4; ++g) { const f32x16& o = d0 ? o1 : o0;
                    const f32x4 v = {o[4 * g] * inv, o[4 * g + 1] * inv, o[4 * g + 2] * inv, o[4 * g + 3] * inv};
                    *(LAS f32x4*)(stg + r32 * 272 + (32 * d0 + 8 * g + 4 * hi) * 4) = v; }
#pragma unroll
            for (int i2 = 0; i2 < 4; ++i2) { const int row = i2 * 8 + (lane >> 3), ch = lane & 7;
                const f32x4 va = *(const LAS f32x4*)(stg + row * 272 + ch * 32), vb = *(const LAS f32x4*)(stg + row * 272 + ch * 32 + 16);
                const u32x4 gg = gpre[i2];
                u32x4 w;
                w.x = pk2(va[0] * bflo(gg.x), va[1] * bfhi(gg.x)); w.y = pk2(va[2] * bflo(gg.y), va[3] * bfhi(gg.y));
                w.z = pk2(vb[0] * bflo(gg.z), vb[1] * bfhi(gg.z)); w.w = pk2(vb[2] * bflo(gg.w), vb[3] * bfhi(gg.w));
                __builtin_amdgcn_raw_buffer_store_b128(w, ors, (row * LDO + ch * 8) * 2, 0, 16); }
        }
        DMA_DRAIN();
        if (!fail && lane == 0) __hip_atomic_fetch_add(acnt + 16 * d.panel, 1u, __ATOMIC_RELAXED, __HIP_MEMORY_SCOPE_AGENT);
        __syncthreads();
        if (!ADAPT && fail && tid == 0) flag[0] = 0u;
        ++uidx;
        if (!has_next) break;
        vpar = (NT + vpar) & 1;
        d = dn; un = un_next;
#pragma unroll
        for (int d0 = 0; d0 < ND0; ++d0) qr[d0] = qn[d0];
    }
    return failbits;
#undef GLDS16
#undef DMA_DRAIN
#undef DMAK_
#undef DMAV_
#undef DMAK
#undef DMAV
#undef ROT
#undef KFADDR
#undef PE
#undef FILL_A
#undef QK_PHASE
#undef MASKT
#undef DECIDE
#undef EXP4
#undef VOFFS
#undef PV_PHASE
#undef STEP
}

template <int MODE, class MK>
__device__ __forceinline__ unsigned attn_stream_phase(LAS char* lds, const MK& mk, int first, int stride, int nunits, unsigned* acnt, volatile LAS unsigned* flag) {
    constexpr int DQK = MODE == 0 ? 96 : 64, NCH = DQK / 8, ND0 = DQK / 16, KB = NCH * 1024, VOFF = 3 * KB, NG = 2 * ND0, NHELD = 8, NLATE = NG - NHELD, STG_OFF = VOFF + 2 * 8192;
    static_assert(STG_OFF + 8 * 32 * 272 <= 131072, "attention LDS map");
    constexpr int LDQ = MODE == 0 ? 768 : 1024, LDK0 = MODE == 0 ? 512 : 256, LDV = LDK0, LDO = 1024;
    int un = first; if (un >= nunits) return 0u;
    unsigned failbits = 0u; int uidx = 0;
    const int tid = opaque_tid(), lane = tid & 63, r32 = lane & 31, hi = lane >> 5; const int wid = __builtin_amdgcn_readfirstlane(tid >> 6);
    const int kdst = wid * 1024, k1dst = (8 + (wid & 3)) * 1024, vdst = VOFF + wid * 1024;
    const int vlane = ((lane >> 4) & 1) * 32 + (lane & 3) * 8 + (4 * hi + ((lane & 15) >> 2)) * 64;
    const int kfo = hi * 1024 + r32 * 16;
    Desc d; mk(un, d);
    const unsigned kvo = (unsigned)(lane * LDK0 + wid * 8) * 2u, k1vo = (unsigned)(lane * 32 + (wid & 3) * 8) * 2u;
    const unsigned vvo = (unsigned)((16 * (wid & 3) + (lane >> 2)) * LDV + (wid >> 2) * 32 + (lane & 3) * 8) * 2u;
    const unsigned qvo = (unsigned)(r32 * LDQ + hi * 8) * 2u;
#define GLDS16(vo, sb, l) asm volatile("s_mov_b32 m0, %2\n\ts_nop 0\n\tglobal_load_lds_dwordx4 %0, %1" :: "v"(vo), "s"(sb), "s"((unsigned)(size_t)(l)) : "memory", "m0")
#define DMA_DRAIN() asm volatile("s_waitcnt vmcnt(0)" ::: "memory")
#define DMAK_(dd, t, soff) do { const size_t _r = (size_t)tile_row(dd, t); GLDS16(kvo, (dd).k0 + _r * LDK0, lds + (soff) + kdst); if (MODE == 0 && wid < 4) GLDS16(k1vo, (dd).k1 + _r * 32, lds + (soff) + k1dst); } while (0)
#define DMAV_(dd, t, vslot) do { const size_t _r = (size_t)tile_row(dd, t); GLDS16(vvo, (dd).v + _r * LDV, lds + (vslot) * 8192 + vdst); } while (0)
    int sl_cur = 0, sl_nxt = KB, sl_fre = 2 * KB;
    int vpar = 0;
    DMAK_(d, 0, sl_cur); DMAK_(d, 1, sl_nxt); DMAV_(d, 0, vpar);
    bf16x8 qr[ND0];
#pragma unroll
    for (int d0 = 0; d0 < ND0; ++d0) qr[d0] = *(const bf16x8*)(d.qptr + (size_t)r32 * LDQ + d0 * 16 + hi * 8);
    DMA_DRAIN(); __syncthreads();
#pragma unroll
    for (int d0 = 0; d0 < ND0; ++d0) PIN(qr[d0]);
#define ROT() do { const int o_ = sl_cur; sl_cur = sl_nxt; sl_nxt = sl_fre; sl_fre = o_; } while (0)
#define KFADDR(i, soff) (lds + (soff) + kfo + ((i) >> 1) * 2048 + ((i) & 1) * 512)
#define PE(P0, P1, e) ((e) < 16 ? P0[(e) & 15] : P1[(e) & 15])
#define FILL_A(P0, P1, g) do { \
        _Pragma("unroll") for (int e_ = (32 * (g)) / NG; e_ < (32 * ((g) + 1)) / NG; ++e_) sacc += PE(P0, P1, e_); \
        _Pragma("unroll") for (int k_ = (16 * (g)) / NG; k_ < (16 * ((g) + 1)) / NG; ++k_) { pw[k_ >> 2][k_ & 3] = pk2(PE(P0, P1, 2 * k_), PE(P0, P1, 2 * k_ + 1)); } } while (0)
#define QK_PHASE(C0, C1, P0, P1, HAVE_P) do { \
        bf16x8 kl_[NLATE > 0 ? NLATE : 1]; \
        _Pragma("unroll") for (int i_ = 0; i_ < NLATE; ++i_) kl_[i_] = *(const LAS bf16x8*)KFADDR(NHELD + i_, sl_cur); \
        _Pragma("unroll") for (int g_ = 0; g_ < NG; ++g_) { const int d0_ = g_ >> 1; \
            const bf16x8 kk_ = g_ < NHELD ? kf[g_ < NHELD ? g_ : 0] : kl_[g_ >= NHELD ? g_ - NHELD : 0]; \
            if ((g_ & 1) == 0) C0 = __builtin_amdgcn_mfma_f32_32x32x16_bf16(kk_, qr[d0_], d0_ == 0 ? (f32x16){} : C0, 0, 0, 0); \
            else C1 = __builtin_amdgcn_mfma_f32_32x32x16_bf16(kk_, qr[d0_], d0_ == 0 ? (f32x16){} : C1, 0, 0, 0); \
            if (g_ < NHELD) kf[g_ < NHELD ? g_ : 0] = *(const LAS bf16x8*)KFADDR(g_, sl_nxt); \
            if (HAVE_P) FILL_A(P0, P1, g_); \
            SBAR(); } } while (0)
#define MASKT(C0, C1, t_) do { if (MODE == 1 && (t_) >= d.n_a) { const int key0_ = d.key_b + 64 * ((t_) - d.n_a); \
        if (key0_ - (qb0 + 31) < -128 || key0_ + 63 - qb0 > 128) { const int k0p_ = key0_ - d.qpos; \
            _Pragma("unroll") for (int r = 0; r < 16; ++r) { const int d_ = k0p_ + crow(r, hi); if (d_ > 128 || d_ < -128) C0[r] = -1e30f; if (d_ + 32 > 128 || d_ + 32 < -128) C1[r] = -1e30f; } } } } while (0)
#define EXP4(C0, C1, j) do { _Pragma("unroll") for (int e_ = 4 * (j); e_ < 4 * (j) + 4; ++e_) { if (e_ < 16) C0[e_ & 15] = __builtin_amdgcn_exp2f(C0[e_ & 15]); else C1[e_ & 15] = __builtin_amdgcn_exp2f(C1[e_ & 15]); } \
        if (4 * (j) < 16) PIN(C0); else PIN(C1); } while (0)
#define VOFFS(j) ((((j) & 1) * 4096) + (((j) >> 1) * 1024))
#define PV_PHASE(C0, C1, HAVE_C, tp_) do { \
        const LAS char* vp_ = lds + VOFF + (((tp_) + vpar) & 1) * 8192 + vlane; \
        s16x4 vl_[8], vh_[8]; \
        vl_[0] = vtr(vp_ + VOFFS(0)); vh_[0] = vtr(vp_ + VOFFS(0) + 512); vl_[1] = vtr(vp_ + VOFFS(1)); vh_[1] = vtr(vp_ + VOFFS(1) + 512); \
        _Pragma("unroll") for (int j = 0; j < 8; ++j) { const int ks = j >> 1, dd = j & 1; \
            if (j + 2 < 8) { vl_[j + 2] = vtr(vp_ + VOFFS(j + 2)); vh_[j + 2] = vtr(vp_ + VOFFS(j + 2) + 512); } \
            const bf16x8 vf_ = {vl_[j][0], vl_[j][1], vl_[j][2], vl_[j][3], vh_[j][0], vh_[j][1], vh_[j][2], vh_[j][3]}; \
            if (dd == 0) o0 = __builtin_amdgcn_mfma_f32_32x32x16_bf16(vf_, __builtin_bit_cast(bf16x8, pw[ks]), o0, 0, 0, 0); \
            else o1 = __builtin_amdgcn_mfma_f32_32x32x16_bf16(vf_, __builtin_bit_cast(bf16x8, pw[ks]), o1, 0, 0, 0); \
            if (HAVE_C) EXP4(C0, C1, j); \
            SBAR(); } } while (0)
#define AFTER_DRAIN() do { if (pub) { if (lane == 0) __hip_atomic_fetch_add(acnt + 16 * pub_panel, 1u, __ATOMIC_RELAXED, __HIP_MEMORY_SCOPE_AGENT); pub = false; } } while (0)
#define AFTER_BAR() do { if (flag_up) { if (tid == 0) flag[0] = 0u; flag_up = false; } } while (0)
#define STEP(C0, C1, P0, P1, t_) do { \
        if ((t_) + 2 < NT) DMAK_(d, (t_) + 2, sl_fre); else if (has_next) DMAK_(dn, (t_) + 2 - NT, sl_fre); \
        DMAV_(d, t_, ((t_) + vpar) & 1); \
        float sacc = 0.f; \
        QK_PHASE(C0, C1, P0, P1, true); \
        lsum += sacc; \
        if ((t_) == NT - 1 && has_next) {     \
            _Pragma("unroll") for (int d0 = 0; d0 < ND0; ++d0) GLDS16(qvo, dn.qptr + d0 * 16, lds + STG_OFF + wid * (32 * 272) + d0 * 1024); } \
        MASKT(C0, C1, t_); \
        SBAR(); \
        PV_PHASE(C0, C1, true, (t_) - 1); \
        DMA_DRAIN(); AFTER_DRAIN(); __syncthreads(); AFTER_BAR(); \
        ROT(); } while (0)
#define EPILOGUE() do { \
        float lt = xhalf_sum(lsum); \
        if (p_has_sink) lt += __builtin_amdgcn_exp2f(p_sink2); \
        const float inv = 1.0f / lt; \
        const bool bad = !(lt > 8.7e-19f && lt < 1.2e30f); \
        if (__any(bad) && lane == 0) flag[0] = 1u; \
        __syncthreads(); \
        const bool fail = flag[0] != 0u; \
        if (fail) { failbits |= 1u << p_uidx; flag_up = true; } \
        if (!fail) { \
            LAS char* stg = lds + STG_OFF + wid * (32 * 272); \
            const __amdgpu_buffer_rsrc_t ors = __builtin_amdgcn_make_buffer_rsrc((void*)p_optr, (short)0, 32 * LDO * 2, 0x00020000); \
            _Pragma("unroll") for (int d0 = 0; d0 < 2; ++d0) _Pragma("unroll") for (int g = 0; g < 4; ++g) { const f32x16& o = d0 ? o1 : o0; \
                const f32x4 v = {o[4 * g] * inv, o[4 * g + 1] * inv, o[4 * g + 2] * inv, o[4 * g + 3] * inv}; \
                *(LAS f32x4*)(stg + r32 * 272 + (32 * d0 + 8 * g + 4 * hi) * 4) = v; } \
            _Pragma("unroll") for (int i2 = 0; i2 < 4; ++i2) { const int row = i2 * 8 + (lane >> 3), ch = lane & 7; \
                const f32x4 va = *(const LAS f32x4*)(stg + row * 272 + ch * 32), vb = *(const LAS f32x4*)(stg + row * 272 + ch * 32 + 16); \
                const u32x4 gg = gpre[i2]; \
                u32x4 w; \
                w.x = pk2(va[0] * bflo(gg.x), va[1] * bfhi(gg.x)); w.y = pk2(va[2] * bflo(gg.y), va[3] * bfhi(gg.y)); \
                w.z = pk2(vb[0] * bflo(gg.z), vb[1] * bfhi(gg.z)); w.w = pk2(vb[2] * bflo(gg.w), vb[3] * bfhi(gg.w)); \
                __builtin_amdgcn_raw_buffer_store_b128(w, ors, (row * LDO + ch * 8) * 2, 0, 16); } \
            pub = true; pub_panel = p_panel; } } while (0)
    f32x16 o0 = (f32x16){}, o1 = (f32x16){};
    f32x16 cA0 = (f32x16){}, cA1 = (f32x16){}, cB0 = (f32x16){}, cB1 = (f32x16){};
    u32x4 pw[4];
#pragma unroll
    for (int i = 0; i < 4; ++i) pw[i] = (u32x4){0u, 0u, 0u, 0u};
    bf16x8 kf[NHELD];
#pragma unroll
    for (int i = 0; i < NHELD; ++i) kf[i] = *(const LAS bf16x8*)KFADDR(i, sl_cur);
    float lsum = 0.f;
    bool have_prev = false, pub = false, flag_up = false; int pub_panel = 0;
    bf16* p_optr = d.optr; int p_panel = 0, p_has_sink = 0, p_uidx = 0; float p_sink2 = 0.f;
    for (;;) {
        const int NT = d.n_a + d.n_b;
        const int qb0 = __builtin_amdgcn_readfirstlane(d.qpos);
        const int un_next = un + stride; const bool has_next = un_next < nunits;
        Desc dn = d; if (has_next) mk(un_next, dn);
        if (have_prev) {
#pragma unroll
            for (int d0 = 0; d0 < ND0; ++d0) qr[d0] = *(const LAS bf16x8*)(lds + STG_OFF + wid * (32 * 272) + d0 * 1024 + lane * 16);
        }
        DMAK_(d, 2, sl_fre);
        if (!have_prev) {
            float sacc = 0.f; (void)sacc;
            QK_PHASE(cA0, cA1, cA0, cA1, false);
            MASKT(cA0, cA1, 0);
#pragma unroll
            for (int j = 0; j < 8; ++j) { EXP4(cA0, cA1, j); SBAR(); }
            DMA_DRAIN(); __syncthreads();
            ROT();
        } else {
            DMAV_(d, 0, vpar);
            float sacc = 0.f;
            QK_PHASE(cA0, cA1, cB0, cB1, true);
            lsum += sacc;
            u32x4 gpre[4];
#pragma unroll
            for (int i2 = 0; i2 < 4; ++i2) gpre[i2] = *(const u32x4*)(p_optr + (size_t)(i2 * 8 + (lane >> 3)) * LDO + (lane & 7) * 8);
            MASKT(cA0, cA1, 0);
            SBAR();
            PV_PHASE(cA0, cA1, true, -1);
            DMA_DRAIN(); AFTER_DRAIN(); __syncthreads(); AFTER_BAR();
            ROT();
            EPILOGUE();
            o0 = (f32x16){}; o1 = (f32x16){}; lsum = 0.f;
        }
        int t = 1;
        for (; t + 1 < NT; t += 2) { STEP(cB0, cB1, cA0, cA1, t); STEP(cA0, cA1, cB0, cB1, t + 1); }
        if (t < NT) { STEP(cB0, cB1, cA0, cA1, t); }
        else { cB0 = cA0; cB1 = cA1; }
        p_optr = d.optr; p_panel = d.panel; p_has_sink = d.has_sink; p_sink2 = d.sink2; p_uidx = uidx;
        if (!has_next) break;
        vpar = (NT + vpar) & 1;
        d = dn; un = un_next; have_prev = true; ++uidx;
    }
    {
        const int NT = d.n_a + d.n_b;
        u32x4 gpre[4];
#pragma unroll
        for (int i2 = 0; i2 < 4; ++i2) gpre[i2] = *(const u32x4*)(p_optr + (size_t)(i2 * 8 + (lane >> 3)) * LDO + (lane & 7) * 8);
        float sacc = 0.f;
#pragma unroll
        for (int g = 0; g < NG; ++g) FILL_A(cB0, cB1, g);
        lsum += sacc;
        PV_PHASE(cB0, cB1, false, NT - 1);
        AFTER_DRAIN();
        EPILOGUE();
        DMA_DRAIN(); AFTER_DRAIN(); __syncthreads(); AFTER_BAR();
    }
    return failbits;
#undef GLDS16
#undef DMA_DRAIN
#undef DMAK_
#undef DMAV_
#undef ROT
#undef KFADDR
#undef PE
#undef FILL_A
#undef QK_PHASE
#undef MASKT
#undef EXP4
#undef VOFFS
#undef PV_PHASE
#undef AFTER_DRAIN
#undef AFTER_BAR
#undef STEP
#undef EPILOGUE
}
#undef SBAR
}

#define XB_TMO      128
#define XB_XCNT(j)  (256  + 64 * (j))
#define XB_XSUB(j)  (1280 + 64 * (j))
#define XB_XGEN(j)  (2304 + 64 * (j))
#define XB_TOP      3328
#define XB_TOPGEN   3392
#define XCD_BAR_WORDS 3456
#define XB_SPIN_CAP (1u << 20)
__device__ __forceinline__ unsigned xb_ld(unsigned* p)              { return __hip_atomic_load(p, __ATOMIC_RELAXED, __HIP_MEMORY_SCOPE_AGENT); }
__device__ __forceinline__ unsigned xb_add(unsigned* p, unsigned v) { return __hip_atomic_fetch_add(p, v, __ATOMIC_RELAXED, __HIP_MEMORY_SCOPE_AGENT); }
__device__ __forceinline__ unsigned xb_xcc_id() { return (unsigned)__builtin_amdgcn_s_getreg((3 << 11) | 20) & 0xFu; }
#define XB_SPIN(cond, bar) do { unsigned _sp = 0; while (cond) { __builtin_amdgcn_s_sleep(1); \
    if ((++_sp & 255u) == 0u) { if (xb_ld(&(bar)[XB_TMO])) break; if (_sp > XB_SPIN_CAP) { atomicAdd(&(bar)[XB_TMO], 1u); break; } } } } while (0)
struct XcdBarrier { unsigned* bar; unsigned x; volatile LAS unsigned* st; };
__device__ __forceinline__ XcdBarrier xcd_barrier_post(unsigned* bar, volatile LAS unsigned* st) {
    XcdBarrier b; b.bar = bar; b.x = xb_xcc_id(); b.st = st;
    if (threadIdx.x == 0) (void)xb_add(&bar[XB_XCNT(b.x)], 1u);
    return b;
}
__device__ __forceinline__ void xcd_barrier_complete(unsigned* bar, unsigned x, unsigned& nloc, unsigned& nx) {
    const unsigned G = gridDim.x * gridDim.y * gridDim.z;
    unsigned sum, cnt, mine, sp = 0u;
    for (;;) {
        sum = 0u; cnt = 0u; mine = 0u;
#pragma unroll
        for (unsigned j = 0; j < 16; ++j) { const unsigned c = xb_ld(&bar[XB_XCNT(j)]); sum += c; cnt += (c > 0u) ? 1u : 0u; mine = (j == x) ? c : mine; }
        if (sum == G) break;
        __builtin_amdgcn_s_sleep(1);
        if ((++sp & 255u) == 0u) { if (xb_ld(&bar[XB_TMO])) break; if (sp > XB_SPIN_CAP) { atomicAdd(&bar[XB_TMO], 1u); break; } }
    }
    nloc = mine > 0u ? mine : 1u; nx = cnt > 0u ? cnt : 1u;
}
__device__ __forceinline__ void xcd_barrier(const XcdBarrier& b0) {
    asm volatile("s_waitcnt vmcnt(0)" ::: "memory");
    __syncthreads();
    if (threadIdx.x == 0) {
        XcdBarrier b = b0; b.x = xb_xcc_id();
        unsigned* bar = b.bar; asm volatile("" : "+s"(bar));
        asm volatile("buffer_inv sc1" ::: "memory");
        __builtin_amdgcn_s_waitcnt(0);
        unsigned nloc = b.st[0], nx = b.st[1];
        if (nloc == 0u) { xcd_barrier_complete(bar, b.x, nloc, nx); b.st[0] = nloc; b.st[1] = nx; }
        const unsigned old = xb_add(&bar[XB_XSUB(b.x)], 1u);
        const unsigned gen = old / nloc;
        if (old + 1u == (gen + 1u) * nloc) {
            __builtin_amdgcn_fence(__ATOMIC_RELEASE, "agent");
            asm volatile("s_waitcnt vmcnt(0)" ::: "memory");
            const unsigned og = xb_add(&bar[XB_TOP], 1u);
            const unsigned want = (og / nx + 1u) * nx;
            if (og + 1u != want) XB_SPIN(xb_ld(&bar[XB_TOP]) < want, bar);
            asm volatile("s_waitcnt vmcnt(0)" ::: "memory");
        } else {
            const unsigned want = (gen + 1u) * nx;
            XB_SPIN(xb_ld(&bar[XB_TOP]) < want, bar);
            asm volatile("s_waitcnt vmcnt(0)" ::: "memory");
        }
    }
    __syncthreads();
}

struct Args { const float* in[23]; float* out; unsigned char* ws; int ph_lo, ph_hi; };
constexpr int NWAVES = 8;
constexpr int N_PHASES = 1 + 4 + 2 + 4 + 2;
constexpr int RING_BYTES = 131072, MISC_OFF = RING_BYTES + 320, LDS_BYTES = 147456;

struct TMap { int kind, row_off, col_off, ldw; const float* nscale; float scale; };
__device__ __forceinline__ void tmap(const TMap& tm, int n, int& drow, float& sc) {
    drow = n + tm.row_off; sc = tm.scale;
    switch (tm.kind) {
        case 1: if (n >= 672) drow += 96; break;
        case 2: { const int e = n % 96; if (e >= 64) { const int d = e - 64; const int p = (d & 7) | ((d & 8) << 1) | ((d & 16) >> 1); drow = n - e + 64 + p; } } break;
        case 3: { const int h = n >> 7, e = n & 127; drow = (e < 64) ? h * 64 + e : 512 + h * 64 + (e - 64); } break;
        case 4: sc = tm.nscale[n]; break;
        case 5: if (n >= 1024) sc = 1.f; break;
        default: break;
    }
}
__device__ __forceinline__ void transpose_item(const float* W, int K, int N, bf16* WT, const TMap& tm, LAS float* scr, int item, int lane) {
    const int nblk = N / 32, kb = item / nblk, nb = item % nblk, k0 = 64 * kb, n0 = 32 * nb;
    f32x4 wv[8];
#pragma unroll
    for (int i = 0; i < 8; ++i) wv[i] = *(const f32x4*)(W + (size_t)(k0 + 8 * i + (lane >> 3)) * N + n0 + 4 * (lane & 7));
#pragma unroll
    for (int i = 0; i < 8; ++i) { LAS float* d = scr + (8 * i + (lane >> 3)) * 33 + 4 * (lane & 7); d[0] = wv[i][0]; d[1] = wv[i][1]; d[2] = wv[i][2]; d[3] = wv[i][3]; }
    LDS_WAIT(); asm volatile("" ::: "memory");
    const int c = lane & 7;
#pragma unroll
    for (int j = 0; j < 4; ++j) { const int n = (lane >> 3) + 8 * j; const LAS float* s = scr + (8 * c) * 33 + n;
        int drow; float sc; tmap(tm, n0 + n, drow, sc);
        u32x4 o; o.x = pk2(s[0 * 33] * sc, s[1 * 33] * sc); o.y = pk2(s[2 * 33] * sc, s[3 * 33] * sc); o.z = pk2(s[4 * 33] * sc, s[5 * 33] * sc); o.w = pk2(s[6 * 33] * sc, s[7 * 33] * sc);
        *(u32x4*)(WT + (size_t)drow * tm.ldw + tm.col_off + k0 + 8 * c) = o; }
    LDS_WAIT(); asm volatile("" ::: "memory");
}

__device__ __forceinline__ f32x4 mod_load(const float* MODPp, const float* ada_b, int l, int midx, int off) {
    f32x4 s = *(const f32x4*)(ada_b + l * 3072 + off);
#pragma unroll
    for (int kq = 0; kq < 4; ++kq) s += *(const f32x4*)(MODPp + ((size_t)((kq * 4 + l) * 9 + midx)) * 3072 + off);
    return s;
}
__device__ __forceinline__ void ada_item(int it, const float* cvec, const float* cctx, const float* ada_w, float* modp, LAS unsigned char* lds, int tid, int lane, int wave) {
    LAS float* red = (LAS float*)lds;
    const int l = it / 48, rem = it % 48, cc = rem >> 2, kq = rem & 3, k0 = kq * 256 + wave * 32;
    float sv[9];
#pragma unroll
    for (int j = 0; j < 9; ++j) { const float c = (j < 8) ? cvec[j * 1024 + k0 + (lane & 31)] : cctx[k0 + (lane & 31)]; sv[j] = c / (1.f + expf(-c)); }
    f32x4 acc[9];
#pragma unroll
    for (int j = 0; j < 9; ++j) acc[j] = (f32x4){0.f, 0.f, 0.f, 0.f};
    const float* wp = ada_w + ((size_t)l * 1024 + k0) * 3072 + cc * 256 + 4 * lane;
    f32x4 wv[32];
#pragma unroll
    for (int kk = 0; kk < 32; ++kk) wv[kk] = *(const f32x4*)(wp + (size_t)kk * 3072);
    asm volatile("" ::: "memory");
#pragma unroll
    for (int kk = 0; kk < 32; ++kk) {
#pragma unroll
        for (int j = 0; j < 9; ++j) { const float sc = __int_as_float(__builtin_amdgcn_readlane(__float_as_int(sv[j]), kk)); acc[j] += wv[kk] * sc; }
    }
#pragma unroll
    for (int j = 0; j < 9; ++j) *(LAS f32x4*)(red + (wave * 9 + j) * 256 + 4 * lane) = acc[j];
    __syncthreads();
    for (int idx = tid; idx < 9 * 256; idx += NWAVES * 64) { const int j = idx >> 8, col = idx & 255; float sm = 0.f;
#pragma unroll
        for (int w = 0; w < 8; ++w) sm += red[(w * 9 + j) * 256 + col];
        modp[((size_t)((kq * 4 + l) * 9 + j)) * 3072 + cc * 256 + col] = sm; }
    __syncthreads();
}
constexpr int CI1 = 1104, CI2 = 144, CI3 = 128, CI4 = 1024, CI5 = 512, CI6 = 1280, CI7 = 512, CIMLA = CI1 + CI2 + CI3 + CI4 + CI5, CISWA = CI6 + CI7;
__device__ __forceinline__ void conv_item(int r, int i, unsigned char* ws, LAS float* scr, int lane) {
    unsigned char* wm = ws + (i ? WS_W_MLA1 : WS_W_MLA0); unsigned char* wsw = ws + (i ? WS_W_SWA1 : WS_W_SWA0);
    if (r < CI1) { const int nb = r % 69; if (nb >= 37 && nb < 53) return;
        TMap tm{1, 0, 0, 1024, nullptr, 1.f}; transpose_item(ARG_IN(12) + (size_t)i * 1024 * 2208, 1024, 2208, (bf16*)wm, tm, scr, r, lane); return; } r -= CI1;
    if (r < CI2) { TMap tm{2, 0, 0, 384, nullptr, MLA_SC}; transpose_item(ARG_IN(15) + (size_t)i * 384 * 768, 384, 768, (bf16*)(wm + SZ_WIN_MLA), tm, scr, r, lane); return; } r -= CI2;
    if (r < CI3) { TMap tm{3, 0, 0, 256, nullptr, 1.f}; transpose_item(ARG_IN(16) + (size_t)i * 256 * 1024, 256, 1024, (bf16*)(wm + SZ_WIN_MLA + SZ_WUQ), tm, scr, r, lane); return; } r -= CI3;
    if (r < CI4) {
        const int g = r >> 8, kb = (r >> 4) & 15, eb = r & 15, k = kb * 64 + lane;
        const float* wi = ARG_IN(12) + (size_t)i * 1024 * 2208 + (size_t)k * 2208 + 1184 + g * 128;
        const float* wp = ARG_IN(17) + ((size_t)i * 4 + g) * 128 * 128 + eb * 8; const float* sp = ARG_IN(18) + i * 512 + g * 128 + eb * 8;
#pragma unroll
        for (int q = 0; q < 4; ++q) { const int c = 32 * q + (lane >> 1); *(LAS f32x4*)(scr + c * 8 + 4 * (lane & 1)) = *(const f32x4*)(wp + (size_t)c * 128 + 4 * (lane & 1)); }
        LDS_WAIT(); asm volatile("" ::: "memory");
        float acc[8];
#pragma unroll
        for (int e = 0; e < 8; ++e) acc[e] = 0.f;
#pragma nounroll
        for (int hc = 0; hc < 2; ++hc) {
            f32x4 arow[16];
#pragma unroll
            for (int q = 0; q < 16; ++q) arow[q] = *(const f32x4*)(wi + 64 * hc + 4 * q);
            const LAS float* sw = scr + 64 * hc * 8;
#pragma unroll
            for (int q = 0; q < 16; ++q) {
#pragma unroll
                for (int cc = 0; cc < 4; ++cc) { const float a = arow[q][cc];
                    const f32x4 w0 = *(const LAS f32x4*)(sw + (4 * q + cc) * 8), w1 = *(const LAS f32x4*)(sw + (4 * q + cc) * 8 + 4);
                    acc[0] += a * w0[0]; acc[1] += a * w0[1]; acc[2] += a * w0[2]; acc[3] += a * w0[3]; acc[4] += a * w1[0]; acc[5] += a * w1[1]; acc[6] += a * w1[2]; acc[7] += a * w1[3]; } }
        }
        bf16* dst = (bf16*)wm + (size_t)(1280 + g * 128 + eb * 8) * 1024 + k;
#pragma unroll
        for (int e = 0; e < 8; ++e) dst[(size_t)e * 1024] = (bf16)f2bf(acc[e] * sp[e]);
        LDS_WAIT(); asm volatile("" ::: "memory");
        return; } r -= CI4;
    if (r < CI5) { TMap tm{0, 0, 0, 1024, nullptr, 1.f}; transpose_item(ARG_IN(19) + (size_t)i * 1024 * 1024, 1024, 1024, (bf16*)(wm + SZ_WIN_MLA + SZ_WUQ + SZ_WUKV + SZ_WPOOL), tm, scr, r, lane); return; } r -= CI5;
    if (r < CI6) { TMap tm{5, 0, 0, 1024, nullptr, SWA_SC}; transpose_item(ARG_IN(20) + (size_t)i * 1024 * 2560, 1024, 2560, (bf16*)wsw, tm, scr, r, lane); return; } r -= CI6;
    { TMap tm{0, 0, 0, 1024, nullptr, 1.f}; transpose_item(ARG_IN(22) + (size_t)i * 1024 * 1024, 1024, 1024, (bf16*)(wsw + SZ_WIN_SWA), tm, scr, r, lane); }
}
__device__ __forceinline__ int mod_index(int row) { return row < RP ? 8 : ((row - RP) >> 11); }

__global__ void __launch_bounds__(NWAVES * 64, 2) fwd_kernel(Args args) {
    extern __shared__ __attribute__((aligned(16))) unsigned char lds_raw[];
    LAS unsigned char* lds = (LAS unsigned char*)lds_raw;
    volatile LAS unsigned* MISC = (volatile LAS unsigned*)(lds + MISC_OFF);
    const int G = gridDim.x; const int bx = blockIdx.x; const int vcu = (G % 8 == 0) ? (bx % 8) * (G / 8) + bx / 8 : bx;
    const int NGW = G * NWAVES;
    { const int tid0 = threadIdx.x; for (int u = tid0; u < (LDS_BYTES - RING_BYTES) / 4; u += NWAVES * 64) ((LAS unsigned*)(lds + RING_BYTES))[u] = 0u; }
    __syncthreads();
    XcdBarrier bar; bar.bar = (unsigned*)((unsigned char*)arg_ptr(24) + WS_CTL) + 1024; bar.x = 0; bar.st = nullptr;
    if (!MK_PER_PHASE) bar = xcd_barrier_post(bar.bar, MISC + 8);
    const int lo = MK_PER_PHASE ? args.ph_lo : 0, hi = MK_PER_PHASE ? args.ph_hi : N_PHASES;
    int pid = 0;
#define IN_PH() (lo <= pid && pid < hi)
#define END_PH() do { if (!MK_PER_PHASE && lo <= pid && pid + 1 < hi) xcd_barrier(bar); ++pid; } while (0)
#define PH_BEGIN() unsigned char* const ws = (unsigned char*)arg_ptr(24); float* const out = (float*)arg_ptr(23); \
    const int tid = opaque_tid(), lane = tid & 63, wave = __builtin_amdgcn_readfirstlane(tid >> 6), gw = vcu * NWAVES + wave; (void)out; (void)lane; (void)gw; (void)ws
#define MOD ((float*)(ws + WS_MOD))
#define ROPE8 ((float*)(ws + WS_ROPE8))
#define ROPE16 ((float*)(ws + WS_ROPE16))
#define MODP ((float*)(ws + WS_MODP))
#define Hb ((bf16*)(ws + WS_H))
#define GAB ((bf16*)(ws + WS_GAB))
#define CQ ((bf16*)(ws + WS_CQ))
#define CKV ((bf16*)(ws + WS_CKV))
#define KRB ((bf16*)(ws + WS_KRB))
#define KRF ((float*)(ws + WS_KRF))
#define KN ((bf16*)(ws + WS_KN))
#define VP ((bf16*)(ws + WS_KN))
#define VV ((bf16*)(ws + WS_V))
#define PO ((bf16*)(ws + WS_PO))
#define SQ ((bf16*)(ws + WS_CQ))
#define SK ((bf16*)(ws + WS_SK))
#define SV ((bf16*)(ws + WS_SV))

    if (IN_PH()) { PH_BEGIN();
        { const float* cvec = ARG_IN(6); const float* cctx = ARG_IN(7); const float* ada_w = ARG_IN(8);
          int nad = 0;
          for (int it = bx; it < 48; it += G) { ada_item(it, cvec, cctx, ada_w, MODP, lds, tid, lane, wave); ++nad; }
          if (nad) {
              __builtin_amdgcn_fence(__ATOMIC_RELEASE, "agent"); asm volatile("s_waitcnt vmcnt(0)" ::: "memory"); __syncthreads();
              if (tid == 0) __hip_atomic_fetch_add((unsigned*)(ws + WS_CTL) + CW_ADA, (unsigned)nad, __ATOMIC_RELEASE, __HIP_MEMORY_SCOPE_AGENT); } }
        for (int e = bx * 512 + tid; e < 64 * 8 + 64 * 16; e += G * 512) {
            if (e < 512) { const int pos = e >> 3, i = e & 7; const float inv = powf(10000.f, -(float)i / 8.f), a = (float)pos * inv; ROPE8[2 * e] = cosf(a); ROPE8[2 * e + 1] = sinf(a); }
            else { const int f = e - 512, pos = f >> 4, i = f & 15; const float inv = powf(10000.f, -(float)i / 16.f), a = (float)pos * inv; ROPE16[2 * f] = cosf(a); ROPE16[2 * f + 1] = sinf(a); }
        }
        LAS float* scr = (LAS float*)(lds + wave * 16384);
        for (int it = gw; it < CIMLA; it += NGW) if (!(it >= CI1 + CI2 + CI3 && it < CI1 + CI2 + CI3 + CI4)) conv_item(it, 0, ws, scr, lane);
        const u32x4 z = {0u, 0u, 0u, 0u};
        for (int e = bx * 512 + tid; e < 2 * 96 * 128; e += G * 512) { const int i = e / (96 * 128), f = e % (96 * 128);
            *(u32x4*)(ws + (i ? WS_W_MLA1 : WS_W_MLA0) + (size_t)672 * 2048 + (size_t)f * 16) = z; }
        const float* npre = ARG_IN(10); const float* xin0 = ARG_IN(0); const float* xin1 = ARG_IN(1); const float* adab = ARG_IN(9);
        {
            LAS float* scr = (LAS float*)(lds + wave * 16384);
            for (int it = gw; it < 2 * CI4; it += NGW) conv_item(CI1 + CI2 + CI3 + (it & (CI4 - 1)), it >= CI4 ? 1 : 0, ws, scr, lane);
        }
        {
            if (wave == 0) { unsigned sp = 0; unsigned* ctlw = (unsigned*)(ws + WS_CTL);
                asm volatile("buffer_inv sc1" ::: "memory");
                while (__hip_atomic_load(ctlw + CW_ADA, __ATOMIC_RELAXED, __HIP_MEMORY_SCOPE_AGENT) < 48u) { __builtin_amdgcn_s_sleep(2);
                    if ((++sp & 1023u) == 0u) { if (__hip_atomic_load(ctlw + CW_TMO, __ATOMIC_RELAXED, __HIP_MEMORY_SCOPE_AGENT) || sp > (1u << 22)) { __hip_atomic_store(ctlw + CW_TMO, 1u, __ATOMIC_RELAXED, __HIP_MEMORY_SCOPE_AGENT); break; } } }
                asm volatile("s_waitcnt vmcnt(0)" ::: "memory"); }
            __syncthreads();
        }
        {
            const float* npost0 = ARG_IN(11);
            for (int it = bx; it < 9; it += G) { const int l = 0, j = it;
                for (int c = tid * 4; c < 1024; c += NWAVES * 64 * 4) { float* cf = MOD + (size_t)(l * 9 + j) * 3072;
                    *(f32x4*)(cf + c) = mod_load(MODP, adab, l, j, 2048 + c) * *(const f32x4*)(npost0 + l * 1024 + c);
                    *(f32x4*)(cf + 1024 + c) = *(const f32x4*)(npre + l * 1024 + c) * (mod_load(MODP, adab, l, j, 1024 + c) + 1.f);
                    *(f32x4*)(cf + 2048 + c) = mod_load(MODP, adab, l, j, c); } }
        }
        for (int chunk = gw; chunk < R / 12; chunk += NGW) {
            int curm = -1; f32x4 cB[4], cC[4];
#pragma unroll
            for (int j = 0; j < 4; ++j) { cB[j] = (f32x4){0.f, 0.f, 0.f, 0.f}; cC[j] = cB[j]; }
            for (int rr = 0; rr < 12; rr += 2) {
                f32x4 v[2][4];
#pragma unroll
                for (int q = 0; q < 2; ++q) { const int row = chunk * 12 + rr + q; const float* xr = row < RP ? xin0 + (size_t)row * D : xin1 + (size_t)(row - RP) * D;
#pragma unroll
                    for (int j = 0; j < 4; ++j) v[q][j] = *(const f32x4*)(xr + 8 * lane + 512 * (j >> 1) + 4 * (j & 1)); }
#pragma unroll
                for (int q = 0; q < 2; ++q) { const int row = chunk * 12 + rr + q, midx = mod_index(row);
                    if (midx != curm) { curm = midx;
#pragma unroll
                        for (int j = 0; j < 4; ++j) { const int c = 8 * lane + 512 * (j >> 1) + 4 * (j & 1); const f32x4 g = *(const f32x4*)(npre + c), sc = mod_load(MODP, adab, 0, midx, 1024 + c); cB[j] = g * (sc + 1.f); cC[j] = mod_load(MODP, adab, 0, midx, c); } }
                    float ss = 0.f;
#pragma unroll
                    for (int j = 0; j < 4; ++j) ss += v[q][j][0] * v[q][j][0] + v[q][j][1] * v[q][j][1] + v[q][j][2] * v[q][j][2] + v[q][j][3] * v[q][j][3];
                    const float rstd = 1.f / sqrtf(wave_sum(ss) * (1.f / D) + EPS);
#pragma unroll
                    for (int j2 = 0; j2 < 2; ++j2) { const f32x4 ha = v[q][2 * j2] * rstd * cB[2 * j2] + cC[2 * j2], hc = v[q][2 * j2 + 1] * rstd * cB[2 * j2 + 1] + cC[2 * j2 + 1];
                        u32x4 w; w.x = pk2(ha[0], ha[1]); w.y = pk2(ha[2], ha[3]); w.z = pk2(hc[0], hc[1]); w.w = pk2(hc[2], hc[3]); *(u32x4*)(Hb + (size_t)row * D + 8 * lane + 512 * j2) = w; }
                }
            }
        }
    }
    END_PH();

    for (int l = 0; l < NL; ++l) {
        const int i = l >> 1;
        if ((l & 1) == 0) {
#define WM_BASE (ws + (i ? WS_W_MLA1 : WS_W_MLA0))
#define M_WinT ((const bf16*)WM_BASE)
#define M_WuqT ((const bf16*)(WM_BASE + SZ_WIN_MLA))
#define M_WukvT ((const bf16*)(WM_BASE + SZ_WIN_MLA + SZ_WUQ))
#define M_WpT ((const bf16*)(WM_BASE + SZ_WIN_MLA + SZ_WUQ + SZ_WUKV))
#define M_WoT ((const bf16*)(WM_BASE + SZ_WIN_MLA + SZ_WUQ + SZ_WUKV + SZ_WPOOL))
            if (IN_PH()) { PH_BEGIN();
                const bool split = l == 2;
                pg8::Gemm g{Hb, M_WinT, R, 2304, 1024, 1024}; pg8::SkipOrder S; S.s.init(R, split ? 2048 : 2304, G, bx); S.skip = split ? 4 : -1;
                pg8::EpiMlaIn E{CQ, CKV, GAB, VP, KRF};
                pg8::gemm_phase<pg8::EpiMlaIn, true, pg8::SkipOrder>(lds, g, S, E);
                if (l == 0) {
                    const float* cvec = ARG_IN(6); const float* cctx = ARG_IN(7); const float* ada_w = ARG_IN(8);
                    unsigned* qt = (unsigned*)(ws + WS_CTL) + CW_QH + 64; LAS float* scr = (LAS float*)(lds + wave * 16384);
                    constexpr int NCH_SWA = (CISWA + 7) / 8;
                    for (;;) {
                        __syncthreads();
                        if (tid == 0) MISC[0] = __hip_atomic_fetch_add(qt, 1u, __ATOMIC_RELAXED, __HIP_MEMORY_SCOPE_AGENT);
                        __syncthreads();
                        const int item = (int)MISC[0];
                        if (item >= 144 + 2 * NCH_SWA) break;
                        if (item < 144) ada_item(48 + item, cvec, cctx, ada_w, MODP, lds, tid, lane, wave);
                        else { const int c2 = item - 144, inst = c2 >= NCH_SWA ? 1 : 0, r2 = (c2 - inst * NCH_SWA) * 8 + wave; if (r2 < CISWA) conv_item(CIMLA + r2, inst, ws, scr, lane); }
                    }
                }
            }
            END_PH();
            if (IN_PH()) { PH_BEGIN();
                const float* gq = ARG_IN(13) + i * 384; const float* gkv = ARG_IN(14) + i * 256;
                const float* cckv = ARG_IN(2); const float* ckr = ARG_IN(3);
                if (l == 0) {
                    const float* npost0 = ARG_IN(11); const float* npre0 = ARG_IN(10); const float* adab = ARG_IN(9);
                    for (int it = bx; it < 27; it += G) { const int l2 = 1 + it / 9, j = it % 9;
                        for (int c = tid * 4; c < 1024; c += NWAVES * 64 * 4) { float* cf = MOD + (size_t)(l2 * 9 + j) * 3072;
                            *(f32x4*)(cf + c) = mod_load(MODP, adab, l2, j, 2048 + c) * *(const f32x4*)(npost0 + l2 * 1024 + c);
                            *(f32x4*)(cf + 1024 + c) = *(const f32x4*)(npre0 + l2 * 1024 + c) * (mod_load(MODP, adab, l2, j, 1024 + c) + 1.f);
                            *(f32x4*)(cf + 2048 + c) = mod_load(MODP, adab, l2, j, c); } }
                }
                const int half = 1 << (lane >> 4);
                float pm[16];
#pragma unroll
                for (int k = 0; k < 16; ++k) pm[k] = (k - 8 >= -half && k - 8 < half) ? 1.f : 0.f;
                f32x4 gq0 = {0.f, 0.f, 0.f, 0.f}, gq1 = gq0, gk0 = gq0, gk1 = gq0;
                if (lane < 48) { gq0 = *(const f32x4*)(gq + 8 * lane); gq1 = *(const f32x4*)(gq + 8 * lane + 4); }
                if (lane < 32) { gk0 = *(const f32x4*)(gkv + 8 * lane); gk1 = *(const f32x4*)(gkv + 8 * lane + 4); }
                for (int chunk = gw; chunk < R / 12; chunk += NGW) {
                    const int r0 = chunk * 12;
                    const int xl = r0 + 18; const int Bs = xl < RP ? (xl & ~255) : (xl >= R ? R : RP + ((xl - RP) & ~2047)); const bool hasB = Bs > r0 - 8;
                    u32x4 win[27];
#pragma unroll
                    for (int k = 0; k < 27; ++k) { int x = r0 - 8 + k; x = x < 0 ? 0 : (x >= R ? R - 1 : x); win[k] = *(const u32x4*)(VP + (size_t)x * 512 + 8 * lane); }
                    {
#pragma unroll
                        for (int hb = 0; hb < 2; ++hb) {
                            u32x4 wq[6], wk[6]; float kr[6];
#pragma unroll
                            for (int q = 0; q < 6; ++q) { const int row = r0 + 6 * hb + q; const bool prompt = row < RP; const int rk = prompt ? row : RP + ((row - RP) >> 11) * 2304 + ((row - RP) & 2047);
                                wq[q] = (u32x4){0u, 0u, 0u, 0u}; wk[q] = wq[q]; kr[q] = 0.f;
                                if (lane < 48) wq[q] = *(const u32x4*)(CQ + (size_t)row * 384 + 8 * lane);
                                if (lane < 32) { wk[q] = *(const u32x4*)(CKV + (size_t)rk * 256 + 8 * lane); kr[q] = KRF[(size_t)row * 32 + lane]; } }
#pragma unroll
                            for (int q = 0; q < 6; ++q) { const int row = r0 + 6 * hb + q; const bool prompt = row < RP; const int b = prompt ? row >> 8 : (row - RP) >> 11, t = prompt ? row & 255 : (row - RP) & 2047;
                                const int rk = prompt ? row : RP + b * 2304 + t;
                                { const u32x4 w = wq[q]; float v[8] = {bflo(w.x), bfhi(w.x), bflo(w.y), bfhi(w.y), bflo(w.z), bfhi(w.z), bflo(w.w), bfhi(w.w)}; float ss = 0.f;
#pragma unroll
                                  for (int e = 0; e < 8; ++e) ss += v[e] * v[e];
                                  const float rstd = 1.f / sqrtf(wave_sum(ss) * (1.f / 384.f) + EPS);
                                  if (lane < 48) { u32x4 o; o.x = pk2(v[0] * rstd * gq0[0], v[1] * rstd * gq0[1]); o.y = pk2(v[2] * rstd * gq0[2], v[3] * rstd * gq0[3]); o.z = pk2(v[4] * rstd * gq1[0], v[5] * rstd * gq1[1]); o.w = pk2(v[6] * rstd * gq1[2], v[7] * rstd * gq1[3]);
                                      *(u32x4*)(CQ + (size_t)row * 384 + 8 * lane) = o; } }
                                { const u32x4 w = wk[q]; float v[8] = {bflo(w.x), bfhi(w.x), bflo(w.y), bfhi(w.y), bflo(w.z), bfhi(w.z), bflo(w.w), bfhi(w.w)}; float ss = 0.f;
#pragma unroll
                                  for (int e = 0; e < 8; ++e) ss += v[e] * v[e];
                                  const float rstd = 1.f / sqrtf(wave_sum(ss) * (1.f / 256.f) + EPS);
                                  if (lane < 32) { const f32x4 y0 = {v[0] * rstd * gk0[0], v[1] * rstd * gk0[1], v[2] * rstd * gk0[2], v[3] * rstd * gk0[3]}, y1 = {v[4] * rstd * gk1[0], v[5] * rstd * gk1[1], v[6] * rstd * gk1[2], v[7] * rstd * gk1[3]};
                                      u32x4 o; o.x = pk2(y0[0], y0[1]); o.y = pk2(y0[2], y0[3]); o.z = pk2(y1[0], y1[1]); o.w = pk2(y1[2], y1[3]);
                                      *(u32x4*)(CKV + (size_t)rk * 256 + 8 * lane) = o;
                                      if (prompt) { float* st = out + OFF_CKV + ((size_t)(b * 2 + i) * 256 + t) * 256 + 8 * lane; *(f32x4*)st = y0; *(f32x4*)(st + 4) = y1; } } }
                                { const float kv = kr[q];
                                  const float pr = __int_as_float(__builtin_amdgcn_update_dpp(0, __float_as_int(kv), 0x128, 0xf, 0xf, true));
                                  if (lane < 32) { if (prompt) out[OFF_KR + ((size_t)(b * 2 + i) * 256 + t) * 32 + lane] = kv;
                                      const int part = lane >> 4, fi = lane & 7; const bool isx2 = (lane & 8) != 0; const float x1 = isx2 ? pr : kv, x2 = isx2 ? kv : pr;
                                      float o1 = x1, o2 = x2;
                                      if (!prompt) { const int pos = part ? (t & 63) : (t >> 6); const float cs = ROPE8[(pos * 8 + fi) * 2], sn = ROPE8[(pos * 8 + fi) * 2 + 1]; o1 = x1 * cs - x2 * sn; o2 = x1 * sn + x2 * cs; }
                                      KRB[(size_t)rk * 32 + (isx2 ? 16 : 0) + part * 8 + fi] = (bf16)f2bf(isx2 ? o2 : o1); } }
                            }
                            asm volatile("" ::: "memory");
                        }
                    }
#pragma unroll
                    for (int ri = 0; ri < 12; ++ri) {
                        const bool sideR = (r0 + ri) >= Bs;
                        float sA[8]; float cntf = 0.f;
#pragma unroll
                        for (int e = 0; e < 8; ++e) sA[e] = 0.f;
#pragma unroll
                        for (int k = 0; k < 16; ++k) { const int x = r0 + ri + k - 8; const bool valid = !hasB || ((x >= Bs) == sideR); const float m = valid ? pm[k] : 0.f; const u32x4 w = win[ri + k]; cntf += m;
                            sA[0] += bflo(w.x) * m; sA[1] += bfhi(w.x) * m; sA[2] += bflo(w.y) * m; sA[3] += bfhi(w.y) * m;
                            sA[4] += bflo(w.z) * m; sA[5] += bfhi(w.z) * m; sA[6] += bflo(w.w) * m; sA[7] += bfhi(w.w) * m; }
                        const float ic = 1.f / cntf; const u32x4 w = win[ri + 8];
                        bf16* gp = GAB + (size_t)(r0 + ri) * 1024 + 512 + 8 * lane; const u32x4 gg = *(const u32x4*)gp;
                        u32x4 o; o.x = pk2((sA[0] * ic - bflo(w.x)) * bflo(gg.x), (sA[1] * ic - bfhi(w.x)) * bfhi(gg.x)); o.y = pk2((sA[2] * ic - bflo(w.y)) * bflo(gg.y), (sA[3] * ic - bfhi(w.y)) * bfhi(gg.y));
                        o.z = pk2((sA[4] * ic - bflo(w.z)) * bflo(gg.z), (sA[5] * ic - bfhi(w.z)) * bfhi(gg.z)); o.w = pk2((sA[6] * ic - bflo(w.w)) * bflo(gg.w), (sA[7] * ic - bfhi(w.w)) * bfhi(gg.w));
                        *(u32x4*)gp = o;
                    }
                }
                for (int ci = gw; ci < 2048; ci += NGW) {
                    const int b = ci >> 8, p = ci & 255, rk = RP + b * 2304 + 2048 + p;
                    if (lane < 32) { const float* sp = cckv + ((size_t)(b * 2 + i) * 256 + p) * 256 + 8 * lane; const f32x4 y0 = *(const f32x4*)sp, y1 = *(const f32x4*)(sp + 4);
                        u32x4 o; o.x = pk2(y0[0], y0[1]); o.y = pk2(y0[2], y0[3]); o.z = pk2(y1[0], y1[1]); o.w = pk2(y1[2], y1[3]); *(u32x4*)(CKV + (size_t)rk * 256 + 8 * lane) = o; }
                    if (lane < 16) { const int part = lane >> 3, fi = lane & 7; const float* sp = ckr + ((size_t)(b * 2 + i) * 256 + p) * 32 + part * 16 + fi;
                        KRB[(size_t)rk * 32 + lane] = (bf16)f2bf(sp[0]); KRB[(size_t)rk * 32 + 16 + lane] = (bf16)f2bf(sp[8]); }
                }
            }
            END_PH();
            if (IN_PH()) { PH_BEGIN();
                const bool split = l == 2;
                if (split && bx >= 160) { pg8::Gemm g{Hb, M_WinT, R, 2304, 1024, 1024}; pg8::OneTile S{bx - 160, 4}; pg8::EpiMlaIn E{CQ, CKV, GAB, VP, KRF}; pg8::gemm_phase<pg8::EpiMlaIn, true, pg8::OneTile>(lds, g, S, E); }
                { pg8::Gemm g{CQ, M_WuqT, R, 768, 384, 384}; pg8::StaticOrder S; S.init(R, 768, G, split ? (bx + 160) % G : bx); pg8::EpiQ E{PO, ROPE8}; pg8::gemm_phase<pg8::EpiQ, true>(lds, g, S, E); }
                if (split ? bx < 160 : bx >= 32) { pg8::Gemm g{CKV, M_WukvT, RK, 1024, 256, 256}; pg8::StaticOrder S; S.init(RK, 1024, split ? 160 : G - 32, split ? bx : bx - 32); pg8::EpiBf16 E{KN, 512, 512, (size_t)(WS_V - WS_KN) / 2}; pg8::gemm_phase<pg8::EpiBf16, true>(lds, g, S, E); }
            }
            END_PH();
            if (IN_PH()) { PH_BEGIN();
                struct MlaMk { bf16 *hb, *kn, *vv, *gab, *krb; int wave;
                    __device__ __forceinline__ void operator()(int un, att::Desc& d) const {
                        d.n_b = 0; d.row_b = 0; d.key_b = 0; d.qpos = 0; d.sink2 = 0.f; d.has_sink = 0; d.k1 = krb;
                        int h, qrow, krow;
                        if (un < 512) { const int b = un >> 6, qb = un & 7; h = (un >> 3) & 7; qrow = RP + b * 2048 + qb * 256 + wave * 32; krow = RP + b * 2304; d.n_a = 36; }
                        else { const int v = un - 512, b = v >> 3; h = v & 7; qrow = b * 256 + wave * 32; krow = b * 256; d.n_a = 4; }
                        d.row_a = krow; d.qptr = hb + (size_t)qrow * 768 + h * 96; d.k0 = kn + h * 64; d.v = vv + h * 64; d.optr = gab + (size_t)qrow * 1024 + h * 64; d.panel = qrow >> 8; } };
                const MlaMk mk{PO, KN, VV, GAB, KRB, wave};
                { unsigned* acnt = (unsigned*)(ws + WS_CTL) + CW_ACNT + l * 2048;
                  const unsigned fb = att::attn_stream_phase<0, MlaMk>((LAS char*)lds, mk, vcu, G, 768, acnt, MISC + 4);
                  for (int i2 = 0; (fb >> i2) != 0u; ++i2) if ((fb >> i2) & 1u) (void)att::attn_phase<0, MlaMk, true>((LAS char*)lds, mk, vcu + i2 * G, 1 << 28, 768, acnt, MISC + 4); }
            }
        } else {
#define WS_BASE (ws + (i ? WS_W_SWA1 : WS_W_SWA0))
#define S_WinT ((const bf16*)WS_BASE)
#define S_WoT ((const bf16*)(WS_BASE + SZ_WIN_SWA))
            if (IN_PH()) { PH_BEGIN();
                const float* ck = ARG_IN(4); const float* cv = ARG_IN(5);
                for (int e = bx * 512 + tid; e < 2 * 2048 * 32; e += G * 512) {
                    const int which = e / (2048 * 32), f = e % (2048 * 32), rowi = f >> 5, ch = f & 31, b = rowi >> 8, p = rowi & 255;
                    const float* s = (which ? cv : ck) + ((size_t)(b * 2 + i) * 256 + p) * 256 + 8 * ch; const f32x4 y0 = *(const f32x4*)s, y1 = *(const f32x4*)(s + 4);
                    u32x4 o; o.x = pk2(y0[0], y0[1]); o.y = pk2(y0[2], y0[3]); o.z = pk2(y1[0], y1[1]); o.w = pk2(y1[2], y1[3]);
                    *(u32x4*)((which ? SV : SK) + (size_t)(RP + b * 2304 + 2048 + p) * 256 + 8 * ch) = o;
                }
                pg8::Gemm g{Hb, S_WinT, R, 2560, 1024, 1024}; pg8::StaticOrder S; S.init(R, 2560, G, bx);
                pg8::EpiSwaIn E{SQ, SK, SV, GAB, out + OFF_K + (size_t)i * 65536, out + OFF_V + (size_t)i * 65536, ROPE16};
                pg8::gemm_phase<pg8::EpiSwaIn, true>(lds, g, S, E);
                if (l == 1) {
                    unsigned* qt = (unsigned*)(ws + WS_CTL) + CW_QH + 80; LAS float* scr = (LAS float*)(lds + wave * 16384);
                    constexpr int NCH_MLA = (CIMLA + 7) / 8;
                    for (;;) {
                        __syncthreads();
                        if (tid == 0) MISC[0] = __hip_atomic_fetch_add(qt, 1u, __ATOMIC_RELAXED, __HIP_MEMORY_SCOPE_AGENT);
                        __syncthreads();
                        const int item = (int)MISC[0];
                        if (item >= NCH_MLA) break;
                        const int r2 = item * 8 + wave; if (r2 < CIMLA && !(r2 >= CI1 + CI2 + CI3 && r2 < CI1 + CI2 + CI3 + CI4)) conv_item(r2, 1, ws, scr, lane);
                    }
                }
            }
            END_PH();
            if (IN_PH()) { PH_BEGIN();
                struct SwaMk { bf16 *sq, *sk, *sv, *gab; const float* sink; int wave, lane;
                    __device__ __forceinline__ void operator()(int un, att::Desc& d) const {
                        d.k1 = nullptr; d.has_sink = 1; d.n_a = 4;
                        int kvh, qrow, q0;
                        if (un < 1024) { const int b = un >> 7, blk = un & 31; kvh = (un >> 5) & 3; q0 = blk * 64; const int kb = RP + b * 2304;
                            qrow = RP + b * 2048 + q0 + (wave & 1) * 32; d.row_a = kb + 2048;
                            const int kfirst = q0 - 128 > 0 ? q0 - 128 : 0, klast = q0 + 128 < 2048 - 64 ? q0 + 128 : 2048 - 64;
                            d.key_b = kfirst; d.row_b = kb + kfirst; d.n_b = (klast - kfirst) / 64 + 1; }
                        else { const int v = un - 1024, b = v >> 4, blk = v & 3; kvh = (v >> 2) & 3; q0 = blk * 64; qrow = b * 256 + q0 + (wave & 1) * 32; d.row_a = b * 256; d.n_b = 0; d.row_b = 0; d.key_b = 0; }
                        const int head = kvh * 4 + (wave >> 1);
                        d.qpos = q0 + (wave & 1) * 32 + (lane & 31); d.sink2 = sink[head] * LOG2E;
                        d.qptr = sq + (size_t)qrow * 1024 + head * 64; d.k0 = sk + kvh * 64; d.v = sv + kvh * 64; d.optr = gab + (size_t)qrow * 1024 + head * 64; d.panel = qrow >> 8; } };
                const SwaMk mk{SQ, SK, SV, GAB, ARG_IN(21) + i * 16, wave, lane};
                { unsigned* acnt = (unsigned*)(ws + WS_CTL) + CW_ACNT + l * 2048;
                  const unsigned fb = att::attn_stream_phase<1, SwaMk>((LAS char*)lds, mk, vcu, G, 1536, acnt, MISC + 4);
                  for (int i2 = 0; (fb >> i2) != 0u; ++i2) if ((fb >> i2) & 1u) (void)att::attn_phase<1, SwaMk, true>((LAS char*)lds, mk, vcu + i2 * G, 1 << 28, 1536, acnt, MISC + 4); }
            }
        }
        if (IN_PH()) { PH_BEGIN();
            unsigned* ctlw = (unsigned*)(ws + WS_CTL); unsigned* cnt = ctlw + CW_CNT + l * 2048; unsigned* qh = ctlw + CW_QH + l * 16; unsigned* tmo = ctlw + CW_TMO;
            {
                const bf16* WoT = (l & 1) ? (const bf16*)(ws + (i ? WS_W_SWA1 : WS_W_SWA0) + SZ_WIN_SWA) : (const bf16*)(ws + (i ? WS_W_MLA1 : WS_W_MLA0) + SZ_WIN_MLA + SZ_WUQ + SZ_WUKV + SZ_WPOOL);
                {
                    const unsigned need = (l & 1) ? 128u : 64u;
                    if (wave == 0) { const unsigned* acnt = ctlw + CW_ACNT + l * 2048;
                        asm volatile("buffer_inv sc1" ::: "memory");
                        for (int u = vcu; u < 384; u += G) { unsigned sp = 0;
                            while (__hip_atomic_load(acnt + 16 * (u >> 2), __ATOMIC_RELAXED, __HIP_MEMORY_SCOPE_AGENT) < need) { __builtin_amdgcn_s_sleep(2);
                                if ((++sp & 1023u) == 0u) { if (__hip_atomic_load(tmo, __ATOMIC_RELAXED, __HIP_MEMORY_SCOPE_AGENT) || sp > (1u << 22)) { __hip_atomic_store(tmo, 1u, __ATOMIC_RELAXED, __HIP_MEMORY_SCOPE_AGENT); break; } } } }
                        asm volatile("s_waitcnt vmcnt(0)" ::: "memory"); }
                    __syncthreads(); }
                pg8::Gemm g{GAB, WoT, R, 1024, 1024, 1024}; pg8::PanelOrder S{G, vcu, 384}; pg8::EpiOutPub E{Hb, cnt};
                pg8::gemm_phase<pg8::EpiOutPub, true, pg8::PanelOrder>(lds, g, S, E);
            }
            const float* xin0 = ARG_IN(0); const float* xin1 = ARG_IN(1); const bool has_next = l + 1 < NL;
            const int panel = vcu >= 128 ? (vcu - 128) >> 1 : 64 + (vcu >> 2);
            const int rbase = vcu >= 128 ? panel * 256 + ((vcu - 128) & 1) * 128 : panel * 256 + (vcu & 3) * 64;
            const int nrw = vcu >= 128 ? 16 : 8;
#define WAIT_PANEL() do { if (wave == 0) { unsigned sp = 0; asm volatile("buffer_inv sc1" ::: "memory"); \
                while (__hip_atomic_load(cnt + 16 * panel, __ATOMIC_RELAXED, __HIP_MEMORY_SCOPE_AGENT) < 32u) { __builtin_amdgcn_s_sleep(2); \
                    if ((++sp & 1023u) == 0u) { if (__hip_atomic_load(tmo, __ATOMIC_RELAXED, __HIP_MEMORY_SCOPE_AGENT) || sp > (1u << 22)) { __hip_atomic_store(tmo, 1u, __ATOMIC_RELAXED, __HIP_MEMORY_SCOPE_AGENT); break; } } } \
                asm volatile("s_waitcnt vmcnt(0)" ::: "memory"); } \
            __syncthreads(); } while (0)
            {
                const int row0 = rbase + wave * nrw, midx = mod_index(row0); const int ln = has_next ? l + 1 : l;
                const float* cf = MOD + (size_t)(l * 9 + midx) * 3072; const float* cfn = MOD + (size_t)(ln * 9 + midx) * 3072;
                f32x4 cA[4], cB[4], cC[4];
#pragma unroll
                for (int k = 0; k < 4; ++k) { const int c = 8 * lane + 512 * (k >> 1) + 4 * (k & 1); cA[k] = *(const f32x4*)(cf + c); cB[k] = *(const f32x4*)(cfn + 1024 + c); cC[k] = *(const f32x4*)(cfn + 2048 + c); }
#define FINAL_ROW(row, xv, ov) do { float ss = 0.f; \
                    _Pragma("unroll") for (int k = 0; k < 4; ++k) ss += ov[k][0] * ov[k][0] + ov[k][1] * ov[k][1] + ov[k][2] * ov[k][2] + ov[k][3] * ov[k][3]; \
                    const float rstd = 1.f / sqrtf(wave_sum(ss) * (1.f / D) + EPS); float s2 = 0.f; \
                    _Pragma("unroll") for (int k = 0; k < 4; ++k) { xv[k] = xv[k] + ov[k] * rstd * cA[k]; s2 += xv[k][0] * xv[k][0] + xv[k][1] * xv[k][1] + xv[k][2] * xv[k][2] + xv[k][3] * xv[k][3]; } \
                    if (has_next) { const float r2 = 1.f / sqrtf(wave_sum(s2) * (1.f / D) + EPS); \
                        _Pragma("unroll") for (int j2 = 0; j2 < 2; ++j2) { const f32x4 xa = xv[2 * j2], xc = xv[2 * j2 + 1]; \
                            u32x4 wx; wx.x = pk2(xa[0], xa[1]); wx.y = pk2(xa[2], xa[3]); wx.z = pk2(xc[0], xc[1]); wx.w = pk2(xc[2], xc[3]); \
                            *(u32x4*)((bf16*)out + (size_t)(row) * 2048 + 8 * lane + 512 * j2) = wx; \
                            const f32x4 ha = xa * r2 * cB[2 * j2] + cC[2 * j2], hc = xc * r2 * cB[2 * j2 + 1] + cC[2 * j2 + 1]; \
                            u32x4 wh; wh.x = pk2(ha[0], ha[1]); wh.y = pk2(ha[2], ha[3]); wh.z = pk2(hc[0], hc[1]); wh.w = pk2(hc[2], hc[3]); \
                            *(u32x4*)(Hb + (size_t)(row) * D + 8 * lane + 512 * j2) = wh; } \
                    } else { _Pragma("unroll") for (int k = 0; k < 4; ++k) *(f32x4*)(out + (size_t)(row) * D + 8 * lane + 512 * (k >> 1) + 4 * (k & 1)) = xv[k]; } } while (0)
#define UNPK(W_, LO_, HI_) do { const u32x4 t_ = (W_); LO_ = (f32x4){bflo(t_.x), bfhi(t_.x), bflo(t_.y), bfhi(t_.y)}; HI_ = (f32x4){bflo(t_.z), bfhi(t_.z), bflo(t_.w), bfhi(t_.w)}; } while (0)
                if (l == 0) {
                    WAIT_PANEL();
                    for (int rr = 0; rr < nrw; rr += 4) {
                        f32x4 xq[4][4]; u32x4 oq[4][2];
#pragma unroll
                        for (int q = 0; q < 4; ++q) { const int row = row0 + rr + q; const float* xr = row < RP ? xin0 + (size_t)row * D : xin1 + (size_t)(row - RP) * D;
#pragma unroll
                            for (int k = 0; k < 4; ++k) xq[q][k] = *(const f32x4*)(xr + 8 * lane + 512 * (k >> 1) + 4 * (k & 1));
#pragma unroll
                            for (int j2 = 0; j2 < 2; ++j2) oq[q][j2] = *(const u32x4*)(Hb + (size_t)row * D + 8 * lane + 512 * j2); }
#pragma unroll
                        for (int q = 0; q < 4; ++q) { f32x4 ov[4]; UNPK(oq[q][0], ov[0], ov[1]); UNPK(oq[q][1], ov[2], ov[3]); FINAL_ROW(row0 + rr + q, xq[q], ov); }
                    }
                } else {
                    u32x4 xw[8][2], ow[8][2];
#pragma unroll
                    for (int q = 0; q < 8; ++q)
#pragma unroll
                        for (int j2 = 0; j2 < 2; ++j2) xw[q][j2] = *(const u32x4*)((const bf16*)out + (size_t)(row0 + q) * 2048 + 8 * lane + 512 * j2);
                    WAIT_PANEL();
                    for (int rr = 0; rr < nrw; rr += 8) {
                        if (rr > 0) {
#pragma unroll
                            for (int q = 0; q < 8; ++q)
#pragma unroll
                                for (int j2 = 0; j2 < 2; ++j2) xw[q][j2] = *(const u32x4*)((const bf16*)out + (size_t)(row0 + rr + q) * 2048 + 8 * lane + 512 * j2);
                        }
#pragma unroll
                        for (int q = 0; q < 8; ++q)
#pragma unroll
                            for (int j2 = 0; j2 < 2; ++j2) ow[q][j2] = *(const u32x4*)(Hb + (size_t)(row0 + rr + q) * D + 8 * lane + 512 * j2);
#pragma unroll
                        for (int q = 0; q < 8; ++q) { f32x4 xv[4], ov[4]; UNPK(xw[q][0], xv[0], xv[1]); UNPK(xw[q][1], xv[2], xv[3]); UNPK(ow[q][0], ov[0], ov[1]); UNPK(ow[q][1], ov[2], ov[3]); FINAL_ROW(row0 + rr + q, xv, ov); }
                    }
                }
#undef FINAL_ROW
#undef UNPK
#undef WAIT_PANEL
            }
        }
        END_PH();
    }
#undef IN_PH
#undef END_PH
}


extern "C" void kernel_launch(void* const* d_in, const int* in_sizes, int n_in, void* d_out, int out_size, void* d_ws, size_t ws_size, hipStream_t stream) {
    static int grid = 0;
    if (grid == 0) {
        if (n_in != 23 || out_size != OUT_TOTAL || ws_size < WS_END) { fprintf(stderr, "kernel_launch: unexpected shapes (n_in %d out %d ws %zu)\n", n_in, out_size, ws_size); grid = -1; return; }
        int dev = 0, cus = 0;
        if (hipGetDevice(&dev) != hipSuccess || hipDeviceGetAttribute(&cus, hipDeviceAttributeMultiprocessorCount, dev) != hipSuccess) { grid = -1; return; }
        if (hipFuncSetAttribute((const void*)fwd_kernel, hipFuncAttributeMaxDynamicSharedMemorySize, LDS_BYTES) != hipSuccess) { fprintf(stderr, "kernel_launch: hipFuncSetAttribute failed\n"); grid = -1; return; }
        int per_cu = 0;
        if (hipOccupancyMaxActiveBlocksPerMultiprocessor(&per_cu, (const void*)fwd_kernel, NWAVES * 64, LDS_BYTES) != hipSuccess || per_cu < 1) { fprintf(stderr, "kernel_launch: occupancy query says %d\n", per_cu); }
        (void)hipGetLastError();
        grid = cus;
    }
    if (grid < 0) return;
    (void)hipMemsetAsync((char*)d_ws + WS_CTL, 0, CTL_ZERO_BYTES, stream);
    Args a{};
    for (int i = 0; i < 23; ++i) a.in[i] = (const float*)d_in[i];
    a.out = (float*)d_out; a.ws = (unsigned char*)d_ws;
#if MK_PER_PHASE
    for (int p = 0; p < N_PHASES; ++p) { a.ph_lo = p; a.ph_hi = p + 1; hipLaunchKernelGGL(fwd_kernel, dim3(grid), dim3(NWAVES * 64), LDS_BYTES, stream, a); }
#else
    a.ph_lo = 0; a.ph_hi = N_PHASES;
    hipLaunchKernelGGL(fwd_kernel, dim3(grid), dim3(NWAVES * 64), LDS_BYTES, stream, a);
#endif
}
```
